# Optimizing an MI355X kernel written in HIP

```python
import math
import jax, jax.numpy as jnp
from jax import lax
import numpy as np

D_MODEL = 2048
BATCH = 2
SEQ = 4096
DEPTH = 1

MEM_LEN = 256
ATT_HEADS = 8
HEAD_DIM = 128
ATT_WIDTH = ATT_HEADS * HEAD_DIM
IDX_HEADS = 16
IDX_DIM = 64
TOPK_MAX = 256
Q_BLOCK = 128
POOL_WINDOWS = (2, 4, 8, 16)
N_POOL = len(POOL_WINDOWS)
POOL_GROUP = 128
POOL_WIDTH = N_POOL * POOL_GROUP
MEM_HEADS = 4
MEM_WIDTH = MEM_HEADS * HEAD_DIM
N_BRANCH = 3
D_FF = 5632
ALPHA = (2 * DEPTH) ** 0.25
BETA = (8 * DEPTH) ** -0.25
LN_EPS = 1e-5
SPLIT_SIZES = (ATT_WIDTH, ATT_WIDTH, ATT_WIDTH, IDX_HEADS * IDX_DIM, IDX_DIM, IDX_HEADS, POOL_WIDTH, MEM_WIDTH, N_BRANCH * D_MODEL)
SPLIT_IDX = tuple(int(v) for v in np.cumsum(SPLIT_SIZES)[:-1])
D_IN = int(sum(SPLIT_SIZES))

kernel_name = "hybrid_dsa_pool_mem_macaron_deepnorm"

f32 = jnp.float32


def layer_norm(x, g, b):
    x32 = x.astype(f32)
    mu = jnp.mean(x32, axis=-1, keepdims=True)
    var = jnp.mean(jnp.square(x32 - mu), axis=-1, keepdims=True)
    y = (x32 - mu) * lax.rsqrt(var + LN_EPS) * g.astype(f32) + b.astype(f32)
    return y.astype(x.dtype)


def swiglu(x, w_up, w_down):
    a, u = jnp.split(x @ w_up, 2, axis=-1)
    return (jax.nn.silu(a) * u) @ w_down


def alibi_slopes(n):
    return jnp.exp2(-8.0 * jnp.arange(1, n + 1, dtype=f32) / n)


def dsa_attention(q, k, v, q_idx, k_idx, w_idx):
    B, S = q.shape[0], q.shape[1]
    topk = min(TOPK_MAX, S // 4)
    nb = S // Q_BLOCK
    slopes = alibi_slopes(ATT_HEADS)
    key_pos = jnp.arange(S, dtype=jnp.int32)
    scale = HEAD_DIM ** -0.5

    def blockify(a):
        return a.reshape((B, nb, Q_BLOCK) + a.shape[2:]).swapaxes(0, 1)

    def one_block(args):
        qb, qib, wb, start = args
        q_pos = start + jnp.arange(Q_BLOCK, dtype=jnp.int32)
        causal = key_pos[None, :] <= q_pos[:, None]
        logits = jnp.einsum('bqhd,bsd->bqhs', qib, k_idx, preferred_element_type=f32) * (IDX_DIM ** -0.5)
        wts = wb.astype(f32) * (IDX_HEADS ** -0.5)
        score = jnp.einsum('bqh,bqhs->bqs', wts, jax.nn.relu(logits))
        score = jnp.where(causal[None], score, -jnp.inf)
        _, sel = lax.top_k(score, topk)
        valid = sel <= q_pos[None, :, None]
        k_sel = jax.vmap(lambda a, i: a[i])(k, sel)
        v_sel = jax.vmap(lambda a, i: a[i])(v, sel)
        s = jnp.einsum('bqhd,bqkhd->bqhk', qb, k_sel, preferred_element_type=f32) * scale
        dist = (q_pos[None, :, None] - sel).astype(f32)
        s = s - slopes[None, None, :, None] * dist[:, :, None, :]
        s = jnp.where(valid[:, :, None, :], s, -jnp.inf)
        p = jax.nn.softmax(s, axis=-1).astype(v.dtype)
        return jnp.einsum('bqhk,bqkhd->bqhd', p, v_sel)

    starts = jnp.arange(nb, dtype=jnp.int32) * Q_BLOCK
    out = lax.map(one_block, (blockify(q), blockify(q_idx), blockify(w_idx), starts))
    return out.swapaxes(0, 1).reshape(B, S, ATT_HEADS * HEAD_DIM)


def multiscale_pool(u, w_pool, pool_scale):
    B, S, _ = u.shape
    ug = u.reshape(B, S, N_POOL, POOL_GROUP).astype(f32)
    c = jnp.pad(jnp.cumsum(ug, axis=1), ((0, 0), (1, 0), (0, 0), (0, 0)))
    t = jnp.arange(S)
    outs = []
    for g, w in enumerate(POOL_WINDOWS):
        lo = jnp.maximum(t - w + 1, 0)
        cnt = (t - lo + 1).astype(f32)
        mean = (c[:, t + 1, g] - c[:, lo, g]) / cnt[None, :, None]
        outs.append(mean - ug[:, :, g])
    pooled = jnp.stack(outs, axis=2).astype(u.dtype)
    mixed = jnp.einsum('bsgc,gcd->bsgd', pooled, w_pool)
    return mixed.reshape(B, S, POOL_WIDTH) * pool_scale


def memory_attention(qm, mem, w_mem_kv):
    B, S = qm.shape[0], qm.shape[1]
    kv = (mem @ w_mem_kv).reshape(B, mem.shape[1], 2, MEM_HEADS, HEAD_DIM)
    km, vm = kv[:, :, 0], kv[:, :, 1]
    s = jnp.einsum('bqhd,bmhd->bhqm', qm, km, preferred_element_type=f32) * (HEAD_DIM ** -0.5)
    p = jax.nn.softmax(s, axis=-1).astype(vm.dtype)
    return jnp.einsum('bhqm,bmhd->bqhd', p, vm).reshape(B, S, MEM_WIDTH)


def token_mix(h, mem, w_in, b_gate, w_mem_kv, w_pool, pool_scale, w_br_att, w_br_pool, w_br_mem, w_out):
    B, S, D = h.shape
    z = h @ w_in
    q, k, v, qi, ki, wi, u, qm, gl = jnp.split(z, SPLIT_IDX, axis=-1)
    hd = (B, S, ATT_HEADS, HEAD_DIM)
    a = dsa_attention(q.reshape(hd), k.reshape(hd), v.reshape(hd), qi.reshape(B, S, IDX_HEADS, IDX_DIM), ki, wi)
    p = multiscale_pool(u, w_pool, pool_scale)
    m = memory_attention(qm.reshape(B, S, MEM_HEADS, HEAD_DIM), mem, w_mem_kv)
    gates = jax.nn.sigmoid((gl + b_gate).astype(f32)).astype(h.dtype).reshape(B, S, N_BRANCH, D)
    y = gates[:, :, 0] * (a @ w_br_att) + gates[:, :, 1] * (p @ w_br_pool) + gates[:, :, 2] * (m @ w_br_mem)
    return y @ w_out


def setup_inputs(seed: int = 0) -> dict:
    key = jax.random.key(seed)
    ks = jax.random.split(key, 21)
    L, D = DEPTH, D_MODEL

    def n(k, shape, scale):
        return jax.random.normal(k, shape, jnp.float32) * scale

    return {
        "x": n(ks[0], (BATCH, SEQ, D), 1.0),
        "mem": n(ks[1], (BATCH, MEM_LEN, D), 1.0),
        "w_ffn1_up": n(ks[2], (L, D, 2 * D_FF), D ** -0.5),
        "w_ffn1_down": n(ks[3], (L, D_FF, D), BETA * D_FF ** -0.5),
        "ln1_g": 1.0 + n(ks[4], (L, D), 0.02),
        "ln1_b": n(ks[5], (L, D), 0.02),
        "w_in": n(ks[6], (L, D, D_IN), D ** -0.5),
        "b_gate": n(ks[7], (L, N_BRANCH * D), 0.1),
        "w_mem_kv": n(ks[8], (L, D, 2 * MEM_WIDTH), D ** -0.5),
        "w_pool": n(ks[9], (L, N_POOL, POOL_GROUP, POOL_GROUP), POOL_GROUP ** -0.5),
        "pool_scale": 1.0 + n(ks[10], (L, POOL_WIDTH), 0.02),
        "w_br_att": n(ks[11], (L, ATT_WIDTH, D), ATT_WIDTH ** -0.5),
        "w_br_pool": n(ks[12], (L, POOL_WIDTH, D), POOL_WIDTH ** -0.5),
        "w_br_mem": n(ks[13], (L, MEM_WIDTH, D), MEM_WIDTH ** -0.5),
        "w_out": n(ks[14], (L, D, D), BETA * D ** -0.5),
        "ln2_g": 1.0 + n(ks[15], (L, D), 0.02),
        "ln2_b": n(ks[16], (L, D), 0.02),
        "w_ffn2_up": n(ks[17], (L, D, 2 * D_FF), D ** -0.5),
        "w_ffn2_down": n(ks[18], (L, D_FF, D), BETA * D_FF ** -0.5),
        "ln3_g": 1.0 + n(ks[19], (L, D), 0.02),
        "ln3_b": n(ks[20], (L, D), 0.02),
    }


def reference(x, mem, w_ffn1_up, w_ffn1_down, ln1_g, ln1_b, w_in, b_gate, w_mem_kv, w_pool, pool_scale, w_br_att, w_br_pool, w_br_mem, w_out, ln2_g, ln2_b, w_ffn2_up, w_ffn2_down, ln3_g, ln3_b):
    h = x
    for l in range(DEPTH):
        h = layer_norm(ALPHA * h + 0.5 * swiglu(h, w_ffn1_up[l], w_ffn1_down[l]), ln1_g[l], ln1_b[l])
        mix = token_mix(h, mem, w_in[l], b_gate[l], w_mem_kv[l], w_pool[l], pool_scale[l], w_br_att[l], w_br_pool[l], w_br_mem[l], w_out[l])
        h = layer_norm(ALPHA * h + mix, ln2_g[l], ln2_b[l])
        h = layer_norm(ALPHA * h + 0.5 * swiglu(h, w_ffn2_up[l], w_ffn2_down[l]), ln3_g[l], ln3_b[l])
    return h
```

```cpp
#include <hip/hip_runtime.h>
#include <hip/hip_bf16.h>
#include <cstdio>
#include <cstdint>

#ifndef MK_PER_PHASE
#define MK_PER_PHASE 1
#endif

namespace pg8 {
#define PG8_LAS __attribute__((address_space(3)))
typedef unsigned short bf16_t;
typedef short bf16x8 __attribute__((ext_vector_type(8)));
typedef float f32x4 __attribute__((ext_vector_type(4)));
typedef float f32x2 __attribute__((ext_vector_type(2)));
typedef unsigned u32x4 __attribute__((ext_vector_type(4)));
typedef unsigned u32x2 __attribute__((ext_vector_type(2)));
constexpr int BM = 256, BK = 64, HALF = 128, HTB = HALF * BK * 2, STAGE_BYTES = 8 * HTB, NXCD = 8, WGM = 8;

__host__ __device__ __forceinline__ int lds_byte(int r, int c) { const int st = (r >> 4) * 2 + (c >> 5), rr = r & 15, cc = c & 31, ob = rr * 64 + cc * 2; return st * 1024 + (ob ^ (((ob >> 9) & 1) << 5)); }
__host__ __device__ __forceinline__ void stage_rc(int b, int& R, int& C) { const int st = b / 1024, sb = b % 1024, swz = sb ^ (((sb >> 9) & 1) << 5); R = (st >> 1) * 16 + swz / 64; C = (st & 1) * 32 + (swz % 64) / 2; }
__host__ __device__ __forceinline__ int perm32(int rho) { const int n = rho >> 4, i = rho & 15; return 8 * (i >> 2) + 4 * n + (i & 3); }

struct Unit { int pm, pn; };
struct Gemm { const bf16_t* A; const bf16_t* Bt; int M, N, K; };

struct StaticOrder {
    int nM, nN, nwg, G, c;
    __host__ __device__ void init(int M, int N, int G_, int c_) { nM = M / BM; nN = N / BM; nwg = nM * nN; G = G_; c = c_; }
    __host__ __device__ bool next(int i, Unit& u) const {
        const long L = (long)i * G + c; if (L >= nwg) return false;
        int wgid = (int)L; { const int q = nwg / NXCD, r = nwg % NXCD, xcd = wgid % NXCD, off = wgid / NXCD; wgid = (xcd < r ? xcd * (q + 1) : r * (q + 1) + (xcd - r) * q) + off; }
        const int nig = WGM * nN, gid = wgid / nig, fm = gid * WGM, gsz = (nM - fm) < WGM ? (nM - fm) : WGM;
        u.pm = fm + ((wgid % nig) % gsz); u.pn = (wgid % nig) / gsz; return true;
    }
    __device__ __forceinline__ void a_ready(const Unit&) const {}
    __device__ __forceinline__ void done(const Unit&) const {}
};
struct OrderZ {
    StaticOrder so;
    __device__ __forceinline__ bool next(int i, Unit& u) const {
        const long L = (long)i * so.G + so.c;
        if (L < so.nwg) return so.next(i, u);
        if (L < so.nwg + 8) { const int e = (int)(L - so.nwg); u.pm = 32 + (e >> 2); u.pn = 45 + (e & 3); return true; }
        return false;
    }
    __device__ __forceinline__ void a_ready(const Unit&) const {}
    __device__ __forceinline__ void done(const Unit&) const {}
};

__device__ __forceinline__ unsigned cvt_pk_bf16(float lo, float hi) { unsigned r; asm volatile("v_cvt_pk_bf16_f32 %0, %1, %2" : "=v"(r) : "v"(lo), "v"(hi)); return r; }
__device__ __forceinline__ float bf_lo(unsigned w) { return __uint_as_float(w << 16); }
__device__ __forceinline__ float bf_hi(unsigned w) { return __uint_as_float(w & 0xffff0000u); }
__device__ __forceinline__ float sigmoidf_(float x) { return __builtin_amdgcn_rcpf(1.0f + __builtin_amdgcn_exp2f(-1.4426950408889634f * x)); }

struct EpiSwiglu {
    static constexpr bool PERM = true, AFTER_DRAIN = false;
    bf16_t* G; int ldg;
    __device__ __forceinline__ void operator()(const f32x4 (&acc)[2][2][4][2], const Unit& u, int wr, int wc, int fr, int fq) const {
        const int row0 = u.pm * BM + wr * 64 + fr, col0 = u.pn * HALF + wc * 32 + 8 * fq;
#pragma unroll
        for (int ai = 0; ai < 2; ++ai)
#pragma unroll
            for (int m = 0; m < 4; ++m) {
                bf16_t* rowp = G + (size_t)(row0 + ai * HALF + m * 16) * ldg + col0;
                float g[8];
#pragma unroll
                for (int n = 0; n < 2; ++n)
#pragma unroll
                    for (int e = 0; e < 4; ++e) { const float a = acc[ai][0][m][n][e], uu = acc[ai][1][m][n][e]; g[n * 4 + e] = a * uu * sigmoidf_(a); }
                u32x4 w; w.x = cvt_pk_bf16(g[0], g[1]); w.y = cvt_pk_bf16(g[2], g[3]); w.z = cvt_pk_bf16(g[4], g[5]); w.w = cvt_pk_bf16(g[6], g[7]);
                *(u32x4*)rowp = w;
            }
    }
};
template <bool RESBF> struct EpiRes {
    static constexpr bool PERM = false, AFTER_DRAIN = false;
    float* out; const void* res; int ldc; float alpha, sc;
    __device__ __forceinline__ void operator()(const f32x4 (&acc)[2][2][4][2], const Unit& u, int wr, int wc, int fr, int fq) const {
        const int row0 = u.pm * BM + wr * 64 + fr, col0 = u.pn * BM + wc * 32 + 4 * fq;
#pragma unroll
        for (int ai = 0; ai < 2; ++ai)
#pragma unroll
            for (int m = 0; m < 4; ++m) { const size_t off = (size_t)(row0 + ai * HALF + m * 16) * ldc + col0;
#pragma unroll
                for (int bj = 0; bj < 2; ++bj)
#pragma unroll
                    for (int n = 0; n < 2; ++n) { const size_t o = off + bj * HALF + n * 16; f32x4 r;
                        if (RESBF) { const u32x2 w = *(const u32x2*)((const bf16_t*)res + o); r = (f32x4){bf_lo(w.x), bf_hi(w.x), bf_lo(w.y), bf_hi(w.y)}; }
                        else r = *(const f32x4*)((const float*)res + o);
                        *(f32x4*)(out + o) = r * alpha + acc[ai][bj][m][n] * sc; } }
    }
};
template <int PASS> struct EpiBranch {
    static constexpr bool PERM = false, AFTER_DRAIN = false;
    float* Y; bf16_t* Y16; const bf16_t* gate;
    __device__ __forceinline__ void operator()(const f32x4 (&acc)[2][2][4][2], const Unit& u, int wr, int wc, int fr, int fq) const {
        const int row0 = u.pm * BM + wr * 64 + fr, col0 = u.pn * BM + wc * 32 + 4 * fq;
#pragma unroll
        for (int ai = 0; ai < 2; ++ai)
#pragma unroll
            for (int m = 0; m < 4; ++m) { const size_t row = (size_t)(row0 + ai * HALF + m * 16);
#pragma unroll
                for (int bj = 0; bj < 2; ++bj)
#pragma unroll
                    for (int n = 0; n < 2; ++n) { const int col = col0 + bj * HALF + n * 16;
                        const u32x2 w = *(const u32x2*)(gate + row * 6144 + PASS * 2048 + col);
                        f32x4 v = acc[ai][bj][m][n] * (f32x4){bf_lo(w.x), bf_hi(w.x), bf_lo(w.y), bf_hi(w.y)};
                        if (PASS > 0) v += *(const f32x4*)(Y + row * 2048 + col);
                        if (PASS < 2) *(f32x4*)(Y + row * 2048 + col) = v;
                        else { u32x2 o; o.x = cvt_pk_bf16(v[0], v[1]); o.y = cvt_pk_bf16(v[2], v[3]); *(u32x2*)(Y16 + row * 2048 + col) = o; } } }
    }
};
struct EpiZ {
    static constexpr bool PERM = true, AFTER_DRAIN = false;
    bf16_t *Q, *K, *V, *QI, *KI, *U, *QM, *GATE, *KM, *VM; float* WI; const float* bgate;
    __device__ __forceinline__ void operator()(const f32x4 (&acc)[2][2][4][2], const Unit& u, int wr, int wc, int fr, int fq) const {
        const int pn = u.pn;
        bf16_t* base; int ld, ct = 0, mode = 0, rowoff = 0;
        if (pn < 4) { base = Q; ld = 1024; ct = pn; }
        else if (pn < 8) { base = K; ld = 1024; ct = pn - 4; }
        else if (pn < 12) { base = V; ld = 1024; ct = pn - 8; }
        else if (pn < 16) { base = QI; ld = 1024; ct = pn - 12; }
        else if (pn == 16) { base = KI; ld = 64; mode = 2; }
        else if (pn < 19) { base = U; ld = 512; ct = pn - 17; }
        else if (pn < 21) { base = QM; ld = 512; ct = pn - 19; }
        else if (pn < 45) { base = GATE; ld = 6144; ct = pn - 21; mode = 1; }
        else if (pn < 47) { base = KM; ld = 512; ct = pn - 45; rowoff = 8192; }
        else { base = VM; ld = 512; ct = pn - 47; rowoff = 8192; }
        const int row0 = u.pm * BM + wr * 64 + fr - rowoff, cl = wc * 32 + 8 * fq;
        if (mode == 2) {
#pragma unroll
            for (int ai = 0; ai < 2; ++ai)
#pragma unroll
                for (int m = 0; m < 4; ++m) { const size_t row = (size_t)(row0 + ai * HALF + m * 16);
                    const f32x4 v0 = acc[ai][0][m][0], v1 = acc[ai][0][m][1];
                    if (cl < 64) { u32x4 w; w.x = cvt_pk_bf16(v0[0], v0[1]); w.y = cvt_pk_bf16(v0[2], v0[3]); w.z = cvt_pk_bf16(v1[0], v1[1]); w.w = cvt_pk_bf16(v1[2], v1[3]); *(u32x4*)(KI + row * 64 + cl) = w; }
                    else if (cl < 80) { const float s = 1.0f / 32.0f;
                        *(f32x4*)(WI + row * 16 + (cl - 64)) = v0 * s; *(f32x4*)(WI + row * 16 + (cl - 64) + 4) = v1 * s; } }
            return;
        }
        const int col0 = ct * BM + cl;
        f32x4 bv[2][2];
#pragma unroll
        for (int bj = 0; bj < 2; ++bj)
#pragma unroll
            for (int n = 0; n < 2; ++n) bv[bj][n] = (mode == 1) ? *(const f32x4*)(bgate + col0 + bj * HALF + 4 * n) : (f32x4){0.f, 0.f, 0.f, 0.f};
#pragma unroll
        for (int ai = 0; ai < 2; ++ai)
#pragma unroll
            for (int m = 0; m < 4; ++m) { bf16_t* rowp = base + (size_t)(row0 + ai * HALF + m * 16) * ld + col0;
#pragma unroll
                for (int bj = 0; bj < 2; ++bj) { f32x4 v0 = acc[ai][bj][m][0], v1 = acc[ai][bj][m][1];
                    if (mode == 1) { v0 += bv[bj][0]; v1 += bv[bj][1];
#pragma unroll
                        for (int e = 0; e < 4; ++e) { v0[e] = sigmoidf_(v0[e]); v1[e] = sigmoidf_(v1[e]); } }
                    u32x4 w; w.x = cvt_pk_bf16(v0[0], v0[1]); w.y = cvt_pk_bf16(v0[2], v0[3]); w.z = cvt_pk_bf16(v1[0], v1[1]); w.w = cvt_pk_bf16(v1[2], v1[3]);
                    *(u32x4*)(rowp + bj * HALF) = w; } }
    }
};

template <class Epi, class Sched, bool ALIGN_EPI = false, bool SP2 = false>
__device__ __forceinline__ void gemm_phase(PG8_LAS unsigned char* lds, const Gemm g, const Sched& S, const Epi& E) {
    const int tid = threadIdx.x, wid = __builtin_amdgcn_readfirstlane(tid >> 6), lane = tid & 63, wr = wid >> 2, wc = wid & 3, fr = lane & 15, fq = lane >> 4;
    const int K = g.K, nt = K / BK;
    unsigned voffA[2], voffB[2];
#pragma unroll
    for (int i = 0; i < 2; ++i) { int R, C; stage_rc(tid * 16 + i * 8192, R, C); const int Rb = Epi::PERM ? ((R & ~31) + perm32(R & 31)) : R;
        voffA[i] = (unsigned)(R * K + C) * 2u; voffB[i] = (unsigned)(Rb * K + C) * 2u; }
    const size_t kstep = (size_t)(BK * 2);
    const size_t hstep = (size_t)HALF * K * 2;
    const size_t tstep = 2 * hstep;
    const unsigned ldsw = (unsigned)wid * 1024u;
    const int aoff = lds_byte(wr * 64 + fr, fq * 8), boff = lds_byte(wc * 32 + fr, fq * 8);
#define PG8_SA(b, h) (((b) * 2 + (h)) * HTB)
#define PG8_SB(b, h) ((4 + (b) * 2 + (h)) * HTB)
#define PG8_STAGE(bufoff, gbase, voff) do { _Pragma("unroll") for (int _i = 0; _i < 2; ++_i) \
        __builtin_amdgcn_global_load_lds((const unsigned*)((const char*)(gbase) + (voff)[_i]), (PG8_LAS unsigned*)(lds + (bufoff) + ldsw + _i * 8192), 16, 0, 0); } while (0)
#define PG8_LDA(dst, b, h) do { _Pragma("unroll") for (int m = 0; m < 4; ++m) _Pragma("unroll") for (int k = 0; k < 2; ++k) dst[m][k] = *(const PG8_LAS bf16x8*)(lds + PG8_SA(b, h) + aoff + m * 2048 + k * 1024); } while (0)
#define PG8_LDB(dst, b, h) do { _Pragma("unroll") for (int n = 0; n < 2; ++n) _Pragma("unroll") for (int k = 0; k < 2; ++k) dst[n][k] = *(const PG8_LAS bf16x8*)(lds + PG8_SB(b, h) + boff + n * 2048 + k * 1024); } while (0)
#define PG8_MMA(ai, bj, At, Bt) do { __builtin_amdgcn_s_setprio(1); _Pragma("unroll") for (int m = 0; m < 4; ++m) _Pragma("unroll") for (int n = 0; n < 2; ++n) _Pragma("unroll") for (int k = 0; k < 2; ++k) \
        acc[ai][bj][m][n] = __builtin_amdgcn_mfma_f32_16x16x32_bf16(Bt[n][k], At[m][k], acc[ai][bj][m][n], 0, 0, 0); __builtin_amdgcn_s_setprio(0); } while (0)
#define PG8_WAIT_V(n) asm volatile("s_waitcnt vmcnt(" #n ")" ::: "memory")
#define PG8_WAIT_L(n) asm volatile("s_waitcnt lgkmcnt(" #n ")" ::: "memory")
#define PG8_BAR __builtin_amdgcn_s_barrier()
#define PG8_SCHED __builtin_amdgcn_sched_barrier(0)
    Unit cur, nxt; int ui = 0;
    if (!S.next(0, cur)) return;
    f32x4 acc[2][2][4][2];
#pragma unroll
    for (int a = 0; a < 2; ++a)
#pragma unroll
        for (int b = 0; b < 2; ++b)
#pragma unroll
            for (int m = 0; m < 4; ++m)
#pragma unroll
                for (int n = 0; n < 2; ++n) acc[a][b][m][n] = (f32x4){0.f, 0.f, 0.f, 0.f};
    bf16x8 At[4][2], B0[2][2], B1[2][2];
    const char* cA = (const char*)g.A + (size_t)cur.pm * tstep; const char* cB = (const char*)g.Bt + (size_t)cur.pn * tstep;
    S.a_ready(cur);
    if constexpr (SP2) {
        PG8_STAGE(PG8_SB(0, 0), cB, voffB); PG8_STAGE(PG8_SB(0, 1), cB + hstep, voffB); PG8_STAGE(PG8_SA(0, 0), cA, voffA); PG8_STAGE(PG8_SA(0, 1), cA + hstep, voffA);
        if (wr == 1) PG8_BAR;
        PG8_WAIT_V(2); PG8_BAR;
        PG8_STAGE(PG8_SB(1, 0), cB + kstep, voffB); PG8_STAGE(PG8_SA(1, 0), cA + kstep, voffA); PG8_STAGE(PG8_SB(1, 1), cB + hstep + kstep, voffB);
        PG8_WAIT_V(6); PG8_BAR;
    } else {
        PG8_STAGE(PG8_SB(0, 0), cB, voffB); PG8_STAGE(PG8_SA(0, 0), cA, voffA); PG8_STAGE(PG8_SB(0, 1), cB + hstep, voffB); PG8_STAGE(PG8_SA(0, 1), cA + hstep, voffA);
        if (wr == 1) PG8_BAR;
        PG8_WAIT_V(4); PG8_BAR;
        PG8_STAGE(PG8_SB(1, 0), cB + kstep, voffB); PG8_STAGE(PG8_SA(1, 0), cA + kstep, voffA); PG8_STAGE(PG8_SB(1, 1), cB + hstep + kstep, voffB);
        PG8_WAIT_V(6); PG8_BAR;
    }
    for (;;) {
        const bool has_next = S.next(ui + 1, nxt);
        const char* nA = has_next ? (const char*)g.A + (size_t)nxt.pm * tstep : cA; const char* nB = has_next ? (const char*)g.Bt + (size_t)nxt.pn * tstep : cB;
        for (int t = 0; t < nt; t += 2) {
            const bool last = (t == nt - 2);
            const char* a1 = cA + (size_t)(t + 1) * kstep;
            const char* a2 = last ? nA : cA + (size_t)(t + 2) * kstep; const char* b2 = last ? nB : cB + (size_t)(t + 2) * kstep;
            const char* a3 = a2 + kstep; const char* b3 = b2 + kstep;
            if (last && has_next) S.a_ready(nxt);
            if constexpr (SP2) {
            PG8_LDB(B0, 0, 0); PG8_LDB(B1, 0, 1); PG8_SCHED; PG8_LDA(At, 0, 0); PG8_STAGE(PG8_SA(1, 1), a1 + hstep, voffA);
            PG8_WAIT_V(8); PG8_WAIT_L(0); PG8_BAR; PG8_MMA(0, 0, At, B0); PG8_MMA(0, 1, At, B1); PG8_BAR; PG8_SCHED;
            PG8_LDA(At, 0, 1); PG8_STAGE(PG8_SB(0, 0), b2, voffB); PG8_STAGE(PG8_SB(0, 1), b2 + hstep, voffB); PG8_STAGE(PG8_SA(0, 0), a2, voffA);
            PG8_WAIT_V(8); PG8_WAIT_L(0); PG8_BAR; PG8_MMA(1, 0, At, B0); PG8_MMA(1, 1, At, B1); PG8_BAR; PG8_SCHED;
            PG8_LDB(B0, 1, 0); PG8_LDB(B1, 1, 1); PG8_SCHED; PG8_LDA(At, 1, 0); PG8_STAGE(PG8_SA(0, 1), a2 + hstep, voffA);
            PG8_WAIT_V(8); PG8_WAIT_L(0); PG8_BAR; PG8_MMA(0, 0, At, B0); PG8_MMA(0, 1, At, B1); PG8_BAR; PG8_SCHED;
            PG8_LDA(At, 1, 1); PG8_STAGE(PG8_SB(1, 0), b3, voffB); PG8_STAGE(PG8_SB(1, 1), b3 + hstep, voffB); PG8_STAGE(PG8_SA(1, 0), a3, voffA);
            PG8_WAIT_V(8); PG8_WAIT_L(0); PG8_BAR; PG8_MMA(1, 0, At, B0); PG8_MMA(1, 1, At, B1); PG8_BAR; PG8_SCHED;
            } else {
            PG8_LDB(B0, 0, 0); PG8_SCHED; PG8_LDA(At, 0, 0); PG8_STAGE(PG8_SA(1, 1), a1 + hstep, voffA);
            PG8_WAIT_L(8); PG8_BAR; PG8_WAIT_L(0); PG8_MMA(0, 0, At, B0); PG8_BAR; PG8_SCHED;
            PG8_LDB(B1, 0, 1); PG8_STAGE(PG8_SB(0, 0), b2, voffB);
            PG8_BAR; PG8_WAIT_L(0); PG8_MMA(0, 1, At, B1); PG8_BAR;
            PG8_LDA(At, 0, 1); PG8_STAGE(PG8_SA(0, 0), a2, voffA);
            PG8_BAR; PG8_WAIT_L(0); PG8_MMA(1, 0, At, B0); PG8_BAR; PG8_SCHED;
            PG8_STAGE(PG8_SB(0, 1), b2 + hstep, voffB);
            PG8_WAIT_V(6); PG8_BAR; PG8_MMA(1, 1, At, B1); PG8_BAR;
            PG8_LDB(B0, 1, 0); PG8_SCHED; PG8_LDA(At, 1, 0); PG8_STAGE(PG8_SA(0, 1), a2 + hstep, voffA);
            PG8_WAIT_L(8); PG8_BAR; PG8_WAIT_L(0); PG8_MMA(0, 0, At, B0); PG8_BAR; PG8_SCHED;
            PG8_LDB(B1, 1, 1); PG8_STAGE(PG8_SB(1, 0), b3, voffB);
            PG8_BAR; PG8_WAIT_L(0); PG8_MMA(0, 1, At, B1); PG8_BAR;
            PG8_LDA(At, 1, 1); PG8_STAGE(PG8_SA(1, 0), a3, voffA);
            PG8_BAR; PG8_WAIT_L(0); PG8_MMA(1, 0, At, B0); PG8_BAR; PG8_SCHED;
            PG8_STAGE(PG8_SB(1, 1), b3 + hstep, voffB);
            PG8_WAIT_V(6); PG8_BAR; PG8_MMA(1, 1, At, B1); PG8_BAR;
            }
        }
        if constexpr (ALIGN_EPI) { if (wr == 0) PG8_BAR; }
        if constexpr (!Epi::AFTER_DRAIN) { E(acc, cur, wr, wc, fr, fq); S.done(cur); }
        if (!has_next) break;
#pragma unroll
        for (int a = 0; a < 2; ++a)
#pragma unroll
            for (int b = 0; b < 2; ++b)
#pragma unroll
                for (int m = 0; m < 4; ++m)
#pragma unroll
                    for (int n = 0; n < 2; ++n) acc[a][b][m][n] = (f32x4){0.f, 0.f, 0.f, 0.f};
        cur = nxt; cA = nA; cB = nB; ++ui;
        if constexpr (ALIGN_EPI) { if (wr == 1) PG8_BAR; }
    }
    PG8_WAIT_V(0);
    if constexpr (!ALIGN_EPI) { if (wr == 0) PG8_BAR; }
    PG8_BAR;
#undef PG8_SA
#undef PG8_SB
#undef PG8_STAGE
#undef PG8_LDA
#undef PG8_LDB
#undef PG8_MMA
#undef PG8_WAIT_V
#undef PG8_WAIT_L
#undef PG8_BAR
#undef PG8_SCHED
}
}

namespace att {
using bf16 = __hip_bfloat16;
typedef short bf16x8 __attribute__((ext_vector_type(8)));
typedef short s16x4 __attribute__((ext_vector_type(4)));
typedef float f32x16 __attribute__((ext_vector_type(16)));
typedef float f32x4 __attribute__((ext_vector_type(4)));
typedef unsigned u32x4 __attribute__((ext_vector_type(4)));
typedef unsigned u32x2 __attribute__((ext_vector_type(2)));
constexpr int D = 128;
constexpr float SCALE = 0.08838834764831845f;
constexpr float THR = 8.f;
constexpr int NW = 8, QBLK = 32, KVBLK = 64, QB = NW * QBLK;
constexpr int SHM_V = KVBLK * D * 2, SHM_K = KVBLK * D * 2;
constexpr int LDS_BYTES = 2 * SHM_V + 2 * SHM_K + NW * 64 * 4;
#define KSWZ(row, colB) ((row) * 256 + ((colB) ^ (((row) & 7) << 4)))
#define SBAR() __builtin_amdgcn_sched_barrier(0)
__device__ __forceinline__ int v_st(int k, int c) { const int kk = (k & ~0xC) | ((k & 4) << 1) | ((k & 8) >> 1); return ((kk >> 3) * 4 + (c >> 5)) * 512 + ((kk & 7) * 32 + (c & 31)) * 2; }
__device__ __forceinline__ int v_rd_base(int lane) { return ((lane & 3) << 3) | (((lane >> 2) & 3) << 6) | (((lane >> 4) & 1) << 5) | (((lane >> 5) & 1) << 8); }
constexpr int v_rd_off(int d0, int ks, int half) { return d0 * 512 + ks * 4096 + half * 2048; }
__device__ __forceinline__ int crow(int r, int hi) { return (r & 3) + 8 * (r >> 2) + 4 * hi; }
__device__ __forceinline__ unsigned cvtpk(float lo, float hi) { unsigned r; asm volatile("v_cvt_pk_bf16_f32 %0, %1, %2" : "=v"(r) : "v"(lo), "v"(hi)); return r; }
__device__ __forceinline__ bf16x8 load8(const bf16* p) { return *reinterpret_cast<const bf16x8*>(p); }
__device__ __forceinline__ void mask_alibi(f32x16& p0, f32x16& p1, u32x2 mw, int dq, int hi, float ah) {
    const float NEG = -__builtin_inff();
    const unsigned w0 = mw.x >> (4 * hi), w1 = mw.y >> (4 * hi);
    const float dqf = (float)dq;
#pragma unroll
    for (int r = 0; r < 16; ++r) {
        const int c = (r & 3) + 8 * (r >> 2);
        p0[r] = ((w0 >> c) & 1u) ? fmaf(ah, (float)c - dqf, p0[r]) : NEG;
        p1[r] = ((w1 >> c) & 1u) ? fmaf(ah, (float)(c + 32) - dqf, p1[r]) : NEG;
    }
}
__device__ __forceinline__ void partialSM(f32x16& p0, f32x16& p1, float& m_reg, float& mn, float& alpha) {
    float pmax = p0[0];
#pragma unroll
    for (int r = 1; r < 16; ++r) pmax = fmaxf(pmax, p0[r]);
#pragma unroll
    for (int r = 0; r < 16; ++r) pmax = fmaxf(pmax, p1[r]);
    { auto rr = __builtin_amdgcn_permlane32_swap(__float_as_uint(pmax), __float_as_uint(pmax), false, false);
      pmax = fmaxf(__uint_as_float(rr[0]), __uint_as_float(rr[1])); }
    constexpr float C2 = 1.4426950408889634f * SCALE;
    if (__builtin_expect(__all((pmax - m_reg) * SCALE <= THR), 1)) { mn = m_reg; alpha = 1.f; }
    else { mn = fmaxf(m_reg, pmax); alpha = __builtin_amdgcn_exp2f((m_reg - mn) * C2); m_reg = mn; }
    const float mnL = -mn * C2;
#pragma unroll
    for (int r = 0; r < 16; ++r) p0[r] = fmaf(p0[r], C2, mnL);
#pragma unroll
    for (int r = 0; r < 16; ++r) p1[r] = fmaf(p1[r], C2, mnL);
#pragma unroll
    for (int r = 0; r < 16; ++r) p0[r] = __builtin_amdgcn_exp2f(p0[r]);
}
__device__ __forceinline__ void finishSM(f32x16& p0, f32x16& p1, float alpha, float& l_reg, bf16x8& pa0, bf16x8& pa1, bf16x8& pa2, bf16x8& pa3) {
#pragma unroll
    for (int r = 0; r < 16; ++r) p1[r] = __builtin_amdgcn_exp2f(p1[r]);
    float ps = 0;
#pragma unroll
    for (int r = 0; r < 16; ++r) ps += p0[r];
#pragma unroll
    for (int r = 0; r < 16; ++r) ps += p1[r];
    { auto rr = __builtin_amdgcn_permlane32_swap(__float_as_uint(ps), __float_as_uint(ps), false, false);
      ps = __uint_as_float(rr[0]) + __uint_as_float(rr[1]); }
    l_reg = l_reg * alpha + ps;
#define PK4(P, B_, OUT) do { unsigned a0 = cvtpk(P[B_+0], P[B_+1]), a1 = cvtpk(P[B_+2], P[B_+3]);                          \
        unsigned b0 = cvtpk(P[B_+4], P[B_+5]), b1 = cvtpk(P[B_+6], P[B_+7]);                                             \
        auto r0 = __builtin_amdgcn_permlane32_swap(a0, b0, false, false); auto r1 = __builtin_amdgcn_permlane32_swap(a1, b1, false, false); \
        u32x4 w = {r0[0], r1[0], r0[1], r1[1]}; OUT = *reinterpret_cast<bf16x8*>(&w); } while (0)
    PK4(p0, 0, pa0); PK4(p0, 8, pa1); PK4(p1, 0, pa2); PK4(p1, 8, pa3);
#undef PK4
}
template <int KB>
__device__ __forceinline__ void qkt(f32x16& p0, f32x16& p1, const char* K_lds, int r32, int hi, const bf16x8* qr) {
    p0 = f32x16{}; p1 = f32x16{};
    const char* kb[4];
#pragma unroll
    for (int dd = 0; dd < 4; ++dd) kb[dd] = K_lds + KB * SHM_K + KSWZ(r32, (dd * 16 + hi * 8) * 2);
#pragma unroll
    for (int d0 = 0; d0 < 8; ++d0) { const char* a = kb[d0 & 3] + (d0 >> 2) * 128;
        bf16x8 b0 = *reinterpret_cast<const bf16x8*>(a);
        bf16x8 b1 = *reinterpret_cast<const bf16x8*>(a + 32 * 256);
        p0 = __builtin_amdgcn_mfma_f32_32x32x16_bf16(b0, qr[d0], p0, 0, 0, 0);
        p1 = __builtin_amdgcn_mfma_f32_32x32x16_bf16(b1, qr[d0], p1, 0, 0, 0); }
}
template <int VB>
__device__ __forceinline__ void pv_tile(f32x16* o, int vb0, bf16x8 pa0, bf16x8 pa1, bf16x8 pa2, bf16x8 pa3) {
#define TRRD(dst, off) asm volatile("ds_read_b64_tr_b16 %0, %1 offset:%2" : "=&v"(dst) : "v"(vb0), "i"(off) : "memory")
#define PV_D0(d0) do { s16x4 l0, l1, l2, l3, h0, h1, h2, h3; constexpr int b_ = VB * SHM_V + v_rd_off(d0, 0, 0); \
        TRRD(l0, b_); TRRD(h0, b_ + 2048); TRRD(l1, b_ + 4096); TRRD(h1, b_ + 6144); TRRD(l2, b_ + 8192); TRRD(h2, b_ + 10240); TRRD(l3, b_ + 12288); TRRD(h3, b_ + 14336); \
        asm volatile("s_waitcnt lgkmcnt(0)" ::: "memory"); SBAR();   \
        o[d0] = __builtin_amdgcn_mfma_f32_32x32x16_bf16(pa0, (bf16x8){l0[0], l0[1], l0[2], l0[3], h0[0], h0[1], h0[2], h0[3]}, o[d0], 0, 0, 0);   \
        o[d0] = __builtin_amdgcn_mfma_f32_32x32x16_bf16(pa1, (bf16x8){l1[0], l1[1], l1[2], l1[3], h1[0], h1[1], h1[2], h1[3]}, o[d0], 0, 0, 0);   \
        o[d0] = __builtin_amdgcn_mfma_f32_32x32x16_bf16(pa2, (bf16x8){l2[0], l2[1], l2[2], l2[3], h2[0], h2[1], h2[2], h2[3]}, o[d0], 0, 0, 0);   \
        o[d0] = __builtin_amdgcn_mfma_f32_32x32x16_bf16(pa3, (bf16x8){l3[0], l3[1], l3[2], l3[3], h3[0], h3[1], h3[2], h3[3]}, o[d0], 0, 0, 0); } while (0)
    PV_D0(0); PV_D0(1); PV_D0(2); PV_D0(3);
#undef PV_D0
#undef TRRD
}
template <int LD, bool MASKED>
__device__ __forceinline__ void attn_block(const bf16* Q, const bf16* Kh, const bf16* Vh, bf16* O, int NT, int P0, const unsigned* maskbase, float ah, char* lds) {
    const int tid = threadIdx.x, wid = __builtin_amdgcn_readfirstlane(tid >> 6), lane = tid & 63, r32 = lane & 31, hi = lane >> 5;
    const int qlo = P0 + wid * QBLK, qm = qlo + r32 - 4 * hi;
    char* V_lds = lds; char* K_lds = lds + 2 * SHM_V;
    float* ws = (float*)(lds + 2 * SHM_V + 2 * SHM_K) + wid * 64; float* li_l = ws, * al_l = ws + 32;
    float m_reg = -1e30f, l_reg = 0; f32x16 o[4] = {};
    const int sr = tid >> 4, sc = (tid & 15) * 8, vst0 = v_st(sr, sc), vst1 = v_st(32 + sr, sc), kws = KSWZ(sr, sc * 2);
    const int vb0 = (int)(uintptr_t)V_lds + v_rd_base(lane);
    const unsigned* mrow = MASKED ? maskbase + (size_t)(qlo + r32) * 128 : nullptr;
    bf16x8 qr[8], st_v0, st_v1, st_k0, st_k1;
#define ROW(p, k0, rr) ((p) + (size_t)((k0) + (rr)) * LD + sc)
#define VMW() asm volatile("s_waitcnt vmcnt(0)" ::: "memory")
#define SLOAD_H(k0) do { st_v0 = load8(ROW(Vh, k0, sr)); st_v1 = load8(ROW(Vh, k0, 32 + sr)); st_k0 = load8(ROW(Kh, k0, sr)); st_k1 = load8(ROW(Kh, k0, 32 + sr)); } while (0)
#define SWRITE_HK(bf) do { *(bf16x8*)(K_lds + (bf) * SHM_K + kws) = st_k0; *(bf16x8*)(K_lds + (bf) * SHM_K + kws + 32 * 256) = st_k1; } while (0)
#define SWRITE_HV(bf) do { *(bf16x8*)(V_lds + (bf) * SHM_V + vst0) = st_v0; *(bf16x8*)(V_lds + (bf) * SHM_V + vst1) = st_v1; } while (0)
#define SWRITE_H(bf) do { SWRITE_HV(bf); SWRITE_HK(bf); } while (0)
#define RESC(a) do { if (__any((a) < 1.f)) { if (hi == 0) al_l[r32] = (a); asm volatile("s_waitcnt lgkmcnt(0)" ::: "memory");              \
                     for (int d_ = 0; d_ < 4; ++d_) for (int r = 0; r < 16; ++r) o[d_][r] *= al_l[crow(r, hi)]; } } while (0)
#define KBASE(t) ((t) * KVBLK)
#define MLOAD(dst, t) do { if (MASKED) dst = *(const u32x2*)(mrow + 2 * (t)); } while (0)
#define MASKT(P0_, P1_, mw_, t) do { if (MASKED) mask_alibi(P0_, P1_, mw_, qm - KBASE(t), hi, ah); } while (0)
#pragma unroll
    for (int d0 = 0; d0 < 8; ++d0) qr[d0] = load8(Q + (size_t)(wid * QBLK + r32) * LD + d0 * 16 + hi * 8);
    SLOAD_H(0); VMW(); SWRITE_HK(0);
    __syncthreads();
    f32x16 pA0, pA1, pB0, pB1; float mnA, mnB, alA, alB; bf16x8 pa0, pa1, pa2, pa3;
    u32x2 mwA = {0u, 0u}, mwB = {0u, 0u};
    SWRITE_HV(0); SBAR();
    MLOAD(mwA, 0);
    if (NT > 1) SLOAD_H(KBASE(1));
    SBAR(); qkt<0>(pA0, pA1, K_lds, r32, hi, qr);
    MASKT(pA0, pA1, mwA, 0); partialSM(pA0, pA1, m_reg, mnA, alA);
    if (NT > 1) { VMW(); SWRITE_H(1); }
    __syncthreads();
#define HALF_STEP(PX0, PX1, mwX, mnX, alX, PY0, PY1, alY, t, KB, VB, SB) do {                                                 \
        SBAR(); MLOAD(mwX, t); qkt<KB>(PX0, PX1, K_lds, r32, hi, qr);                                                         \
        finishSM(PY0, PY1, alY, l_reg, pa0, pa1, pa2, pa3); SBAR();                                                           \
        if ((t) + 1 < NT) { SLOAD_H(KBASE((t) + 1)); SBAR(); }                                                                \
        pv_tile<VB>(o, vb0, pa0, pa1, pa2, pa3); MASKT(PX0, PX1, mwX, (t)); partialSM(PX0, PX1, m_reg, mnX, alX);             \
        __syncthreads();                                                                                                      \
        if ((t) + 1 < NT) { VMW(); SWRITE_H(SB); }                                                                            \
        RESC(alX); __syncthreads(); } while (0)
    for (int t = 1; t + 1 < NT; t += 2) {
        HALF_STEP(pB0, pB1, mwB, mnB, alB, pA0, pA1, alA, t, 1, 0, 0);
        HALF_STEP(pA0, pA1, mwA, mnA, alA, pB0, pB1, alB, t + 1, 0, 1, 1);
    }
    const bool even = (NT & 1) == 0;
    if (even) { SBAR(); MLOAD(mwB, NT - 1); qkt<1>(pB0, pB1, K_lds, r32, hi, qr); SBAR(); }
    finishSM(pA0, pA1, alA, l_reg, pa0, pa1, pa2, pa3); SBAR();
    pv_tile<0>(o, vb0, pa0, pa1, pa2, pa3);
    if (even) { MASKT(pB0, pB1, mwB, NT - 1); partialSM(pB0, pB1, m_reg, mnB, alB); __syncthreads(); RESC(alB);
        finishSM(pB0, pB1, alB, l_reg, pa0, pa1, pa2, pa3); SBAR(); pv_tile<1>(o, vb0, pa0, pa1, pa2, pa3); }
    SBAR();
    if (hi == 0) li_l[r32] = l_reg; asm volatile("s_waitcnt lgkmcnt(0)" ::: "memory");
    float rli[16];
#pragma unroll
    for (int r = 0; r < 16; ++r) rli[r] = __builtin_amdgcn_rcpf(li_l[crow(r, hi)]);
    bf16* Ow = O + (size_t)(wid * QBLK) * LD;
#pragma unroll
    for (int r = 0; r < 16; ++r) { const int orow = crow(r, hi);
#pragma unroll
        for (int d0 = 0; d0 < 4; ++d0) { const float v = o[d0][r] * rli[r];
            const float vn = __shfl_xor(v, 1);
            if ((r32 & 1) == 0) *(unsigned*)(Ow + (size_t)orow * LD + d0 * 32 + r32) = cvtpk(v, vn); } }
    __syncthreads();
#undef ROW
#undef VMW
#undef SLOAD_H
#undef SWRITE_HK
#undef SWRITE_HV
#undef SWRITE_H
#undef RESC
#undef KBASE
#undef MLOAD
#undef MASKT
#undef HALF_STEP
}
#undef KSWZ
#undef SBAR
}

constexpr int NWAVES = 8;
constexpr int BATCH = 2, SEQ = 4096, DM = 2048, T = BATCH * SEQ, FF = 5632, NUP = 2 * FF;
constexpr int NIN = 11344, NIN_PAD = 11520;
constexpr int MEMLEN = 256, TOPK = 256;
constexpr float ALPHA = 1.189207115002721f;
constexpr float LN_EPS = 1e-5f;
constexpr int N_PHASES = 13;

constexpr size_t WS_CTL = 0, CTL_ZERO_BYTES = 1u << 20;
constexpr size_t WS_BIG = 1u << 20;
constexpr size_t O_X16 = 0, O_WUP1 = O_X16 + (size_t)T * DM * 2, O_WDN1 = O_WUP1 + (size_t)NUP * DM * 2, O_G = O_WDN1 + (size_t)DM * FF * 2, BIG_BYTES = O_G + (size_t)T * FF * 2;
constexpr size_t O_Q = 0, O_K = O_Q + (size_t)T * 1024 * 2, O_V = O_K + (size_t)T * 1024 * 2, O_QI = O_V + (size_t)T * 1024 * 2, O_KI = O_QI + (size_t)T * 1024 * 2,
                 O_WI = O_KI + (size_t)T * 64 * 2, O_U = O_WI + (size_t)T * 16 * 4, O_QM = O_U + (size_t)T * 512 * 2, O_GATE = O_QM + (size_t)T * 512 * 2, O_MIXEND = O_GATE + (size_t)T * 6144 * 2;
static_assert(O_MIXEND <= BIG_BYTES, "mixer view fits");
constexpr size_t WS_WIN = WS_BIG + BIG_BYTES;
constexpr size_t WS_WMKV = WS_WIN + (size_t)NIN_PAD * DM * 2;
constexpr size_t WS_WBA = WS_WMKV + (size_t)1024 * DM * 2;
constexpr size_t WS_WBP = WS_WBA + (size_t)DM * 1024 * 2;
constexpr size_t WS_WBM = WS_WBP + (size_t)DM * 512 * 2;
constexpr size_t WS_WOUT = WS_WBM + (size_t)DM * 512 * 2;
constexpr size_t WS_WUP2 = WS_WOUT + (size_t)DM * DM * 2;
constexpr size_t WS_WDN2 = WS_WUP2 + (size_t)NUP * DM * 2;
constexpr size_t WS_WPOOL = WS_WDN2 + (size_t)DM * FF * 2;
constexpr size_t WS_H1 = WS_WPOOL + (size_t)4 * 128 * 128 * 2;
constexpr size_t WS_MEM16 = WS_H1 + (size_t)T * DM * 2;
constexpr size_t WS_A16 = WS_MEM16 + (size_t)512 * DM * 2;
constexpr size_t WS_P16 = WS_A16 + (size_t)T * 1024 * 2;
constexpr size_t WS_M16 = WS_P16 + (size_t)T * 512 * 2;
constexpr size_t WS_Y16 = WS_M16 + (size_t)T * 512 * 2;
constexpr size_t WS_KM = WS_Y16 + (size_t)T * DM * 2;
constexpr size_t WS_VM = WS_KM + (size_t)512 * 512 * 2;
constexpr size_t WS_MASK = WS_VM + (size_t)512 * 512 * 2;
constexpr size_t WS_END = WS_MASK + (size_t)T * 128 * 4;
constexpr int CW_BAR = 4096;

constexpr int RING_OFF = 0, RING_BYTES = 131072;
constexpr int LDSCTL_OFF = RING_BYTES, MISC_OFF = LDSCTL_OFF + 320;
constexpr int LDS_BYTES = 147456;

#define GAS __attribute__((address_space(1)))
#define LAS __attribute__((address_space(3)))
typedef unsigned short bf16;
typedef unsigned v4u __attribute__((ext_vector_type(4)));
typedef unsigned v2u __attribute__((ext_vector_type(2)));
typedef float f32x4 __attribute__((ext_vector_type(4)));
typedef float f32x16 __attribute__((ext_vector_type(16)));
typedef short bf16x8 __attribute__((ext_vector_type(8)));
#define LDS_WAIT() asm volatile("s_waitcnt lgkmcnt(0)" ::: "memory")
__device__ __forceinline__ unsigned f2bf(float f) { unsigned u = __builtin_bit_cast(unsigned, f); return (u + 0x7fffu + ((u >> 16) & 1u)) >> 16; }
__device__ __forceinline__ unsigned pk2(float lo, float hi) { return f2bf(lo) | (f2bf(hi) << 16); }

#define XB_TMO      128
#define XB_XCNT(j)  (256  + 64 * (j))
#define XB_XSUB(j)  (1280 + 64 * (j))
#define XB_XGEN(j)  (2304 + 64 * (j))
#define XB_TOP      3328
#define XB_TOPGEN   3392
#define XCD_BAR_WORDS 3456
#define XB_SPIN_CAP (1u << 22)
__device__ __forceinline__ unsigned xb_ld(unsigned* p)              { return __hip_atomic_load(p, __ATOMIC_RELAXED, __HIP_MEMORY_SCOPE_AGENT); }
__device__ __forceinline__ unsigned xb_add(unsigned* p, unsigned v) { return __hip_atomic_fetch_add(p, v, __ATOMIC_RELAXED, __HIP_MEMORY_SCOPE_AGENT); }
__device__ __forceinline__ unsigned xb_xcc_id() { return (unsigned)__builtin_amdgcn_s_getreg((3 << 11) | 20) & 0xFu; }
#define XB_SPIN(cond, bar) do { unsigned _sp = 0; while (cond) { __builtin_amdgcn_s_sleep(1); \
    if ((++_sp & 255u) == 0u) { if (xb_ld(&(bar)[XB_TMO])) break; if (_sp > XB_SPIN_CAP) { atomicAdd(&(bar)[XB_TMO], 1u); break; } } } } while (0)
struct XcdBarrier { unsigned* bar; unsigned x; volatile LAS unsigned* st; };
__device__ __forceinline__ XcdBarrier xcd_barrier_post(unsigned* bar, volatile LAS unsigned* st) {
    XcdBarrier b; b.bar = bar; b.x = xb_xcc_id(); b.st = st;
    if (threadIdx.x == 0) (void)xb_add(&bar[XB_XCNT(b.x)], 1u);
    return b;
}
__device__ __forceinline__ void xcd_barrier_complete(unsigned* bar, unsigned x, unsigned& nloc, unsigned& nx) {
    const unsigned G = gridDim.x * gridDim.y * gridDim.z;
    unsigned sum, cnt, mine, sp = 0u;
    for (;;) {
        sum = 0u; cnt = 0u; mine = 0u;
#pragma unroll
        for (unsigned j = 0; j < 16; ++j) { const unsigned c = xb_ld(&bar[XB_XCNT(j)]); sum += c; cnt += (c > 0u) ? 1u : 0u; mine = (j == x) ? c : mine; }
        if (sum == G) break;
        __builtin_amdgcn_s_sleep(1);
        if ((++sp & 255u) == 0u) { if (xb_ld(&bar[XB_TMO])) break; if (sp > XB_SPIN_CAP) { atomicAdd(&bar[XB_TMO], 1u); break; } }
    }
    nloc = mine > 0u ? mine : 1u; nx = cnt > 0u ? cnt : 1u;
}
__device__ __forceinline__ void xcd_barrier(const XcdBarrier& b) {
    asm volatile("s_waitcnt vmcnt(0)" ::: "memory");
    __syncthreads();
    if (threadIdx.x == 0) {
        unsigned* bar = b.bar;
        __builtin_amdgcn_s_waitcnt(0);
        unsigned nloc = b.st[0], nx = b.st[1];
        if (nloc == 0u) { xcd_barrier_complete(bar, b.x, nloc, nx); b.st[0] = nloc; b.st[1] = nx; }
        const unsigned old = xb_add(&bar[XB_XSUB(b.x)], 1u);
        const unsigned gen = old / nloc;
        if (old + 1u == (gen + 1u) * nloc) {
            __builtin_amdgcn_fence(__ATOMIC_RELEASE, "agent");
            asm volatile("s_waitcnt vmcnt(0)" ::: "memory");
            const unsigned og = xb_add(&bar[XB_TOP], 1u);
            const unsigned tg = og / nx;
            if (og + 1u == (tg + 1u) * nx) xb_add(&bar[XB_TOPGEN], 1u);
            else XB_SPIN(xb_ld(&bar[XB_TOPGEN]) == tg, bar);
            __builtin_amdgcn_fence(__ATOMIC_ACQUIRE, "agent");
            xb_add(&bar[XB_XGEN(b.x)], 1u);
            asm volatile("s_waitcnt vmcnt(0)" ::: "memory");
        } else {
            XB_SPIN(xb_ld(&bar[XB_XGEN(b.x)]) == gen, bar);
            __builtin_amdgcn_fence(__ATOMIC_ACQUIRE, "agent");
            asm volatile("s_waitcnt vmcnt(0)" ::: "memory");
        }
    }
    __syncthreads();
}

__device__ __forceinline__ float wave_sum(float v) {
#pragma unroll
    for (int o = 1; o < 64; o <<= 1) v += __shfl_xor(v, o);
    return v;
}
template <int MAP>
__device__ __forceinline__ void p0_transpose_item(const float* W, int K, int N, int NP, bf16* WT, LAS float* scr, int item, int lane) {
    const int nblk = NP / 32, kb = item / nblk, nb = item % nblk, k0 = 64 * kb, np0 = 32 * nb;
    int n0 = np0; int nvalid = 32;
    if (MAP == 1) n0 = ((np0 >> 7) & 1) * FF + (np0 >> 8) * 128 + (np0 & 127);
    if (MAP == 2) { if (np0 < 4096) n0 = np0; else if (np0 < 4352) { n0 = np0; nvalid = 4176 - np0; nvalid = nvalid < 0 ? 0 : (nvalid > 32 ? 32 : nvalid); } else n0 = np0 - 176; }
    float v[32];
    const bool ok = (lane & 31) < nvalid;
#pragma unroll
    for (int i = 0; i < 32; ++i) { const int kk = 2 * i + (lane >> 5); v[i] = ok ? W[(size_t)(k0 + kk) * N + n0 + (lane & 31)] : 0.f; }
#pragma unroll
    for (int i = 0; i < 32; ++i) { const int kk = 2 * i + (lane >> 5); scr[kk * 33 + (lane & 31)] = v[i]; }
    LDS_WAIT(); asm volatile("" ::: "memory");
    const int c = lane & 7;
#pragma unroll
    for (int j = 0; j < 4; ++j) { const int n = (lane >> 3) + 8 * j; const LAS float* s = scr + (8 * c) * 33 + n;
        v4u o; o.x = pk2(s[0 * 33], s[1 * 33]); o.y = pk2(s[2 * 33], s[3 * 33]); o.z = pk2(s[4 * 33], s[5 * 33]); o.w = pk2(s[6 * 33], s[7 * 33]);
        *(GAS v4u*)(WT + (size_t)(np0 + n) * K + k0 + 8 * c) = o; }
    LDS_WAIT(); asm volatile("" ::: "memory");
}
template <bool OUT_BF16>
__device__ __forceinline__ void ln_row(const float* xrow, const float* gam, const float* bet, void* orow, int lane) {
    const GAS f32x4* xr = (const GAS f32x4*)xrow + lane;
    f32x4 v[8]; float s = 0.f;
#pragma unroll
    for (int j = 0; j < 8; ++j) { v[j] = xr[64 * j]; s += (v[j].x + v[j].y) + (v[j].z + v[j].w); }
    const float mean = wave_sum(s) * (1.f / DM); float s2 = 0.f;
#pragma unroll
    for (int j = 0; j < 8; ++j) { v[j] = v[j] - mean; s2 += (v[j].x * v[j].x + v[j].y * v[j].y) + (v[j].z * v[j].z + v[j].w * v[j].w); }
    const float rstd = 1.f / sqrtf(wave_sum(s2) * (1.f / DM) + LN_EPS);
#pragma unroll
    for (int j = 0; j < 8; ++j) {
        const f32x4 gg = ((const GAS f32x4*)gam)[lane + 64 * j], bb = ((const GAS f32x4*)bet)[lane + 64 * j];
        const f32x4 y = v[j] * rstd * gg + bb;
        if (OUT_BF16) { ((GAS v2u*)orow)[lane + 64 * j] = (v2u){pk2(y.x, y.y), pk2(y.z, y.w)}; }
        else ((GAS f32x4*)orow)[lane + 64 * j] = y;
    }
}

__device__ __forceinline__ unsigned ordkey(float s) { const unsigned u = __float_as_uint(s); return u ^ ((unsigned)((int)u >> 31) | 0x80000000u); }
__device__ __forceinline__ void indexer_unit(LAS unsigned char* lds, int b, int uidx, const bf16* QI16, const bf16* KI16, const float* WI, unsigned* MASKQ) {
    const int tid = threadIdx.x, lane = tid & 63, wid = __builtin_amdgcn_readfirstlane(tid >> 6), r = lane & 31, h = lane >> 5;
    const int q0 = uidx * 16 + 2 * wid, tq = q0 + h;
    const int nchunk = ((uidx * 16 + 15) >> 8) + 1;
    bf16x8 aq[4];
    { const int qa = q0 + ((r >> 2) & 1), head = (r & 3) + 4 * (r >> 3);
      const bf16* qp = QI16 + (size_t)(b * SEQ + qa) * 1024 + head * 64 + 8 * h;
#pragma unroll
      for (int ks = 0; ks < 4; ++ks) aq[ks] = *(const GAS bf16x8*)(qp + ks * 16); }
    float w[16];
    { const GAS f32x4* wp = (const GAS f32x4*)(WI + (size_t)(b * SEQ + tq) * 16);
#pragma unroll
      for (int i = 0; i < 4; ++i) { const f32x4 t = wp[i]; w[4 * i] = t.x; w[4 * i + 1] = t.y; w[4 * i + 2] = t.z; w[4 * i + 3] = t.w; } }
    unsigned key[128];
    const char* kbase = (const char*)(KI16 + (size_t)(b * SEQ) * 64);
    unsigned soff[4];
#pragma unroll
    for (int i = 0; i < 4; ++i) { const int kk = (wid * 4 + i) * 8 + (lane >> 3), cs = lane & 7; soff[i] = (unsigned)(kk * 128 + ((cs ^ ((kk >> 1) & 7)) << 4)); }
#define IDX_STAGE(c_) do { _Pragma("unroll") for (int i = 0; i < 4; ++i) \
        __builtin_amdgcn_global_load_lds((const unsigned*)(kbase + (size_t)(c_) * 32768 + soff[i]), (LAS unsigned*)(lds + ((c_) & 1) * 32768 + (wid * 4 + i) * 1024), 16, 0, 0); } while (0)
    const int x = (r >> 1) & 7;
    int roff[4];
#pragma unroll
    for (int ks = 0; ks < 4; ++ks) roff[ks] = r * 128 + (((2 * ks + h) ^ x) << 4);
    __syncthreads();
    IDX_STAGE(0);
#pragma unroll
    for (int c = 0; c < 16; ++c) {
        if (c < nchunk) {
            asm volatile("s_waitcnt vmcnt(0)" ::: "memory");
            __syncthreads();
            if (c + 1 < nchunk) IDX_STAGE(c + 1);
#pragma unroll
            for (int jj = 0; jj < 8; ++jj) {
                const int j = c * 8 + jj;
                f32x16 acc = {};
#pragma unroll
                for (int ks = 0; ks < 4; ++ks) { const bf16x8 bk = *(const LAS bf16x8*)(lds + (c & 1) * 32768 + jj * 4096 + roff[ks]);
                    acc = __builtin_amdgcn_mfma_f32_32x32x16_bf16(aq[ks], bk, acc, 0, 0, 0); }
                float s = 0.f;
#pragma unroll
                for (int i = 0; i < 16; ++i) s = fmaf(w[i], fmaxf(acc[i], 0.f), s);
                unsigned kj = (j * 32 + r <= tq) ? ordkey(s) : 0u;
                asm volatile("" : "+v"(kj));
                key[j] = kj;
                __builtin_amdgcn_sched_barrier(0);
            }
        } else {
#pragma unroll
            for (int jj = 0; jj < 8; ++jj) key[c * 8 + jj] = 0u;
        }
    }
#undef IDX_STAGE
    unsigned thr = 1u;
    {
        unsigned lo = 0u, hi = 0xFFFFFFFFu; bool done = (tq + 1 <= TOPK);
        while (!__all(done)) {
            const unsigned mid = lo + ((hi - lo) >> 1);
            int cnt = 0;
#pragma unroll
            for (int j = 0; j < 128; ++j) cnt += (key[j] >= mid) ? 1 : 0;
#pragma unroll
            for (int o = 1; o < 32; o <<= 1) cnt += __shfl_xor(cnt, o);
            if (!done) {
                if (cnt >= TOPK) lo = mid; else hi = mid;
                if (cnt == TOPK) { thr = mid; done = true; }
                else if (hi - lo <= 1u) { thr = lo; done = true; }
            }
        }
    }
    LAS unsigned* mb = (LAS unsigned*)(lds + 65536) + wid * 256;
#pragma unroll
    for (int j = 0; j < 128; ++j) {
        const unsigned long long bal = __ballot(key[j] >= thr);
        const unsigned val = h ? (unsigned)(bal >> 32) : (unsigned)bal;
        if (r == 0) mb[h * 128 + j] = val;
        asm volatile("" ::: "memory");
    }
    LDS_WAIT(); asm volatile("" ::: "memory");
    GAS unsigned* mp = (GAS unsigned*)(MASKQ + (size_t)(b * SEQ + q0) * 128);
#pragma unroll
    for (int i = 0; i < 4; ++i) mp[64 * i + lane] = mb[64 * i + lane];
    LDS_WAIT(); asm volatile("" ::: "memory");
}

__device__ __forceinline__ void pool_task(int task, const bf16* U16, const bf16* WPT, const float* pscale, bf16* P16, int lane) {
    const int tile = task >> 2, g = task & 3, r = lane & 31, h = lane >> 5;
    const int tk = tile * 32 + r, pos = tk & (SEQ - 1), wlen = 2 << g;
    const int cnt = (pos + 1 < wlen) ? pos + 1 : wlen;
    const float rc = 1.0f / (float)cnt;
    bf16x8 pa[8];
#pragma unroll
    for (int ks = 0; ks < 8; ++ks) {
        const bf16* up = U16 + (size_t)tk * 512 + g * 128 + ks * 16 + 8 * h;
        float sum[8], self[8];
#pragma unroll
        for (int e = 0; e < 8; ++e) sum[e] = 0.f;
        for (int i = 0; i < wlen; ++i) {
            if (i < cnt) { const v4u t = *(const GAS v4u*)(up - (size_t)i * 512);
                const float f0 = pg8::bf_lo(t.x), f1 = pg8::bf_hi(t.x), f2 = pg8::bf_lo(t.y), f3 = pg8::bf_hi(t.y), f4 = pg8::bf_lo(t.z), f5 = pg8::bf_hi(t.z), f6 = pg8::bf_lo(t.w), f7 = pg8::bf_hi(t.w);
                if (i == 0) { self[0] = f0; self[1] = f1; self[2] = f2; self[3] = f3; self[4] = f4; self[5] = f5; self[6] = f6; self[7] = f7; }
                sum[0] += f0; sum[1] += f1; sum[2] += f2; sum[3] += f3; sum[4] += f4; sum[5] += f5; sum[6] += f6; sum[7] += f7; }
        }
        v4u o; o.x = pk2(sum[0] * rc - self[0], sum[1] * rc - self[1]); o.y = pk2(sum[2] * rc - self[2], sum[3] * rc - self[3]);
        o.z = pk2(sum[4] * rc - self[4], sum[5] * rc - self[5]); o.w = pk2(sum[6] * rc - self[6], sum[7] * rc - self[7]);
        pa[ks] = __builtin_bit_cast(bf16x8, o);
    }
#pragma unroll
    for (int nb = 0; nb < 4; ++nb) {
        f32x16 acc = {};
        const bf16* wp = WPT + (size_t)g * 16384 + (size_t)(nb * 32 + r) * 128 + 8 * h;
#pragma unroll
        for (int ks = 0; ks < 8; ++ks) { const bf16x8 bk = *(const GAS bf16x8*)(wp + ks * 16); acc = __builtin_amdgcn_mfma_f32_32x32x16_bf16(pa[ks], bk, acc, 0, 0, 0); }
        const int col = g * 128 + nb * 32 + r; const float ps = pscale[col];
#pragma unroll
        for (int i = 0; i < 16; ++i) { const int tok = tile * 32 + (i & 3) + 8 * (i >> 2) + 4 * h; P16[(size_t)tok * 512 + col] = (bf16)f2bf(acc[i] * ps); }
    }
}

struct Args { const float* in[21]; float* out; unsigned char* ws; int ph_lo, ph_hi; };
__global__ void __launch_bounds__(NWAVES * 64, 2) mk_fwd(Args args) {
    extern __shared__ __attribute__((aligned(16))) unsigned char lds[];
    LAS unsigned char* L = (LAS unsigned char*)lds;
    volatile LAS unsigned* MISC = (volatile LAS unsigned*)(L + MISC_OFF);
    const int tid = threadIdx.x, lane = tid & 63, wave = __builtin_amdgcn_readfirstlane(tid >> 6);
    const int G = gridDim.x, bx = blockIdx.x;
    const int vcu = (G % 8 == 0) ? (bx % 8) * (G / 8) + bx / 8 : bx;
    const int gw = vcu * NWAVES + wave, NGW = G * NWAVES;
    unsigned char* ws = args.ws;
    for (int u = tid; u < (LDS_BYTES - LDSCTL_OFF) / 4; u += NWAVES * 64) ((LAS unsigned*)(L + LDSCTL_OFF))[u] = 0u;
    __syncthreads();
    XcdBarrier bar; bar.bar = (unsigned*)(ws + WS_CTL) + CW_BAR; bar.x = 0; bar.st = nullptr;
    if (!MK_PER_PHASE) bar = xcd_barrier_post((unsigned*)(ws + WS_CTL) + CW_BAR, MISC + 8);
    const int lo = args.ph_lo, hi = args.ph_hi;
#ifndef PH_MASK
#define PH_MASK 0x1FFF
#endif
#define IN(k) (((PH_MASK >> (k)) & 1) && lo <= (k) && (k) < hi)
#define SEAM(k) do { if (IN(k) && IN((k) + 1)) xcd_barrier(bar); } while (0)
    const float* x = args.in[0]; const float* mem = args.in[1];
    bf16* BIG = (bf16*)(ws + WS_BIG);
    bf16 *X16 = (bf16*)(ws + WS_BIG + O_X16), *WUP1 = (bf16*)(ws + WS_BIG + O_WUP1), *WDN1 = (bf16*)(ws + WS_BIG + O_WDN1), *Gb = (bf16*)(ws + WS_BIG + O_G);
    bf16 *Q16 = (bf16*)(ws + WS_BIG + O_Q), *K16 = (bf16*)(ws + WS_BIG + O_K), *V16 = (bf16*)(ws + WS_BIG + O_V), *QI16 = (bf16*)(ws + WS_BIG + O_QI), *KI16 = (bf16*)(ws + WS_BIG + O_KI);
    float* WI = (float*)(ws + WS_BIG + O_WI);
    bf16 *U16 = (bf16*)(ws + WS_BIG + O_U), *QM16 = (bf16*)(ws + WS_BIG + O_QM), *GATE = (bf16*)(ws + WS_BIG + O_GATE);
    bf16 *WIN = (bf16*)(ws + WS_WIN), *WMKV = (bf16*)(ws + WS_WMKV), *WBA = (bf16*)(ws + WS_WBA), *WBP = (bf16*)(ws + WS_WBP), *WBM = (bf16*)(ws + WS_WBM), *WOUT = (bf16*)(ws + WS_WOUT);
    bf16 *WUP2 = (bf16*)(ws + WS_WUP2), *WDN2 = (bf16*)(ws + WS_WDN2), *WPT = (bf16*)(ws + WS_WPOOL);
    bf16 *H1 = (bf16*)(ws + WS_H1), *MEM16 = (bf16*)(ws + WS_MEM16), *A16 = (bf16*)(ws + WS_A16), *P16 = (bf16*)(ws + WS_P16), *M16 = (bf16*)(ws + WS_M16), *H2 = (bf16*)(ws + WS_A16);
    bf16 *Y16 = (bf16*)(ws + WS_Y16), *KM = (bf16*)(ws + WS_KM), *VM = (bf16*)(ws + WS_VM);
    unsigned* MASKQ = (unsigned*)(ws + WS_MASK);
    float* R = args.out;
    (void)BIG;

    if (IN(0)) {
        LAS float* scr = (LAS float*)(L + RING_OFF + wave * 16384);
        constexpr int I_UP = (DM / 64) * (NUP / 32), I_DN = (FF / 64) * (DM / 32), I_IN = (DM / 64) * (NIN_PAD / 32), I_MKV = (DM / 64) * (1024 / 32), I_BA = (1024 / 64) * (DM / 32),
                      I_BP = (512 / 64) * (DM / 32), I_OUT = (DM / 64) * (DM / 32), I_PL = (128 / 64) * (128 / 32);
        constexpr int NITEMS = 2 * I_UP + 2 * I_DN + I_IN + I_MKV + I_BA + 2 * I_BP + I_OUT + 4 * I_PL;
        for (int it = gw; it < NITEMS; it += NGW) {
            int r = it;
            if (r < I_UP) { p0_transpose_item<1>(args.in[2], DM, NUP, NUP, WUP1, scr, r, lane); continue; } r -= I_UP;
            if (r < I_DN) { p0_transpose_item<0>(args.in[3], FF, DM, DM, WDN1, scr, r, lane); continue; } r -= I_DN;
            if (r < I_IN) { p0_transpose_item<2>(args.in[6], DM, NIN, NIN_PAD, WIN, scr, r, lane); continue; } r -= I_IN;
            if (r < I_MKV) { p0_transpose_item<0>(args.in[8], DM, 1024, 1024, WMKV, scr, r, lane); continue; } r -= I_MKV;
            if (r < I_BA) { p0_transpose_item<0>(args.in[11], 1024, DM, DM, WBA, scr, r, lane); continue; } r -= I_BA;
            if (r < I_BP) { p0_transpose_item<0>(args.in[12], 512, DM, DM, WBP, scr, r, lane); continue; } r -= I_BP;
            if (r < I_BP) { p0_transpose_item<0>(args.in[13], 512, DM, DM, WBM, scr, r, lane); continue; } r -= I_BP;
            if (r < I_OUT) { p0_transpose_item<0>(args.in[14], DM, DM, DM, WOUT, scr, r, lane); continue; } r -= I_OUT;
            if (r < I_UP) { p0_transpose_item<1>(args.in[17], DM, NUP, NUP, WUP2, scr, r, lane); continue; } r -= I_UP;
            if (r < I_DN) { p0_transpose_item<0>(args.in[18], FF, DM, DM, WDN2, scr, r, lane); continue; } r -= I_DN;
            { const int g = r / I_PL; p0_transpose_item<0>(args.in[9] + (size_t)g * 16384, 128, 128, 128, WPT + (size_t)g * 16384, scr, r % I_PL, lane); }
        }
        for (size_t i = (size_t)gw * 64 + lane; i < (size_t)T * DM / 8; i += (size_t)NGW * 64) {
            const f32x4 a = ((const GAS f32x4*)x)[2 * i], c = ((const GAS f32x4*)x)[2 * i + 1];
            ((GAS v4u*)X16)[i] = (v4u){pk2(a.x, a.y), pk2(a.z, a.w), pk2(c.x, c.y), pk2(c.z, c.w)};
        }
        for (size_t i = (size_t)gw * 64 + lane; i < (size_t)512 * DM / 8; i += (size_t)NGW * 64) {
            const f32x4 a = ((const GAS f32x4*)mem)[2 * i], c = ((const GAS f32x4*)mem)[2 * i + 1];
            ((GAS v4u*)MEM16)[i] = (v4u){pk2(a.x, a.y), pk2(a.z, a.w), pk2(c.x, c.y), pk2(c.z, c.w)};
        }
    }
    SEAM(0);
    if (IN(1)) {
        pg8::Gemm g{X16, WUP1, T, NUP, DM}; pg8::StaticOrder S; S.init(T, NUP, G, bx);
        pg8::EpiSwiglu E{Gb, FF};
        pg8::gemm_phase<pg8::EpiSwiglu, pg8::StaticOrder, true, true>(L + RING_OFF, g, S, E);
    }
    SEAM(1);
    if (IN(2)) {
        pg8::Gemm g{Gb, WDN1, T, DM, FF}; pg8::StaticOrder S; S.init(T, DM, G, bx);
        pg8::EpiRes<false> E{R, x, DM, ALPHA, 0.5f};
        pg8::gemm_phase<pg8::EpiRes<false>, pg8::StaticOrder, true, true>(L + RING_OFF, g, S, E);
    }
    SEAM(2);
    if (IN(3)) { for (int m = gw; m < T; m += NGW) ln_row<true>(R + (size_t)m * DM, args.in[4], args.in[5], H1 + (size_t)m * DM, lane); }
    SEAM(3);
    if (IN(4)) {
        pg8::Gemm g{H1, WIN, T, NIN_PAD, DM}; pg8::OrderZ S; S.so.init(T, NIN_PAD, G, bx);
        pg8::EpiZ E{Q16, K16, V16, QI16, KI16, U16, QM16, GATE, KM, VM, WI, args.in[7]};
        pg8::gemm_phase<pg8::EpiZ, pg8::OrderZ, true, true>(L + RING_OFF, g, S, E);
    }
    SEAM(4);
    if (IN(5)) {
        for (int task = gw; task < 1024; task += NGW) pool_task(task, U16, WPT, args.in[10], P16, lane);
        for (int pp = vcu; pp < 256; pp += G) {
            const int b = pp >> 7, p = pp & 127;
#pragma unroll 1
            for (int k2 = 0; k2 < 2; ++k2) indexer_unit(L + RING_OFF, b, k2 ? 255 - p : p, QI16, KI16, WI, MASKQ);
        }
        __syncthreads();
    }
    SEAM(5);
    if (IN(6)) {
        const int xcd = bx & 7, ix = bx >> 3;
        if (ix < 32) {
            const int bh = xcd * 2 + (ix >> 4), qb = ix & 15, b = bh >> 3, hh = bh & 7;
            const size_t rowbase = (size_t)b * SEQ;
            const float ah = exp2f(-(float)(hh + 1)) * 11.313708498984761f;
            att::attn_block<1024, true>((const att::bf16*)(Q16 + (rowbase + qb * 256) * 1024 + hh * 128), (const att::bf16*)(K16 + rowbase * 1024 + hh * 128),
                                        (const att::bf16*)(V16 + rowbase * 1024 + hh * 128), (att::bf16*)(A16 + (rowbase + qb * 256) * 1024 + hh * 128),
                                        4 * (qb + 1), qb * 256, MASKQ + rowbase * 128, ah, (char*)lds + RING_OFF);
            if (qb < 8) { const int mi = bh * 8 + qb;
                const int mb = mi >> 6, mh = (mi >> 4) & 3, mq = mi & 15; const size_t mrow = (size_t)mb * SEQ + mq * 256;
                att::attn_block<512, false>((const att::bf16*)(QM16 + mrow * 512 + mh * 128), (const att::bf16*)(KM + (size_t)mb * MEMLEN * 512 + mh * 128),
                                            (const att::bf16*)(VM + (size_t)mb * MEMLEN * 512 + mh * 128), (att::bf16*)(M16 + mrow * 512 + mh * 128),
                                            MEMLEN / 64, 0, nullptr, 0.f, (char*)lds + RING_OFF); }
        }
    }
    SEAM(6);
    if (IN(7)) {
        pg8::StaticOrder S; S.init(T, DM, G, bx);
        { pg8::Gemm g{A16, WBA, T, DM, 1024}; pg8::EpiBranch<0> E{R, Y16, GATE}; pg8::gemm_phase<pg8::EpiBranch<0>, pg8::StaticOrder, true, true>(L + RING_OFF, g, S, E); }
        { pg8::Gemm g{P16, WBP, T, DM, 512}; pg8::EpiBranch<1> E{R, Y16, GATE}; pg8::gemm_phase<pg8::EpiBranch<1>, pg8::StaticOrder, true, true>(L + RING_OFF, g, S, E); }
        { pg8::Gemm g{M16, WBM, T, DM, 512}; pg8::EpiBranch<2> E{R, Y16, GATE}; pg8::gemm_phase<pg8::EpiBranch<2>, pg8::StaticOrder, true, true>(L + RING_OFF, g, S, E); }
    }
    SEAM(7);
    if (IN(8)) {
        pg8::Gemm g{Y16, WOUT, T, DM, DM}; pg8::StaticOrder S; S.init(T, DM, G, bx);
        pg8::EpiRes<true> E{R, H1, DM, ALPHA, 1.0f};
        pg8::gemm_phase<pg8::EpiRes<true>, pg8::StaticOrder, true, true>(L + RING_OFF, g, S, E);
    }
    SEAM(8);
    if (IN(9)) { for (int m = gw; m < T; m += NGW) ln_row<true>(R + (size_t)m * DM, args.in[15], args.in[16], H2 + (size_t)m * DM, lane); }
    SEAM(9);
    bf16* G2 = (bf16*)(ws + WS_BIG);
    if (IN(10)) {
        pg8::Gemm g{H2, WUP2, T, NUP, DM}; pg8::StaticOrder S; S.init(T, NUP, G, bx);
        pg8::EpiSwiglu E{G2, FF};
        pg8::gemm_phase<pg8::EpiSwiglu, pg8::StaticOrder, true, true>(L + RING_OFF, g, S, E);
    }
    SEAM(10);
    if (IN(11)) {
        pg8::Gemm g{G2, WDN2, T, DM, FF}; pg8::StaticOrder S; S.init(T, DM, G, bx);
        pg8::EpiRes<true> E{R, H2, DM, ALPHA, 0.5f};
        pg8::gemm_phase<pg8::EpiRes<true>, pg8::StaticOrder, true, true>(L + RING_OFF, g, S, E);
    }
    SEAM(11);
    if (IN(12)) { for (int m = gw; m < T; m += NGW) ln_row<false>(R + (size_t)m * DM, args.in[19], args.in[20], R + (size_t)m * DM, lane); }
#undef IN
#undef SEAM
}

extern "C" void kernel_launch(void* const* d_in, const int* in_sizes, int n_in, void* d_out, int out_size, void* d_ws, size_t ws_size, hipStream_t stream) {
    static int grid = 0;
    if (grid == 0) {
        if (n_in != 21 || in_sizes[0] != T * DM || out_size != T * DM || ws_size < WS_END) {
            fprintf(stderr, "kernel_launch: shape/workspace mismatch (n_in %d, in0 %d, out %d, ws %zu, need %zu); nothing launched\n", n_in, n_in > 0 ? in_sizes[0] : -1, out_size, ws_size, (size_t)WS_END);
            grid = -1; return; }
        int dev = 0, cus = 0;
        if (hipGetDevice(&dev) != hipSuccess || hipDeviceGetAttribute(&cus, hipDeviceAttributeMultiprocessorCount, dev) != hipSuccess) { grid = -1; return; }
        if (hipFuncSetAttribute((const void*)mk_fwd, hipFuncAttributeMaxDynamicSharedMemorySize, LDS_BYTES) != hipSuccess) { fprintf(stderr, "kernel_launch: hipFuncSetAttribute failed\n"); grid = -1; return; }
        (void)hipGetLastError();
        grid = cus;
        if (grid != 256) fprintf(stderr, "kernel_launch: %d CUs (built for 256)\n", grid);
    }
    if (grid < 0) return;
    if (hipMemsetAsync((char*)d_ws + WS_CTL, 0, CTL_ZERO_BYTES, stream) != hipSuccess) return;
    Args a{};
    for (int i = 0; i < 21; ++i) a.in[i] = (const float*)d_in[i];
    a.out = (float*)d_out; a.ws = (unsigned char*)d_ws;
#if MK_PER_PHASE
    for (int p = 0; p < N_PHASES; ++p) { a.ph_lo = p; a.ph_hi = p + 1; hipLaunchKernelGGL(mk_fwd, dim3(grid), dim3(NWAVES * 64), LDS_BYTES, stream, a); }
#else
    a.ph_lo = 0; a.ph_hi = N_PHASES;
    hipLaunchKernelGGL(mk_fwd, dim3(grid), dim3(NWAVES * 64), LDS_BYTES, stream, a);
#endif
}
```

```cpp
#include <hip/hip_runtime.h>
#include <hip/hip_bf16.h>
#include <cstdio>
#include <cstdint>

#ifndef MK_PER_PHASE
#define MK_PER_PHASE 0
#endif

namespace pg8 {
#define PG8_LAS __attribute__((address_space(3)))
typedef unsigned short bf16_t;
typedef short bf16x8 __attribute__((ext_vector_type(8)));
typedef float f32x4 __attribute__((ext_vector_type(4)));
typedef float f32x2 __attribute__((ext_vector_type(2)));
typedef unsigned u32x4 __attribute__((ext_vector_type(4)));
typedef unsigned u32x2 __attribute__((ext_vector_type(2)));
constexpr int BM = 256, BK = 64, HALF = 128, HTB = HALF * BK * 2, STAGE_BYTES = 8 * HTB, NXCD = 8, WGM = 8;

__host__ __device__ __forceinline__ int lds_byte(int r, int c) { const int st = (r >> 4) * 2 + (c >> 5), rr = r & 15, cc = c & 31, ob = rr * 64 + cc * 2; return st * 1024 + (ob ^ (((ob >> 9) & 1) << 5)); }
__host__ __device__ __forceinline__ void stage_rc(int b, int& R, int& C) { const int st = b / 1024, sb = b % 1024, swz = sb ^ (((sb >> 9) & 1) << 5); R = (st >> 1) * 16 + swz / 64; C = (st & 1) * 32 + (swz % 64) / 2; }
__host__ __device__ __forceinline__ int perm32(int rho) { const int n = rho >> 4, i = rho & 15; return 8 * (i >> 2) + 4 * n + (i & 3); }

struct Unit { int pm, pn; };
struct Gemm { const bf16_t* A; const bf16_t* Bt; int M, N, K; };

struct StaticOrder {
    int nM, nN, nwg, G, c;
    __host__ __device__ void init(int M, int N, int G_, int c_) { nM = M / BM; nN = N / BM; nwg = nM * nN; G = G_; c = c_; }
    __host__ __device__ bool next(int i, Unit& u) const {
        const long L = (long)i * G + c; if (L >= nwg) return false;
        int wgid = (int)L; { const int q = nwg / NXCD, r = nwg % NXCD, xcd = wgid % NXCD, off = wgid / NXCD; wgid = (xcd < r ? xcd * (q + 1) : r * (q + 1) + (xcd - r) * q) + off; }
        const int nig = WGM * nN, gid = wgid / nig, fm = gid * WGM, gsz = (nM - fm) < WGM ? (nM - fm) : WGM;
        u.pm = fm + ((wgid % nig) % gsz); u.pn = (wgid % nig) / gsz; return true;
    }
    __device__ __forceinline__ void a_ready(const Unit&) const {}
    __device__ __forceinline__ void done(const Unit&) const {}
};
struct OrderZ {
    StaticOrder so;
    __device__ __forceinline__ bool next(int i, Unit& u) const {
        const long L = (long)i * so.G + so.c;
        if (L < so.nwg) return so.next(i, u);
        if (L < so.nwg + 8) { const int e = (int)(L - so.nwg); u.pm = 32 + (e >> 2); u.pn = 45 + (e & 3); return true; }
        return false;
    }
    __device__ __forceinline__ void a_ready(const Unit&) const {}
    __device__ __forceinline__ void done(const Unit&) const {}
};

__device__ __forceinline__ unsigned cvt_pk_bf16(float lo, float hi) { unsigned r; asm volatile("v_cvt_pk_bf16_f32 %0, %1, %2" : "=v"(r) : "v"(lo), "v"(hi)); return r; }
__device__ __forceinline__ float bf_lo(unsigned w) { return __uint_as_float(w << 16); }
__device__ __forceinline__ float bf_hi(unsigned w) { return __uint_as_float(w & 0xffff0000u); }
__device__ __forceinline__ float sigmoidf_(float x) { return __builtin_amdgcn_rcpf(1.0f + __builtin_amdgcn_exp2f(-1.4426950408889634f * x)); }

struct EpiSwiglu {
    static constexpr bool PERM = true, AFTER_DRAIN = false;
    bf16_t* G; int ldg;
    __device__ __forceinline__ void operator()(const f32x4 (&acc)[2][2][4][2], const Unit& u, int wr, int wc, int fr, int fq) const {
        const int row0 = u.pm * BM + wr * 64 + fr, col0 = u.pn * HALF + wc * 32 + 8 * fq;
#pragma unroll
        for (int ai = 0; ai < 2; ++ai)
#pragma unroll
            for (int m = 0; m < 4; ++m) {
                bf16_t* rowp = G + (size_t)(row0 + ai * HALF + m * 16) * ldg + col0;
                float g[8];
#pragma unroll
                for (int n = 0; n < 2; ++n)
#pragma unroll
                    for (int e = 0; e < 4; ++e) { const float a = acc[ai][0][m][n][e], uu = acc[ai][1][m][n][e]; g[n * 4 + e] = a * uu * sigmoidf_(a); }
                u32x4 w; w.x = cvt_pk_bf16(g[0], g[1]); w.y = cvt_pk_bf16(g[2], g[3]); w.z = cvt_pk_bf16(g[4], g[5]); w.w = cvt_pk_bf16(g[6], g[7]);
                *(u32x4*)rowp = w;
            }
    }
};
template <bool RESBF> struct EpiRes {
    static constexpr bool PERM = false, AFTER_DRAIN = false;
    float* out; const void* res; int ldc; float alpha, sc;
    __device__ __forceinline__ void operator()(const f32x4 (&acc)[2][2][4][2], const Unit& u, int wr, int wc, int fr, int fq) const {
        const int row0 = u.pm * BM + wr * 64 + fr, col0 = u.pn * BM + wc * 32 + 4 * fq;
#pragma unroll
        for (int ai = 0; ai < 2; ++ai)
#pragma unroll
            for (int m = 0; m < 4; ++m) { const size_t off = (size_t)(row0 + ai * HALF + m * 16) * ldc + col0;
#pragma unroll
                for (int bj = 0; bj < 2; ++bj)
#pragma unroll
                    for (int n = 0; n < 2; ++n) { const size_t o = off + bj * HALF + n * 16; f32x4 r;
                        if (RESBF) { const u32x2 w = *(const u32x2*)((const bf16_t*)res + o); r = (f32x4){bf_lo(w.x), bf_hi(w.x), bf_lo(w.y), bf_hi(w.y)}; }
                        else r = *(const f32x4*)((const float*)res + o);
                        *(f32x4*)(out + o) = r * alpha + acc[ai][bj][m][n] * sc; } }
    }
};
template <int PASS> struct EpiBranch {
    static constexpr bool PERM = false, AFTER_DRAIN = false;
    float* Y; bf16_t* Y16; const bf16_t* gate;
    __device__ __forceinline__ void operator()(const f32x4 (&acc)[2][2][4][2], const Unit& u, int wr, int wc, int fr, int fq) const {
        const int row0 = u.pm * BM + wr * 64 + fr, col0 = u.pn * BM + wc * 32 + 4 * fq;
#pragma unroll
        for (int ai = 0; ai < 2; ++ai)
#pragma unroll
            for (int m = 0; m < 4; ++m) { const size_t row = (size_t)(row0 + ai * HALF + m * 16);
#pragma unroll
                for (int bj = 0; bj < 2; ++bj)
#pragma unroll
                    for (int n = 0; n < 2; ++n) { const int col = col0 + bj * HALF + n * 16;
                        const u32x2 w = *(const u32x2*)(gate + row * 6144 + PASS * 2048 + col);
                        f32x4 v = acc[ai][bj][m][n] * (f32x4){bf_lo(w.x), bf_hi(w.x), bf_lo(w.y), bf_hi(w.y)};
                        if (PASS > 0) v += *(const f32x4*)(Y + row * 2048 + col);
                        if (PASS < 2) *(f32x4*)(Y + row * 2048 + col) = v;
                        else { u32x2 o; o.x = cvt_pk_bf16(v[0], v[1]); o.y = cvt_pk_bf16(v[2], v[3]); *(u32x2*)(Y16 + row * 2048 + col) = o; } } }
    }
};
struct EpiZ {
    static constexpr bool PERM = true, AFTER_DRAIN = false;
    bf16_t *Q, *K, *V, *QI, *KI, *U, *QM, *GATE, *KM, *VM; float* WI; const float* bgate;
    __device__ __forceinline__ void operator()(const f32x4 (&acc)[2][2][4][2], const Unit& u, int wr, int wc, int fr, int fq) const {
        const int pn = u.pn;
        bf16_t* base; int ld, ct = 0, mode = 0, rowoff = 0;
        if (pn < 4) { base = Q; ld = 1024; ct = pn; }
        else if (pn < 8) { base = K; ld = 1024; ct = pn - 4; }
        else if (pn < 12) { base = V; ld = 1024; ct = pn - 8; }
        else if (pn < 16) { base = QI; ld = 1024; ct = pn - 12; }
        else if (pn == 16) { base = KI; ld = 64; mode = 2; }
        else if (pn < 19) { base = U; ld = 512; ct = pn - 17; }
        else if (pn < 21) { base = QM; ld = 512; ct = pn - 19; }
        else if (pn < 45) { base = GATE; ld = 6144; ct = pn - 21; mode = 1; }
        else if (pn < 47) { base = KM; ld = 512; ct = pn - 45; rowoff = 8192; }
        else { base = VM; ld = 512; ct = pn - 47; rowoff = 8192; }
        const int row0 = u.pm * BM + wr * 64 + fr - rowoff, cl = wc * 32 + 8 * fq;
        if (mode == 2) {
#pragma unroll
            for (int ai = 0; ai < 2; ++ai)
#pragma unroll
                for (int m = 0; m < 4; ++m) { const size_t row = (size_t)(row0 + ai * HALF + m * 16);
                    const f32x4 v0 = acc[ai][0][m][0], v1 = acc[ai][0][m][1];
                    if (cl < 64) { u32x4 w; w.x = cvt_pk_bf16(v0[0], v0[1]); w.y = cvt_pk_bf16(v0[2], v0[3]); w.z = cvt_pk_bf16(v1[0], v1[1]); w.w = cvt_pk_bf16(v1[2], v1[3]); *(u32x4*)(KI + row * 64 + cl) = w; }
                    else if (cl < 80) { const float s = 1.0f / 32.0f;
                        *(f32x4*)(WI + row * 16 + (cl - 64)) = v0 * s; *(f32x4*)(WI + row * 16 + (cl - 64) + 4) = v1 * s; } }
            return;
        }
        const int col0 = ct * BM + cl;
        f32x4 bv[2][2];
#pragma unroll
        for (int bj = 0; bj < 2; ++bj)
#pragma unroll
            for (int n = 0; n < 2; ++n) bv[bj][n] = (mode == 1) ? *(const f32x4*)(bgate + col0 + bj * HALF + 4 * n) : (f32x4){0.f, 0.f, 0.f, 0.f};
#pragma unroll
        for (int ai = 0; ai < 2; ++ai)
#pragma unroll
            for (int m = 0; m < 4; ++m) { bf16_t* rowp = base + (size_t)(row0 + ai * HALF + m * 16) * ld + col0;
#pragma unroll
                for (int bj = 0; bj < 2; ++bj) { f32x4 v0 = acc[ai][bj][m][0], v1 = acc[ai][bj][m][1];
                    if (mode == 1) { v0 += bv[bj][0]; v1 += bv[bj][1];
#pragma unroll
                        for (int e = 0; e < 4; ++e) { v0[e] = sigmoidf_(v0[e]); v1[e] = sigmoidf_(v1[e]); } }
                    u32x4 w; w.x = cvt_pk_bf16(v0[0], v0[1]); w.y = cvt_pk_bf16(v0[2], v0[3]); w.z = cvt_pk_bf16(v1[0], v1[1]); w.w = cvt_pk_bf16(v1[2], v1[3]);
                    *(u32x4*)(rowp + bj * HALF) = w; } }
    }
};

template <class Epi, class Sched, bool ALIGN_EPI = false, bool SP2 = false>
__device__ __forceinline__ void gemm_phase(PG8_LAS unsigned char* lds, const Gemm g, const Sched& S, const Epi& E) {
    const int tid = threadIdx.x, wid = __builtin_amdgcn_readfirstlane(tid >> 6), lane = tid & 63, wr = wid >> 2, wc = wid & 3, fr = lane & 15, fq = lane >> 4;
    const int K = g.K, nt = K / BK;
    unsigned voffA[2], voffB[2];
#pragma unroll
    for (int i = 0; i < 2; ++i) { int R, C; stage_rc(tid * 16 + i * 8192, R, C); const int Rb = Epi::PERM ? ((R & ~31) + perm32(R & 31)) : R;
        voffA[i] = (unsigned)(R * K + C) * 2u; voffB[i] = (unsigned)(Rb * K + C) * 2u; }
    const size_t kstep = (size_t)(BK * 2);
    const size_t hstep = (size_t)HALF * K * 2;
    const size_t tstep = 2 * hstep;
    const unsigned ldsw = (unsigned)wid * 1024u;
    const int aoff = lds_byte(wr * 64 + fr, fq * 8), boff = lds_byte(wc * 32 + fr, fq * 8);
#define PG8_SA(b, h) (((b) * 2 + (h)) * HTB)
#define PG8_SB(b, h) ((4 + (b) * 2 + (h)) * HTB)
#define PG8_STAGE(bufoff, gbase, voff) do { _Pragma("unroll") for (int _i = 0; _i < 2; ++_i) \
        __builtin_amdgcn_global_load_lds((const unsigned*)((const char*)(gbase) + (voff)[_i]), (PG8_LAS unsigned*)(lds + (bufoff) + ldsw + _i * 8192), 16, 0, 0); } while (0)
#define PG8_LDA(dst, b, h) do { _Pragma("unroll") for (int m = 0; m < 4; ++m) _Pragma("unroll") for (int k = 0; k < 2; ++k) dst[m][k] = *(const PG8_LAS bf16x8*)(lds + PG8_SA(b, h) + aoff + m * 2048 + k * 1024); } while (0)
#define PG8_LDB(dst, b, h) do { _Pragma("unroll") for (int n = 0; n < 2; ++n) _Pragma("unroll") for (int k = 0; k < 2; ++k) dst[n][k] = *(const PG8_LAS bf16x8*)(lds + PG8_SB(b, h) + boff + n * 2048 + k * 1024); } while (0)
#define PG8_MMA(ai, bj, At, Bt) do { __builtin_amdgcn_s_setprio(1); _Pragma("unroll") for (int m = 0; m < 4; ++m) _Pragma("unroll") for (int n = 0; n < 2; ++n) _Pragma("unroll") for (int k = 0; k < 2; ++k) \
        acc[ai][bj][m][n] = __builtin_amdgcn_mfma_f32_16x16x32_bf16(Bt[n][k], At[m][k], acc[ai][bj][m][n], 0, 0, 0); __builtin_amdgcn_s_setprio(0); } while (0)
#define PG8_WAIT_V(n) asm volatile("s_waitcnt vmcnt(" #n ")" ::: "memory")
#define PG8_WAIT_L(n) asm volatile("s_waitcnt lgkmcnt(" #n ")" ::: "memory")
#define PG8_BAR __builtin_amdgcn_s_barrier()
#define PG8_SCHED __builtin_amdgcn_sched_barrier(0)
    Unit cur, nxt; int ui = 0;
    if (!S.next(0, cur)) return;
    f32x4 acc[2][2][4][2];
#pragma unroll
    for (int a = 0; a < 2; ++a)
#pragma unroll
        for (int b = 0; b < 2; ++b)
#pragma unroll
            for (int m = 0; m < 4; ++m)
#pragma unroll
                for (int n = 0; n < 2; ++n) acc[a][b][m][n] = (f32x4){0.f, 0.f, 0.f, 0.f};
    bf16x8 At[4][2], B0[2][2], B1[2][2];
    const char* cA = (const char*)g.A + (size_t)cur.pm * tstep; const char* cB = (const char*)g.Bt + (size_t)cur.pn * tstep;
    S.a_ready(cur);
    if constexpr (SP2) {
        PG8_STAGE(PG8_SB(0, 0), cB, voffB); PG8_STAGE(PG8_SB(0, 1), cB + hstep, voffB); PG8_STAGE(PG8_SA(0, 0), cA, voffA); PG8_STAGE(PG8_SA(0, 1), cA + hstep, voffA);
        if (wr == 1) PG8_BAR;
        PG8_WAIT_V(2); PG8_BAR;
        PG8_STAGE(PG8_SB(1, 0), cB + kstep, voffB); PG8_STAGE(PG8_SA(1, 0), cA + kstep, voffA); PG8_STAGE(PG8_SB(1, 1), cB + hstep + kstep, voffB);
        PG8_WAIT_V(6); PG8_BAR;
    } else {
        PG8_STAGE(PG8_SB(0, 0), cB, voffB); PG8_STAGE(PG8_SA(0, 0), cA, voffA); PG8_STAGE(PG8_SB(0, 1), cB + hstep, voffB); PG8_STAGE(PG8_SA(0, 1), cA + hstep, voffA);
        if (wr == 1) PG8_BAR;
        PG8_WAIT_V(4); PG8_BAR;
        PG8_STAGE(PG8_SB(1, 0), cB + kstep, voffB); PG8_STAGE(PG8_SA(1, 0), cA + kstep, voffA); PG8_STAGE(PG8_SB(1, 1), cB + hstep + kstep, voffB);
        PG8_WAIT_V(6); PG8_BAR;
    }
    for (;;) {
        const bool has_next = S.next(ui + 1, nxt);
        const char* nA = has_next ? (const char*)g.A + (size_t)nxt.pm * tstep : cA; const char* nB = has_next ? (const char*)g.Bt + (size_t)nxt.pn * tstep : cB;
        for (int t = 0; t < nt; t += 2) {
            const bool last = (t == nt - 2);
            const char* a1 = cA + (size_t)(t + 1) * kstep;
            const char* a2 = last ? nA : cA + (size_t)(t + 2) * kstep; const char* b2 = last ? nB : cB + (size_t)(t + 2) * kstep;
            const char* a3 = a2 + kstep; const char* b3 = b2 + kstep;
            if (last && has_next) S.a_ready(nxt);
            if constexpr (SP2) {
            PG8_LDB(B0, 0, 0); PG8_LDB(B1, 0, 1); PG8_SCHED; PG8_LDA(At, 0, 0); PG8_STAGE(PG8_SA(1, 1), a1 + hstep, voffA);
            PG8_WAIT_V(8); PG8_WAIT_L(0); PG8_BAR; PG8_MMA(0, 0, At, B0); PG8_MMA(0, 1, At, B1); PG8_BAR; PG8_SCHED;
            PG8_LDA(At, 0, 1); PG8_STAGE(PG8_SB(0, 0), b2, voffB); PG8_STAGE(PG8_SB(0, 1), b2 + hstep, voffB); PG8_STAGE(PG8_SA(0, 0), a2, voffA);
            PG8_WAIT_V(8); PG8_WAIT_L(0); PG8_BAR; PG8_MMA(1, 0, At, B0); PG8_MMA(1, 1, At, B1); PG8_BAR; PG8_SCHED;
            PG8_LDB(B0, 1, 0); PG8_LDB(B1, 1, 1); PG8_SCHED; PG8_LDA(At, 1, 0); PG8_STAGE(PG8_SA(0, 1), a2 + hstep, voffA);
            PG8_WAIT_V(8); PG8_WAIT_L(0); PG8_BAR; PG8_MMA(0, 0, At, B0); PG8_MMA(0, 1, At, B1); PG8_BAR; PG8_SCHED;
            PG8_LDA(At, 1, 1); PG8_STAGE(PG8_SB(1, 0), b3, voffB); PG8_STAGE(PG8_SB(1, 1), b3 + hstep, voffB); PG8_STAGE(PG8_SA(1, 0), a3, voffA);
            PG8_WAIT_V(8); PG8_WAIT_L(0); PG8_BAR; PG8_MMA(1, 0, At, B0); PG8_MMA(1, 1, At, B1); PG8_BAR; PG8_SCHED;
            } else {
            PG8_LDB(B0, 0, 0); PG8_SCHED; PG8_LDA(At, 0, 0); PG8_STAGE(PG8_SA(1, 1), a1 + hstep, voffA);
            PG8_WAIT_L(8); PG8_BAR; PG8_WAIT_L(0); PG8_MMA(0, 0, At, B0); PG8_BAR; PG8_SCHED;
            PG8_LDB(B1, 0, 1); PG8_STAGE(PG8_SB(0, 0), b2, voffB);
            PG8_BAR; PG8_WAIT_L(0); PG8_MMA(0, 1, At, B1); PG8_BAR;
            PG8_LDA(At, 0, 1); PG8_STAGE(PG8_SA(0, 0), a2, voffA);
            PG8_BAR; PG8_WAIT_L(0); PG8_MMA(1, 0, At, B0); PG8_BAR; PG8_SCHED;
            PG8_STAGE(PG8_SB(0, 1), b2 + hstep, voffB);
            PG8_WAIT_V(6); PG8_BAR; PG8_MMA(1, 1, At, B1); PG8_BAR;
            PG8_LDB(B0, 1, 0); PG8_SCHED; PG8_LDA(At, 1, 0); PG8_STAGE(PG8_SA(0, 1), a2 + hstep, voffA);
            PG8_WAIT_L(8); PG8_BAR; PG8_WAIT_L(0); PG8_MMA(0, 0, At, B0); PG8_BAR; PG8_SCHED;
            PG8_LDB(B1, 1, 1); PG8_STAGE(PG8_SB(1, 0), b3, voffB);
            PG8_BAR; PG8_WAIT_L(0); PG8_MMA(0, 1, At, B1); PG8_BAR;
            PG8_LDA(At, 1, 1); PG8_STAGE(PG8_SA(1, 0), a3, voffA);
            PG8_BAR; PG8_WAIT_L(0); PG8_MMA(1, 0, At, B0); PG8_BAR; PG8_SCHED;
            PG8_STAGE(PG8_SB(1, 1), b3 + hstep, voffB);
            PG8_WAIT_V(6); PG8_BAR; PG8_MMA(1, 1, At, B1); PG8_BAR;
            }
        }
        if constexpr (ALIGN_EPI) { if (wr == 0) PG8_BAR; }
        if constexpr (!Epi::AFTER_DRAIN) { E(acc, cur, wr, wc, fr, fq); S.done(cur); }
        if (!has_next) break;
#pragma unroll
        for (int a = 0; a < 2; ++a)
#pragma unroll
            for (int b = 0; b < 2; ++b)
#pragma unroll
                for (int m = 0; m < 4; ++m)
#pragma unroll
                    for (int n = 0; n < 2; ++n) acc[a][b][m][n] = (f32x4){0.f, 0.f, 0.f, 0.f};
        cur = nxt; cA = nA; cB = nB; ++ui;
        if constexpr (ALIGN_EPI) { if (wr == 1) PG8_BAR; }
    }
    PG8_WAIT_V(0);
    if constexpr (!ALIGN_EPI) { if (wr == 0) PG8_BAR; }
    PG8_BAR;
#undef PG8_SA
#undef PG8_SB
#undef PG8_STAGE
#undef PG8_LDA
#undef PG8_LDB
#undef PG8_MMA
#undef PG8_WAIT_V
#undef PG8_WAIT_L
#undef PG8_BAR
#undef PG8_SCHED
}
}

namespace att {
using bf16 = __hip_bfloat16;
typedef short bf16x8 __attribute__((ext_vector_type(8)));
typedef short s16x4 __attribute__((ext_vector_type(4)));
typedef float f32x16 __attribute__((ext_vector_type(16)));
typedef float f32x4 __attribute__((ext_vector_type(4)));
typedef unsigned u32x4 __attribute__((ext_vector_type(4)));
typedef unsigned u32x2 __attribute__((ext_vector_type(2)));
constexpr int D = 128;
constexpr float SCALE = 0.08838834764831845f;
constexpr float THR = 8.f;
constexpr int NW = 8, QBLK = 32, KVBLK = 64, QB = NW * QBLK;
constexpr int SHM_V = KVBLK * D * 2, SHM_K = KVBLK * D * 2;
constexpr int LDS_BYTES = 2 * SHM_V + 2 * SHM_K + NW * 64 * 4;
#define KSWZ(row, colB) ((row) * 256 + ((colB) ^ (((row) & 7) << 4)))
#define SBAR() __builtin_amdgcn_sched_barrier(0)
__device__ __forceinline__ int v_st(int k, int c) { const int kk = (k & ~0xC) | ((k & 4) << 1) | ((k & 8) >> 1); return ((kk >> 3) * 4 + (c >> 5)) * 512 + ((kk & 7) * 32 + (c & 31)) * 2; }
__device__ __forceinline__ int v_rd_base(int lane) { return ((lane & 3) << 3) | (((lane >> 2) & 3) << 6) | (((lane >> 4) & 1) << 5) | (((lane >> 5) & 1) << 8); }
constexpr int v_rd_off(int d0, int ks, int half) { return d0 * 512 + ks * 4096 + half * 2048; }
__device__ __forceinline__ int crow(int r, int hi) { return (r & 3) + 8 * (r >> 2) + 4 * hi; }
__device__ __forceinline__ unsigned cvtpk(float lo, float hi) { unsigned r; asm volatile("v_cvt_pk_bf16_f32 %0, %1, %2" : "=v"(r) : "v"(lo), "v"(hi)); return r; }
__device__ __forceinline__ bf16x8 load8(const bf16* p) { return *reinterpret_cast<const bf16x8*>(p); }
__device__ __forceinline__ void mask_alibi(f32x16& p0, f32x16& p1, u32x2 mw, int dq, int hi, float ah) {
    const float NEG = -__builtin_inff();
    const unsigned w0 = mw.x >> (4 * hi), w1 = mw.y >> (4 * hi);
    const float dqf = (float)dq;
#pragma unroll
    for (int r = 0; r < 16; ++r) {
        const int c = (r & 3) + 8 * (r >> 2);
        p0[r] = ((w0 >> c) & 1u) ? fmaf(ah, (float)c - dqf, p0[r]) : NEG;
        p1[r] = ((w1 >> c) & 1u) ? fmaf(ah, (float)(c + 32) - dqf, p1[r]) : NEG;
    }
}
__device__ __forceinline__ void partialSM(f32x16& p0, f32x16& p1, float& m_reg, float& mn, float& alpha) {
    float pmax = p0[0];
#pragma unroll
    for (int r = 1; r < 16; ++r) pmax = fmaxf(pmax, p0[r]);
#pragma unroll
    for (int r = 0; r < 16; ++r) pmax = fmaxf(pmax, p1[r]);
    { auto rr = __builtin_amdgcn_permlane32_swap(__float_as_uint(pmax), __float_as_uint(pmax), false, false);
      pmax = fmaxf(__uint_as_float(rr[0]), __uint_as_float(rr[1])); }
    constexpr float C2 = 1.4426950408889634f * SCALE;
    if (__builtin_expect(__all((pmax - m_reg) * SCALE <= THR), 1)) { mn = m_reg; alpha = 1.f; }
    else { mn = fmaxf(m_reg, pmax); alpha = __builtin_amdgcn_exp2f((m_reg - mn) * C2); m_reg = mn; }
    const float mnL = -mn * C2;
#pragma unroll
    for (int r = 0; r < 16; ++r) p0[r] = fmaf(p0[r], C2, mnL);
#pragma unroll
    for (int r = 0; r < 16; ++r) p1[r] = fmaf(p1[r], C2, mnL);
#pragma unroll
    for (int r = 0; r < 16; ++r) p0[r] = __builtin_amdgcn_exp2f(p0[r]);
}
__device__ __forceinline__ void finishSM(f32x16& p0, f32x16& p1, float alpha, float& l_reg, bf16x8& pa0, bf16x8& pa1, bf16x8& pa2, bf16x8& pa3) {
#pragma unroll
    for (int r = 0; r < 16; ++r) p1[r] = __builtin_amdgcn_exp2f(p1[r]);
    float ps = 0;
#pragma unroll
    for (int r = 0; r < 16; ++r) ps += p0[r];
#pragma unroll
    for (int r = 0; r < 16; ++r) ps += p1[r];
    { auto rr = __builtin_amdgcn_permlane32_swap(__float_as_uint(ps), __float_as_uint(ps), false, false);
      ps = __uint_as_float(rr[0]) + __uint_as_float(rr[1]); }
    l_reg = l_reg * alpha + ps;
#define PK4(P, B_, OUT) do { unsigned a0 = cvtpk(P[B_+0], P[B_+1]), a1 = cvtpk(P[B_+2], P[B_+3]);                          \
        unsigned b0 = cvtpk(P[B_+4], P[B_+5]), b1 = cvtpk(P[B_+6], P[B_+7]);                                             \
        auto r0 = __builtin_amdgcn_permlane32_swap(a0, b0, false, false); auto r1 = __builtin_amdgcn_permlane32_swap(a1, b1, false, false); \
        u32x4 w = {r0[0], r1[0], r0[1], r1[1]}; OUT = *reinterpret_cast<bf16x8*>(&w); } while (0)
    PK4(p0, 0, pa0); PK4(p0, 8, pa1); PK4(p1, 0, pa2); PK4(p1, 8, pa3);
#undef PK4
}
template <int KB>
__device__ __forceinline__ void qkt(f32x16& p0, f32x16& p1, const char* K_lds, int r32, int hi, const bf16x8* qr) {
    p0 = f32x16{}; p1 = f32x16{};
    const char* kb[4];
#pragma unroll
    for (int dd = 0; dd < 4; ++dd) kb[dd] = K_lds + KB * SHM_K + KSWZ(r32, (dd * 16 + hi * 8) * 2);
#pragma unroll
    for (int d0 = 0; d0 < 8; ++d0) { const char* a = kb[d0 & 3] + (d0 >> 2) * 128;
        bf16x8 b0 = *reinterpret_cast<const bf16x8*>(a);
        bf16x8 b1 = *reinterpret_cast<const bf16x8*>(a + 32 * 256);
        p0 = __builtin_amdgcn_mfma_f32_32x32x16_bf16(b0, qr[d0], p0, 0, 0, 0);
        p1 = __builtin_amdgcn_mfma_f32_32x32x16_bf16(b1, qr[d0], p1, 0, 0, 0); }
}
template <int VB>
__device__ __forceinline__ void pv_tile(f32x16* o, int vb0, bf16x8 pa0, bf16x8 pa1, bf16x8 pa2, bf16x8 pa3) {
#define TRRD(dst, off) asm volatile("ds_read_b64_tr_b16 %0, %1 offset:%2" : "=&v"(dst) : "v"(vb0), "i"(off) : "memory")
#define PV_D0(d0) do { s16x4 l0, l1, l2, l3, h0, h1, h2, h3; constexpr int b_ = VB * SHM_V + v_rd_off(d0, 0, 0); \
        TRRD(l0, b_); TRRD(h0, b_ + 2048); TRRD(l1, b_ + 4096); TRRD(h1, b_ + 6144); TRRD(l2, b_ + 8192); TRRD(h2, b_ + 10240); TRRD(l3, b_ + 12288); TRRD(h3, b_ + 14336); \
        asm volatile("s_waitcnt lgkmcnt(0)" ::: "memory"); SBAR();   \
        o[d0] = __builtin_amdgcn_mfma_f32_32x32x16_bf16(pa0, (bf16x8){l0[0], l0[1], l0[2], l0[3], h0[0], h0[1], h0[2], h0[3]}, o[d0], 0, 0, 0);   \
        o[d0] = __builtin_amdgcn_mfma_f32_32x32x16_bf16(pa1, (bf16x8){l1[0], l1[1], l1[2], l1[3], h1[0], h1[1], h1[2], h1[3]}, o[d0], 0, 0, 0);   \
        o[d0] = __builtin_amdgcn_mfma_f32_32x32x16_bf16(pa2, (bf16x8){l2[0], l2[1], l2[2], l2[3], h2[0], h2[1], h2[2], h2[3]}, o[d0], 0, 0, 0);   \
        o[d0] = __builtin_amdgcn_mfma_f32_32x32x16_bf16(pa3, (bf16x8){l3[0], l3[1], l3[2], l3[3], h3[0], h3[1], h3[2], h3[3]}, o[d0], 0, 0, 0); } while (0)
    PV_D0(0); PV_D0(1); PV_D0(2); PV_D0(3);
#undef PV_D0
#undef TRRD
}
template <int LD, bool MASKED>
__device__ __forceinline__ void attn_block(const bf16* Q, const bf16* Kh, const bf16* Vh, bf16* O, int NT, int P0, const unsigned* maskbase, float ah, char* lds) {
    const int tid = threadIdx.x, wid = __builtin_amdgcn_readfirstlane(tid >> 6), lane = tid & 63, r32 = lane & 31, hi = lane >> 5;
    const int qlo = P0 + wid * QBLK, qm = qlo + r32 - 4 * hi;
    char* V_lds = lds; char* K_lds = lds + 2 * SHM_V;
    float* ws = (float*)(lds + 2 * SHM_V + 2 * SHM_K) + wid * 64; float* li_l = ws, * al_l = ws + 32;
    float m_reg = -1e30f, l_reg = 0; f32x16 o[4] = {};
    const int sr = tid >> 4, sc = (tid & 15) * 8, vst0 = v_st(sr, sc), vst1 = v_st(32 + sr, sc), kws = KSWZ(sr, sc * 2);
    const int vb0 = (int)(uintptr_t)V_lds + v_rd_base(lane);
    const unsigned* mrow = MASKED ? maskbase + (size_t)(qlo + r32) * 128 : nullptr;
    bf16x8 qr[8], st_v0, st_v1, st_k0, st_k1;
#define ROW(p, k0, rr) ((p) + (size_t)((k0) + (rr)) * LD + sc)
#define VMW() asm volatile("s_waitcnt vmcnt(0)" ::: "memory")
#define SLOAD_H(k0) do { st_v0 = load8(ROW(Vh, k0, sr)); st_v1 = load8(ROW(Vh, k0, 32 + sr)); st_k0 = load8(ROW(Kh, k0, sr)); st_k1 = load8(ROW(Kh, k0, 32 + sr)); } while (0)
#define SWRITE_HK(bf) do { *(bf16x8*)(K_lds + (bf) * SHM_K + kws) = st_k0; *(bf16x8*)(K_lds + (bf) * SHM_K + kws + 32 * 256) = st_k1; } while (0)
#define SWRITE_HV(bf) do { *(bf16x8*)(V_lds + (bf) * SHM_V + vst0) = st_v0; *(bf16x8*)(V_lds + (bf) * SHM_V + vst1) = st_v1; } while (0)
#define SWRITE_H(bf) do { SWRITE_HV(bf); SWRITE_HK(bf); } while (0)
#define RESC(a) do { if (__any((a) < 1.f)) { if (hi == 0) al_l[r32] = (a); asm volatile("s_waitcnt lgkmcnt(0)" ::: "memory");              \
                     for (int d_ = 0; d_ < 4; ++d_) for (int r = 0; r < 16; ++r) o[d_][r] *= al_l[crow(r, hi)]; } } while (0)
#define KBASE(t) ((t) * KVBLK)
#define MLOAD(dst, t) do { if (MASKED) dst = *(const u32x2*)(mrow + 2 * (t)); } while (0)
#define MASKT(P0_, P1_, mw_, t) do { if (MASKED) mask_alibi(P0_, P1_, mw_, qm - KBASE(t), hi, ah); } while (0)
#pragma unroll
    for (int d0 = 0; d0 < 8; ++d0) qr[d0] = load8(Q + (size_t)(wid * QBLK + r32) * LD + d0 * 16 + hi * 8);
    SLOAD_H(0); VMW(); SWRITE_HK(0);
    __syncthreads();
    f32x16 pA0, pA1, pB0, pB1; float mnA, mnB, alA, alB; bf16x8 pa0, pa1, pa2, pa3;
    u32x2 mwA = {0u, 0u}, mwB = {0u, 0u};
    SWRITE_HV(0); SBAR();
    MLOAD(mwA, 0);
    if (NT > 1) SLOAD_H(KBASE(1));
    SBAR(); qkt<0>(pA0, pA1, K_lds, r32, hi, qr);
    MASKT(pA0, pA1, mwA, 0); partialSM(pA0, pA1, m_reg, mnA, alA);
    if (NT > 1) { VMW(); SWRITE_H(1); }
    __syncthreads();
#define HALF_STEP(PX0, PX1, mwX, mnX, alX, PY0, PY1, alY, t, KB, VB, SB) do {                                                 \
        SBAR(); MLOAD(mwX, t); qkt<KB>(PX0, PX1, K_lds, r32, hi, qr);                                                         \
        finishSM(PY0, PY1, alY, l_reg, pa0, pa1, pa2, pa3); SBAR();                                                           \
        if ((t) + 1 < NT) { SLOAD_H(KBASE((t) + 1)); SBAR(); }                                                                \
        pv_tile<VB>(o, vb0, pa0, pa1, pa2, pa3); MASKT(PX0, PX1, mwX, (t)); partialSM(PX0, PX1, m_reg, mnX, alX);             \
        __syncthreads();                                                                                                      \
        if ((t) + 1 < NT) { VMW(); SWRITE_H(SB); }                                                                            \
        RESC(alX); __syncthreads(); } while (0)
    for (int t = 1; t + 1 < NT; t += 2) {
        HALF_STEP(pB0, pB1, mwB, mnB, alB, pA0, pA1, alA, t, 1, 0, 0);
        HALF_STEP(pA0, pA1, mwA, mnA, alA, pB0, pB1, alB, t + 1, 0, 1, 1);
    }
    const bool even = (NT & 1) == 0;
    if (even) { SBAR(); MLOAD(mwB, NT - 1); qkt<1>(pB0, pB1, K_lds, r32, hi, qr); SBAR(); }
    finishSM(pA0, pA1, alA, l_reg, pa0, pa1, pa2, pa3); SBAR();
    pv_tile<0>(o, vb0, pa0, pa1, pa2, pa3);
    if (even) { MASKT(pB0, pB1, mwB, NT - 1); partialSM(pB0, pB1, m_reg, mnB, alB); __syncthreads(); RESC(alB);
        finishSM(pB0, pB1, alB, l_reg, pa0, pa1, pa2, pa3); SBAR(); pv_tile<1>(o, vb0, pa0, pa1, pa2, pa3); }
    SBAR();
    if (hi == 0) li_l[r32] = l_reg; asm volatile("s_waitcnt lgkmcnt(0)" ::: "memory");
    float rli[16];
#pragma unroll
    for (int r = 0; r < 16; ++r) rli[r] = __builtin_amdgcn_rcpf(li_l[crow(r, hi)]);
    bf16* Ow = O + (size_t)(wid * QBLK) * LD;
#pragma unroll
    for (int r = 0; r < 16; ++r) { const int orow = crow(r, hi);
#pragma unroll
        for (int d0 = 0; d0 < 4; ++d0) { const float v = o[d0][r] * rli[r];
            const float vn = __shfl_xor(v, 1);
            if ((r32 & 1) == 0) *(unsigned*)(Ow + (size_t)orow * LD + d0 * 32 + r32) = cvtpk(v, vn); } }
    __syncthreads();
#undef ROW
#undef VMW
#undef SLOAD_H
#undef SWRITE_HK
#undef SWRITE_HV
#undef SWRITE_H
#undef RESC
#undef KBASE
#undef MLOAD
#undef MASKT
#undef HALF_STEP
}
#undef KSWZ
#undef SBAR
}

constexpr int NWAVES = 8;
constexpr int BATCH = 2, SEQ = 4096, DM = 2048, T = BATCH * SEQ, FF = 5632, NUP = 2 * FF;
constexpr int NIN = 11344, NIN_PAD = 11520;
constexpr int MEMLEN = 256, TOPK = 256;
constexpr float ALPHA = 1.189207115002721f;
constexpr float LN_EPS = 1e-5f;
constexpr int N_PHASES = 13;

constexpr size_t WS_CTL = 0, CTL_ZERO_BYTES = 1u << 20;
constexpr size_t WS_BIG = 1u << 20;
constexpr size_t O_X16 = 0, O_WUP1 = O_X16 + (size_t)T * DM * 2, O_WDN1 = O_WUP1 + (size_t)NUP * DM * 2, O_G = O_WDN1 + (size_t)DM * FF * 2, BIG_BYTES = O_G + (size_t)T * FF * 2;
constexpr size_t O_Q = 0, O_K = O_Q + (size_t)T * 1024 * 2, O_V = O_K + (size_t)T * 1024 * 2, O_QI = O_V + (size_t)T * 1024 * 2, O_KI = O_QI + (size_t)T * 1024 * 2,
                 O_WI = O_KI + (size_t)T * 64 * 2, O_U = O_WI + (size_t)T * 16 * 4, O_QM = O_U + (size_t)T * 512 * 2, O_GATE = O_QM + (size_t)T * 512 * 2, O_MIXEND = O_GATE + (size_t)T * 6144 * 2;
static_assert(O_MIXEND <= BIG_BYTES, "mixer view fits");
constexpr size_t WS_WIN = WS_BIG + BIG_BYTES;
constexpr size_t WS_WMKV = WS_WIN + (size_t)NIN_PAD * DM * 2;
constexpr size_t WS_WBA = WS_WMKV + (size_t)1024 * DM * 2;
constexpr size_t WS_WBP = WS_WBA + (size_t)DM * 1024 * 2;
constexpr size_t WS_WBM = WS_WBP + (size_t)DM * 512 * 2;
constexpr size_t WS_WOUT = WS_WBM + (size_t)DM * 512 * 2;
constexpr size_t WS_WUP2 = WS_WOUT + (size_t)DM * DM * 2;
constexpr size_t WS_WDN2 = WS_WUP2 + (size_t)NUP * DM * 2;
constexpr size_t WS_WPOOL = WS_WDN2 + (size_t)DM * FF * 2;
constexpr size_t WS_H1 = WS_WPOOL + (size_t)4 * 128 * 128 * 2;
constexpr size_t WS_MEM16 = WS_H1 + (size_t)T * DM * 2;
constexpr size_t WS_A16 = WS_MEM16 + (size_t)512 * DM * 2;
constexpr size_t WS_P16 = WS_A16 + (size_t)T * 1024 * 2;
constexpr size_t WS_M16 = WS_P16 + (size_t)T * 512 * 2;
constexpr size_t WS_Y16 = WS_M16 + (size_t)T * 512 * 2;
constexpr size_t WS_KM = WS_Y16 + (size_t)T * DM * 2;
constexpr size_t WS_VM = WS_KM + (size_t)512 * 512 * 2;
constexpr size_t WS_MASK = WS_VM + (size_t)512 * 512 * 2;
constexpr size_t WS_END = WS_MASK + (size_t)T * 128 * 4;
constexpr int CW_BAR = 4096;

constexpr int RING_OFF = 0, RING_BYTES = 131072;
constexpr int LDSCTL_OFF = RING_BYTES, MISC_OFF = LDSCTL_OFF + 320;
constexpr int LDS_BYTES = 147456;

#define GAS __attribute__((address_space(1)))
#define LAS __attribute__((address_space(3)))
typedef unsigned short bf16;
typedef unsigned v4u __attribute__((ext_vector_type(4)));
typedef unsigned v2u __attribute__((ext_vector_type(2)));
typedef float f32x4 __attribute__((ext_vector_type(4)));
typedef float f32x16 __attribute__((ext_vector_type(16)));
typedef short bf16x8 __attribute__((ext_vector_type(8)));
#define LDS_WAIT() asm volatile("s_waitcnt lgkmcnt(0)" ::: "memory")
__device__ __forceinline__ unsigned f2bf(float f) { unsigned u = __builtin_bit_cast(unsigned, f); return (u + 0x7fffu + ((u >> 16) & 1u)) >> 16; }
__device__ __forceinline__ unsigned pk2(float lo, float hi) { return f2bf(lo) | (f2bf(hi) << 16); }

#define XB_TMO      128
#define XB_XCNT(j)  (256  + 64 * (j))
#define XB_XSUB(j)  (1280 + 64 * (j))
#define XB_XGEN(j)  (2304 + 64 * (j))
#define XB_TOP      3328
#define XB_TOPGEN   3392
#define XCD_BAR_WORDS 3456
#define XB_SPIN_CAP (1u << 22)
__device__ __forceinline__ unsigned xb_ld(unsigned* p)              { return __hip_atomic_load(p, __ATOMIC_RELAXED, __HIP_MEMORY_SCOPE_AGENT); }
__device__ __forceinline__ unsigned xb_add(unsigned* p, unsigned v) { return __hip_atomic_fetch_add(p, v, __ATOMIC_RELAXED, __HIP_MEMORY_SCOPE_AGENT); }
__device__ __forceinline__ unsigned xb_xcc_id() { return (unsigned)__builtin_amdgcn_s_getreg((3 << 11) | 20) & 0xFu; }
#define XB_SPIN(cond, bar) do { unsigned _sp = 0; while (cond) { __builtin_amdgcn_s_sleep(1); \
    if ((++_sp & 255u) == 0u) { if (xb_ld(&(bar)[XB_TMO])) break; if (_sp > XB_SPIN_CAP) { atomicAdd(&(bar)[XB_TMO], 1u); break; } } } } while (0)
struct XcdBarrier { unsigned* bar; unsigned x; volatile LAS unsigned* st; };
__device__ __forceinline__ XcdBarrier xcd_barrier_post(unsigned* bar, volatile LAS unsigned* st) {
    XcdBarrier b; b.bar = bar; b.x = xb_xcc_id(); b.st = st;
    if (threadIdx.x == 0) (void)xb_add(&bar[XB_XCNT(b.x)], 1u);
    return b;
}
__device__ __forceinline__ void xcd_barrier_complete(unsigned* bar, unsigned x, unsigned& nloc, unsigned& nx) {
    const unsigned G = gridDim.x * gridDim.y * gridDim.z;
    unsigned sum, cnt, mine, sp = 0u;
    for (;;) {
        sum = 0u; cnt = 0u; mine = 0u;
#pragma unroll
        for (unsigned j = 0; j < 16; ++j) { const unsigned c = xb_ld(&bar[XB_XCNT(j)]); sum += c; cnt += (c > 0u) ? 1u : 0u; mine = (j == x) ? c : mine; }
        if (sum == G) break;
        __builtin_amdgcn_s_sleep(1);
        if ((++sp & 255u) == 0u) { if (xb_ld(&bar[XB_TMO])) break; if (sp > XB_SPIN_CAP) { atomicAdd(&bar[XB_TMO], 1u); break; } }
    }
    nloc = mine > 0u ? mine : 1u; nx = cnt > 0u ? cnt : 1u;
}
__device__ __forceinline__ void xcd_barrier(const XcdBarrier& b) {
    asm volatile("s_waitcnt vmcnt(0)" ::: "memory");
    __syncthreads();
    if (threadIdx.x == 0) {
        unsigned* bar = b.bar;
        __builtin_amdgcn_s_waitcnt(0);
        unsigned nloc = b.st[0], nx = b.st[1];
        if (nloc == 0u) { xcd_barrier_complete(bar, b.x, nloc, nx); b.st[0] = nloc; b.st[1] = nx; }
        const unsigned old = xb_add(&bar[XB_XSUB(b.x)], 1u);
        const unsigned gen = old / nloc;
        if (old + 1u == (gen + 1u) * nloc) {
            __builtin_amdgcn_fence(__ATOMIC_RELEASE, "agent");
            asm volatile("s_waitcnt vmcnt(0)" ::: "memory");
            const unsigned og = xb_add(&bar[XB_TOP], 1u);
            const unsigned tg = og / nx;
            if (og + 1u == (tg + 1u) * nx) xb_add(&bar[XB_TOPGEN], 1u);
            else XB_SPIN(xb_ld(&bar[XB_TOPGEN]) == tg, bar);
            __builtin_amdgcn_fence(__ATOMIC_ACQUIRE, "agent");
            xb_add(&bar[XB_XGEN(b.x)], 1u);
            asm volatile("s_waitcnt vmcnt(0)" ::: "memory");
        } else {
            XB_SPIN(xb_ld(&bar[XB_XGEN(b.x)]) == gen, bar);
            __builtin_amdgcn_fence(__ATOMIC_ACQUIRE, "agent");
            asm volatile("s_waitcnt vmcnt(0)" ::: "memory");
        }
    }
    __syncthreads();
}

__device__ __forceinline__ float wave_sum(float v) {
#pragma unroll
    for (int o = 1; o < 64; o <<= 1) v += __shfl_xor(v, o);
    return v;
}
template <int MAP>
__device__ __forceinline__ void p0_transpose_item(const float* W, int K, int N, int NP, bf16* WT, LAS float* scr, int item, int lane) {
    const int nblk = NP / 32, kb = item / nblk, nb = item % nblk, k0 = 64 * kb, np0 = 32 * nb;
    int n0 = np0; int nvalid = 32;
    if (MAP == 1) n0 = ((np0 >> 7) & 1) * FF + (np0 >> 8) * 128 + (np0 & 127);
    if (MAP == 2) { if (np0 < 4096) n0 = np0; else if (np0 < 4352) { n0 = np0; nvalid = 4176 - np0; nvalid = nvalid < 0 ? 0 : (nvalid > 32 ? 32 : nvalid); } else n0 = np0 - 176; }
    float v[32];
    const bool ok = (lane & 31) < nvalid;
#pragma unroll
    for (int i = 0; i < 32; ++i) { const int kk = 2 * i + (lane >> 5); v[i] = ok ? W[(size_t)(k0 + kk) * N + n0 + (lane & 31)] : 0.f; }
#pragma unroll
    for (int i = 0; i < 32; ++i) { const int kk = 2 * i + (lane >> 5); scr[kk * 33 + (lane & 31)] = v[i]; }
    LDS_WAIT(); asm volatile("" ::: "memory");
    const int c = lane & 7;
#pragma unroll
    for (int j = 0; j < 4; ++j) { const int n = (lane >> 3) + 8 * j; const LAS float* s = scr + (8 * c) * 33 + n;
        v4u o; o.x = pk2(s[0 * 33], s[1 * 33]); o.y = pk2(s[2 * 33], s[3 * 33]); o.z = pk2(s[4 * 33], s[5 * 33]); o.w = pk2(s[6 * 33], s[7 * 33]);
        *(GAS v4u*)(WT + (size_t)(np0 + n) * K + k0 + 8 * c) = o; }
    LDS_WAIT(); asm volatile("" ::: "memory");
}
template <bool OUT_BF16>
__device__ __forceinline__ void ln_row(const float* xrow, const float* gam, const float* bet, void* orow, int lane) {
    const GAS f32x4* xr = (const GAS f32x4*)xrow + lane;
    f32x4 v[8]; float s = 0.f;
#pragma unroll
    for (int j = 0; j < 8; ++j) { v[j] = xr[64 * j]; s += (v[j].x + v[j].y) + (v[j].z + v[j].w); }
    const float mean = wave_sum(s) * (1.f / DM); float s2 = 0.f;
#pragma unroll
    for (int j = 0; j < 8; ++j) { v[j] = v[j] - mean; s2 += (v[j].x * v[j].x + v[j].y * v[j].y) + (v[j].z * v[j].z + v[j].w * v[j].w); }
    const float rstd = 1.f / sqrtf(wave_sum(s2) * (1.f / DM) + LN_EPS);
#pragma unroll
    for (int j = 0; j < 8; ++j) {
        const f32x4 gg = ((const GAS f32x4*)gam)[lane + 64 * j], bb = ((const GAS f32x4*)bet)[lane + 64 * j];
        const f32x4 y = v[j] * rstd * gg + bb;
        if (OUT_BF16) { ((GAS v2u*)orow)[lane + 64 * j] = (v2u){pk2(y.x, y.y), pk2(y.z, y.w)}; }
        else ((GAS f32x4*)orow)[lane + 64 * j] = y;
    }
}

__device__ __forceinline__ unsigned ordkey(float s) { const unsigned u = __float_as_uint(s); return u ^ ((unsigned)((int)u >> 31) | 0x80000000u); }
__device__ __forceinline__ void indexer_unit(LAS unsigned char* lds, int b, int uidx, const bf16* QI16, const bf16* KI16, const float* WI, unsigned* MASKQ) {
    const int tid = threadIdx.x, lane = tid & 63, wid = __builtin_amdgcn_readfirstlane(tid >> 6), r = lane & 31, h = lane >> 5;
    const int q0 = uidx * 16 + 2 * wid, tq = q0 + h;
    const int nchunk = ((uidx * 16 + 15) >> 8) + 1;
    bf16x8 aq[4];
    { const int qa = q0 + ((r >> 2) & 1), head = (r & 3) + 4 * (r >> 3);
      const bf16* qp = QI16 + (size_t)(b * SEQ + qa) * 1024 + head * 64 + 8 * h;
#pragma unroll
      for (int ks = 0; ks < 4; ++ks) aq[ks] = *(const GAS bf16x8*)(qp + ks * 16); }
    float w[16];
    { const GAS f32x4* wp = (const GAS f32x4*)(WI + (size_t)(b * SEQ + tq) * 16);
#pragma unroll
      for (int i = 0; i < 4; ++i) { const f32x4 t = wp[i]; w[4 * i] = t.x; w[4 * i + 1] = t.y; w[4 * i + 2] = t.z; w[4 * i + 3] = t.w; } }
    unsigned key[128];
    const char* kbase = (const char*)(KI16 + (size_t)(b * SEQ) * 64);
    unsigned soff[4];
#pragma unroll
    for (int i = 0; i < 4; ++i) { const int kk = (wid * 4 + i) * 8 + (lane >> 3), cs = lane & 7; soff[i] = (unsigned)(kk * 128 + ((cs ^ ((kk >> 1) & 7)) << 4)); }
#define IDX_STAGE(c_) do { _Pragma("unroll") for (int i = 0; i < 4; ++i) \
        __builtin_amdgcn_global_load_lds((const unsigned*)(kbase + (size_t)(c_) * 32768 + soff[i]), (LAS unsigned*)(lds + ((c_) & 1) * 32768 + (wid * 4 + i) * 1024), 16, 0, 0); } while (0)
    const int x = (r >> 1) & 7;
    int roff[4];
#pragma unroll
    for (int ks = 0; ks < 4; ++ks) roff[ks] = r * 128 + (((2 * ks + h) ^ x) << 4);
    __syncthreads();
    IDX_STAGE(0);
#pragma unroll
    for (int c = 0; c < 16; ++c) {
        if (c < nchunk) {
            asm volatile("s_waitcnt vmcnt(0)" ::: "memory");
            __syncthreads();
            if (c + 1 < nchunk) IDX_STAGE(c + 1);
#pragma unroll
            for (int jj = 0; jj < 8; ++jj) {
                const int j = c * 8 + jj;
                f32x16 acc = {};
#pragma unroll
                for (int ks = 0; ks < 4; ++ks) { const bf16x8 bk = *(const LAS bf16x8*)(lds + (c & 1) * 32768 + jj * 4096 + roff[ks]);
                    acc = __builtin_amdgcn_mfma_f32_32x32x16_bf16(aq[ks], bk, acc, 0, 0, 0); }
                float s = 0.f;
#pragma unroll
                for (int i = 0; i < 16; ++i) s = fmaf(w[i], fmaxf(acc[i], 0.f), s);
                unsigned kj = (j * 32 + r <= tq) ? ordkey(s) : 0u;
                asm volatile("" : "+v"(kj));
                key[j] = kj;
                __builtin_amdgcn_sched_barrier(0);
            }
        } else {
#pragma unroll
            for (int jj = 0; jj < 8; ++jj) key[c * 8 + jj] = 0u;
        }
    }
#undef IDX_STAGE
    unsigned thr = 1u;
    {
        unsigned lo = 0u, hi = 0xFFFFFFFFu; bool done = (tq + 1 <= TOPK);
        while (!__all(done)) {
            const unsigned mid = lo + ((hi - lo) >> 1);
            int cnt = 0;
#pragma unroll
            for (int j = 0; j < 128; ++j) cnt += (key[j] >= mid) ? 1 : 0;
#pragma unroll
            for (int o = 1; o < 32; o <<= 1) cnt += __shfl_xor(cnt, o);
            if (!done) {
                if (cnt >= TOPK) lo = mid; else hi = mid;
                if (cnt == TOPK) { thr = mid; done = true; }
                else if (hi - lo <= 1u) { thr = lo; done = true; }
            }
        }
    }
    LAS unsigned* mb = (LAS unsigned*)(lds + 65536) + wid * 256;
#pragma unroll
    for (int j = 0; j < 128; ++j) {
        const unsigned long long bal = __ballot(key[j] >= thr);
        const unsigned val = h ? (unsigned)(bal >> 32) : (unsigned)bal;
        if (r == 0) mb[h * 128 + j] = val;
        asm volatile("" ::: "memory");
    }
    LDS_WAIT(); asm volatile("" ::: "memory");
    GAS unsigned* mp = (GAS unsigned*)(MASKQ + (size_t)(b * SEQ + q0) * 128);
#pragma unroll
    for (int i = 0; i < 4; ++i) mp[64 * i + lane] = mb[64 * i + lane];
    LDS_WAIT(); asm volatile("" ::: "memory");
}

__device__ __forceinline__ void pool_task(int task, const bf16* U16, const bf16* WPT, const float* pscale, bf16* P16, int lane) {
    const int tile = task >> 2, g = task & 3, r = lane & 31, h = lane >> 5;
    const int tk = tile * 32 + r, pos = tk & (SEQ - 1), wlen = 2 << g;
    const int cnt = (pos + 1 < wlen) ? pos + 1 : wlen;
    const float rc = 1.0f / (float)cnt;
    bf16x8 pa[8];
#pragma unroll
    for (int ks = 0; ks < 8; ++ks) {
        const bf16* up = U16 + (size_t)tk * 512 + g * 128 + ks * 16 + 8 * h;
        float sum[8], self[8];
#pragma unroll
        for (int e = 0; e < 8; ++e) sum[e] = 0.f;
        for (int i = 0; i < wlen; ++i) {
            if (i < cnt) { const v4u t = *(const GAS v4u*)(up - (size_t)i * 512);
                const float f0 = pg8::bf_lo(t.x), f1 = pg8::bf_hi(t.x), f2 = pg8::bf_lo(t.y), f3 = pg8::bf_hi(t.y), f4 = pg8::bf_lo(t.z), f5 = pg8::bf_hi(t.z), f6 = pg8::bf_lo(t.w), f7 = pg8::bf_hi(t.w);
                if (i == 0) { self[0] = f0; self[1] = f1; self[2] = f2; self[3] = f3; self[4] = f4; self[5] = f5; self[6] = f6; self[7] = f7; }
                sum[0] += f0; sum[1] += f1; sum[2] += f2; sum[3] += f3; sum[4] += f4; sum[5] += f5; sum[6] += f6; sum[7] += f7; }
        }
        v4u o; o.x = pk2(sum[0] * rc - self[0], sum[1] * rc - self[1]); o.y = pk2(sum[2] * rc - self[2], sum[3] * rc - self[3]);
        o.z = pk2(sum[4] * rc - self[4], sum[5] * rc - self[5]); o.w = pk2(sum[6] * rc - self[6], sum[7] * rc - self[7]);
        pa[ks] = __builtin_bit_cast(bf16x8, o);
    }
#pragma unroll
    for (int nb = 0; nb < 4; ++nb) {
        f32x16 acc = {};
        const bf16* wp = WPT + (size_t)g * 16384 + (size_t)(nb * 32 + r) * 128 + 8 * h;
#pragma unroll
        for (int ks = 0; ks < 8; ++ks) { const bf16x8 bk = *(const GAS bf16x8*)(wp + ks * 16); acc = __builtin_amdgcn_mfma_f32_32x32x16_bf16(pa[ks], bk, acc, 0, 0, 0); }
        const int col = g * 128 + nb * 32 + r; const float ps = pscale[col];
#pragma unroll
        for (int i = 0; i < 16; ++i) { const int tok = tile * 32 + (i & 3) + 8 * (i >> 2) + 4 * h; P16[(size_t)tok * 512 + col] = (bf16)f2bf(acc[i] * ps); }
    }
}

struct Args { const float* in[21]; float* out; unsigned char* ws; int ph_lo, ph_hi; };
__global__ void __launch_bounds__(NWAVES * 64, 2) mk_fwd(Args args) {
    extern __shared__ __attribute__((aligned(16))) unsigned char lds[];
    LAS unsigned char* L = (LAS unsigned char*)lds;
    volatile LAS unsigned* MISC = (volatile LAS unsigned*)(L + MISC_OFF);
    const int tid = threadIdx.x, lane = tid & 63, wave = __builtin_amdgcn_readfirstlane(tid >> 6);
    const int G = gridDim.x, bx = blockIdx.x;
    const int vcu = (G % 8 == 0) ? (bx % 8) * (G / 8) + bx / 8 : bx;
    const int gw = vcu * NWAVES + wave, NGW = G * NWAVES;
    unsigned char* ws = args.ws;
    for (int u = tid; u < (LDS_BYTES - LDSCTL_OFF) / 4; u += NWAVES * 64) ((LAS unsigned*)(L + LDSCTL_OFF))[u] = 0u;
    __syncthreads();
    XcdBarrier bar; bar.bar = (unsigned*)(ws + WS_CTL) + CW_BAR; bar.x = 0; bar.st = nullptr;
    if (!MK_PER_PHASE) bar = xcd_barrier_post((unsigned*)(ws + WS_CTL) + CW_BAR, MISC + 8);
    const int lo = args.ph_lo, hi = args.ph_hi;
#ifndef PH_MASK
#define PH_MASK 0x1FFF
#endif
#define IN(k) (((PH_MASK >> (k)) & 1) && lo <= (k) && (k) < hi)
#define SEAM(k) do { if (IN(k) && IN((k) + 1)) xcd_barrier(bar); } while (0)
    const float* x = args.in[0]; const float* mem = args.in[1];
    bf16* BIG = (bf16*)(ws + WS_BIG);
    bf16 *X16 = (bf16*)(ws + WS_BIG + O_X16), *WUP1 = (bf16*)(ws + WS_BIG + O_WUP1), *WDN1 = (bf16*)(ws + WS_BIG + O_WDN1), *Gb = (bf16*)(ws + WS_BIG + O_G);
    bf16 *Q16 = (bf16*)(ws + WS_BIG + O_Q), *K16 = (bf16*)(ws + WS_BIG + O_K), *V16 = (bf16*)(ws + WS_BIG + O_V), *QI16 = (bf16*)(ws + WS_BIG + O_QI), *KI16 = (bf16*)(ws + WS_BIG + O_KI);
    float* WI = (float*)(ws + WS_BIG + O_WI);
    bf16 *U16 = (bf16*)(ws + WS_BIG + O_U), *QM16 = (bf16*)(ws + WS_BIG + O_QM), *GATE = (bf16*)(ws + WS_BIG + O_GATE);
    bf16 *WIN = (bf16*)(ws + WS_WIN), *WMKV = (bf16*)(ws + WS_WMKV), *WBA = (bf16*)(ws + WS_WBA), *WBP = (bf16*)(ws + WS_WBP), *WBM = (bf16*)(ws + WS_WBM), *WOUT = (bf16*)(ws + WS_WOUT);
    bf16 *WUP2 = (bf16*)(ws + WS_WUP2), *WDN2 = (bf16*)(ws + WS_WDN2), *WPT = (bf16*)(ws + WS_WPOOL);
    bf16 *H1 = (bf16*)(ws + WS_H1), *MEM16 = (bf16*)(ws + WS_MEM16), *A16 = (bf16*)(ws + WS_A16), *P16 = (bf16*)(ws + WS_P16), *M16 = (bf16*)(ws + WS_M16), *H2 = (bf16*)(ws + WS_A16);
    bf16 *Y16 = (bf16*)(ws + WS_Y16), *KM = (bf16*)(ws + WS_KM), *VM = (bf16*)(ws + WS_VM);
    unsigned* MASKQ = (unsigned*)(ws + WS_MASK);
    float* R = args.out;
    (void)BIG;

    if (IN(0)) {
        LAS float* scr = (LAS float*)(L + RING_OFF + wave * 16384);
        constexpr int I_UP = (DM / 64) * (NUP / 32), I_DN = (FF / 64) * (DM / 32), I_IN = (DM / 64) * (NIN_PAD / 32), I_MKV = (DM / 64) * (1024 / 32), I_BA = (1024 / 64) * (DM / 32),
                      I_BP = (512 / 64) * (DM / 32), I_OUT = (DM / 64) * (DM / 32), I_PL = (128 / 64) * (128 / 32);
        constexpr int NITEMS = 2 * I_UP + 2 * I_DN + I_IN + I_MKV + I_BA + 2 * I_BP + I_OUT + 4 * I_PL;
        for (int it = gw; it < NITEMS; it += NGW) {
            int r = it;
            if (r < I_UP) { p0_transpose_item<1>(args.in[2], DM, NUP, NUP, WUP1, scr, r, lane); continue; } r -= I_UP;
            if (r < I_DN) { p0_transpose_item<0>(args.in[3], FF, DM, DM, WDN1, scr, r, lane); continue; } r -= I_DN;
            if (r < I_IN) { p0_transpose_item<2>(args.in[6], DM, NIN, NIN_PAD, WIN, scr, r, lane); continue; } r -= I_IN;
            if (r < I_MKV) { p0_transpose_item<0>(args.in[8], DM, 1024, 1024, WMKV, scr, r, lane); continue; } r -= I_MKV;
            if (r < I_BA) { p0_transpose_item<0>(args.in[11], 1024, DM, DM, WBA, scr, r, lane); continue; } r -= I_BA;
            if (r < I_BP) { p0_transpose_item<0>(args.in[12], 512, DM, DM, WBP, scr, r, lane); continue; } r -= I_BP;
            if (r < I_BP) { p0_transpose_item<0>(args.in[13], 512, DM, DM, WBM, scr, r, lane); continue; } r -= I_BP;
            if (r < I_OUT) { p0_transpose_item<0>(args.in[14], DM, DM, DM, WOUT, scr, r, lane); continue; } r -= I_OUT;
            if (r < I_UP) { p0_transpose_item<1>(args.in[17], DM, NUP, NUP, WUP2, scr, r, lane); continue; } r -= I_UP;
            if (r < I_DN) { p0_transpose_item<0>(args.in[18], FF, DM, DM, WDN2, scr, r, lane); continue; } r -= I_DN;
            { const int g = r / I_PL; p0_transpose_item<0>(args.in[9] + (size_t)g * 16384, 128, 128, 128, WPT + (size_t)g * 16384, scr, r % I_PL, lane); }
        }
        for (size_t i = (size_t)gw * 64 + lane; i < (size_t)T * DM / 8; i += (size_t)NGW * 64) {
            const f32x4 a = ((const GAS f32x4*)x)[2 * i], c = ((const GAS f32x4*)x)[2 * i + 1];
            ((GAS v4u*)X16)[i] = (v4u){pk2(a.x, a.y), pk2(a.z, a.w), pk2(c.x, c.y), pk2(c.z, c.w)};
        }
        for (size_t i = (size_t)gw * 64 + lane; i < (size_t)512 * DM / 8; i += (size_t)NGW * 64) {
            const f32x4 a = ((const GAS f32x4*)mem)[2 * i], c = ((const GAS f32x4*)mem)[2 * i + 1];
            ((GAS v4u*)MEM16)[i] = (v4u){pk2(a.x, a.y), pk2(a.z, a.w), pk2(c.x, c.y), pk2(c.z, c.w)};
        }
    }
    SEAM(0);
    if (IN(1)) {
        pg8::Gemm g{X16, WUP1, T, NUP, DM}; pg8::StaticOrder S; S.init(T, NUP, G, bx);
        pg8::EpiSwiglu E{Gb, FF};
        pg8::gemm_phase<pg8::EpiSwiglu, pg8::StaticOrder, true, true>(L + RING_OFF, g, S, E);
    }
    SEAM(1);
    if (IN(2)) {
        pg8::Gemm g{Gb, WDN1, T, DM, FF}; pg8::StaticOrder S; S.init(T, DM, G, bx);
        pg8::EpiRes<false> E{R, x, DM, ALPHA, 0.5f};
        pg8::gemm_phase<pg8::EpiRes<false>, pg8::StaticOrder, true, true>(L + RING_OFF, g, S, E);
    }
    SEAM(2);
    if (IN(3)) { for (int m = gw; m < T; m += NGW) ln_row<true>(R + (size_t)m * DM, args.in[4], args.in[5], H1 + (size_t)m * DM, lane); }
    SEAM(3);
    if (IN(4)) {
        pg8::Gemm g{H1, WIN, T, NIN_PAD, DM}; pg8::OrderZ S; S.so.init(T, NIN_PAD, G, bx);
        pg8::EpiZ E{Q16, K16, V16, QI16, KI16, U16, QM16, GATE, KM, VM, WI, args.in[7]};
        pg8::gemm_phase<pg8::EpiZ, pg8::OrderZ, true, true>(L + RING_OFF, g, S, E);
    }
    SEAM(4);
    if (IN(5)) {
        for (int task = gw; task < 1024; task += NGW) pool_task(task, U16, WPT, args.in[10], P16, lane);
        for (int pp = vcu; pp < 256; pp += G) {
            const int b = pp >> 7, p = pp & 127;
#pragma unroll 1
            for (int k2 = 0; k2 < 2; ++k2) indexer_unit(L + RING_OFF, b, k2 ? 255 - p : p, QI16, KI16, WI, MASKQ);
        }
        __syncthreads();
    }
    SEAM(5);
    if (IN(6)) {
        const int xcd = bx & 7, ix = bx >> 3;
        if (ix < 32) {
            const int bh = xcd * 2 + (ix >> 4), qb = ix & 15, b = bh >> 3, hh = bh & 7;
            const size_t rowbase = (size_t)b * SEQ;
            const float ah = exp2f(-(float)(hh + 1)) * 11.313708498984761f;
            att::attn_block<1024, true>((const att::bf16*)(Q16 + (rowbase + qb * 256) * 1024 + hh * 128), (const att::bf16*)(K16 + rowbase * 1024 + hh * 128),
                                        (const att::bf16*)(V16 + rowbase * 1024 + hh * 128), (att::bf16*)(A16 + (rowbase + qb * 256) * 1024 + hh * 128),
                                        4 * (qb + 1), qb * 256, MASKQ + rowbase * 128, ah, (char*)lds + RING_OFF);
            if (qb < 8) { const int mi = bh * 8 + qb;
                const int mb = mi >> 6, mh = (mi >> 4) & 3, mq = mi & 15; const size_t mrow = (size_t)mb * SEQ + mq * 256;
                att::attn_block<512, false>((const att::bf16*)(QM16 + mrow * 512 + mh * 128), (const att::bf16*)(KM + (size_t)mb * MEMLEN * 512 + mh * 128),
                                            (const att::bf16*)(VM + (size_t)mb * MEMLEN * 512 + mh * 128), (att::bf16*)(M16 + mrow * 512 + mh * 128),
                                            MEMLEN / 64, 0, nullptr, 0.f, (char*)lds + RING_OFF); }
        }
    }
    SEAM(6);
    if (IN(7)) {
        pg8::StaticOrder S; S.init(T, DM, G, bx);
        { pg8::Gemm g{A16, WBA, T, DM, 1024}; pg8::EpiBranch<0> E{R, Y16, GATE}; pg8::gemm_phase<pg8::EpiBranch<0>, pg8::StaticOrder, true, true>(L + RING_OFF, g, S, E); }
        { pg8::Gemm g{P16, WBP, T, DM, 512}; pg8::EpiBranch<1> E{R, Y16, GATE}; pg8::gemm_phase<pg8::EpiBranch<1>, pg8::StaticOrder, true, true>(L + RING_OFF, g, S, E); }
        { pg8::Gemm g{M16, WBM, T, DM, 512}; pg8::EpiBranch<2> E{R, Y16, GATE}; pg8::gemm_phase<pg8::EpiBranch<2>, pg8::StaticOrder, true, true>(L + RING_OFF, g, S, E); }
    }
    SEAM(7);
    if (IN(8)) {
        pg8::Gemm g{Y16, WOUT, T, DM, DM}; pg8::StaticOrder S; S.init(T, DM, G, bx);
        pg8::EpiRes<true> E{R, H1, DM, ALPHA, 1.0f};
        pg8::gemm_phase<pg8::EpiRes<true>, pg8::StaticOrder, true, true>(L + RING_OFF, g, S, E);
    }
    SEAM(8);
    if (IN(9)) { for (int m = gw; m < T; m += NGW) ln_row<true>(R + (size_t)m * DM, args.in[15], args.in[16], H2 + (size_t)m * DM, lane); }
    SEAM(9);
    bf16* G2 = (bf16*)(ws + WS_BIG);
    if (IN(10)) {
        pg8::Gemm g{H2, WUP2, T, NUP, DM}; pg8::StaticOrder S; S.init(T, NUP, G, bx);
        pg8::EpiSwiglu E{G2, FF};
        pg8::gemm_phase<pg8::EpiSwiglu, pg8::StaticOrder, true, true>(L + RING_OFF, g, S, E);
    }
    SEAM(10);
    if (IN(11)) {
        pg8::Gemm g{G2, WDN2, T, DM, FF}; pg8::StaticOrder S; S.init(T, DM, G, bx);
        pg8::EpiRes<true> E{R, H2, DM, ALPHA, 0.5f};
        pg8::gemm_phase<pg8::EpiRes<true>, pg8::StaticOrder, true, true>(L + RING_OFF, g, S, E);
    }
    SEAM(11);
    if (IN(12)) { for (int m = gw; m < T; m += NGW) ln_row<false>(R + (size_t)m * DM, args.in[19], args.in[20], R + (size_t)m * DM, lane); }
#undef IN
#undef SEAM
}

extern "C" void kernel_launch(void* const* d_in, const int* in_sizes, int n_in, void* d_out, int out_size, void* d_ws, size_t ws_size, hipStream_t stream) {
    static int grid = 0;
    if (grid == 0) {
        if (n_in != 21 || in_sizes[0] != T * DM || out_size != T * DM || ws_size < WS_END) {
            fprintf(stderr, "kernel_launch: shape/workspace mismatch (n_in %d, in0 %d, out %d, ws %zu, need %zu); nothing launched\n", n_in, n_in > 0 ? in_sizes[0] : -1, out_size, ws_size, (size_t)WS_END);
            grid = -1; return; }
        int dev = 0, cus = 0;
        if (hipGetDevice(&dev) != hipSuccess || hipDeviceGetAttribute(&cus, hipDeviceAttributeMultiprocessorCount, dev) != hipSuccess) { grid = -1; return; }
        if (hipFuncSetAttribute((const void*)mk_fwd, hipFuncAttributeMaxDynamicSharedMemorySize, LDS_BYTES) != hipSuccess) { fprintf(stderr, "kernel_launch: hipFuncSetAttribute failed\n"); grid = -1; return; }
        (void)hipGetLastError();
        grid = cus;
        if (grid != 256) fprintf(stderr, "kernel_launch: %d CUs (built for 256)\n", grid);
    }
    if (grid < 0) return;
    if (hipMemsetAsync((char*)d_ws + WS_CTL, 0, CTL_ZERO_BYTES, stream) != hipSuccess) return;
    Args a{};
    for (int i = 0; i < 21; ++i) a.in[i] = (const float*)d_in[i];
    a.out = (float*)d_out; a.ws = (unsigned char*)d_ws;
#if MK_PER_PHASE
    for (int p = 0; p < N_PHASES; ++p) { a.ph_lo = p; a.ph_hi = p + 1; hipLaunchKernelGGL(mk_fwd, dim3(grid), dim3(NWAVES * 64), LDS_BYTES, stream, a); }
#else
    a.ph_lo = 0; a.ph_hi = N_PHASES;
    hipLaunchKernelGGL(mk_fwd, dim3(grid), dim3(NWAVES * 64), LDS_BYTES, stream, a);
#endif
}
```

```cpp
#include <hip/hip_runtime.h>
#include <hip/hip_bf16.h>
#include <cstdio>
#include <cstdint>

#ifndef MK_PER_PHASE
#define MK_PER_PHASE 0
#endif

namespace pg8 {
#define PG8_LAS __attribute__((address_space(3)))
typedef unsigned short bf16_t;
typedef short bf16x8 __attribute__((ext_vector_type(8)));
typedef float f32x4 __attribute__((ext_vector_type(4)));
typedef float f32x2 __attribute__((ext_vector_type(2)));
typedef unsigned u32x4 __attribute__((ext_vector_type(4)));
typedef unsigned u32x2 __attribute__((ext_vector_type(2)));
typedef int i32x4 __attribute__((ext_vector_type(4)));
template <bool I8> struct AccSel { typedef f32x4 type; };
template <> struct AccSel<true> { typedef i32x4 type; };
constexpr int BM = 256, BK = 64, HALF = 128, HTB = HALF * BK * 2, STAGE_BYTES = 8 * HTB, NXCD = 8, WGM = 8;

__host__ __device__ __forceinline__ int lds_byte(int r, int c) { const int st = (r >> 4) * 2 + (c >> 5), rr = r & 15, cc = c & 31, ob = rr * 64 + cc * 2; return st * 1024 + (ob ^ (((ob >> 9) & 1) << 5)); }
__host__ __device__ __forceinline__ void stage_rc(int b, int& R, int& C) { const int st = b / 1024, sb = b % 1024, swz = sb ^ (((sb >> 9) & 1) << 5); R = (st >> 1) * 16 + swz / 64; C = (st & 1) * 32 + (swz % 64) / 2; }
__host__ __device__ __forceinline__ int perm32(int rho) { const int n = rho >> 4, i = rho & 15; return 8 * (i >> 2) + 4 * n + (i & 3); }

struct Unit { int pm, pn; };
struct Gemm { const bf16_t* A; const bf16_t* Bt; int M, N, K; };

struct StaticOrder {
    int nM, nN, nwg, G, c;
    __host__ __device__ void init(int M, int N, int G_, int c_) { nM = M / BM; nN = N / BM; nwg = nM * nN; G = G_; c = c_; }
    __host__ __device__ bool next(int i, Unit& u) const {
        const long L = (long)i * G + c; if (L >= nwg) return false;
        int wgid = (int)L; { const int q = nwg / NXCD, r = nwg % NXCD, xcd = wgid % NXCD, off = wgid / NXCD; wgid = (xcd < r ? xcd * (q + 1) : r * (q + 1) + (xcd - r) * q) + off; }
        const int nig = WGM * nN, gid = wgid / nig, fm = gid * WGM, gsz = (nM - fm) < WGM ? (nM - fm) : WGM;
        u.pm = fm + ((wgid % nig) % gsz); u.pn = (wgid % nig) / gsz; return true;
    }
    __device__ __forceinline__ void a_ready(const Unit&) const {}
    __device__ __forceinline__ void done(const Unit&) const {}
};
struct OrderZ {
    StaticOrder so;
    __device__ __forceinline__ bool next(int i, Unit& u) const {
        const long L = (long)i * so.G + so.c;
        if (L < so.nwg) return so.next(i, u);
        if (L < so.nwg + 8) { const int e = (int)(L - so.nwg); u.pm = 32 + (e >> 2); u.pn = 45 + (e & 3); return true; }
        return false;
    }
    __device__ __forceinline__ void a_ready(const Unit&) const {}
    __device__ __forceinline__ void done(const Unit&) const {}
};

__device__ __forceinline__ unsigned cvt_pk_bf16(float lo, float hi) { unsigned r; asm volatile("v_cvt_pk_bf16_f32 %0, %1, %2" : "=v"(r) : "v"(lo), "v"(hi)); return r; }
__device__ __forceinline__ float bf_lo(unsigned w) { return __uint_as_float(w << 16); }
__device__ __forceinline__ float bf_hi(unsigned w) { return __uint_as_float(w & 0xffff0000u); }
__device__ __forceinline__ float sigmoidf_(float x) { return __builtin_amdgcn_rcpf(1.0f + __builtin_amdgcn_exp2f(-1.4426950408889634f * x)); }

struct EpiSwiglu {
    static constexpr bool PERM = true, AFTER_DRAIN = false;
    bf16_t* G; int ldg;
    __device__ __forceinline__ void operator()(const f32x4 (&acc)[2][2][4][2], const Unit& u, int wr, int wc, int fr, int fq) const {
        const int row0 = u.pm * BM + wr * 64 + fr, col0 = u.pn * HALF + wc * 32 + 8 * fq;
#pragma unroll
        for (int ai = 0; ai < 2; ++ai)
#pragma unroll
            for (int m = 0; m < 4; ++m) {
                bf16_t* rowp = G + (size_t)(row0 + ai * HALF + m * 16) * ldg + col0;
                float g[8];
#pragma unroll
                for (int n = 0; n < 2; ++n)
#pragma unroll
                    for (int e = 0; e < 4; ++e) { const float a = acc[ai][0][m][n][e], uu = acc[ai][1][m][n][e]; g[n * 4 + e] = a * uu * sigmoidf_(a); }
                u32x4 w; w.x = cvt_pk_bf16(g[0], g[1]); w.y = cvt_pk_bf16(g[2], g[3]); w.z = cvt_pk_bf16(g[4], g[5]); w.w = cvt_pk_bf16(g[6], g[7]);
                *(u32x4*)rowp = w;
            }
    }
};
struct EpiSwigluI8 {
    static constexpr bool PERM = true, AFTER_DRAIN = false;
    signed char* G; int ldg; const float* sx; const float* gq; const float* wdq;
    __device__ __forceinline__ void operator()(const i32x4 (&acc)[2][2][4][2], const Unit& u, int wr, int wc, int fr, int fq) const {
        const int row0 = u.pm * BM + wr * 64 + fr, col0 = u.pn * HALF + wc * 32 + 8 * fq;
        const float wd = *wdq;
#pragma unroll
        for (int ai = 0; ai < 2; ++ai)
#pragma unroll
            for (int m = 0; m < 4; ++m) {
                const int row = row0 + ai * HALF + m * 16;
                const float sa = sx[row] * wd, gm = gq[row];
                unsigned w[2];
#pragma unroll
                for (int n = 0; n < 2; ++n) { int q[4];
#pragma unroll
                    for (int e = 0; e < 4; ++e) { const float a = (float)acc[ai][0][m][n][e] * sa, uu = (float)acc[ai][1][m][n][e] * sa; const float g = a * uu * sigmoidf_(a);
                        q[e] = (int)__builtin_rintf(fminf(fmaxf(g * gm, -127.f), 127.f)); }
                    w[n] = (unsigned)(q[0] & 255) | ((unsigned)(q[1] & 255) << 8) | ((unsigned)(q[2] & 255) << 16) | ((unsigned)q[3] << 24); }
                *(u32x2*)(G + (size_t)row * ldg + col0) = (u32x2){w[0], w[1]};
            }
    }
};
template <bool RESBF> struct EpiResI8 {
    static constexpr bool PERM = false, AFTER_DRAIN = false;
    float* out; const void* res; int ldc; float alpha, sc; const float* sg; const float* wdq;
    __device__ __forceinline__ void operator()(const i32x4 (&acc)[2][2][4][2], const Unit& u, int wr, int wc, int fr, int fq) const {
        const int row0 = u.pm * BM + wr * 64 + fr, col0 = u.pn * BM + wc * 32 + 4 * fq;
        const float wd = *wdq * sc;
#pragma unroll
        for (int ai = 0; ai < 2; ++ai)
#pragma unroll
            for (int m = 0; m < 4; ++m) { const int row = row0 + ai * HALF + m * 16; const size_t off = (size_t)row * ldc + col0; const float s = sg[row] * wd;
#pragma unroll
                for (int bj = 0; bj < 2; ++bj)
#pragma unroll
                    for (int n = 0; n < 2; ++n) { const size_t o = off + bj * HALF + n * 16; f32x4 r;
                        if (RESBF) { const u32x2 w = *(const u32x2*)((const bf16_t*)res + o); r = (f32x4){bf_lo(w.x), bf_hi(w.x), bf_lo(w.y), bf_hi(w.y)}; }
                        else r = *(const f32x4*)((const float*)res + o);
                        const i32x4 a = acc[ai][bj][m][n];
                        *(f32x4*)(out + o) = r * alpha + (f32x4){(float)a[0], (float)a[1], (float)a[2], (float)a[3]} * s; } }
    }
};
template <bool RESBF> struct EpiRes {
    static constexpr bool PERM = false, AFTER_DRAIN = false;
    float* out; const void* res; int ldc; float alpha, sc;
    __device__ __forceinline__ void operator()(const f32x4 (&acc)[2][2][4][2], const Unit& u, int wr, int wc, int fr, int fq) const {
        const int row0 = u.pm * BM + wr * 64 + fr, col0 = u.pn * BM + wc * 32 + 4 * fq;
#pragma unroll
        for (int ai = 0; ai < 2; ++ai)
#pragma unroll
            for (int m = 0; m < 4; ++m) { const size_t off = (size_t)(row0 + ai * HALF + m * 16) * ldc + col0;
#pragma unroll
                for (int bj = 0; bj < 2; ++bj)
#pragma unroll
                    for (int n = 0; n < 2; ++n) { const size_t o = off + bj * HALF + n * 16; f32x4 r;
                        if (RESBF) { const u32x2 w = *(const u32x2*)((const bf16_t*)res + o); r = (f32x4){bf_lo(w.x), bf_hi(w.x), bf_lo(w.y), bf_hi(w.y)}; }
                        else r = *(const f32x4*)((const float*)res + o);
                        *(f32x4*)(out + o) = r * alpha + acc[ai][bj][m][n] * sc; } }
    }
};
template <int PASS> struct EpiBranch {
    static constexpr bool PERM = false, AFTER_DRAIN = false;
    float* Y; bf16_t* Y16; const bf16_t* gate;
    __device__ __forceinline__ void operator()(const f32x4 (&acc)[2][2][4][2], const Unit& u, int wr, int wc, int fr, int fq) const {
        const int row0 = u.pm * BM + wr * 64 + fr, col0 = u.pn * BM + wc * 32 + 4 * fq;
#pragma unroll
        for (int ai = 0; ai < 2; ++ai)
#pragma unroll
            for (int m = 0; m < 4; ++m) { const size_t row = (size_t)(row0 + ai * HALF + m * 16);
#pragma unroll
                for (int bj = 0; bj < 2; ++bj)
#pragma unroll
                    for (int n = 0; n < 2; ++n) { const int col = col0 + bj * HALF + n * 16;
                        const u32x2 w = *(const u32x2*)(gate + row * 6144 + PASS * 2048 + col);
                        f32x4 v = acc[ai][bj][m][n] * (f32x4){bf_lo(w.x), bf_hi(w.x), bf_lo(w.y), bf_hi(w.y)};
                        if (PASS > 0) v += *(const f32x4*)(Y + row * 2048 + col);
                        if (PASS < 2) *(f32x4*)(Y + row * 2048 + col) = v;
                        else { u32x2 o; o.x = cvt_pk_bf16(v[0], v[1]); o.y = cvt_pk_bf16(v[2], v[3]); *(u32x2*)(Y16 + row * 2048 + col) = o; } } }
    }
};
struct EpiZ {
    static constexpr bool PERM = true, AFTER_DRAIN = false;
    bf16_t *Q, *K, *V, *QI, *KI, *U, *QM, *GATE, *KM, *VM; float* WI; const float* bgate;
    __device__ __forceinline__ void operator()(const f32x4 (&acc)[2][2][4][2], const Unit& u, int wr, int wc, int fr, int fq) const {
        const int pn = u.pn;
        bf16_t* base; int ld, ct = 0, mode = 0, rowoff = 0;
        if (pn < 4) { base = Q; ld = 1024; ct = pn; }
        else if (pn < 8) { base = K; ld = 1024; ct = pn - 4; }
        else if (pn < 12) { base = V; ld = 1024; ct = pn - 8; }
        else if (pn < 16) { base = QI; ld = 1024; ct = pn - 12; }
        else if (pn == 16) { base = KI; ld = 64; mode = 2; }
        else if (pn < 19) { base = U; ld = 512; ct = pn - 17; }
        else if (pn < 21) { base = QM; ld = 512; ct = pn - 19; }
        else if (pn < 45) { base = GATE; ld = 6144; ct = pn - 21; mode = 1; }
        else if (pn < 47) { base = KM; ld = 512; ct = pn - 45; rowoff = 8192; }
        else { base = VM; ld = 512; ct = pn - 47; rowoff = 8192; }
        const int row0 = u.pm * BM + wr * 64 + fr - rowoff, cl = wc * 32 + 8 * fq;
        if (mode == 2) {
#pragma unroll
            for (int ai = 0; ai < 2; ++ai)
#pragma unroll
                for (int m = 0; m < 4; ++m) { const size_t row = (size_t)(row0 + ai * HALF + m * 16);
                    const f32x4 v0 = acc[ai][0][m][0], v1 = acc[ai][0][m][1];
                    if (cl < 64) { u32x4 w; w.x = cvt_pk_bf16(v0[0], v0[1]); w.y = cvt_pk_bf16(v0[2], v0[3]); w.z = cvt_pk_bf16(v1[0], v1[1]); w.w = cvt_pk_bf16(v1[2], v1[3]); *(u32x4*)(KI + row * 64 + cl) = w; }
                    else if (cl < 80) { const float s = 1.0f / 32.0f;
                        *(f32x4*)(WI + row * 16 + (cl - 64)) = v0 * s; *(f32x4*)(WI + row * 16 + (cl - 64) + 4) = v1 * s; } }
            return;
        }
        const int col0 = ct * BM + cl;
        f32x4 bv[2][2];
#pragma unroll
        for (int bj = 0; bj < 2; ++bj)
#pragma unroll
            for (int n = 0; n < 2; ++n) bv[bj][n] = (mode == 1) ? *(const f32x4*)(bgate + col0 + bj * HALF + 4 * n) : (f32x4){0.f, 0.f, 0.f, 0.f};
#pragma unroll
        for (int ai = 0; ai < 2; ++ai)
#pragma unroll
            for (int m = 0; m < 4; ++m) { bf16_t* rowp = base + (size_t)(row0 + ai * HALF + m * 16) * ld + col0;
#pragma unroll
                for (int bj = 0; bj < 2; ++bj) { f32x4 v0 = acc[ai][bj][m][0], v1 = acc[ai][bj][m][1];
                    if (mode == 1) { v0 += bv[bj][0]; v1 += bv[bj][1];
#pragma unroll
                        for (int e = 0; e < 4; ++e) { v0[e] = sigmoidf_(v0[e]); v1[e] = sigmoidf_(v1[e]); } }
                    u32x4 w; w.x = cvt_pk_bf16(v0[0], v0[1]); w.y = cvt_pk_bf16(v0[2], v0[3]); w.z = cvt_pk_bf16(v1[0], v1[1]); w.w = cvt_pk_bf16(v1[2], v1[3]);
                    *(u32x4*)(rowp + bj * HALF) = w; } }
    }
};

template <class Epi, class Sched, bool ALIGN_EPI = false, bool SP2 = false, bool I8 = false>
__device__ __forceinline__ void gemm_phase(PG8_LAS unsigned char* lds, const Gemm g, const Sched& S, const Epi& E) {
    int tid_ = threadIdx.x; asm volatile("" : "+v"(tid_));
    const int tid = tid_, wid = __builtin_amdgcn_readfirstlane(tid >> 6), lane = tid & 63, wr = wid >> 2, wc = wid & 3, fr = lane & 15, fq = lane >> 4;
    const int K = g.K, nt = K / BK;
    unsigned voffA[2], voffB[2];
#pragma unroll
    for (int i = 0; i < 2; ++i) { int R, C; stage_rc(tid * 16 + i * 8192, R, C); const int Rb = Epi::PERM ? ((R & ~31) + perm32(R & 31)) : R;
        voffA[i] = (unsigned)(R * K + C) * 2u; voffB[i] = (unsigned)(Rb * K + C) * 2u; }
    const size_t kstep = (size_t)(BK * 2);
    const size_t hstep = (size_t)HALF * K * 2;
    const size_t tstep = 2 * hstep;
    const unsigned ldsw = (unsigned)wid * 1024u;
    const int aoff = lds_byte(wr * 64 + fr, fq * 8), boff = lds_byte(wc * 32 + fr, fq * 8);
#define PG8_SA(b, h) (((b) * 2 + (h)) * HTB)
#define PG8_SB(b, h) ((4 + (b) * 2 + (h)) * HTB)
#define PG8_STAGE(bufoff, gbase, voff) do { _Pragma("unroll") for (int _i = 0; _i < 2; ++_i) \
        __builtin_amdgcn_global_load_lds((const unsigned*)((const char*)(gbase) + (voff)[_i]), (PG8_LAS unsigned*)(lds + (bufoff) + ldsw + _i * 8192), 16, 0, 0); } while (0)
#define PG8_LDA(dst, b, h) do { _Pragma("unroll") for (int m = 0; m < 4; ++m) _Pragma("unroll") for (int k = 0; k < 2; ++k) dst[m][k] = *(const PG8_LAS bf16x8*)(lds + PG8_SA(b, h) + aoff + m * 2048 + k * 1024); } while (0)
#define PG8_LDB(dst, b, h) do { _Pragma("unroll") for (int n = 0; n < 2; ++n) _Pragma("unroll") for (int k = 0; k < 2; ++k) dst[n][k] = *(const PG8_LAS bf16x8*)(lds + PG8_SB(b, h) + boff + n * 2048 + k * 1024); } while (0)
#define PG8_MMA(ai, bj, At, Bt) do { __builtin_amdgcn_s_setprio(1); _Pragma("unroll") for (int m = 0; m < 4; ++m) _Pragma("unroll") for (int n = 0; n < 2; ++n) _Pragma("unroll") for (int k = 0; k < 2; ++k) \
        { if constexpr (I8) acc[ai][bj][m][n] = __builtin_amdgcn_mfma_i32_16x16x64_i8(__builtin_bit_cast(i32x4, Bt[n][k]), __builtin_bit_cast(i32x4, At[m][k]), acc[ai][bj][m][n], 0, 0, 0); \
          else acc[ai][bj][m][n] = __builtin_amdgcn_mfma_f32_16x16x32_bf16(Bt[n][k], At[m][k], acc[ai][bj][m][n], 0, 0, 0); } __builtin_amdgcn_s_setprio(0); } while (0)
#define PG8_WAIT_V(n) asm volatile("s_waitcnt vmcnt(" #n ")" ::: "memory")
#define PG8_WAIT_L(n) asm volatile("s_waitcnt lgkmcnt(" #n ")" ::: "memory")
#define PG8_BAR __builtin_amdgcn_s_barrier()
#define PG8_SCHED __builtin_amdgcn_sched_barrier(0)
    Unit cur, nxt; int ui = 0;
    if (!S.next(0, cur)) return;
    typedef typename AccSel<I8>::type acc_t;
    acc_t acc[2][2][4][2];
#pragma unroll
    for (int a = 0; a < 2; ++a)
#pragma unroll
        for (int b = 0; b < 2; ++b)
#pragma unroll
            for (int m = 0; m < 4; ++m)
#pragma unroll
                for (int n = 0; n < 2; ++n) acc[a][b][m][n] = acc_t{};
    bf16x8 At[4][2], B0[2][2], B1[2][2];
    const char* cA = (const char*)g.A + (size_t)cur.pm * tstep; const char* cB = (const char*)g.Bt + (size_t)cur.pn * tstep;
    S.a_ready(cur);
    if constexpr (SP2) {
        PG8_STAGE(PG8_SB(0, 0), cB, voffB); PG8_STAGE(PG8_SB(0, 1), cB + hstep, voffB); PG8_STAGE(PG8_SA(0, 0), cA, voffA); PG8_STAGE(PG8_SA(0, 1), cA + hstep, voffA);
        if (wr == 1) PG8_BAR;
        PG8_WAIT_V(2); PG8_BAR;
        PG8_STAGE(PG8_SB(1, 0), cB + kstep, voffB); PG8_STAGE(PG8_SA(1, 0), cA + kstep, voffA); PG8_STAGE(PG8_SB(1, 1), cB + hstep + kstep, voffB);
        PG8_WAIT_V(6); PG8_BAR;
    } else {
        PG8_STAGE(PG8_SB(0, 0), cB, voffB); PG8_STAGE(PG8_SA(0, 0), cA, voffA); PG8_STAGE(PG8_SB(0, 1), cB + hstep, voffB); PG8_STAGE(PG8_SA(0, 1), cA + hstep, voffA);
        if (wr == 1) PG8_BAR;
        PG8_WAIT_V(4); PG8_BAR;
        PG8_STAGE(PG8_SB(1, 0), cB + kstep, voffB); PG8_STAGE(PG8_SA(1, 0), cA + kstep, voffA); PG8_STAGE(PG8_SB(1, 1), cB + hstep + kstep, voffB);
        PG8_WAIT_V(6); PG8_BAR;
    }
    for (;;) {
        const bool has_next = S.next(ui + 1, nxt);
        const char* nA = has_next ? (const char*)g.A + (size_t)nxt.pm * tstep : cA; const char* nB = has_next ? (const char*)g.Bt + (size_t)nxt.pn * tstep : cB;
        for (int t = 0; t < nt; t += 2) {
            const bool last = (t == nt - 2);
            const char* a1 = cA + (size_t)(t + 1) * kstep;
            const char* a2 = last ? nA : cA + (size_t)(t + 2) * kstep; const char* b2 = last ? nB : cB + (size_t)(t + 2) * kstep;
            const char* a3 = a2 + kstep; const char* b3 = b2 + kstep;
            if (last && has_next) S.a_ready(nxt);
            if constexpr (SP2) {
            PG8_LDB(B0, 0, 0); PG8_LDB(B1, 0, 1); PG8_SCHED; PG8_LDA(At, 0, 0); PG8_STAGE(PG8_SA(1, 1), a1 + hstep, voffA);
            PG8_WAIT_V(8); PG8_WAIT_L(0); PG8_BAR; PG8_MMA(0, 0, At, B0); PG8_MMA(0, 1, At, B1); PG8_BAR; PG8_SCHED;
            PG8_LDA(At, 0, 1); PG8_STAGE(PG8_SB(0, 0), b2, voffB); PG8_STAGE(PG8_SB(0, 1), b2 + hstep, voffB); PG8_STAGE(PG8_SA(0, 0), a2, voffA);
            PG8_WAIT_V(8); PG8_WAIT_L(0); PG8_BAR; PG8_MMA(1, 0, At, B0); PG8_MMA(1, 1, At, B1); PG8_BAR; PG8_SCHED;
            PG8_LDB(B0, 1, 0); PG8_LDB(B1, 1, 1); PG8_SCHED; PG8_LDA(At, 1, 0); PG8_STAGE(PG8_SA(0, 1), a2 + hstep, voffA);
            PG8_WAIT_V(8); PG8_WAIT_L(0); PG8_BAR; PG8_MMA(0, 0, At, B0); PG8_MMA(0, 1, At, B1); PG8_BAR; PG8_SCHED;
            PG8_LDA(At, 1, 1); PG8_STAGE(PG8_SB(1, 0), b3, voffB); PG8_STAGE(PG8_SB(1, 1), b3 + hstep, voffB); PG8_STAGE(PG8_SA(1, 0), a3, voffA);
            PG8_WAIT_V(8); PG8_WAIT_L(0); PG8_BAR; PG8_MMA(1, 0, At, B0); PG8_MMA(1, 1, At, B1); PG8_BAR; PG8_SCHED;
            } else {
            PG8_LDB(B0, 0, 0); PG8_SCHED; PG8_LDA(At, 0, 0); PG8_STAGE(PG8_SA(1, 1), a1 + hstep, voffA);
            PG8_WAIT_L(8); PG8_BAR; PG8_WAIT_L(0); PG8_MMA(0, 0, At, B0); PG8_BAR; PG8_SCHED;
            PG8_LDB(B1, 0, 1); PG8_STAGE(PG8_SB(0, 0), b2, voffB);
            PG8_BAR; PG8_WAIT_L(0); PG8_MMA(0, 1, At, B1); PG8_BAR;
            PG8_LDA(At, 0, 1); PG8_STAGE(PG8_SA(0, 0), a2, voffA);
            PG8_BAR; PG8_WAIT_L(0); PG8_MMA(1, 0, At, B0); PG8_BAR; PG8_SCHED;
            PG8_STAGE(PG8_SB(0, 1), b2 + hstep, voffB);
            PG8_WAIT_V(6); PG8_BAR; PG8_MMA(1, 1, At, B1); PG8_BAR;
            PG8_LDB(B0, 1, 0); PG8_SCHED; PG8_LDA(At, 1, 0); PG8_STAGE(PG8_SA(0, 1), a2 + hstep, voffA);
            PG8_WAIT_L(8); PG8_BAR; PG8_WAIT_L(0); PG8_MMA(0, 0, At, B0); PG8_BAR; PG8_SCHED;
            PG8_LDB(B1, 1, 1); PG8_STAGE(PG8_SB(1, 0), b3, voffB);
            PG8_BAR; PG8_WAIT_L(0); PG8_MMA(0, 1, At, B1); PG8_BAR;
            PG8_LDA(At, 1, 1); PG8_STAGE(PG8_SA(1, 0), a3, voffA);
            PG8_BAR; PG8_WAIT_L(0); PG8_MMA(1, 0, At, B0); PG8_BAR; PG8_SCHED;
            PG8_STAGE(PG8_SB(1, 1), b3 + hstep, voffB);
            PG8_WAIT_V(6); PG8_BAR; PG8_MMA(1, 1, At, B1); PG8_BAR;
            }
        }
        if constexpr (ALIGN_EPI) { if (wr == 0) PG8_BAR; }
        if constexpr (!Epi::AFTER_DRAIN) { E(acc, cur, wr, wc, fr, fq); S.done(cur); }
        if (!has_next) break;
#pragma unroll
        for (int a = 0; a < 2; ++a)
#pragma unroll
            for (int b = 0; b < 2; ++b)
#pragma unroll
                for (int m = 0; m < 4; ++m)
#pragma unroll
                    for (int n = 0; n < 2; ++n) acc[a][b][m][n] = acc_t{};
        cur = nxt; cA = nA; cB = nB; ++ui;
        if constexpr (ALIGN_EPI) { if (wr == 1) PG8_BAR; }
    }
    PG8_WAIT_V(0);
    if constexpr (!ALIGN_EPI) { if (wr == 0) PG8_BAR; }
    PG8_BAR;
#undef PG8_SA
#undef PG8_SB
#undef PG8_STAGE
#undef PG8_LDA
#undef PG8_LDB
#undef PG8_MMA
#undef PG8_WAIT_V
#undef PG8_WAIT_L
#undef PG8_BAR
#undef PG8_SCHED
}
}

namespace att {
using bf16 = __hip_bfloat16;
typedef short bf16x8 __attribute__((ext_vector_type(8)));
typedef short s16x4 __attribute__((ext_vector_type(4)));
typedef float f32x16 __attribute__((ext_vector_type(16)));
typedef float f32x4 __attribute__((ext_vector_type(4)));
typedef unsigned u32x4 __attribute__((ext_vector_type(4)));
typedef unsigned u32x2 __attribute__((ext_vector_type(2)));
constexpr int D = 128;
constexpr float SCALE = 0.08838834764831845f;
constexpr float THR = 8.f;
constexpr int NW = 8, QBLK = 32, KVBLK = 64, QB = NW * QBLK;
constexpr int SHM_V = KVBLK * D * 2, SHM_K = KVBLK * D * 2;
constexpr int LDS_BYTES = 2 * SHM_V + 2 * SHM_K + NW * 64 * 4;
#define KSWZ(row, colB) ((row) * 256 + ((colB) ^ (((row) & 7) << 4)))
#define SBAR() __builtin_amdgcn_sched_barrier(0)
__device__ __forceinline__ int v_st(int k, int c) { const int kk = (k & ~0xC) | ((k & 4) << 1) | ((k & 8) >> 1); return ((kk >> 3) * 4 + (c >> 5)) * 512 + ((kk & 7) * 32 + (c & 31)) * 2; }
__device__ __forceinline__ int v_rd_base(int lane) { return ((lane & 3) << 3) | (((lane >> 2) & 3) << 6) | (((lane >> 4) & 1) << 5) | (((lane >> 5) & 1) << 8); }
constexpr int v_rd_off(int d0, int ks, int half) { return d0 * 512 + ks * 4096 + half * 2048; }
__device__ __forceinline__ int crow(int r, int hi) { return (r & 3) + 8 * (r >> 2) + 4 * hi; }
__device__ __forceinline__ unsigned cvtpk(float lo, float hi) { unsigned r; asm volatile("v_cvt_pk_bf16_f32 %0, %1, %2" : "=v"(r) : "v"(lo), "v"(hi)); return r; }
__device__ __forceinline__ bf16x8 load8(const bf16* p) { return *reinterpret_cast<const bf16x8*>(p); }
__device__ __forceinline__ void mask_alibi(f32x16& p0, f32x16& p1, u32x2 mw, int dq, int hi, float ah) {
    const float NEG = -__builtin_inff();
    const unsigned w0 = mw.x >> (4 * hi), w1 = mw.y >> (4 * hi);
    const float dqf = (float)dq;
#pragma unroll
    for (int r = 0; r < 16; ++r) {
        const int c = (r & 3) + 8 * (r >> 2);
        p0[r] = ((w0 >> c) & 1u) ? fmaf(ah, (float)c - dqf, p0[r]) : NEG;
        p1[r] = ((w1 >> c) & 1u) ? fmaf(ah, (float)(c + 32) - dqf, p1[r]) : NEG;
    }
}
__device__ __forceinline__ void partialSM(f32x16& p0, f32x16& p1, float& m_reg, float& mn, float& alpha) {
    float pmax = p0[0];
#pragma unroll
    for (int r = 1; r < 16; ++r) pmax = fmaxf(pmax, p0[r]);
#pragma unroll
    for (int r = 0; r < 16; ++r) pmax = fmaxf(pmax, p1[r]);
    { auto rr = __builtin_amdgcn_permlane32_swap(__float_as_uint(pmax), __float_as_uint(pmax), false, false);
      pmax = fmaxf(__uint_as_float(rr[0]), __uint_as_float(rr[1])); }
    constexpr float C2 = 1.4426950408889634f * SCALE;
    if (__builtin_expect(__all((pmax - m_reg) * SCALE <= THR), 1)) { mn = m_reg; alpha = 1.f; }
    else { mn = fmaxf(m_reg, pmax); alpha = __builtin_amdgcn_exp2f((m_reg - mn) * C2); m_reg = mn; }
    const float mnL = -mn * C2;
#pragma unroll
    for (int r = 0; r < 16; ++r) p0[r] = fmaf(p0[r], C2, mnL);
#pragma unroll
    for (int r = 0; r < 16; ++r) p1[r] = fmaf(p1[r], C2, mnL);
#pragma unroll
    for (int r = 0; r < 16; ++r) p0[r] = __builtin_amdgcn_exp2f(p0[r]);
}
__device__ __forceinline__ void finishSM(f32x16& p0, f32x16& p1, float alpha, float& l_reg, bf16x8& pa0, bf16x8& pa1, bf16x8& pa2, bf16x8& pa3) {
#pragma unroll
    for (int r = 0; r < 16; ++r) p1[r] = __builtin_amdgcn_exp2f(p1[r]);
    float ps = 0;
#pragma unroll
    for (int r = 0; r < 16; ++r) ps += p0[r];
#pragma unroll
    for (int r = 0; r < 16; ++r) ps += p1[r];
    { auto rr = __builtin_amdgcn_permlane32_swap(__float_as_uint(ps), __float_as_uint(ps), false, false);
      ps = __uint_as_float(rr[0]) + __uint_as_float(rr[1]); }
    l_reg = l_reg * alpha + ps;
#define PK4(P, B_, OUT) do { unsigned a0 = cvtpk(P[B_+0], P[B_+1]), a1 = cvtpk(P[B_+2], P[B_+3]);                          \
        unsigned b0 = cvtpk(P[B_+4], P[B_+5]), b1 = cvtpk(P[B_+6], P[B_+7]);                                             \
        auto r0 = __builtin_amdgcn_permlane32_swap(a0, b0, false, false); auto r1 = __builtin_amdgcn_permlane32_swap(a1, b1, false, false); \
        u32x4 w = {r0[0], r1[0], r0[1], r1[1]}; OUT = *reinterpret_cast<bf16x8*>(&w); } while (0)
    PK4(p0, 0, pa0); PK4(p0, 8, pa1); PK4(p1, 0, pa2); PK4(p1, 8, pa3);
#undef PK4
}
template <int KB>
__device__ __forceinline__ void qkt(f32x16& p0, f32x16& p1, const char* K_lds, int r32, int hi, const bf16x8* qr) {
    p0 = f32x16{}; p1 = f32x16{};
    const char* kb[4];
#pragma unroll
    for (int dd = 0; dd < 4; ++dd) kb[dd] = K_lds + KB * SHM_K + KSWZ(r32, (dd * 16 + hi * 8) * 2);
#pragma unroll
    for (int d0 = 0; d0 < 8; ++d0) { const char* a = kb[d0 & 3] + (d0 >> 2) * 128;
        bf16x8 b0 = *reinterpret_cast<const bf16x8*>(a);
        bf16x8 b1 = *reinterpret_cast<const bf16x8*>(a + 32 * 256);
        p0 = __builtin_amdgcn_mfma_f32_32x32x16_bf16(b0, qr[d0], p0, 0, 0, 0);
        p1 = __builtin_amdgcn_mfma_f32_32x32x16_bf16(b1, qr[d0], p1, 0, 0, 0); }
}
template <int VB>
__device__ __forceinline__ void pv_tile(f32x16* o, int vb0, bf16x8 pa0, bf16x8 pa1, bf16x8 pa2, bf16x8 pa3) {
#define TRRD(dst, off) asm volatile("ds_read_b64_tr_b16 %0, %1 offset:%2" : "=&v"(dst) : "v"(vb0), "i"(off) : "memory")
#define PV_D0(d0) do { s16x4 l0, l1, l2, l3, h0, h1, h2, h3; constexpr int b_ = VB * SHM_V + v_rd_off(d0, 0, 0); \
        TRRD(l0, b_); TRRD(h0, b_ + 2048); TRRD(l1, b_ + 4096); TRRD(h1, b_ + 6144); TRRD(l2, b_ + 8192); TRRD(h2, b_ + 10240); TRRD(l3, b_ + 12288); TRRD(h3, b_ + 14336); \
        asm volatile("s_waitcnt lgkmcnt(0)" ::: "memory"); SBAR();   \
        o[d0] = __builtin_amdgcn_mfma_f32_32x32x16_bf16(pa0, (bf16x8){l0[0], l0[1], l0[2], l0[3], h0[0], h0[1], h0[2], h0[3]}, o[d0], 0, 0, 0);   \
        o[d0] = __builtin_amdgcn_mfma_f32_32x32x16_bf16(pa1, (bf16x8){l1[0], l1[1], l1[2], l1[3], h1[0], h1[1], h1[2], h1[3]}, o[d0], 0, 0, 0);   \
        o[d0] = __builtin_amdgcn_mfma_f32_32x32x16_bf16(pa2, (bf16x8){l2[0], l2[1], l2[2], l2[3], h2[0], h2[1], h2[2], h2[3]}, o[d0], 0, 0, 0);   \
        o[d0] = __builtin_amdgcn_mfma_f32_32x32x16_bf16(pa3, (bf16x8){l3[0], l3[1], l3[2], l3[3], h3[0], h3[1], h3[2], h3[3]}, o[d0], 0, 0, 0); } while (0)
    PV_D0(0); PV_D0(1); PV_D0(2); PV_D0(3);
#undef PV_D0
#undef TRRD
}
template <int LD, bool MASKED>
__device__ __forceinline__ void attn_block(const bf16* Q, const bf16* Kh, const bf16* Vh, bf16* O, int NT, int P0, const unsigned* maskbase, float ah, char* lds) {
    int tid_ = threadIdx.x; asm volatile("" : "+v"(tid_));
    const int tid = tid_, wid = __builtin_amdgcn_readfirstlane(tid >> 6), lane = tid & 63, r32 = lane & 31, hi = lane >> 5;
    const int qlo = P0 + wid * QBLK, qm = qlo + r32 - 4 * hi;
    char* V_lds = lds; char* K_lds = lds + 2 * SHM_V;
    float* ws = (float*)(lds + 2 * SHM_V + 2 * SHM_K) + wid * 64; float* li_l = ws, * al_l = ws + 32;
    float m_reg = -1e30f, l_reg = 0; f32x16 o[4] = {};
    const int sr = tid >> 4, sc = (tid & 15) * 8, vst0 = v_st(sr, sc), vst1 = v_st(32 + sr, sc), kws = KSWZ(sr, sc * 2);
    const int vb0 = (int)(uintptr_t)V_lds + v_rd_base(lane);
    const unsigned* mrow = MASKED ? maskbase + (size_t)(qlo + r32) * 128 : nullptr;
    bf16x8 qr[8], st_v0, st_v1, st_k0, st_k1;
#define ROW(p, k0, rr) ((p) + (size_t)((k0) + (rr)) * LD + sc)
#define VMW() asm volatile("s_waitcnt vmcnt(0)" ::: "memory")
#define SLOAD_H(k0) do { st_v0 = load8(ROW(Vh, k0, sr)); st_v1 = load8(ROW(Vh, k0, 32 + sr)); st_k0 = load8(ROW(Kh, k0, sr)); st_k1 = load8(ROW(Kh, k0, 32 + sr)); } while (0)
#define SWRITE_HK(bf) do { *(bf16x8*)(K_lds + (bf) * SHM_K + kws) = st_k0; *(bf16x8*)(K_lds + (bf) * SHM_K + kws + 32 * 256) = st_k1; } while (0)
#define SWRITE_HV(bf) do { *(bf16x8*)(V_lds + (bf) * SHM_V + vst0) = st_v0; *(bf16x8*)(V_lds + (bf) * SHM_V + vst1) = st_v1; } while (0)
#define SWRITE_H(bf) do { SWRITE_HV(bf); SWRITE_HK(bf); } while (0)
#define RESC(a) do { if (__any((a) < 1.f)) { if (hi == 0) al_l[r32] = (a); asm volatile("s_waitcnt lgkmcnt(0)" ::: "memory");              \
                     for (int d_ = 0; d_ < 4; ++d_) for (int r = 0; r < 16; ++r) o[d_][r] *= al_l[crow(r, hi)]; } } while (0)
#define KBASE(t) ((t) * KVBLK)
#define MLOAD(dst, t) do { if (MASKED) dst = *(const u32x2*)(mrow + 2 * (t)); } while (0)
#define MASKT(P0_, P1_, mw_, t) do { if (MASKED) mask_alibi(P0_, P1_, mw_, qm - KBASE(t), hi, ah); } while (0)
#pragma unroll
    for (int d0 = 0; d0 < 8; ++d0) qr[d0] = load8(Q + (size_t)(wid * QBLK + r32) * LD + d0 * 16 + hi * 8);
    SLOAD_H(0); VMW(); SWRITE_HK(0);
    __syncthreads();
    f32x16 pA0, pA1, pB0, pB1; float mnA, mnB, alA, alB; bf16x8 pa0, pa1, pa2, pa3;
    u32x2 mwA = {0u, 0u}, mwB = {0u, 0u};
    SWRITE_HV(0); SBAR();
    MLOAD(mwA, 0);
    if (NT > 1) SLOAD_H(KBASE(1));
    SBAR(); qkt<0>(pA0, pA1, K_lds, r32, hi, qr);
    MASKT(pA0, pA1, mwA, 0); partialSM(pA0, pA1, m_reg, mnA, alA);
    if (NT > 1) { VMW(); SWRITE_H(1); }
    __syncthreads();
#define HALF_STEP(PX0, PX1, mwX, mnX, alX, PY0, PY1, alY, t, KB, VB, SB) do {                                                 \
        SBAR(); MLOAD(mwX, t); qkt<KB>(PX0, PX1, K_lds, r32, hi, qr);                                                         \
        finishSM(PY0, PY1, alY, l_reg, pa0, pa1, pa2, pa3); SBAR();                                                           \
        if ((t) + 1 < NT) { SLOAD_H(KBASE((t) + 1)); SBAR(); }                                                                \
        pv_tile<VB>(o, vb0, pa0, pa1, pa2, pa3); MASKT(PX0, PX1, mwX, (t)); partialSM(PX0, PX1, m_reg, mnX, alX);             \
        __syncthreads();                                                                                                      \
        if ((t) + 1 < NT) { VMW(); SWRITE_H(SB); }                                                                            \
        RESC(alX); __syncthreads(); } while (0)
    for (int t = 1; t + 1 < NT; t += 2) {
        HALF_STEP(pB0, pB1, mwB, mnB, alB, pA0, pA1, alA, t, 1, 0, 0);
        HALF_STEP(pA0, pA1, mwA, mnA, alA, pB0, pB1, alB, t + 1, 0, 1, 1);
    }
    const bool even = (NT & 1) == 0;
    if (even) { SBAR(); MLOAD(mwB, NT - 1); qkt<1>(pB0, pB1, K_lds, r32, hi, qr); SBAR(); }
    finishSM(pA0, pA1, alA, l_reg, pa0, pa1, pa2, pa3); SBAR();
    pv_tile<0>(o, vb0, pa0, pa1, pa2, pa3);
    if (even) { MASKT(pB0, pB1, mwB, NT - 1); partialSM(pB0, pB1, m_reg, mnB, alB); __syncthreads(); RESC(alB);
        finishSM(pB0, pB1, alB, l_reg, pa0, pa1, pa2, pa3); SBAR(); pv_tile<1>(o, vb0, pa0, pa1, pa2, pa3); }
    SBAR();
    if (hi == 0) li_l[r32] = l_reg; asm volatile("s_waitcnt lgkmcnt(0)" ::: "memory");
    float rli[16];
#pragma unroll
    for (int r = 0; r < 16; ++r) rli[r] = __builtin_amdgcn_rcpf(li_l[crow(r, hi)]);
    bf16* Ow = O + (size_t)(wid * QBLK) * LD;
#pragma unroll
    for (int r = 0; r < 16; ++r) { const int orow = crow(r, hi);
#pragma unroll
        for (int d0 = 0; d0 < 4; ++d0) { const float v = o[d0][r] * rli[r];
            const float vn = __shfl_xor(v, 1);
            if ((r32 & 1) == 0) *(unsigned*)(Ow + (size_t)orow * LD + d0 * 32 + r32) = cvtpk(v, vn); } }
    __syncthreads();
#undef ROW
#undef VMW
#undef SLOAD_H
#undef SWRITE_HK
#undef SWRITE_HV
#undef SWRITE_H
#undef RESC
#undef KBASE
#undef MLOAD
#undef MASKT
#undef HALF_STEP
}
#undef KSWZ
#undef SBAR
}

constexpr int NWAVES = 8;
constexpr int BATCH = 2, SEQ = 4096, DM = 2048, T = BATCH * SEQ, FF = 5632, NUP = 2 * FF;
constexpr int NIN = 11344, NIN_PAD = 11520;
constexpr int MEMLEN = 256, TOPK = 256;
constexpr float ALPHA = 1.189207115002721f;
constexpr float LN_EPS = 1e-5f;
constexpr int N_PHASES = 13;

constexpr size_t WS_CTL = 0, CTL_ZERO_BYTES = 1u << 20;
constexpr size_t WS_BIG = 1u << 20;
constexpr size_t O_X16 = 0, O_WUP1 = O_X16 + (size_t)T * DM * 2, O_WDN1 = O_WUP1 + (size_t)NUP * DM * 2, O_G = O_WDN1 + (size_t)DM * FF * 2, BIG_BYTES = O_G + (size_t)T * FF * 2;
constexpr size_t O_Q = 0, O_K = O_Q + (size_t)T * 1024 * 2, O_V = O_K + (size_t)T * 1024 * 2, O_QI = O_V + (size_t)T * 1024 * 2, O_KI = O_QI + (size_t)T * 1024 * 2,
                 O_WI = O_KI + (size_t)T * 64 * 2, O_U = O_WI + (size_t)T * 16 * 4, O_QM = O_U + (size_t)T * 512 * 2, O_GATE = O_QM + (size_t)T * 512 * 2, O_MIXEND = O_GATE + (size_t)T * 6144 * 2;
static_assert(O_MIXEND <= BIG_BYTES, "mixer view fits");
constexpr size_t WS_WIN = WS_BIG + BIG_BYTES;
constexpr size_t WS_WMKV = WS_WIN + (size_t)NIN_PAD * DM * 2;
constexpr size_t WS_WBA = WS_WMKV + (size_t)1024 * DM * 2;
constexpr size_t WS_WBP = WS_WBA + (size_t)DM * 1024 * 2;
constexpr size_t WS_WBM = WS_WBP + (size_t)DM * 512 * 2;
constexpr size_t WS_WOUT = WS_WBM + (size_t)DM * 512 * 2;
constexpr size_t WS_WUP2 = WS_WOUT + (size_t)DM * DM * 2;
constexpr size_t WS_WDN2 = WS_WUP2 + (size_t)NUP * DM * 2;
constexpr size_t WS_WPOOL = WS_WDN2 + (size_t)DM * FF * 2;
constexpr size_t WS_H1 = WS_WPOOL + (size_t)4 * 128 * 128 * 2;
constexpr size_t WS_MEM16 = WS_H1 + (size_t)T * DM * 2;
constexpr size_t WS_A16 = WS_MEM16 + (size_t)512 * DM * 2;
constexpr size_t WS_P16 = WS_A16 + (size_t)T * 1024 * 2;
constexpr size_t WS_M16 = WS_P16 + (size_t)T * 512 * 2;
constexpr size_t WS_Y16 = WS_M16 + (size_t)T * 512 * 2;
constexpr size_t WS_KM = WS_Y16 + (size_t)T * DM * 2;
constexpr size_t WS_VM = WS_KM + (size_t)512 * 512 * 2;
constexpr size_t WS_MASK = WS_VM + (size_t)512 * 512 * 2;
constexpr size_t WS_END = WS_MASK + (size_t)T * 128 * 4;
constexpr int CW_BAR = 4096;
constexpr size_t WS_QS = 65536;
constexpr size_t WS_ROWQ = 131072;
static_assert(WS_ROWQ + (size_t)6 * 8192 * 4 <= (1u << 20), "control region");

constexpr int RING_OFF = 0, RING_BYTES = 131072;
constexpr int LDSCTL_OFF = RING_BYTES, MISC_OFF = LDSCTL_OFF + 320;
constexpr int LDS_BYTES = 147456;

#define GAS __attribute__((address_space(1)))
#define LAS __attribute__((address_space(3)))
typedef unsigned short bf16;
typedef unsigned v4u __attribute__((ext_vector_type(4)));
typedef unsigned v2u __attribute__((ext_vector_type(2)));
typedef float f32x4 __attribute__((ext_vector_type(4)));
typedef float f32x16 __attribute__((ext_vector_type(16)));
typedef short bf16x8 __attribute__((ext_vector_type(8)));
#define LDS_WAIT() asm volatile("s_waitcnt lgkmcnt(0)" ::: "memory")
__device__ __forceinline__ unsigned f2bf(float f) { unsigned u = __builtin_bit_cast(unsigned, f); return (u + 0x7fffu + ((u >> 16) & 1u)) >> 16; }
__device__ __forceinline__ unsigned pk2(float lo, float hi) { return f2bf(lo) | (f2bf(hi) << 16); }

#define XB_TMO      128
#define XB_XCNT(j)  (256  + 64 * (j))
#define XB_XSUB(j)  (1280 + 64 * (j))
#define XB_XGEN(j)  (2304 + 64 * (j))
#define XB_TOP      3328
#define XB_TOPGEN   3392
#define XCD_BAR_WORDS 3456
#define XB_SPIN_CAP (1u << 22)
__device__ __forceinline__ unsigned xb_ld(unsigned* p)              { return __hip_atomic_load(p, __ATOMIC_RELAXED, __HIP_MEMORY_SCOPE_AGENT); }
__device__ __forceinline__ unsigned xb_add(unsigned* p, unsigned v) { return __hip_atomic_fetch_add(p, v, __ATOMIC_RELAXED, __HIP_MEMORY_SCOPE_AGENT); }
__device__ __forceinline__ unsigned xb_xcc_id() { return (unsigned)__builtin_amdgcn_s_getreg((3 << 11) | 20) & 0xFu; }
#define XB_SPIN(cond, bar) do { unsigned _sp = 0; while (cond) { __builtin_amdgcn_s_sleep(1); \
    if ((++_sp & 255u) == 0u) { if (xb_ld(&(bar)[XB_TMO])) break; if (_sp > XB_SPIN_CAP) { atomicAdd(&(bar)[XB_TMO], 1u); break; } } } } while (0)
struct XcdBarrier { unsigned* bar; unsigned x; volatile LAS unsigned* st; };
__device__ __forceinline__ XcdBarrier xcd_barrier_post(unsigned* bar, volatile LAS unsigned* st) {
    XcdBarrier b; b.bar = bar; b.x = xb_xcc_id(); b.st = st;
    if (threadIdx.x == 0) (void)xb_add(&bar[XB_XCNT(b.x)], 1u);
    return b;
}
__device__ __forceinline__ void xcd_barrier_complete(unsigned* bar, unsigned x, unsigned& nloc, unsigned& nx) {
    const unsigned G = gridDim.x * gridDim.y * gridDim.z;
    unsigned sum, cnt, mine, sp = 0u;
    for (;;) {
        sum = 0u; cnt = 0u; mine = 0u;
#pragma unroll
        for (unsigned j = 0; j < 16; ++j) { const unsigned c = xb_ld(&bar[XB_XCNT(j)]); sum += c; cnt += (c > 0u) ? 1u : 0u; mine = (j == x) ? c : mine; }
        if (sum == G) break;
        __builtin_amdgcn_s_sleep(1);
        if ((++sp & 255u) == 0u) { if (xb_ld(&bar[XB_TMO])) break; if (sp > XB_SPIN_CAP) { atomicAdd(&bar[XB_TMO], 1u); break; } }
    }
    nloc = mine > 0u ? mine : 1u; nx = cnt > 0u ? cnt : 1u;
}
__device__ __forceinline__ void xcd_barrier(const XcdBarrier& b) {
    asm volatile("s_waitcnt vmcnt(0)" ::: "memory");
    __syncthreads();
    if (threadIdx.x == 0) {
        unsigned* bar = b.bar;
        __builtin_amdgcn_s_waitcnt(0);
        unsigned nloc = b.st[0], nx = b.st[1];
        if (nloc == 0u) { xcd_barrier_complete(bar, b.x, nloc, nx); b.st[0] = nloc; b.st[1] = nx; }
        const unsigned old = xb_add(&bar[XB_XSUB(b.x)], 1u);
        const unsigned gen = old / nloc;
        if (old + 1u == (gen + 1u) * nloc) {
            __builtin_amdgcn_fence(__ATOMIC_RELEASE, "agent");
            asm volatile("s_waitcnt vmcnt(0)" ::: "memory");
            const unsigned og = xb_add(&bar[XB_TOP], 1u);
            const unsigned tg = og / nx;
            if (og + 1u == (tg + 1u) * nx) xb_add(&bar[XB_TOPGEN], 1u);
            else XB_SPIN(xb_ld(&bar[XB_TOPGEN]) == tg, bar);
            __builtin_amdgcn_fence(__ATOMIC_ACQUIRE, "agent");
            xb_add(&bar[XB_XGEN(b.x)], 1u);
            asm volatile("s_waitcnt vmcnt(0)" ::: "memory");
        } else {
            XB_SPIN(xb_ld(&bar[XB_XGEN(b.x)]) == gen, bar);
            __builtin_amdgcn_fence(__ATOMIC_ACQUIRE, "agent");
            asm volatile("s_waitcnt vmcnt(0)" ::: "memory");
        }
    }
    __syncthreads();
}

__device__ __forceinline__ float wave_sum(float v) {
#pragma unroll
    for (int o = 1; o < 64; o <<= 1) v += __shfl_xor(v, o);
    return v;
}
template <int MAP>
__device__ __forceinline__ void p0_transpose_item(const float* W, int K, int N, int NP, bf16* WT, LAS float* scr, int item, int lane) {
    const int nblk = NP / 32, kb = item / nblk, nb = item % nblk, k0 = 64 * kb, np0 = 32 * nb;
    int n0 = np0; int nvalid = 32;
    if (MAP == 1) n0 = ((np0 >> 7) & 1) * FF + (np0 >> 8) * 128 + (np0 & 127);
    if (MAP == 2) { if (np0 < 4096) n0 = np0; else if (np0 < 4352) { n0 = np0; nvalid = 4176 - np0; nvalid = nvalid < 0 ? 0 : (nvalid > 32 ? 32 : nvalid); } else n0 = np0 - 176; }
    float v[32];
    const bool ok = (lane & 31) < nvalid;
#pragma unroll
    for (int i = 0; i < 32; ++i) { const int kk = 2 * i + (lane >> 5); v[i] = ok ? W[(size_t)(k0 + kk) * N + n0 + (lane & 31)] : 0.f; }
#pragma unroll
    for (int i = 0; i < 32; ++i) { const int kk = 2 * i + (lane >> 5); scr[kk * 33 + (lane & 31)] = v[i]; }
    LDS_WAIT(); asm volatile("" ::: "memory");
    const int c = lane & 7;
#pragma unroll
    for (int j = 0; j < 4; ++j) { const int n = (lane >> 3) + 8 * j; const LAS float* s = scr + (8 * c) * 33 + n;
        v4u o; o.x = pk2(s[0 * 33], s[1 * 33]); o.y = pk2(s[2 * 33], s[3 * 33]); o.z = pk2(s[4 * 33], s[5 * 33]); o.w = pk2(s[6 * 33], s[7 * 33]);
        *(GAS v4u*)(WT + (size_t)(np0 + n) * K + k0 + 8 * c) = o; }
    LDS_WAIT(); asm volatile("" ::: "memory");
}
__device__ __forceinline__ unsigned q8(float v, float qw) { return (unsigned)((int)__builtin_rintf(fminf(fmaxf(v * qw, -127.f), 127.f)) & 255); }
template <int MAP>
__device__ __forceinline__ void p0_transpose_item_i8(const float* W, int K, int N, int NP, signed char* WT, LAS float* scr, int item, int lane, float qw) {
    const int nblk = NP / 32, kb = item / nblk, nb = item % nblk, k0 = 64 * kb, np0 = 32 * nb;
    int n0 = np0;
    if (MAP == 1) n0 = ((np0 >> 7) & 1) * FF + (np0 >> 8) * 128 + (np0 & 127);
    float v[32];
#pragma unroll
    for (int i = 0; i < 32; ++i) { const int kk = 2 * i + (lane >> 5); v[i] = W[(size_t)(k0 + kk) * N + n0 + (lane & 31)]; }
#pragma unroll
    for (int i = 0; i < 32; ++i) { const int kk = 2 * i + (lane >> 5); scr[kk * 33 + (lane & 31)] = v[i]; }
    LDS_WAIT(); asm volatile("" ::: "memory");
#pragma unroll
    for (int j = 0; j < 2; ++j) { const int id = lane + 64 * j, n = id >> 2, c = id & 3; const LAS float* sp = scr + (16 * c) * 33 + n;
        v4u o;
        o.x = q8(sp[0 * 33], qw) | (q8(sp[1 * 33], qw) << 8) | (q8(sp[2 * 33], qw) << 16) | (q8(sp[3 * 33], qw) << 24);
        o.y = q8(sp[4 * 33], qw) | (q8(sp[5 * 33], qw) << 8) | (q8(sp[6 * 33], qw) << 16) | (q8(sp[7 * 33], qw) << 24);
        o.z = q8(sp[8 * 33], qw) | (q8(sp[9 * 33], qw) << 8) | (q8(sp[10 * 33], qw) << 16) | (q8(sp[11 * 33], qw) << 24);
        o.w = q8(sp[12 * 33], qw) | (q8(sp[13 * 33], qw) << 8) | (q8(sp[14 * 33], qw) << 16) | (q8(sp[15 * 33], qw) << 24);
        *(GAS v4u*)(WT + (size_t)(np0 + n) * K + k0 + 16 * c) = o; }
    LDS_WAIT(); asm volatile("" ::: "memory");
}
__device__ __forceinline__ float sample_sigma2(const float* W, int K, int N, int lane) {
    float s = 0.f;
#pragma unroll
    for (int j = 0; j < 4; ++j) { const f32x4 v = *(const GAS f32x4*)(W + (size_t)(j * (K / 4)) * N + lane * 4); s += (v.x * v.x + v.y * v.y) + (v.z * v.z + v.w * v.w); }
    return wave_sum(s) * (1.0f / 1024.0f);
}
__device__ __forceinline__ void quant_row_i8(const f32x4 (&v)[8], signed char* qrow, float* sx, float* gq, float* sg, float sig2, int lane) {
    float mx = 0.f, ss = 0.f;
#pragma unroll
    for (int j = 0; j < 8; ++j) { mx = fmaxf(mx, fmaxf(fmaxf(fabsf(v[j].x), fabsf(v[j].y)), fmaxf(fabsf(v[j].z), fabsf(v[j].w)))); ss += (v[j].x * v[j].x + v[j].y * v[j].y) + (v[j].z * v[j].z + v[j].w * v[j].w); }
#pragma unroll
    for (int o = 1; o < 64; o <<= 1) mx = fmaxf(mx, __shfl_xor(mx, o));
    ss = wave_sum(ss);
    const float m = fmaxf(mx, 1e-20f), qm = 127.f / m;
#pragma unroll
    for (int j = 0; j < 8; ++j) ((GAS unsigned*)qrow)[lane + 64 * j] = q8(v[j].x, qm) | (q8(v[j].y, qm) << 8) | (q8(v[j].z, qm) << 16) | (q8(v[j].w, qm) << 24);
    if (lane == 0) { const float clip = fmaxf(12.f * ss * sig2, 1e-20f);
        *sx = m * (1.0f / 127.f); *gq = 127.f / clip; *sg = clip * (1.0f / 127.f); }
}
template <bool OUT_BF16, bool Q8 = false>
__device__ __forceinline__ void ln_row(const float* xrow, const float* gam, const float* bet, void* orow, int lane, signed char* qrow = nullptr, float* sx = nullptr, float* gq = nullptr, float* sg = nullptr, float sig2 = 0.f) {
    const GAS f32x4* xr = (const GAS f32x4*)xrow + lane;
    f32x4 v[8]; float s = 0.f;
#pragma unroll
    for (int j = 0; j < 8; ++j) { v[j] = xr[64 * j]; s += (v[j].x + v[j].y) + (v[j].z + v[j].w); }
    const float mean = wave_sum(s) * (1.f / DM); float s2 = 0.f;
#pragma unroll
    for (int j = 0; j < 8; ++j) { v[j] = v[j] - mean; s2 += (v[j].x * v[j].x + v[j].y * v[j].y) + (v[j].z * v[j].z + v[j].w * v[j].w); }
    const float rstd = 1.f / sqrtf(wave_sum(s2) * (1.f / DM) + LN_EPS);
#pragma unroll
    for (int j = 0; j < 8; ++j) {
        const f32x4 gg = ((const GAS f32x4*)gam)[lane + 64 * j], bb = ((const GAS f32x4*)bet)[lane + 64 * j];
        const f32x4 y = v[j] * rstd * gg + bb;
        if (OUT_BF16) { ((GAS v2u*)orow)[lane + 64 * j] = (v2u){pk2(y.x, y.y), pk2(y.z, y.w)}; }
        else ((GAS f32x4*)orow)[lane + 64 * j] = y;
        if (Q8) v[j] = y;
    }
    if (Q8) quant_row_i8(v, qrow, sx, gq, sg, sig2, lane);
}

__device__ __forceinline__ unsigned ordkey(float s) { const unsigned u = __float_as_uint(s); return u ^ ((unsigned)((int)u >> 31) | 0x80000000u); }
__device__ __forceinline__ void indexer_unit(LAS unsigned char* lds, int b, int uidx, const bf16* QI16, const bf16* KI16, const float* WI, unsigned* MASKQ) {
    int tid_ = threadIdx.x; asm volatile("" : "+v"(tid_));
    const int tid = tid_, lane = tid & 63, wid = __builtin_amdgcn_readfirstlane(tid >> 6), r = lane & 31, h = lane >> 5;
    const int q0 = uidx * 16 + 2 * wid, tq = q0 + h;
    const int nchunk = ((uidx * 16 + 15) >> 8) + 1;
    bf16x8 aq[4];
    { const int qa = q0 + ((r >> 2) & 1), head = (r & 3) + 4 * (r >> 3);
      const bf16* qp = QI16 + (size_t)(b * SEQ + qa) * 1024 + head * 64 + 8 * h;
#pragma unroll
      for (int ks = 0; ks < 4; ++ks) aq[ks] = *(const GAS bf16x8*)(qp + ks * 16); }
    float w[16];
    { const GAS f32x4* wp = (const GAS f32x4*)(WI + (size_t)(b * SEQ + tq) * 16);
#pragma unroll
      for (int i = 0; i < 4; ++i) { const f32x4 t = wp[i]; w[4 * i] = t.x; w[4 * i + 1] = t.y; w[4 * i + 2] = t.z; w[4 * i + 3] = t.w; } }
    unsigned key[128];
    const char* kbase = (const char*)(KI16 + (size_t)(b * SEQ) * 64);
    unsigned soff[4];
#pragma unroll
    for (int i = 0; i < 4; ++i) { const int kk = (wid * 4 + i) * 8 + (lane >> 3), cs = lane & 7; soff[i] = (unsigned)(kk * 128 + ((cs ^ ((kk >> 1) & 7)) << 4)); }
#define IDX_STAGE(c_) do { _Pragma("unroll") for (int i = 0; i < 4; ++i) \
        __builtin_amdgcn_global_load_lds((const unsigned*)(kbase + (size_t)(c_) * 32768 + soff[i]), (LAS unsigned*)(lds + ((c_) & 1) * 32768 + (wid * 4 + i) * 1024), 16, 0, 0); } while (0)
    const int x = (r >> 1) & 7;
    int roff[4];
#pragma unroll
    for (int ks = 0; ks < 4; ++ks) roff[ks] = r * 128 + (((2 * ks + h) ^ x) << 4);
    __syncthreads();
    IDX_STAGE(0);
#pragma unroll
    for (int c = 0; c < 16; ++c) {
        if (c < nchunk) {
            asm volatile("s_waitcnt vmcnt(0)" ::: "memory");
            __syncthreads();
            if (c + 1 < nchunk) IDX_STAGE(c + 1);
#pragma unroll
            for (int jj = 0; jj < 8; ++jj) {
                const int j = c * 8 + jj;
                f32x16 acc = {};
#pragma unroll
                for (int ks = 0; ks < 4; ++ks) { const bf16x8 bk = *(const LAS bf16x8*)(lds + (c & 1) * 32768 + jj * 4096 + roff[ks]);
                    acc = __builtin_amdgcn_mfma_f32_32x32x16_bf16(aq[ks], bk, acc, 0, 0, 0); }
                float s = 0.f;
#pragma unroll
                for (int i = 0; i < 16; ++i) s = fmaf(w[i], fmaxf(acc[i], 0.f), s);
                unsigned kj = (j * 32 + r <= tq) ? ordkey(s) : 0u;
                asm volatile("" : "+v"(kj));
                key[j] = kj;
                __builtin_amdgcn_sched_barrier(0);
            }
        } else {
#pragma unroll
            for (int jj = 0; jj < 8; ++jj) key[c * 8 + jj] = 0u;
        }
    }
#undef IDX_STAGE
    unsigned thr = 1u;
    {
        unsigned lo = 0u, hi = 0xFFFFFFFFu; bool done = (tq + 1 <= TOPK);
        while (!__all(done)) {
            const unsigned mid = lo + ((hi - lo) >> 1);
            int cnt = 0;
#pragma unroll
            for (int j = 0; j < 128; ++j) cnt += (key[j] >= mid) ? 1 : 0;
#pragma unroll
            for (int o = 1; o < 32; o <<= 1) cnt += __shfl_xor(cnt, o);
            if (!done) {
                if (cnt >= TOPK) lo = mid; else hi = mid;
                if (cnt == TOPK) { thr = mid; done = true; }
                else if (hi - lo <= 1u) { thr = lo; done = true; }
            }
        }
    }
    LAS unsigned* mb = (LAS unsigned*)(lds + 65536) + wid * 256;
#pragma unroll
    for (int j = 0; j < 128; ++j) {
        const unsigned long long bal = __ballot(key[j] >= thr);
        const unsigned val = h ? (unsigned)(bal >> 32) : (unsigned)bal;
        if (r == 0) mb[h * 128 + j] = val;
        asm volatile("" ::: "memory");
    }
    LDS_WAIT(); asm volatile("" ::: "memory");
    GAS unsigned* mp = (GAS unsigned*)(MASKQ + (size_t)(b * SEQ + q0) * 128);
#pragma unroll
    for (int i = 0; i < 4; ++i) mp[64 * i + lane] = mb[64 * i + lane];
    LDS_WAIT(); asm volatile("" ::: "memory");
}

__device__ __forceinline__ void pool_task(int task, const bf16* U16, const bf16* WPT, const float* pscale, bf16* P16, int lane) {
    asm volatile("" : "+v"(lane));
    const int tile = task >> 2, g = task & 3, r = lane & 31, h = lane >> 5;
    const int tk = tile * 32 + r, pos = tk & (SEQ - 1), wlen = 2 << g;
    const int cnt = (pos + 1 < wlen) ? pos + 1 : wlen;
    const float rc = 1.0f / (float)cnt;
    bf16x8 pa[8];
#pragma unroll
    for (int ks = 0; ks < 8; ++ks) {
        const bf16* up = U16 + (size_t)tk * 512 + g * 128 + ks * 16 + 8 * h;
        float sum[8], self[8];
#pragma unroll
        for (int e = 0; e < 8; ++e) sum[e] = 0.f;
        for (int i = 0; i < wlen; ++i) {
            if (i < cnt) { const v4u t = *(const GAS v4u*)(up - (size_t)i * 512);
                const float f0 = pg8::bf_lo(t.x), f1 = pg8::bf_hi(t.x), f2 = pg8::bf_lo(t.y), f3 = pg8::bf_hi(t.y), f4 = pg8::bf_lo(t.z), f5 = pg8::bf_hi(t.z), f6 = pg8::bf_lo(t.w), f7 = pg8::bf_hi(t.w);
                if (i == 0) { self[0] = f0; self[1] = f1; self[2] = f2; self[3] = f3; self[4] = f4; self[5] = f5; self[6] = f6; self[7] = f7; }
                sum[0] += f0; sum[1] += f1; sum[2] += f2; sum[3] += f3; sum[4] += f4; sum[5] += f5; sum[6] += f6; sum[7] += f7; }
        }
        v4u o; o.x = pk2(sum[0] * rc - self[0], sum[1] * rc - self[1]); o.y = pk2(sum[2] * rc - self[2], sum[3] * rc - self[3]);
        o.z = pk2(sum[4] * rc - self[4], sum[5] * rc - self[5]); o.w = pk2(sum[6] * rc - self[6], sum[7] * rc - self[7]);
        pa[ks] = __builtin_bit_cast(bf16x8, o);
    }
#pragma unroll
    for (int nb = 0; nb < 4; ++nb) {
        f32x16 acc = {};
        const bf16* wp = WPT + (size_t)g * 16384 + (size_t)(nb * 32 + r) * 128 + 8 * h;
#pragma unroll
        for (int ks = 0; ks < 8; ++ks) { const bf16x8 bk = *(const GAS bf16x8*)(wp + ks * 16); acc = __builtin_amdgcn_mfma_f32_32x32x16_bf16(pa[ks], bk, acc, 0, 0, 0); }
        const int col = g * 128 + nb * 32 + r; const float ps = pscale[col];
#pragma unroll
        for (int i = 0; i < 16; ++i) { const int tok = tile * 32 + (i & 3) + 8 * (i >> 2) + 4 * h; P16[(size_t)tok * 512 + col] = (bf16)f2bf(acc[i] * ps); }
    }
}

struct Args { const float* in[21]; float* out; unsigned char* ws; int ph_lo, ph_hi; };
__global__ void __launch_bounds__(NWAVES * 64, 2) mk_fwd(Args args) {
    extern __shared__ __attribute__((aligned(16))) unsigned char lds[];
    LAS unsigned char* L = (LAS unsigned char*)lds;
    volatile LAS unsigned* MISC = (volatile LAS unsigned*)(L + MISC_OFF);
    const int tid = threadIdx.x, lane = tid & 63, wave = __builtin_amdgcn_readfirstlane(tid >> 6);
    const int G = gridDim.x, bx = blockIdx.x;
    const int vcu = (G % 8 == 0) ? (bx % 8) * (G / 8) + bx / 8 : bx;
    const int gw = vcu * NWAVES + wave, NGW = G * NWAVES;
    unsigned char* ws = args.ws;
    for (int u = tid; u < (LDS_BYTES - LDSCTL_OFF) / 4; u += NWAVES * 64) ((LAS unsigned*)(L + LDSCTL_OFF))[u] = 0u;
    __syncthreads();
    XcdBarrier bar; bar.bar = (unsigned*)(ws + WS_CTL) + CW_BAR; bar.x = 0; bar.st = nullptr;
    if (!MK_PER_PHASE) bar = xcd_barrier_post((unsigned*)(ws + WS_CTL) + CW_BAR, MISC + 8);
    const int lo = args.ph_lo, hi = args.ph_hi;
#ifndef PH_MASK
#define PH_MASK 0x1FFF
#endif
#ifndef REP_MASK
#define REP_MASK 0x0
#endif
#define REP(k) for (int rep_ = 0; rep_ <= ((REP_MASK >> (k)) & 1); ++rep_)
#define REPBAR() do { if (rep_) xcd_barrier(bar); } while (0)
#define IN(k) (((PH_MASK >> (k)) & 1) && lo <= (k) && (k) < hi)
#define SEAM(k) do { if (IN(k) && IN((k) + 1)) xcd_barrier(bar); } while (0)
    const float* x = args.in[0]; const float* mem = args.in[1];
    bf16* BIG = (bf16*)(ws + WS_BIG);
    bf16 *X16 = (bf16*)(ws + WS_BIG + O_X16), *WUP1 = (bf16*)(ws + WS_BIG + O_WUP1), *WDN1 = (bf16*)(ws + WS_BIG + O_WDN1), *Gb = (bf16*)(ws + WS_BIG + O_G);
    bf16 *Q16 = (bf16*)(ws + WS_BIG + O_Q), *K16 = (bf16*)(ws + WS_BIG + O_K), *V16 = (bf16*)(ws + WS_BIG + O_V), *QI16 = (bf16*)(ws + WS_BIG + O_QI), *KI16 = (bf16*)(ws + WS_BIG + O_KI);
    float* WI = (float*)(ws + WS_BIG + O_WI);
    bf16 *U16 = (bf16*)(ws + WS_BIG + O_U), *QM16 = (bf16*)(ws + WS_BIG + O_QM), *GATE = (bf16*)(ws + WS_BIG + O_GATE);
    bf16 *WIN = (bf16*)(ws + WS_WIN), *WMKV = (bf16*)(ws + WS_WMKV), *WBA = (bf16*)(ws + WS_WBA), *WBP = (bf16*)(ws + WS_WBP), *WBM = (bf16*)(ws + WS_WBM), *WOUT = (bf16*)(ws + WS_WOUT);
    bf16 *WUP2 = (bf16*)(ws + WS_WUP2), *WDN2 = (bf16*)(ws + WS_WDN2), *WPT = (bf16*)(ws + WS_WPOOL);
    bf16 *H1 = (bf16*)(ws + WS_H1), *MEM16 = (bf16*)(ws + WS_MEM16), *A16 = (bf16*)(ws + WS_A16), *P16 = (bf16*)(ws + WS_P16), *M16 = (bf16*)(ws + WS_M16), *H2 = (bf16*)(ws + WS_A16);
    bf16 *Y16 = (bf16*)(ws + WS_Y16), *KM = (bf16*)(ws + WS_KM), *VM = (bf16*)(ws + WS_VM);
    unsigned* MASKQ = (unsigned*)(ws + WS_MASK);
    signed char *X8 = (signed char*)(ws + WS_BIG + O_X16), *WUP1q = (signed char*)(ws + WS_BIG + O_WUP1), *WDN1q = (signed char*)(ws + WS_BIG + O_WDN1), *G8 = (signed char*)(ws + WS_BIG + O_G);
    signed char *WUP2q = (signed char*)(ws + WS_WUP2), *WDN2q = (signed char*)(ws + WS_WDN2), *H2q = (signed char*)(ws + WS_Y16), *G28 = (signed char*)(ws + WS_BIG);
    float* QS = (float*)(ws + WS_QS);
    float *SX1 = (float*)(ws + WS_ROWQ), *GQ1 = SX1 + T, *SG1 = GQ1 + T, *SX2 = SG1 + T, *GQ2 = SX2 + T, *SG2 = GQ2 + T;
    float* R = args.out;
    (void)BIG;

    REP(0) if (IN(0)) { REPBAR();
        LAS float* scr = (LAS float*)(L + RING_OFF + wave * 16384);
        const float s2u1 = fmaxf(sample_sigma2(args.in[2], DM, NUP, lane), 1e-30f), s2d1 = fmaxf(sample_sigma2(args.in[3], FF, DM, lane), 1e-30f);
        const float s2u2 = fmaxf(sample_sigma2(args.in[17], DM, NUP, lane), 1e-30f), s2d2 = fmaxf(sample_sigma2(args.in[18], FF, DM, lane), 1e-30f);
        const float qu1 = 127.f / (6.f * sqrtf(s2u1)), qd1 = 127.f / (6.f * sqrtf(s2d1)), qu2 = 127.f / (6.f * sqrtf(s2u2)), qd2 = 127.f / (6.f * sqrtf(s2d2));
        if (gw == 0 && lane == 0) { QS[0] = qu1; QS[1] = 1.f / qu1; QS[2] = s2u1; QS[3] = qd1; QS[4] = 1.f / qd1; QS[8] = qu2; QS[9] = 1.f / qu2; QS[10] = s2u2; QS[11] = qd2; QS[12] = 1.f / qd2; }
        constexpr int I_UP = (DM / 64) * (NUP / 32), I_DN = (FF / 64) * (DM / 32), I_IN = (DM / 64) * (NIN_PAD / 32), I_MKV = (DM / 64) * (1024 / 32), I_BA = (1024 / 64) * (DM / 32),
                      I_BP = (512 / 64) * (DM / 32), I_OUT = (DM / 64) * (DM / 32), I_PL = (128 / 64) * (128 / 32);
        constexpr int NITEMS = 2 * I_UP + 2 * I_DN + I_IN + I_MKV + I_BA + 2 * I_BP + I_OUT + 4 * I_PL;
        for (int it = gw; it < NITEMS; it += NGW) {
            int r = it;
            if (r < I_UP) { p0_transpose_item_i8<1>(args.in[2], DM, NUP, NUP, WUP1q, scr, r, lane, qu1); continue; } r -= I_UP;
            if (r < I_DN) { p0_transpose_item_i8<0>(args.in[3], FF, DM, DM, WDN1q, scr, r, lane, qd1); continue; } r -= I_DN;
            if (r < I_IN) { p0_transpose_item<2>(args.in[6], DM, NIN, NIN_PAD, WIN, scr, r, lane); continue; } r -= I_IN;
            if (r < I_MKV) { p0_transpose_item<0>(args.in[8], DM, 1024, 1024, WMKV, scr, r, lane); continue; } r -= I_MKV;
            if (r < I_BA) { p0_transpose_item<0>(args.in[11], 1024, DM, DM, WBA, scr, r, lane); continue; } r -= I_BA;
            if (r < I_BP) { p0_transpose_item<0>(args.in[12], 512, DM, DM, WBP, scr, r, lane); continue; } r -= I_BP;
            if (r < I_BP) { p0_transpose_item<0>(args.in[13], 512, DM, DM, WBM, scr, r, lane); continue; } r -= I_BP;
            if (r < I_OUT) { p0_transpose_item<0>(args.in[14], DM, DM, DM, WOUT, scr, r, lane); continue; } r -= I_OUT;
            if (r < I_UP) { p0_transpose_item_i8<1>(args.in[17], DM, NUP, NUP, WUP2q, scr, r, lane, qu2); continue; } r -= I_UP;
            if (r < I_DN) { p0_transpose_item_i8<0>(args.in[18], FF, DM, DM, WDN2q, scr, r, lane, qd2); continue; } r -= I_DN;
            { const int g = r / I_PL; p0_transpose_item<0>(args.in[9] + (size_t)g * 16384, 128, 128, 128, WPT + (size_t)g * 16384, scr, r % I_PL, lane); }
        }
        for (int m = gw; m < T; m += NGW) {
            f32x4 v[8];
#pragma unroll
            for (int j = 0; j < 8; ++j) v[j] = ((const GAS f32x4*)(x + (size_t)m * DM))[lane + 64 * j];
            quant_row_i8(v, X8 + (size_t)m * DM, SX1 + m, GQ1 + m, SG1 + m, s2u1, lane);
        }
        for (size_t i = (size_t)gw * 64 + lane; i < (size_t)512 * DM / 8; i += (size_t)NGW * 64) {
            const f32x4 a = ((const GAS f32x4*)mem)[2 * i], c = ((const GAS f32x4*)mem)[2 * i + 1];
            ((GAS v4u*)MEM16)[i] = (v4u){pk2(a.x, a.y), pk2(a.z, a.w), pk2(c.x, c.y), pk2(c.z, c.w)};
        }
    }
    SEAM(0);
    REP(1) if (IN(1)) { REPBAR();
        pg8::Gemm g{(const bf16*)X8, (const bf16*)WUP1q, T, NUP, DM / 2}; pg8::StaticOrder S; S.init(T, NUP, G, bx);
        pg8::EpiSwigluI8 E{G8, FF, SX1, GQ1, QS + 1};
        pg8::gemm_phase<pg8::EpiSwigluI8, pg8::StaticOrder, true, true, true>(L + RING_OFF, g, S, E);
    }
    SEAM(1);
    REP(2) if (IN(2)) { REPBAR();
        pg8::Gemm g{(const bf16*)G8, (const bf16*)WDN1q, T, DM, FF / 2}; pg8::StaticOrder S; S.init(T, DM, G, bx);
        pg8::EpiResI8<false> E{R, x, DM, ALPHA, 0.5f, SG1, QS + 4};
        pg8::gemm_phase<pg8::EpiResI8<false>, pg8::StaticOrder, true, true, true>(L + RING_OFF, g, S, E);
    }
    SEAM(2);
    REP(3) if (IN(3)) { REPBAR(); for (int m = gw; m < T; m += NGW) ln_row<true>(R + (size_t)m * DM, args.in[4], args.in[5], H1 + (size_t)m * DM, lane); }
    SEAM(3);
    REP(4) if (IN(4)) { REPBAR();
        pg8::Gemm g{H1, WIN, T, NIN_PAD, DM}; pg8::OrderZ S; S.so.init(T, NIN_PAD, G, bx);
        pg8::EpiZ E{Q16, K16, V16, QI16, KI16, U16, QM16, GATE, KM, VM, WI, args.in[7]};
        pg8::gemm_phase<pg8::EpiZ, pg8::OrderZ, true, true>(L + RING_OFF, g, S, E);
    }
    SEAM(4);
    REP(5) if (IN(5)) { REPBAR();
        for (int task = gw; task < 1024; task += NGW) pool_task(task, U16, WPT, args.in[10], P16, lane);
        for (int pp = vcu; pp < 256; pp += G) {
            const int b = pp >> 7, p = pp & 127;
#pragma unroll 1
            for (int k2 = 0; k2 < 2; ++k2) indexer_unit(L + RING_OFF, b, k2 ? 255 - p : p, QI16, KI16, WI, MASKQ);
        }
        __syncthreads();
    }
    SEAM(5);
    REP(6) if (IN(6)) { REPBAR();
        const int xcd = bx & 7, ix = bx >> 3;
        if (ix < 32) {
            const int bh = xcd * 2 + (ix >> 4), qb = ix & 15, b = bh >> 3, hh = bh & 7;
            const size_t rowbase = (size_t)b * SEQ;
            const float ah = exp2f(-(float)(hh + 1)) * 11.313708498984761f;
            att::attn_block<1024, true>((const att::bf16*)(Q16 + (rowbase + qb * 256) * 1024 + hh * 128), (const att::bf16*)(K16 + rowbase * 1024 + hh * 128),
                                        (const att::bf16*)(V16 + rowbase * 1024 + hh * 128), (att::bf16*)(A16 + (rowbase + qb * 256) * 1024 + hh * 128),
                                        4 * (qb + 1), qb * 256, MASKQ + rowbase * 128, ah, (char*)lds + RING_OFF);
            if (qb < 8) { const int mi = bh * 8 + qb;
                const int mb = mi >> 6, mh = (mi >> 4) & 3, mq = mi & 15; const size_t mrow = (size_t)mb * SEQ + mq * 256;
                att::attn_block<512, false>((const att::bf16*)(QM16 + mrow * 512 + mh * 128), (const att::bf16*)(KM + (size_t)mb * MEMLEN * 512 + mh * 128),
                                            (const att::bf16*)(VM + (size_t)mb * MEMLEN * 512 + mh * 128), (att::bf16*)(M16 + mrow * 512 + mh * 128),
                                            MEMLEN / 64, 0, nullptr, 0.f, (char*)lds + RING_OFF); }
        }
    }
    SEAM(6);
    REP(7) if (IN(7)) { REPBAR();
        pg8::StaticOrder S; S.init(T, DM, G, bx);
        { pg8::Gemm g{A16, WBA, T, DM, 1024}; pg8::EpiBranch<0> E{R, Y16, GATE}; pg8::gemm_phase<pg8::EpiBranch<0>, pg8::StaticOrder, true, true>(L + RING_OFF, g, S, E); }
        { pg8::Gemm g{P16, WBP, T, DM, 512}; pg8::EpiBranch<1> E{R, Y16, GATE}; pg8::gemm_phase<pg8::EpiBranch<1>, pg8::StaticOrder, true, true>(L + RING_OFF, g, S, E); }
        { pg8::Gemm g{M16, WBM, T, DM, 512}; pg8::EpiBranch<2> E{R, Y16, GATE}; pg8::gemm_phase<pg8::EpiBranch<2>, pg8::StaticOrder, true, true>(L + RING_OFF, g, S, E); }
    }
    SEAM(7);
    REP(8) if (IN(8)) { REPBAR();
        pg8::Gemm g{Y16, WOUT, T, DM, DM}; pg8::StaticOrder S; S.init(T, DM, G, bx);
        pg8::EpiRes<true> E{R, H1, DM, ALPHA, 1.0f};
        pg8::gemm_phase<pg8::EpiRes<true>, pg8::StaticOrder, true, true>(L + RING_OFF, g, S, E);
    }
    SEAM(8);
    REP(9) if (IN(9)) { REPBAR(); const float sig2 = QS[10]; for (int m = gw; m < T; m += NGW) ln_row<true, true>(R + (size_t)m * DM, args.in[15], args.in[16], H2 + (size_t)m * DM, lane, H2q + (size_t)m * DM, SX2 + m, GQ2 + m, SG2 + m, sig2); }
    SEAM(9);
    REP(10) if (IN(10)) { REPBAR();
        pg8::Gemm g{(const bf16*)H2q, (const bf16*)WUP2q, T, NUP, DM / 2}; pg8::StaticOrder S; S.init(T, NUP, G, bx);
        pg8::EpiSwigluI8 E{G28, FF, SX2, GQ2, QS + 9};
        pg8::gemm_phase<pg8::EpiSwigluI8, pg8::StaticOrder, true, true, true>(L + RING_OFF, g, S, E);
    }
    SEAM(10);
    REP(11) if (IN(11)) { REPBAR();
        pg8::Gemm g{(const bf16*)G28, (const bf16*)WDN2q, T, DM, FF / 2}; pg8::StaticOrder S; S.init(T, DM, G, bx);
        pg8::EpiResI8<true> E{R, H2, DM, ALPHA, 0.5f, SG2, QS + 12};
        pg8::gemm_phase<pg8::EpiResI8<true>, pg8::StaticOrder, true, true, true>(L + RING_OFF, g, S, E);
    }
    SEAM(11);
    REP(12) if (IN(12)) { REPBAR(); for (int m = gw; m < T; m += NGW) ln_row<false>(R + (size_t)m * DM, args.in[19], args.in[20], R + (size_t)m * DM, lane); }
#undef IN
#undef SEAM
}

extern "C" void kernel_launch(void* const* d_in, const int* in_sizes, int n_in, void* d_out, int out_size, void* d_ws, size_t ws_size, hipStream_t stream) {
    static int grid = 0;
    if (grid == 0) {
        if (n_in != 21 || in_sizes[0] != T * DM || out_size != T * DM || ws_size < WS_END) {
            fprintf(stderr, "kernel_launch: shape/workspace mismatch (n_in %d, in0 %d, out %d, ws %zu, need %zu); nothing launched\n", n_in, n_in > 0 ? in_sizes[0] : -1, out_size, ws_size, (size_t)WS_END);
            grid = -1; return; }
        int dev = 0, cus = 0;
        if (hipGetDevice(&dev) != hipSuccess || hipDeviceGetAttribute(&cus, hipDeviceAttributeMultiprocessorCount, dev) != hipSuccess) { grid = -1; return; }
        if (hipFuncSetAttribute((const void*)mk_fwd, hipFuncAttributeMaxDynamicSharedMemorySize, LDS_BYTES) != hipSuccess) { fprintf(stderr, "kernel_launch: hipFuncSetAttribute failed\n"); grid = -1; return; }
        (void)hipGetLastError();
        grid = cus;
        if (grid != 256) fprintf(stderr, "kernel_launch: %d CUs (built for 256)\n", grid);
    }
    if (grid < 0) return;
    if (hipMemsetAsync((char*)d_ws + WS_CTL, 0, CTL_ZERO_BYTES, stream) != hipSuccess) return;
    Args a{};
    for (int i = 0; i < 21; ++i) a.in[i] = (const float*)d_in[i];
    a.out = (float*)d_out; a.ws = (unsigned char*)d_ws;
#if MK_PER_PHASE
    for (int p = 0; p < N_PHASES; ++p) { a.ph_lo = p; a.ph_hi = p + 1; hipLaunchKernelGGL(mk_fwd, dim3(grid), dim3(NWAVES * 64), LDS_BYTES, stream, a); }
#else
    a.ph_lo = 0; a.ph_hi = N_PHASES;
    hipLaunchKernelGGL(mk_fwd, dim3(grid), dim3(NWAVES * 64), LDS_BYTES, stream, a);
#endif
}
```

```cpp
#include <hip/hip_runtime.h>
#include <hip/hip_bf16.h>
#include <cstdio>
#include <cstdint>

#ifndef MK_PER_PHASE
#define MK_PER_PHASE 0
#endif

namespace pg8 {
#define PG8_LAS __attribute__((address_space(3)))
typedef unsigned short bf16_t;
typedef short bf16x8 __attribute__((ext_vector_type(8)));
typedef float f32x4 __attribute__((ext_vector_type(4)));
typedef float f32x2 __attribute__((ext_vector_type(2)));
typedef unsigned u32x4 __attribute__((ext_vector_type(4)));
typedef unsigned u32x2 __attribute__((ext_vector_type(2)));
typedef int i32x4 __attribute__((ext_vector_type(4)));
template <bool I8> struct AccSel { typedef f32x4 type; };
template <> struct AccSel<true> { typedef i32x4 type; };
constexpr int BM = 256, BK = 64, HALF = 128, HTB = HALF * BK * 2, STAGE_BYTES = 8 * HTB, NXCD = 8, WGM = 8;

__host__ __device__ __forceinline__ int lds_byte(int r, int c) { const int st = (r >> 4) * 2 + (c >> 5), rr = r & 15, cc = c & 31, ob = rr * 64 + cc * 2; return st * 1024 + (ob ^ (((ob >> 9) & 1) << 5)); }
__host__ __device__ __forceinline__ void stage_rc(int b, int& R, int& C) { const int st = b / 1024, sb = b % 1024, swz = sb ^ (((sb >> 9) & 1) << 5); R = (st >> 1) * 16 + swz / 64; C = (st & 1) * 32 + (swz % 64) / 2; }
__host__ __device__ __forceinline__ int perm32(int rho) { const int n = rho >> 4, i = rho & 15; return 8 * (i >> 2) + 4 * n + (i & 3); }

struct Unit { int pm, pn; };
struct Gemm { const bf16_t* A; const bf16_t* Bt; int M, N, K; };

struct StaticOrder {
    int nM, nN, nwg, G, c;
    __host__ __device__ void init(int M, int N, int G_, int c_) { nM = M / BM; nN = N / BM; nwg = nM * nN; G = G_; c = c_; }
    __host__ __device__ bool next(int i, Unit& u) const {
        const long L = (long)i * G + c; if (L >= nwg) return false;
        int wgid = (int)L; { const int q = nwg / NXCD, r = nwg % NXCD, xcd = wgid % NXCD, off = wgid / NXCD; wgid = (xcd < r ? xcd * (q + 1) : r * (q + 1) + (xcd - r) * q) + off; }
        const int nig = WGM * nN, gid = wgid / nig, fm = gid * WGM, gsz = (nM - fm) < WGM ? (nM - fm) : WGM;
        u.pm = fm + ((wgid % nig) % gsz); u.pn = (wgid % nig) / gsz; return true;
    }
    __device__ __forceinline__ void a_ready(const Unit&) const {}
    __device__ __forceinline__ void done(const Unit&) const {}
};
struct OrderZ {
    StaticOrder so;
    __device__ __forceinline__ bool next(int i, Unit& u) const {
        const long L = (long)i * so.G + so.c;
        if (L < so.nwg) return so.next(i, u);
        if (L < so.nwg + 8) { const int e = (int)(L - so.nwg); u.pm = 32 + (e >> 2); u.pn = so.nN + (e & 3); return true; }
        return false;
    }
    __device__ __forceinline__ void a_ready(const Unit&) const {}
    __device__ __forceinline__ void done(const Unit&) const {}
};
struct OrderQ {
    StaticOrder so; int heavy;
    __device__ __forceinline__ bool next(int i, Unit& u) const {
        const int c = so.c, nl = so.G - heavy; long L;
        if (c >= heavy) { if (i >= 4) return false; L = (long)i * nl + (c - heavy); if (L >= 4L * nl) return false; }
        else { if (i >= 1) return false; L = 4L * nl + c; }
        if (L >= so.nwg) return false;
        int wgid = (int)L; { const int q = so.nwg / NXCD, r = so.nwg % NXCD, xcd = wgid % NXCD, off = wgid / NXCD; wgid = (xcd < r ? xcd * (q + 1) : r * (q + 1) + (xcd - r) * q) + off; }
        const int nig = WGM * so.nN, gid = wgid / nig, fm = gid * WGM, gsz = (so.nM - fm) < WGM ? (so.nM - fm) : WGM;
        u.pm = fm + ((wgid % nig) % gsz); u.pn = (wgid % nig) / gsz; return true;
    }
    __device__ __forceinline__ void a_ready(const Unit&) const {}
    __device__ __forceinline__ void done(const Unit&) const {}
};

__device__ __forceinline__ unsigned cvt_pk_bf16(float lo, float hi) { unsigned r; asm volatile("v_cvt_pk_bf16_f32 %0, %1, %2" : "=v"(r) : "v"(lo), "v"(hi)); return r; }
__device__ __forceinline__ float bf_lo(unsigned w) { return __uint_as_float(w << 16); }
__device__ __forceinline__ float bf_hi(unsigned w) { return __uint_as_float(w & 0xffff0000u); }
__device__ __forceinline__ float sigmoidf_(float x) { return __builtin_amdgcn_rcpf(1.0f + __builtin_amdgcn_exp2f(-1.4426950408889634f * x)); }

struct EpiSwiglu {
    static constexpr bool PERM = true, AFTER_DRAIN = false;
    bf16_t* G; int ldg;
    __device__ __forceinline__ void operator()(const f32x4 (&acc)[2][2][4][2], const Unit& u, int wr, int wc, int fr, int fq) const {
        const int row0 = u.pm * BM + wr * 64 + fr, col0 = u.pn * HALF + wc * 32 + 8 * fq;
#pragma unroll
        for (int ai = 0; ai < 2; ++ai)
#pragma unroll
            for (int m = 0; m < 4; ++m) {
                bf16_t* rowp = G + (size_t)(row0 + ai * HALF + m * 16) * ldg + col0;
                float g[8];
#pragma unroll
                for (int n = 0; n < 2; ++n)
#pragma unroll
                    for (int e = 0; e < 4; ++e) { const float a = acc[ai][0][m][n][e], uu = acc[ai][1][m][n][e]; g[n * 4 + e] = a * uu * sigmoidf_(a); }
                u32x4 w; w.x = cvt_pk_bf16(g[0], g[1]); w.y = cvt_pk_bf16(g[2], g[3]); w.z = cvt_pk_bf16(g[4], g[5]); w.w = cvt_pk_bf16(g[6], g[7]);
                *(u32x4*)rowp = w;
            }
    }
};
struct EpiSwigluI8 {
    static constexpr bool PERM = true, AFTER_DRAIN = false;
    signed char* G; int ldg; const float* sx; const float* gq; const float* wdq;
    __device__ __forceinline__ void operator()(const i32x4 (&acc)[2][2][4][2], const Unit& u, int wr, int wc, int fr, int fq) const {
        const int row0 = u.pm * BM + wr * 64 + fr, col0 = u.pn * HALF + wc * 32 + 8 * fq;
        const float wd = *wdq;
#pragma unroll
        for (int ai = 0; ai < 2; ++ai)
#pragma unroll
            for (int m = 0; m < 4; ++m) {
                const int row = row0 + ai * HALF + m * 16;
                const float sa = sx[row] * wd, gm = gq[row];
                unsigned w[2];
#pragma unroll
                for (int n = 0; n < 2; ++n) { int q[4];
#pragma unroll
                    for (int e = 0; e < 4; ++e) { const float a = (float)acc[ai][0][m][n][e] * sa, uu = (float)acc[ai][1][m][n][e] * sa; const float g = a * uu * sigmoidf_(a);
                        q[e] = (int)__builtin_rintf(fminf(fmaxf(g * gm, -127.f), 127.f)); }
                    w[n] = (unsigned)(q[0] & 255) | ((unsigned)(q[1] & 255) << 8) | ((unsigned)(q[2] & 255) << 16) | ((unsigned)q[3] << 24); }
                *(u32x2*)(G + (size_t)row * ldg + col0) = (u32x2){w[0], w[1]};
            }
    }
};
template <bool RESBF> struct EpiResI8 {
    static constexpr bool PERM = false, AFTER_DRAIN = false;
    float* out; const void* res; int ldc; float alpha, sc; const float* sg; const float* wdq;
    __device__ __forceinline__ void operator()(const i32x4 (&acc)[2][2][4][2], const Unit& u, int wr, int wc, int fr, int fq) const {
        const int row0 = u.pm * BM + wr * 64 + fr, col0 = u.pn * BM + wc * 32 + 4 * fq;
        const float wd = *wdq * sc;
#pragma unroll
        for (int ai = 0; ai < 2; ++ai)
#pragma unroll
            for (int m = 0; m < 4; ++m) { const int row = row0 + ai * HALF + m * 16; const size_t off = (size_t)row * ldc + col0; const float s = sg[row] * wd;
#pragma unroll
                for (int bj = 0; bj < 2; ++bj)
#pragma unroll
                    for (int n = 0; n < 2; ++n) { const size_t o = off + bj * HALF + n * 16; f32x4 r;
                        if (RESBF) { const u32x2 w = *(const u32x2*)((const bf16_t*)res + o); r = (f32x4){bf_lo(w.x), bf_hi(w.x), bf_lo(w.y), bf_hi(w.y)}; }
                        else r = *(const f32x4*)((const float*)res + o);
                        const i32x4 a = acc[ai][bj][m][n];
                        *(f32x4*)(out + o) = r * alpha + (f32x4){(float)a[0], (float)a[1], (float)a[2], (float)a[3]} * s; } }
    }
};
template <bool RESBF> struct EpiRes {
    static constexpr bool PERM = false, AFTER_DRAIN = false;
    float* out; const void* res; int ldc; float alpha, sc;
    __device__ __forceinline__ void operator()(const f32x4 (&acc)[2][2][4][2], const Unit& u, int wr, int wc, int fr, int fq) const {
        const int row0 = u.pm * BM + wr * 64 + fr, col0 = u.pn * BM + wc * 32 + 4 * fq;
#pragma unroll
        for (int ai = 0; ai < 2; ++ai)
#pragma unroll
            for (int m = 0; m < 4; ++m) { const size_t off = (size_t)(row0 + ai * HALF + m * 16) * ldc + col0;
#pragma unroll
                for (int bj = 0; bj < 2; ++bj)
#pragma unroll
                    for (int n = 0; n < 2; ++n) { const size_t o = off + bj * HALF + n * 16; f32x4 r;
                        if (RESBF) { const u32x2 w = *(const u32x2*)((const bf16_t*)res + o); r = (f32x4){bf_lo(w.x), bf_hi(w.x), bf_lo(w.y), bf_hi(w.y)}; }
                        else r = *(const f32x4*)((const float*)res + o);
                        *(f32x4*)(out + o) = r * alpha + acc[ai][bj][m][n] * sc; } }
    }
};
template <int PASS> struct EpiBranch {
    static constexpr bool PERM = false, AFTER_DRAIN = false;
    float* Y; bf16_t* Y16; const bf16_t* gate;
    __device__ __forceinline__ void operator()(const f32x4 (&acc)[2][2][4][2], const Unit& u, int wr, int wc, int fr, int fq) const {
        const int row0 = u.pm * BM + wr * 64 + fr, col0 = u.pn * BM + wc * 32 + 4 * fq;
#pragma unroll
        for (int ai = 0; ai < 2; ++ai)
#pragma unroll
            for (int m = 0; m < 4; ++m) { const size_t row = (size_t)(row0 + ai * HALF + m * 16);
#pragma unroll
                for (int bj = 0; bj < 2; ++bj)
#pragma unroll
                    for (int n = 0; n < 2; ++n) { const int col = col0 + bj * HALF + n * 16;
                        const u32x2 w = *(const u32x2*)(gate + row * 6144 + PASS * 2048 + col);
                        f32x4 v = acc[ai][bj][m][n] * (f32x4){bf_lo(w.x), bf_hi(w.x), bf_lo(w.y), bf_hi(w.y)};
                        if (PASS > 0) v += *(const f32x4*)(Y + row * 2048 + col);
                        if (PASS < 2) *(f32x4*)(Y + row * 2048 + col) = v;
                        else { u32x2 o; o.x = cvt_pk_bf16(v[0], v[1]); o.y = cvt_pk_bf16(v[2], v[3]); *(u32x2*)(Y16 + row * 2048 + col) = o; } } }
    }
};
struct EpiZ {
    static constexpr bool PERM = true, AFTER_DRAIN = false;
    bf16_t *Q, *KI, *KM; float* WI;
    __device__ __forceinline__ void operator()(const f32x4 (&acc)[2][2][4][2], const Unit& u, int wr, int wc, int fr, int fq) const {
        const int pn = u.pn;
        bf16_t* base; int ld, ct = 0, mode = 0, rowoff = 0;
        if (pn < 16) { base = Q + (size_t)(pn >> 2) * ((size_t)8192 * 1024); ld = 1024; ct = pn & 3; }
        else if (pn == 16) { base = KI; ld = 64; mode = 2; }
        else { base = KM + (size_t)((pn - 17) >> 1) * (512 * 512); ld = 512; ct = (pn - 17) & 1; rowoff = 8192; }
        const int row0 = u.pm * BM + wr * 64 + fr - rowoff, cl = wc * 32 + 8 * fq;
        if (mode == 2) {
#pragma unroll
            for (int ai = 0; ai < 2; ++ai)
#pragma unroll
                for (int m = 0; m < 4; ++m) { const size_t row = (size_t)(row0 + ai * HALF + m * 16);
                    const f32x4 v0 = acc[ai][0][m][0], v1 = acc[ai][0][m][1];
                    if (cl < 64) { u32x4 w; w.x = cvt_pk_bf16(v0[0], v0[1]); w.y = cvt_pk_bf16(v0[2], v0[3]); w.z = cvt_pk_bf16(v1[0], v1[1]); w.w = cvt_pk_bf16(v1[2], v1[3]); *(u32x4*)(KI + row * 64 + cl) = w; }
                    else if (cl < 80) { const float s = 1.0f / 32.0f;
                        *(f32x4*)(WI + row * 16 + (cl - 64)) = v0 * s; *(f32x4*)(WI + row * 16 + (cl - 64) + 4) = v1 * s; } }
            return;
        }
        const int col0 = ct * BM + cl;
#pragma unroll
        for (int ai = 0; ai < 2; ++ai)
#pragma unroll
            for (int m = 0; m < 4; ++m) { bf16_t* rowp = base + (size_t)(row0 + ai * HALF + m * 16) * ld + col0;
#pragma unroll
                for (int bj = 0; bj < 2; ++bj) { const f32x4 v0 = acc[ai][bj][m][0], v1 = acc[ai][bj][m][1];
                    u32x4 w; w.x = cvt_pk_bf16(v0[0], v0[1]); w.y = cvt_pk_bf16(v0[2], v0[3]); w.z = cvt_pk_bf16(v1[0], v1[1]); w.w = cvt_pk_bf16(v1[2], v1[3]);
                    *(u32x4*)(rowp + bj * HALF) = w; } }
    }
};
struct EpiZq {
    static constexpr bool PERM = true, AFTER_DRAIN = false;
    bf16_t *U; const float* bgate; const float* sx; const float* wdq;
    __device__ __forceinline__ void operator()(const i32x4 (&acc)[2][2][4][2], const Unit& u, int wr, int wc, int fr, int fq) const {
        const int pn = u.pn; const bool gate = pn >= 4;
        bf16_t* base = U + (size_t)(gate ? 2 : (pn >> 1)) * ((size_t)8192 * 512);
        const int ld = gate ? 6144 : 512, ct = gate ? pn - 4 : (pn & 1);
        const int row0 = u.pm * BM + wr * 64 + fr, col0 = ct * BM + wc * 32 + 8 * fq;
        const float wd = *wdq;
        f32x4 bv[2][2];
#pragma unroll
        for (int bj = 0; bj < 2; ++bj)
#pragma unroll
            for (int n = 0; n < 2; ++n) bv[bj][n] = gate ? *(const f32x4*)(bgate + col0 + bj * HALF + 4 * n) : (f32x4){0.f, 0.f, 0.f, 0.f};
#pragma unroll
        for (int ai = 0; ai < 2; ++ai)
#pragma unroll
            for (int m = 0; m < 4; ++m) { const int row = row0 + ai * HALF + m * 16; bf16_t* rowp = base + (size_t)row * ld + col0; const float sa = sx[row] * wd;
#pragma unroll
                for (int bj = 0; bj < 2; ++bj) { const i32x4 a0 = acc[ai][bj][m][0], a1 = acc[ai][bj][m][1];
                    f32x4 v0 = (f32x4){(float)a0[0], (float)a0[1], (float)a0[2], (float)a0[3]} * sa + bv[bj][0], v1 = (f32x4){(float)a1[0], (float)a1[1], (float)a1[2], (float)a1[3]} * sa + bv[bj][1];
                    if (gate) {
#pragma unroll
                        for (int e = 0; e < 4; ++e) { v0[e] = sigmoidf_(v0[e]); v1[e] = sigmoidf_(v1[e]); } }
                    u32x4 w; w.x = cvt_pk_bf16(v0[0], v0[1]); w.y = cvt_pk_bf16(v0[2], v0[3]); w.z = cvt_pk_bf16(v1[0], v1[1]); w.w = cvt_pk_bf16(v1[2], v1[3]);
                    *(u32x4*)(rowp + bj * HALF) = w; } }
    }
};

template <class Epi, class Sched, bool ALIGN_EPI = false, bool SP2 = false, bool I8 = false>
__device__ __forceinline__ void gemm_phase(PG8_LAS unsigned char* lds, const Gemm g, const Sched& S, const Epi& E) {
    int tid_ = threadIdx.x; asm volatile("" : "+v"(tid_));
    const int tid = tid_, wid = __builtin_amdgcn_readfirstlane(tid >> 6), lane = tid & 63, wr = wid >> 2, wc = wid & 3, fr = lane & 15, fq = lane >> 4;
    const int K = g.K, nt = K / BK;
    unsigned voffA[2], voffB[2];
#pragma unroll
    for (int i = 0; i < 2; ++i) { int R, C; stage_rc(tid * 16 + i * 8192, R, C); const int Rb = Epi::PERM ? ((R & ~31) + perm32(R & 31)) : R;
        voffA[i] = (unsigned)(R * K + C) * 2u; voffB[i] = (unsigned)(Rb * K + C) * 2u; }
    const size_t kstep = (size_t)(BK * 2);
    const size_t hstep = (size_t)HALF * K * 2;
    const size_t tstep = 2 * hstep;
    const unsigned ldsw = (unsigned)wid * 1024u;
    const int aoff = lds_byte(wr * 64 + fr, fq * 8), boff = lds_byte(wc * 32 + fr, fq * 8);
#define PG8_SA(b, h) (((b) * 2 + (h)) * HTB)
#define PG8_SB(b, h) ((4 + (b) * 2 + (h)) * HTB)
#define PG8_STAGE(bufoff, gbase, voff) do { _Pragma("unroll") for (int _i = 0; _i < 2; ++_i) \
        __builtin_amdgcn_global_load_lds((const unsigned*)((const char*)(gbase) + (voff)[_i]), (PG8_LAS unsigned*)(lds + (bufoff) + ldsw + _i * 8192), 16, 0, 0); } while (0)
#define PG8_LDA(dst, b, h) do { _Pragma("unroll") for (int m = 0; m < 4; ++m) _Pragma("unroll") for (int k = 0; k < 2; ++k) dst[m][k] = *(const PG8_LAS bf16x8*)(lds + PG8_SA(b, h) + aoff + m * 2048 + k * 1024); } while (0)
#define PG8_LDB(dst, b, h) do { _Pragma("unroll") for (int n = 0; n < 2; ++n) _Pragma("unroll") for (int k = 0; k < 2; ++k) dst[n][k] = *(const PG8_LAS bf16x8*)(lds + PG8_SB(b, h) + boff + n * 2048 + k * 1024); } while (0)
#define PG8_MMA(ai, bj, At, Bt) do { __builtin_amdgcn_s_setprio(1); _Pragma("unroll") for (int m = 0; m < 4; ++m) _Pragma("unroll") for (int n = 0; n < 2; ++n) _Pragma("unroll") for (int k = 0; k < 2; ++k) \
        { if constexpr (I8) acc[ai][bj][m][n] = __builtin_amdgcn_mfma_i32_16x16x64_i8(__builtin_bit_cast(i32x4, Bt[n][k]), __builtin_bit_cast(i32x4, At[m][k]), acc[ai][bj][m][n], 0, 0, 0); \
          else acc[ai][bj][m][n] = __builtin_amdgcn_mfma_f32_16x16x32_bf16(Bt[n][k], At[m][k], acc[ai][bj][m][n], 0, 0, 0); } __builtin_amdgcn_s_setprio(0); } while (0)
#define PG8_WAIT_V(n) asm volatile("s_waitcnt vmcnt(" #n ")" ::: "memory")
#define PG8_WAIT_L(n) asm volatile("s_waitcnt lgkmcnt(" #n ")" ::: "memory")
#define PG8_BAR __builtin_amdgcn_s_barrier()
#define PG8_SCHED __builtin_amdgcn_sched_barrier(0)
    Unit cur, nxt; int ui = 0;
    if (!S.next(0, cur)) return;
    typedef typename AccSel<I8>::type acc_t;
    acc_t acc[2][2][4][2];
#pragma unroll
    for (int a = 0; a < 2; ++a)
#pragma unroll
        for (int b = 0; b < 2; ++b)
#pragma unroll
            for (int m = 0; m < 4; ++m)
#pragma unroll
                for (int n = 0; n < 2; ++n) acc[a][b][m][n] = acc_t{};
    bf16x8 At[4][2], B0[2][2], B1[2][2];
    const char* cA = (const char*)g.A + (size_t)cur.pm * tstep; const char* cB = (const char*)g.Bt + (size_t)cur.pn * tstep;
    S.a_ready(cur);
    if constexpr (SP2) {
        PG8_STAGE(PG8_SB(0, 0), cB, voffB); PG8_STAGE(PG8_SB(0, 1), cB + hstep, voffB); PG8_STAGE(PG8_SA(0, 0), cA, voffA); PG8_STAGE(PG8_SA(0, 1), cA + hstep, voffA);
        if (wr == 1) PG8_BAR;
        PG8_WAIT_V(2); PG8_BAR;
        PG8_STAGE(PG8_SB(1, 0), cB + kstep, voffB); PG8_STAGE(PG8_SA(1, 0), cA + kstep, voffA); PG8_STAGE(PG8_SB(1, 1), cB + hstep + kstep, voffB);
        PG8_WAIT_V(6); PG8_BAR;
    } else {
        PG8_STAGE(PG8_SB(0, 0), cB, voffB); PG8_STAGE(PG8_SA(0, 0), cA, voffA); PG8_STAGE(PG8_SB(0, 1), cB + hstep, voffB); PG8_STAGE(PG8_SA(0, 1), cA + hstep, voffA);
        if (wr == 1) PG8_BAR;
        PG8_WAIT_V(4); PG8_BAR;
        PG8_STAGE(PG8_SB(1, 0), cB + kstep, voffB); PG8_STAGE(PG8_SA(1, 0), cA + kstep, voffA); PG8_STAGE(PG8_SB(1, 1), cB + hstep + kstep, voffB);
        PG8_WAIT_V(6); PG8_BAR;
    }
    for (;;) {
        const bool has_next = S.next(ui + 1, nxt);
        const char* nA = has_next ? (const char*)g.A + (size_t)nxt.pm * tstep : cA; const char* nB = has_next ? (const char*)g.Bt + (size_t)nxt.pn * tstep : cB;
        for (int t = 0; t < nt; t += 2) {
            const bool last = (t == nt - 2);
            const char* a1 = cA + (size_t)(t + 1) * kstep;
            const char* a2 = last ? nA : cA + (size_t)(t + 2) * kstep; const char* b2 = last ? nB : cB + (size_t)(t + 2) * kstep;
            const char* a3 = a2 + kstep; const char* b3 = b2 + kstep;
            if (last && has_next) S.a_ready(nxt);
            if constexpr (SP2) {
            PG8_LDB(B0, 0, 0); PG8_LDB(B1, 0, 1); PG8_SCHED; PG8_LDA(At, 0, 0); PG8_STAGE(PG8_SA(1, 1), a1 + hstep, voffA);
            PG8_WAIT_V(8); PG8_WAIT_L(0); PG8_BAR; PG8_MMA(0, 0, At, B0); PG8_MMA(0, 1, At, B1); PG8_BAR; PG8_SCHED;
            PG8_LDA(At, 0, 1); PG8_STAGE(PG8_SB(0, 0), b2, voffB); PG8_STAGE(PG8_SB(0, 1), b2 + hstep, voffB); PG8_STAGE(PG8_SA(0, 0), a2, voffA);
            PG8_WAIT_V(8); PG8_WAIT_L(0); PG8_BAR; PG8_MMA(1, 0, At, B0); PG8_MMA(1, 1, At, B1); PG8_BAR; PG8_SCHED;
            PG8_LDB(B0, 1, 0); PG8_LDB(B1, 1, 1); PG8_SCHED; PG8_LDA(At, 1, 0); PG8_STAGE(PG8_SA(0, 1), a2 + hstep, voffA);
            PG8_WAIT_V(8); PG8_WAIT_L(0); PG8_BAR; PG8_MMA(0, 0, At, B0); PG8_MMA(0, 1, At, B1); PG8_BAR; PG8_SCHED;
            PG8_LDA(At, 1, 1); PG8_STAGE(PG8_SB(1, 0), b3, voffB); PG8_STAGE(PG8_SB(1, 1), b3 + hstep, voffB); PG8_STAGE(PG8_SA(1, 0), a3, voffA);
            PG8_WAIT_V(8); PG8_WAIT_L(0); PG8_BAR; PG8_MMA(1, 0, At, B0); PG8_MMA(1, 1, At, B1); PG8_BAR; PG8_SCHED;
            } else {
            PG8_LDB(B0, 0, 0); PG8_SCHED; PG8_LDA(At, 0, 0); PG8_STAGE(PG8_SA(1, 1), a1 + hstep, voffA);
            PG8_WAIT_L(8); PG8_BAR; PG8_WAIT_L(0); PG8_MMA(0, 0, At, B0); PG8_BAR; PG8_SCHED;
            PG8_LDB(B1, 0, 1); PG8_STAGE(PG8_SB(0, 0), b2, voffB);
            PG8_BAR; PG8_WAIT_L(0); PG8_MMA(0, 1, At, B1); PG8_BAR;
            PG8_LDA(At, 0, 1); PG8_STAGE(PG8_SA(0, 0), a2, voffA);
            PG8_BAR; PG8_WAIT_L(0); PG8_MMA(1, 0, At, B0); PG8_BAR; PG8_SCHED;
            PG8_STAGE(PG8_SB(0, 1), b2 + hstep, voffB);
            PG8_WAIT_V(6); PG8_BAR; PG8_MMA(1, 1, At, B1); PG8_BAR;
            PG8_LDB(B0, 1, 0); PG8_SCHED; PG8_LDA(At, 1, 0); PG8_STAGE(PG8_SA(0, 1), a2 + hstep, voffA);
            PG8_WAIT_L(8); PG8_BAR; PG8_WAIT_L(0); PG8_MMA(0, 0, At, B0); PG8_BAR; PG8_SCHED;
            PG8_LDB(B1, 1, 1); PG8_STAGE(PG8_SB(1, 0), b3, voffB);
            PG8_BAR; PG8_WAIT_L(0); PG8_MMA(0, 1, At, B1); PG8_BAR;
            PG8_LDA(At, 1, 1); PG8_STAGE(PG8_SA(1, 0), a3, voffA);
            PG8_BAR; PG8_WAIT_L(0); PG8_MMA(1, 0, At, B0); PG8_BAR; PG8_SCHED;
            PG8_STAGE(PG8_SB(1, 1), b3 + hstep, voffB);
            PG8_WAIT_V(6); PG8_BAR; PG8_MMA(1, 1, At, B1); PG8_BAR;
            }
        }
        if constexpr (ALIGN_EPI) { if (wr == 0) PG8_BAR; }
        if constexpr (!Epi::AFTER_DRAIN) { E(acc, cur, wr, wc, fr, fq); S.done(cur); }
        if (!has_next) break;
#pragma unroll
        for (int a = 0; a < 2; ++a)
#pragma unroll
            for (int b = 0; b < 2; ++b)
#pragma unroll
                for (int m = 0; m < 4; ++m)
#pragma unroll
                    for (int n = 0; n < 2; ++n) acc[a][b][m][n] = acc_t{};
        cur = nxt; cA = nA; cB = nB; ++ui;
        if constexpr (ALIGN_EPI) { if (wr == 1) PG8_BAR; }
    }
    PG8_WAIT_V(0);
    if constexpr (!ALIGN_EPI) { if (wr == 0) PG8_BAR; }
    PG8_BAR;
#undef PG8_SA
#undef PG8_SB
#undef PG8_STAGE
#undef PG8_LDA
#undef PG8_LDB
#undef PG8_MMA
#undef PG8_WAIT_V
#undef PG8_WAIT_L
#undef PG8_BAR
#undef PG8_SCHED
}
}

namespace att {
using bf16 = __hip_bfloat16;
typedef short bf16x8 __attribute__((ext_vector_type(8)));
typedef short s16x4 __attribute__((ext_vector_type(4)));
typedef float f32x16 __attribute__((ext_vector_type(16)));
typedef float f32x4 __attribute__((ext_vector_type(4)));
typedef unsigned u32x4 __attribute__((ext_vector_type(4)));
typedef unsigned u32x2 __attribute__((ext_vector_type(2)));
constexpr int D = 128;
constexpr float SCALE = 0.08838834764831845f;
constexpr float THR = 8.f;
constexpr int NW = 8, QBLK = 32, KVBLK = 64, QB = NW * QBLK;
constexpr int SHM_V = KVBLK * D * 2, SHM_K = KVBLK * D * 2;
constexpr int LDS_BYTES = 2 * SHM_V + 2 * SHM_K + NW * 64 * 4;
#define KSWZ(row, colB) ((row) * 256 + ((colB) ^ (((row) & 7) << 4)))
#define SBAR() __builtin_amdgcn_sched_barrier(0)
__device__ __forceinline__ int v_st(int k, int c) { const int kk = (k & ~0xC) | ((k & 4) << 1) | ((k & 8) >> 1); return ((kk >> 3) * 4 + (c >> 5)) * 512 + ((kk & 7) * 32 + (c & 31)) * 2; }
__device__ __forceinline__ int v_rd_base(int lane) { return ((lane & 3) << 3) | (((lane >> 2) & 3) << 6) | (((lane >> 4) & 1) << 5) | (((lane >> 5) & 1) << 8); }
constexpr int v_rd_off(int d0, int ks, int half) { return d0 * 512 + ks * 4096 + half * 2048; }
__device__ __forceinline__ int crow(int r, int hi) { return (r & 3) + 8 * (r >> 2) + 4 * hi; }
__device__ __forceinline__ unsigned cvtpk(float lo, float hi) { unsigned r; asm volatile("v_cvt_pk_bf16_f32 %0, %1, %2" : "=v"(r) : "v"(lo), "v"(hi)); return r; }
__device__ __forceinline__ bf16x8 load8(const bf16* p) { return *reinterpret_cast<const bf16x8*>(p); }
__device__ __forceinline__ void mask_alibi(f32x16& p0, f32x16& p1, u32x2 mw, int dq, int hi, float ah) {
    const float NEG = -__builtin_inff();
    const unsigned w0 = mw.x >> (4 * hi), w1 = mw.y >> (4 * hi);
    const float dqf = (float)dq;
#pragma unroll
    for (int r = 0; r < 16; ++r) {
        const int c = (r & 3) + 8 * (r >> 2);
        p0[r] = ((w0 >> c) & 1u) ? fmaf(ah, (float)c - dqf, p0[r]) : NEG;
        p1[r] = ((w1 >> c) & 1u) ? fmaf(ah, (float)(c + 32) - dqf, p1[r]) : NEG;
    }
}
__device__ __forceinline__ void partialSM(f32x16& p0, f32x16& p1, float& m_reg, float& mn, float& alpha) {
    float pmax = p0[0];
#pragma unroll
    for (int r = 1; r < 16; ++r) pmax = fmaxf(pmax, p0[r]);
#pragma unroll
    for (int r = 0; r < 16; ++r) pmax = fmaxf(pmax, p1[r]);
    { auto rr = __builtin_amdgcn_permlane32_swap(__float_as_uint(pmax), __float_as_uint(pmax), false, false);
      pmax = fmaxf(__uint_as_float(rr[0]), __uint_as_float(rr[1])); }
    constexpr float C2 = 1.4426950408889634f * SCALE;
    if (__builtin_expect(__all((pmax - m_reg) * SCALE <= THR), 1)) { mn = m_reg; alpha = 1.f; }
    else { mn = fmaxf(m_reg, pmax); alpha = __builtin_amdgcn_exp2f((m_reg - mn) * C2); m_reg = mn; }
    const float mnL = -mn * C2;
#pragma unroll
    for (int r = 0; r < 16; ++r) p0[r] = fmaf(p0[r], C2, mnL);
#pragma unroll
    for (int r = 0; r < 16; ++r) p1[r] = fmaf(p1[r], C2, mnL);
#pragma unroll
    for (int r = 0; r < 16; ++r) p0[r] = __builtin_amdgcn_exp2f(p0[r]);
}
__device__ __forceinline__ void finishSM(f32x16& p0, f32x16& p1, float alpha, float& l_reg, bf16x8& pa0, bf16x8& pa1, bf16x8& pa2, bf16x8& pa3) {
#pragma unroll
    for (int r = 0; r < 16; ++r) p1[r] = __builtin_amdgcn_exp2f(p1[r]);
    float ps = 0;
#pragma unroll
    for (int r = 0; r < 16; ++r) ps += p0[r];
#pragma unroll
    for (int r = 0; r < 16; ++r) ps += p1[r];
    { auto rr = __builtin_amdgcn_permlane32_swap(__float_as_uint(ps), __float_as_uint(ps), false, false);
      ps = __uint_as_float(rr[0]) + __uint_as_float(rr[1]); }
    l_reg = l_reg * alpha + ps;
#define PK4(P, B_, OUT) do { unsigned a0 = cvtpk(P[B_+0], P[B_+1]), a1 = cvtpk(P[B_+2], P[B_+3]);                          \
        unsigned b0 = cvtpk(P[B_+4], P[B_+5]), b1 = cvtpk(P[B_+6], P[B_+7]);                                             \
        auto r0 = __builtin_amdgcn_permlane32_swap(a0, b0, false, false); auto r1 = __builtin_amdgcn_permlane32_swap(a1, b1, false, false); \
        u32x4 w = {r0[0], r1[0], r0[1], r1[1]}; OUT = *reinterpret_cast<bf16x8*>(&w); } while (0)
    PK4(p0, 0, pa0); PK4(p0, 8, pa1); PK4(p1, 0, pa2); PK4(p1, 8, pa3);
#undef PK4
}
template <int KB>
__device__ __forceinline__ void qkt(f32x16& p0, f32x16& p1, const char* K_lds, int r32, int hi, const bf16x8* qr) {
    p0 = f32x16{}; p1 = f32x16{};
    const char* kb[4];
#pragma unroll
    for (int dd = 0; dd < 4; ++dd) kb[dd] = K_lds + KB * SHM_K + KSWZ(r32, (dd * 16 + hi * 8) * 2);
#pragma unroll
    for (int d0 = 0; d0 < 8; ++d0) { const char* a = kb[d0 & 3] + (d0 >> 2) * 128;
        bf16x8 b0 = *reinterpret_cast<const bf16x8*>(a);
        bf16x8 b1 = *reinterpret_cast<const bf16x8*>(a + 32 * 256);
        p0 = __builtin_amdgcn_mfma_f32_32x32x16_bf16(b0, qr[d0], p0, 0, 0, 0);
        p1 = __builtin_amdgcn_mfma_f32_32x32x16_bf16(b1, qr[d0], p1, 0, 0, 0); }
}
template <int VB>
__device__ __forceinline__ void pv_tile(f32x16* o, int vb0, bf16x8 pa0, bf16x8 pa1, bf16x8 pa2, bf16x8 pa3) {
#define TRRD(dst, off) asm volatile("ds_read_b64_tr_b16 %0, %1 offset:%2" : "=&v"(dst) : "v"(vb0), "i"(off) : "memory")
#define PV_D0(d0) do { s16x4 l0, l1, l2, l3, h0, h1, h2, h3; constexpr int b_ = VB * SHM_V + v_rd_off(d0, 0, 0); \
        TRRD(l0, b_); TRRD(h0, b_ + 2048); TRRD(l1, b_ + 4096); TRRD(h1, b_ + 6144); TRRD(l2, b_ + 8192); TRRD(h2, b_ + 10240); TRRD(l3, b_ + 12288); TRRD(h3, b_ + 14336); \
        asm volatile("s_waitcnt lgkmcnt(0)" ::: "memory"); SBAR();   \
        o[d0] = __builtin_amdgcn_mfma_f32_32x32x16_bf16(pa0, (bf16x8){l0[0], l0[1], l0[2], l0[3], h0[0], h0[1], h0[2], h0[3]}, o[d0], 0, 0, 0);   \
        o[d0] = __builtin_amdgcn_mfma_f32_32x32x16_bf16(pa1, (bf16x8){l1[0], l1[1], l1[2], l1[3], h1[0], h1[1], h1[2], h1[3]}, o[d0], 0, 0, 0);   \
        o[d0] = __builtin_amdgcn_mfma_f32_32x32x16_bf16(pa2, (bf16x8){l2[0], l2[1], l2[2], l2[3], h2[0], h2[1], h2[2], h2[3]}, o[d0], 0, 0, 0);   \
        o[d0] = __builtin_amdgcn_mfma_f32_32x32x16_bf16(pa3, (bf16x8){l3[0], l3[1], l3[2], l3[3], h3[0], h3[1], h3[2], h3[3]}, o[d0], 0, 0, 0); } while (0)
    PV_D0(0); PV_D0(1); PV_D0(2); PV_D0(3);
#undef PV_D0
#undef TRRD
}
template <int LD, bool MASKED>
__device__ __forceinline__ void attn_block(const bf16* Q, const bf16* Kh, const bf16* Vh, bf16* O, int NT, int P0, const unsigned* maskbase, float ah, char* lds) {
    int tid_ = threadIdx.x; asm volatile("" : "+v"(tid_));
    const int tid = tid_, wid = __builtin_amdgcn_readfirstlane(tid >> 6), lane = tid & 63, r32 = lane & 31, hi = lane >> 5;
    const int qlo = P0 + wid * QBLK, qm = qlo + r32 - 4 * hi;
    char* V_lds = lds; char* K_lds = lds + 2 * SHM_V;
    float* ws = (float*)(lds + 2 * SHM_V + 2 * SHM_K) + wid * 64; float* li_l = ws, * al_l = ws + 32;
    float m_reg = -1e30f, l_reg = 0; f32x16 o[4] = {};
    const int sr = tid >> 4, sc = (tid & 15) * 8, vst0 = v_st(sr, sc), vst1 = v_st(32 + sr, sc), kws = KSWZ(sr, sc * 2);
    const int vb0 = (int)(uintptr_t)V_lds + v_rd_base(lane);
    const unsigned* mrow = MASKED ? maskbase + (size_t)(qlo + r32) * 128 : nullptr;
    bf16x8 qr[8], st_v0, st_v1, st_k0, st_k1;
#define ROW(p, k0, rr) ((p) + (size_t)((k0) + (rr)) * LD + sc)
#define VMW() asm volatile("s_waitcnt vmcnt(0)" ::: "memory")
#define SLOAD_H(k0) do { st_v0 = load8(ROW(Vh, k0, sr)); st_v1 = load8(ROW(Vh, k0, 32 + sr)); st_k0 = load8(ROW(Kh, k0, sr)); st_k1 = load8(ROW(Kh, k0, 32 + sr)); } while (0)
#define SWRITE_HK(bf) do { *(bf16x8*)(K_lds + (bf) * SHM_K + kws) = st_k0; *(bf16x8*)(K_lds + (bf) * SHM_K + kws + 32 * 256) = st_k1; } while (0)
#define SWRITE_HV(bf) do { *(bf16x8*)(V_lds + (bf) * SHM_V + vst0) = st_v0; *(bf16x8*)(V_lds + (bf) * SHM_V + vst1) = st_v1; } while (0)
#define SWRITE_H(bf) do { SWRITE_HV(bf); SWRITE_HK(bf); } while (0)
#define RESC(a) do { if (__any((a) < 1.f)) { if (hi == 0) al_l[r32] = (a); asm volatile("s_waitcnt lgkmcnt(0)" ::: "memory");              \
                     for (int d_ = 0; d_ < 4; ++d_) for (int r = 0; r < 16; ++r) o[d_][r] *= al_l[crow(r, hi)]; } } while (0)
#define KBASE(t) ((t) * KVBLK)
#define MLOAD(dst, t) do { if (MASKED) dst = *(const u32x2*)(mrow + 2 * (t)); } while (0)
#define MASKT(P0_, P1_, mw_, t) do { if (MASKED) mask_alibi(P0_, P1_, mw_, qm - KBASE(t), hi, ah); } while (0)
#pragma unroll
    for (int d0 = 0; d0 < 8; ++d0) qr[d0] = load8(Q + (size_t)(wid * QBLK + r32) * LD + d0 * 16 + hi * 8);
    SLOAD_H(0); VMW(); SWRITE_HK(0);
    __syncthreads();
    f32x16 pA0, pA1, pB0, pB1; float mnA, mnB, alA, alB; bf16x8 pa0, pa1, pa2, pa3;
    u32x2 mwA = {0u, 0u}, mwB = {0u, 0u};
    SWRITE_HV(0); SBAR();
    MLOAD(mwA, 0);
    if (NT > 1) SLOAD_H(KBASE(1));
    SBAR(); qkt<0>(pA0, pA1, K_lds, r32, hi, qr);
    MASKT(pA0, pA1, mwA, 0); partialSM(pA0, pA1, m_reg, mnA, alA);
    if (NT > 1) { VMW(); SWRITE_H(1); }
    __syncthreads();
#define HALF_STEP(PX0, PX1, mwX, mnX, alX, PY0, PY1, alY, t, KB, VB, SB) do {                                                 \
        SBAR(); MLOAD(mwX, t); qkt<KB>(PX0, PX1, K_lds, r32, hi, qr);                                                         \
        finishSM(PY0, PY1, alY, l_reg, pa0, pa1, pa2, pa3); SBAR();                                                           \
        if ((t) + 1 < NT) { SLOAD_H(KBASE((t) + 1)); SBAR(); }                                                                \
        pv_tile<VB>(o, vb0, pa0, pa1, pa2, pa3); MASKT(PX0, PX1, mwX, (t)); partialSM(PX0, PX1, m_reg, mnX, alX);             \
        __syncthreads();                                                                                                      \
        if ((t) + 1 < NT) { VMW(); SWRITE_H(SB); }                                                                            \
        RESC(alX); __syncthreads(); } while (0)
    for (int t = 1; t + 1 < NT; t += 2) {
        HALF_STEP(pB0, pB1, mwB, mnB, alB, pA0, pA1, alA, t, 1, 0, 0);
        HALF_STEP(pA0, pA1, mwA, mnA, alA, pB0, pB1, alB, t + 1, 0, 1, 1);
    }
    const bool even = (NT & 1) == 0;
    if (even) { SBAR(); MLOAD(mwB, NT - 1); qkt<1>(pB0, pB1, K_lds, r32, hi, qr); SBAR(); }
    finishSM(pA0, pA1, alA, l_reg, pa0, pa1, pa2, pa3); SBAR();
    pv_tile<0>(o, vb0, pa0, pa1, pa2, pa3);
    if (even) { MASKT(pB0, pB1, mwB, NT - 1); partialSM(pB0, pB1, m_reg, mnB, alB); __syncthreads(); RESC(alB);
        finishSM(pB0, pB1, alB, l_reg, pa0, pa1, pa2, pa3); SBAR(); pv_tile<1>(o, vb0, pa0, pa1, pa2, pa3); }
    SBAR();
    if (hi == 0) li_l[r32] = l_reg; asm volatile("s_waitcnt lgkmcnt(0)" ::: "memory");
    float rli[16];
#pragma unroll
    for (int r = 0; r < 16; ++r) rli[r] = __builtin_amdgcn_rcpf(li_l[crow(r, hi)]);
    bf16* Ow = O + (size_t)(wid * QBLK) * LD;
#pragma unroll
    for (int r = 0; r < 16; ++r) { const int orow = crow(r, hi);
#pragma unroll
        for (int d0 = 0; d0 < 4; ++d0) { const float v = o[d0][r] * rli[r];
            const float vn = __shfl_xor(v, 1);
            if ((r32 & 1) == 0) *(unsigned*)(Ow + (size_t)orow * LD + d0 * 32 + r32) = cvtpk(v, vn); } }
    __syncthreads();
#undef ROW
#undef VMW
#undef SLOAD_H
#undef SWRITE_HK
#undef SWRITE_HV
#undef SWRITE_H
#undef RESC
#undef KBASE
#undef MLOAD
#undef MASKT
#undef HALF_STEP
}
#undef KSWZ
#undef SBAR
}

constexpr int NWAVES = 8;
constexpr int BATCH = 2, SEQ = 4096, DM = 2048, T = BATCH * SEQ, FF = 5632, NUP = 2 * FF;
constexpr int NIN = 11344, NIN_PAD = 11520;
constexpr int MEMLEN = 256, TOPK = 256;
constexpr float ALPHA = 1.189207115002721f;
constexpr float LN_EPS = 1e-5f;
constexpr int N_PHASES = 13;

constexpr size_t WS_CTL = 0, CTL_ZERO_BYTES = 1u << 20;
constexpr size_t WS_BIG = 1u << 20;
constexpr size_t O_X16 = 0, O_WUP1 = O_X16 + (size_t)T * DM * 2, O_WDN1 = O_WUP1 + (size_t)NUP * DM * 2, O_G = O_WDN1 + (size_t)DM * FF * 2, BIG_BYTES = O_G + (size_t)T * FF * 2;
constexpr size_t O_Q = 0, O_K = O_Q + (size_t)T * 1024 * 2, O_V = O_K + (size_t)T * 1024 * 2, O_QI = O_V + (size_t)T * 1024 * 2, O_KI = O_QI + (size_t)T * 1024 * 2,
                 O_WI = O_KI + (size_t)T * 64 * 2, O_U = O_WI + (size_t)T * 16 * 4, O_QM = O_U + (size_t)T * 512 * 2, O_GATE = O_QM + (size_t)T * 512 * 2, O_MIXEND = O_GATE + (size_t)T * 6144 * 2;
static_assert(O_MIXEND <= BIG_BYTES, "mixer view fits");
constexpr size_t WS_WIN = WS_BIG + BIG_BYTES;
constexpr int NZB = 4352, NZQ = NIN_PAD - NZB;
constexpr size_t WS_WMKV = WS_WIN + (size_t)NZB * DM * 2;
constexpr size_t WS_WINQ = WS_WMKV + (size_t)1024 * DM * 2;
constexpr size_t WS_WBA = WS_WIN + (size_t)NIN_PAD * DM * 2 + (size_t)1024 * DM * 2;
constexpr size_t WS_WBP = WS_WBA + (size_t)DM * 1024 * 2;
constexpr size_t WS_WBM = WS_WBP + (size_t)DM * 512 * 2;
constexpr size_t WS_WOUT = WS_WBM + (size_t)DM * 512 * 2;
constexpr size_t WS_WUP2 = WS_WOUT + (size_t)DM * DM * 2;
constexpr size_t WS_WDN2 = WS_WUP2 + (size_t)NUP * DM * 2;
constexpr size_t WS_WPOOL = WS_WDN2 + (size_t)DM * FF * 2;
constexpr size_t WS_H1 = WS_WPOOL + (size_t)4 * 128 * 128 * 2;
constexpr size_t WS_MEM16 = WS_H1 + (size_t)T * DM * 2;
constexpr size_t WS_A16 = WS_MEM16 + (size_t)512 * DM * 2;
constexpr size_t WS_P16 = WS_A16 + (size_t)T * 1024 * 2;
constexpr size_t WS_M16 = WS_P16 + (size_t)T * 512 * 2;
constexpr size_t WS_Y16 = WS_M16 + (size_t)T * 512 * 2;
constexpr size_t WS_KM = WS_Y16 + (size_t)T * DM * 2;
constexpr size_t WS_VM = WS_KM + (size_t)512 * 512 * 2;
constexpr size_t WS_MASK = WS_VM + (size_t)512 * 512 * 2;
constexpr size_t WS_END = WS_MASK + (size_t)T * 128 * 4;
constexpr int CW_BAR = 4096;
constexpr size_t WS_QS = 65536;
constexpr size_t WS_ROWQ = 131072;
static_assert(WS_ROWQ + (size_t)9 * 8192 * 4 <= (1u << 20), "control region");

constexpr int RING_OFF = 0, RING_BYTES = 131072;
constexpr int LDSCTL_OFF = RING_BYTES, MISC_OFF = LDSCTL_OFF + 320;
constexpr int LDS_BYTES = 147456;

#define GAS __attribute__((address_space(1)))
#define LAS __attribute__((address_space(3)))
typedef unsigned short bf16;
typedef unsigned v4u __attribute__((ext_vector_type(4)));
typedef unsigned v2u __attribute__((ext_vector_type(2)));
typedef float f32x4 __attribute__((ext_vector_type(4)));
typedef float f32x16 __attribute__((ext_vector_type(16)));
typedef short bf16x8 __attribute__((ext_vector_type(8)));
#define LDS_WAIT() asm volatile("s_waitcnt lgkmcnt(0)" ::: "memory")
__device__ __forceinline__ unsigned f2bf(float f) { unsigned u = __builtin_bit_cast(unsigned, f); return (u + 0x7fffu + ((u >> 16) & 1u)) >> 16; }
__device__ __forceinline__ unsigned pk2(float lo, float hi) { return f2bf(lo) | (f2bf(hi) << 16); }

#define XB_TMO      128
#define XB_XCNT(j)  (256  + 64 * (j))
#define XB_XSUB(j)  (1280 + 64 * (j))
#define XB_XGEN(j)  (2304 + 64 * (j))
#define XB_TOP      3328
#define XB_TOPGEN   3392
#define XCD_BAR_WORDS 3456
#define XB_SPIN_CAP (1u << 22)
__device__ __forceinline__ unsigned xb_ld(unsigned* p)              { return __hip_atomic_load(p, __ATOMIC_RELAXED, __HIP_MEMORY_SCOPE_AGENT); }
__device__ __forceinline__ unsigned xb_add(unsigned* p, unsigned v) { return __hip_atomic_fetch_add(p, v, __ATOMIC_RELAXED, __HIP_MEMORY_SCOPE_AGENT); }
__device__ __forceinline__ unsigned xb_xcc_id() { return (unsigned)__builtin_amdgcn_s_getreg((3 << 11) | 20) & 0xFu; }
#define XB_SPIN(cond, bar) do { unsigned _sp = 0; while (cond) { __builtin_amdgcn_s_sleep(1); \
    if ((++_sp & 255u) == 0u) { if (xb_ld(&(bar)[XB_TMO])) break; if (_sp > XB_SPIN_CAP) { atomicAdd(&(bar)[XB_TMO], 1u); break; } } } } while (0)
struct XcdBarrier { unsigned* bar; unsigned x; volatile LAS unsigned* st; };
__device__ __forceinline__ XcdBarrier xcd_barrier_post(unsigned* bar, volatile LAS unsigned* st) {
    XcdBarrier b; b.bar = bar; b.x = xb_xcc_id(); b.st = st;
    if (threadIdx.x == 0) (void)xb_add(&bar[XB_XCNT(b.x)], 1u);
    return b;
}
__device__ __forceinline__ void xcd_barrier_complete(unsigned* bar, unsigned x, unsigned& nloc, unsigned& nx) {
    const unsigned G = gridDim.x * gridDim.y * gridDim.z;
    unsigned sum, cnt, mine, sp = 0u;
    for (;;) {
        sum = 0u; cnt = 0u; mine = 0u;
#pragma unroll
        for (unsigned j = 0; j < 16; ++j) { const unsigned c = xb_ld(&bar[XB_XCNT(j)]); sum += c; cnt += (c > 0u) ? 1u : 0u; mine = (j == x) ? c : mine; }
        if (sum == G) break;
        __builtin_amdgcn_s_sleep(1);
        if ((++sp & 255u) == 0u) { if (xb_ld(&bar[XB_TMO])) break; if (sp > XB_SPIN_CAP) { atomicAdd(&bar[XB_TMO], 1u); break; } }
    }
    nloc = mine > 0u ? mine : 1u; nx = cnt > 0u ? cnt : 1u;
}
__device__ __forceinline__ void xcd_barrier(const XcdBarrier& b) {
    asm volatile("s_waitcnt vmcnt(0)" ::: "memory");
    __syncthreads();
    if (threadIdx.x == 0) {
        unsigned* bar = b.bar;
        __builtin_amdgcn_s_waitcnt(0);
        unsigned nloc = b.st[0], nx = b.st[1];
        if (nloc == 0u) { xcd_barrier_complete(bar, b.x, nloc, nx); b.st[0] = nloc; b.st[1] = nx; }
        const unsigned old = xb_add(&bar[XB_XSUB(b.x)], 1u);
        const unsigned gen = old / nloc;
        if (old + 1u == (gen + 1u) * nloc) {
            __builtin_amdgcn_fence(__ATOMIC_RELEASE, "agent");
            asm volatile("s_waitcnt vmcnt(0)" ::: "memory");
            const unsigned og = xb_add(&bar[XB_TOP], 1u);
            const unsigned tg = og / nx;
            if (og + 1u == (tg + 1u) * nx) xb_add(&bar[XB_TOPGEN], 1u);
            else XB_SPIN(xb_ld(&bar[XB_TOPGEN]) == tg, bar);
            __builtin_amdgcn_fence(__ATOMIC_ACQUIRE, "agent");
            xb_add(&bar[XB_XGEN(b.x)], 1u);
            asm volatile("s_waitcnt vmcnt(0)" ::: "memory");
        } else {
            XB_SPIN(xb_ld(&bar[XB_XGEN(b.x)]) == gen, bar);
            __builtin_amdgcn_fence(__ATOMIC_ACQUIRE, "agent");
            asm volatile("s_waitcnt vmcnt(0)" ::: "memory");
        }
    }
    __syncthreads();
}

__device__ __forceinline__ float wave_sum(float v) {
#pragma unroll
    for (int o = 1; o < 64; o <<= 1) v += __shfl_xor(v, o);
    return v;
}
template <int MAP>
__device__ __forceinline__ void p0_transpose_item(const float* W, int K, int N, int NP, bf16* WT, LAS float* scr, int item, int lane) {
    const int nblk = NP / 32, kb = item / nblk, nb = item % nblk, k0 = 64 * kb, np0 = 32 * nb;
    int n0 = np0; int nvalid = 32;
    if (MAP == 1) n0 = ((np0 >> 7) & 1) * FF + (np0 >> 8) * 128 + (np0 & 127);
    if (MAP == 2) { if (np0 < 4096) n0 = np0; else if (np0 < 4352) { n0 = np0; nvalid = 4176 - np0; nvalid = nvalid < 0 ? 0 : (nvalid > 32 ? 32 : nvalid); } else n0 = np0 - 176; }
    float v[32];
    const bool ok = (lane & 31) < nvalid;
#pragma unroll
    for (int i = 0; i < 32; ++i) { const int kk = 2 * i + (lane >> 5); v[i] = ok ? W[(size_t)(k0 + kk) * N + n0 + (lane & 31)] : 0.f; }
#pragma unroll
    for (int i = 0; i < 32; ++i) { const int kk = 2 * i + (lane >> 5); scr[kk * 33 + (lane & 31)] = v[i]; }
    LDS_WAIT(); asm volatile("" ::: "memory");
    const int c = lane & 7;
#pragma unroll
    for (int j = 0; j < 4; ++j) { const int n = (lane >> 3) + 8 * j; const LAS float* s = scr + (8 * c) * 33 + n;
        v4u o; o.x = pk2(s[0 * 33], s[1 * 33]); o.y = pk2(s[2 * 33], s[3 * 33]); o.z = pk2(s[4 * 33], s[5 * 33]); o.w = pk2(s[6 * 33], s[7 * 33]);
        *(GAS v4u*)(WT + (size_t)(np0 + n) * K + k0 + 8 * c) = o; }
    LDS_WAIT(); asm volatile("" ::: "memory");
}
__device__ __forceinline__ unsigned q8(float v, float qw) { return (unsigned)((int)__builtin_rintf(fminf(fmaxf(v * qw, -127.f), 127.f)) & 255); }
template <int MAP>
__device__ __forceinline__ void p0_transpose_item_i8(const float* W, int K, int N, int NP, signed char* WT, LAS float* scr, int item, int lane, float qw) {
    const int nblk = NP / 32, kb = item / nblk, nb = item % nblk, k0 = 64 * kb, np0 = 32 * nb;
    int n0 = np0;
    if (MAP == 1) n0 = ((np0 >> 7) & 1) * FF + (np0 >> 8) * 128 + (np0 & 127);
    float v[32];
#pragma unroll
    for (int i = 0; i < 32; ++i) { const int kk = 2 * i + (lane >> 5); v[i] = W[(size_t)(k0 + kk) * N + n0 + (lane & 31)]; }
#pragma unroll
    for (int i = 0; i < 32; ++i) { const int kk = 2 * i + (lane >> 5); scr[kk * 33 + (lane & 31)] = v[i]; }
    LDS_WAIT(); asm volatile("" ::: "memory");
#pragma unroll
    for (int j = 0; j < 2; ++j) { const int id = lane + 64 * j, n = id >> 2, c = id & 3; const LAS float* sp = scr + (16 * c) * 33 + n;
        v4u o;
        o.x = q8(sp[0 * 33], qw) | (q8(sp[1 * 33], qw) << 8) | (q8(sp[2 * 33], qw) << 16) | (q8(sp[3 * 33], qw) << 24);
        o.y = q8(sp[4 * 33], qw) | (q8(sp[5 * 33], qw) << 8) | (q8(sp[6 * 33], qw) << 16) | (q8(sp[7 * 33], qw) << 24);
        o.z = q8(sp[8 * 33], qw) | (q8(sp[9 * 33], qw) << 8) | (q8(sp[10 * 33], qw) << 16) | (q8(sp[11 * 33], qw) << 24);
        o.w = q8(sp[12 * 33], qw) | (q8(sp[13 * 33], qw) << 8) | (q8(sp[14 * 33], qw) << 16) | (q8(sp[15 * 33], qw) << 24);
        *(GAS v4u*)(WT + (size_t)(np0 + n) * K + k0 + 16 * c) = o; }
    LDS_WAIT(); asm volatile("" ::: "memory");
}
__device__ __forceinline__ float sample_sigma2(const float* W, int K, int N, int lane) {
    float s = 0.f;
#pragma unroll
    for (int j = 0; j < 4; ++j) { const f32x4 v = *(const GAS f32x4*)(W + (size_t)(j * (K / 4)) * N + lane * 4); s += (v.x * v.x + v.y * v.y) + (v.z * v.z + v.w * v.w); }
    return wave_sum(s) * (1.0f / 1024.0f);
}
__device__ __forceinline__ void quant_row_i8(const f32x4 (&v)[8], signed char* qrow, float* sx, float* gq, float* sg, float sig2, int lane) {
    float mx = 0.f, ss = 0.f;
#pragma unroll
    for (int j = 0; j < 8; ++j) { mx = fmaxf(mx, fmaxf(fmaxf(fabsf(v[j].x), fabsf(v[j].y)), fmaxf(fabsf(v[j].z), fabsf(v[j].w)))); ss += (v[j].x * v[j].x + v[j].y * v[j].y) + (v[j].z * v[j].z + v[j].w * v[j].w); }
#pragma unroll
    for (int o = 1; o < 64; o <<= 1) mx = fmaxf(mx, __shfl_xor(mx, o));
    ss = wave_sum(ss);
    const float m = fmaxf(mx, 1e-20f), qm = 127.f / m;
#pragma unroll
    for (int j = 0; j < 8; ++j) ((GAS unsigned*)qrow)[lane + 64 * j] = q8(v[j].x, qm) | (q8(v[j].y, qm) << 8) | (q8(v[j].z, qm) << 16) | (q8(v[j].w, qm) << 24);
    if (lane == 0) { const float clip = fmaxf(8.f * ss * sig2, 1e-20f);
        *sx = m * (1.0f / 127.f); *gq = 127.f / clip; *sg = clip * (1.0f / 127.f); }
}
template <bool OUT_BF16, bool Q8 = false>
__device__ __forceinline__ void ln_row(const float* xrow, const float* gam, const float* bet, void* orow, int lane, signed char* qrow = nullptr, float* sx = nullptr, float* gq = nullptr, float* sg = nullptr, float sig2 = 0.f) {
    const GAS f32x4* xr = (const GAS f32x4*)xrow + lane;
    f32x4 v[8]; float s = 0.f;
#pragma unroll
    for (int j = 0; j < 8; ++j) { v[j] = xr[64 * j]; s += (v[j].x + v[j].y) + (v[j].z + v[j].w); }
    const float mean = wave_sum(s) * (1.f / DM); float s2 = 0.f;
#pragma unroll
    for (int j = 0; j < 8; ++j) { v[j] = v[j] - mean; s2 += (v[j].x * v[j].x + v[j].y * v[j].y) + (v[j].z * v[j].z + v[j].w * v[j].w); }
    const float rstd = 1.f / sqrtf(wave_sum(s2) * (1.f / DM) + LN_EPS);
#pragma unroll
    for (int j = 0; j < 8; ++j) {
        const f32x4 gg = ((const GAS f32x4*)gam)[lane + 64 * j], bb = ((const GAS f32x4*)bet)[lane + 64 * j];
        const f32x4 y = v[j] * rstd * gg + bb;
        if (OUT_BF16) { ((GAS v2u*)orow)[lane + 64 * j] = (v2u){pk2(y.x, y.y), pk2(y.z, y.w)}; }
        else ((GAS f32x4*)orow)[lane + 64 * j] = y;
        if (Q8) v[j] = y;
    }
    if (Q8) quant_row_i8(v, qrow, sx, gq, sg, sig2, lane);
}

__device__ __forceinline__ unsigned ordkey(float s) { const unsigned u = __float_as_uint(s); return u ^ ((unsigned)((int)u >> 31) | 0x80000000u); }
__device__ __forceinline__ void indexer_unit(LAS unsigned char* lds, int b, int uidx, const bf16* QI16, const bf16* KI16, const float* WI, unsigned* MASKQ) {
    int tid_ = threadIdx.x; asm volatile("" : "+v"(tid_));
    const int tid = tid_, lane = tid & 63, wid = __builtin_amdgcn_readfirstlane(tid >> 6), r = lane & 31, h = lane >> 5;
    const int q0 = uidx * 16 + 2 * wid, tq = q0 + h;
    const int nchunk = ((uidx * 16 + 15) >> 8) + 1;
    bf16x8 aq[4];
    { const int qa = q0 + ((r >> 2) & 1), head = (r & 3) + 4 * (r >> 3);
      const bf16* qp = QI16 + (size_t)(b * SEQ + qa) * 1024 + head * 64 + 8 * h;
#pragma unroll
      for (int ks = 0; ks < 4; ++ks) aq[ks] = *(const GAS bf16x8*)(qp + ks * 16); }
    float w[16];
    { const GAS f32x4* wp = (const GAS f32x4*)(WI + (size_t)(b * SEQ + tq) * 16);
#pragma unroll
      for (int i = 0; i < 4; ++i) { const f32x4 t = wp[i]; w[4 * i] = t.x; w[4 * i + 1] = t.y; w[4 * i + 2] = t.z; w[4 * i + 3] = t.w; } }
    unsigned key[128];
    const char* kbase = (const char*)(KI16 + (size_t)(b * SEQ) * 64);
    unsigned soff[4];
#pragma unroll
    for (int i = 0; i < 4; ++i) { const int kk = (wid * 4 + i) * 8 + (lane >> 3), cs = lane & 7; soff[i] = (unsigned)(kk * 128 + ((cs ^ ((kk >> 1) & 7)) << 4)); }
#define IDX_STAGE(c_) do { _Pragma("unroll") for (int i = 0; i < 4; ++i) \
        __builtin_amdgcn_global_load_lds((const unsigned*)(kbase + (size_t)(c_) * 32768 + soff[i]), (LAS unsigned*)(lds + ((c_) & 1) * 32768 + (wid * 4 + i) * 1024), 16, 0, 0); } while (0)
    const int x = (r >> 1) & 7;
    int roff[4];
#pragma unroll
    for (int ks = 0; ks < 4; ++ks) roff[ks] = r * 128 + (((2 * ks + h) ^ x) << 4);
    __syncthreads();
    IDX_STAGE(0);
#pragma unroll
    for (int c = 0; c < 16; ++c) {
        if (c < nchunk) {
            asm volatile("s_waitcnt vmcnt(0)" ::: "memory");
            __syncthreads();
            if (c + 1 < nchunk) IDX_STAGE(c + 1);
#pragma unroll
            for (int jj = 0; jj < 8; ++jj) {
                const int j = c * 8 + jj;
                f32x16 acc = {};
#pragma unroll
                for (int ks = 0; ks < 4; ++ks) { const bf16x8 bk = *(const LAS bf16x8*)(lds + (c & 1) * 32768 + jj * 4096 + roff[ks]);
                    acc = __builtin_amdgcn_mfma_f32_32x32x16_bf16(aq[ks], bk, acc, 0, 0, 0); }
                float s = 0.f;
#pragma unroll
                for (int i = 0; i < 16; ++i) s = fmaf(w[i], fmaxf(acc[i], 0.f), s);
                unsigned kj = (j * 32 + r <= tq) ? ordkey(s) : 0u;
                asm volatile("" : "+v"(kj));
                key[j] = kj;
                __builtin_amdgcn_sched_barrier(0);
            }
        } else {
#pragma unroll
            for (int jj = 0; jj < 8; ++jj) key[c * 8 + jj] = 0u;
        }
    }
#undef IDX_STAGE
    unsigned thr = 1u;
    {
        unsigned lo = 0u, hi = 0xFFFFFFFFu; bool done = (tq + 1 <= TOPK);
        while (!__all(done)) {
            const unsigned mid = lo + ((hi - lo) >> 1);
            int cnt = 0;
#pragma unroll
            for (int j = 0; j < 128; ++j) cnt += (key[j] >= mid) ? 1 : 0;
#pragma unroll
            for (int o = 1; o < 32; o <<= 1) cnt += __shfl_xor(cnt, o);
            if (!done) {
                if (cnt >= TOPK) lo = mid; else hi = mid;
                if (cnt == TOPK) { thr = mid; done = true; }
                else if (hi - lo <= 1u) { thr = lo; done = true; }
            }
        }
    }
    LAS unsigned* mb = (LAS unsigned*)(lds + 65536) + wid * 256;
#pragma unroll
    for (int j = 0; j < 128; ++j) {
        const unsigned long long bal = __ballot(key[j] >= thr);
        const unsigned val = h ? (unsigned)(bal >> 32) : (unsigned)bal;
        if (r == 0) mb[h * 128 + j] = val;
        asm volatile("" ::: "memory");
    }
    LDS_WAIT(); asm volatile("" ::: "memory");
    GAS unsigned* mp = (GAS unsigned*)(MASKQ + (size_t)(b * SEQ + q0) * 128);
#pragma unroll
    for (int i = 0; i < 4; ++i) mp[64 * i + lane] = mb[64 * i + lane];
    LDS_WAIT(); asm volatile("" ::: "memory");
}

__device__ __forceinline__ void pool_task(int task, const bf16* U16, const bf16* WPT, const float* pscale, bf16* P16, int lane) {
    asm volatile("" : "+v"(lane));
    const int tile = task >> 2, g = task & 3, r = lane & 31, h = lane >> 5;
    const int tk = tile * 32 + r, pos = tk & (SEQ - 1), wlen = 2 << g;
    const int cnt = (pos + 1 < wlen) ? pos + 1 : wlen;
    const float rc = 1.0f / (float)cnt;
    bf16x8 pa[8];
#pragma unroll
    for (int ks = 0; ks < 8; ++ks) {
        const bf16* up = U16 + (size_t)tk * 512 + g * 128 + ks * 16 + 8 * h;
        float sum[8], self[8];
#pragma unroll
        for (int e = 0; e < 8; ++e) sum[e] = 0.f;
        for (int i = 0; i < wlen; ++i) {
            if (i < cnt) { const v4u t = *(const GAS v4u*)(up - (size_t)i * 512);
                const float f0 = pg8::bf_lo(t.x), f1 = pg8::bf_hi(t.x), f2 = pg8::bf_lo(t.y), f3 = pg8::bf_hi(t.y), f4 = pg8::bf_lo(t.z), f5 = pg8::bf_hi(t.z), f6 = pg8::bf_lo(t.w), f7 = pg8::bf_hi(t.w);
                if (i == 0) { self[0] = f0; self[1] = f1; self[2] = f2; self[3] = f3; self[4] = f4; self[5] = f5; self[6] = f6; self[7] = f7; }
                sum[0] += f0; sum[1] += f1; sum[2] += f2; sum[3] += f3; sum[4] += f4; sum[5] += f5; sum[6] += f6; sum[7] += f7; }
        }
        v4u o; o.x = pk2(sum[0] * rc - self[0], sum[1] * rc - self[1]); o.y = pk2(sum[2] * rc - self[2], sum[3] * rc - self[3]);
        o.z = pk2(sum[4] * rc - self[4], sum[5] * rc - self[5]); o.w = pk2(sum[6] * rc - self[6], sum[7] * rc - self[7]);
        pa[ks] = __builtin_bit_cast(bf16x8, o);
    }
#pragma unroll
    for (int nb = 0; nb < 4; ++nb) {
        f32x16 acc = {};
        const bf16* wp = WPT + (size_t)g * 16384 + (size_t)(nb * 32 + r) * 128 + 8 * h;
#pragma unroll
        for (int ks = 0; ks < 8; ++ks) { const bf16x8 bk = *(const GAS bf16x8*)(wp + ks * 16); acc = __builtin_amdgcn_mfma_f32_32x32x16_bf16(pa[ks], bk, acc, 0, 0, 0); }
        const int col = g * 128 + nb * 32 + r; const float ps = pscale[col];
#pragma unroll
        for (int i = 0; i < 16; ++i) { const int tok = tile * 32 + (i & 3) + 8 * (i >> 2) + 4 * h; P16[(size_t)tok * 512 + col] = (bf16)f2bf(acc[i] * ps); }
    }
}

struct Args { const float* in[21]; float* out; unsigned char* ws; int ph_lo, ph_hi; };
__global__ void __launch_bounds__(NWAVES * 64, 2) mk_fwd(Args args) {
    extern __shared__ __attribute__((aligned(16))) unsigned char lds[];
    LAS unsigned char* L = (LAS unsigned char*)lds;
    volatile LAS unsigned* MISC = (volatile LAS unsigned*)(L + MISC_OFF);
    const int tid = threadIdx.x, lane = tid & 63, wave = __builtin_amdgcn_readfirstlane(tid >> 6);
    const int G = gridDim.x, bx = blockIdx.x;
    const int vcu = (G % 8 == 0) ? (bx % 8) * (G / 8) + bx / 8 : bx;
    const int gw = vcu * NWAVES + wave, NGW = G * NWAVES;
    unsigned char* ws = args.ws;
    for (int u = tid; u < (LDS_BYTES - LDSCTL_OFF) / 4; u += NWAVES * 64) ((LAS unsigned*)(L + LDSCTL_OFF))[u] = 0u;
    __syncthreads();
    XcdBarrier bar; bar.bar = (unsigned*)(ws + WS_CTL) + CW_BAR; bar.x = 0; bar.st = nullptr;
    if (!MK_PER_PHASE) bar = xcd_barrier_post((unsigned*)(ws + WS_CTL) + CW_BAR, MISC + 8);
    const int lo = args.ph_lo, hi = args.ph_hi;
#ifndef PH_MASK
#define PH_MASK 0x1FFF
#endif
#ifndef REP_MASK
#define REP_MASK 0x0
#endif
#define REP(k) for (int rep_ = 0; rep_ <= ((REP_MASK >> (k)) & 1); ++rep_)
#define REPBAR() do { if (rep_) xcd_barrier(bar); } while (0)
#define IN(k) (((PH_MASK >> (k)) & 1) && lo <= (k) && (k) < hi)
#define SEAM(k) do { if (IN(k) && IN((k) + 1)) xcd_barrier(bar); } while (0)
#define XIN (ap->in[0])
#define MEMIN (ap->in[1])
#define WSP_DECL unsigned char* wsp = args.ws; asm volatile("" : "+s"(wsp)); const __attribute__((address_space(4))) Args* ap = (const __attribute__((address_space(4))) Args*)__builtin_amdgcn_kernarg_segment_ptr(); asm volatile("" : "+s"(ap)); (void)wsp; (void)ap
#define BIG ((bf16*)(wsp + WS_BIG))
#define X16 ((bf16*)(wsp + WS_BIG + O_X16))
#define WUP1 ((bf16*)(wsp + WS_BIG + O_WUP1))
#define WDN1 ((bf16*)(wsp + WS_BIG + O_WDN1))
#define Gb ((bf16*)(wsp + WS_BIG + O_G))
#define Q16 ((bf16*)(wsp + WS_BIG + O_Q))
#define K16 ((bf16*)(wsp + WS_BIG + O_K))
#define V16 ((bf16*)(wsp + WS_BIG + O_V))
#define QI16 ((bf16*)(wsp + WS_BIG + O_QI))
#define KI16 ((bf16*)(wsp + WS_BIG + O_KI))
#define WI ((float*)(wsp + WS_BIG + O_WI))
#define U16 ((bf16*)(wsp + WS_BIG + O_U))
#define QM16 ((bf16*)(wsp + WS_BIG + O_QM))
#define GATE ((bf16*)(wsp + WS_BIG + O_GATE))
#define WIN ((bf16*)(wsp + WS_WIN))
#define WMKV ((bf16*)(wsp + WS_WMKV))
#define WBA ((bf16*)(wsp + WS_WBA))
#define WBP ((bf16*)(wsp + WS_WBP))
#define WBM ((bf16*)(wsp + WS_WBM))
#define WOUT ((bf16*)(wsp + WS_WOUT))
#define WUP2 ((bf16*)(wsp + WS_WUP2))
#define WDN2 ((bf16*)(wsp + WS_WDN2))
#define WPT ((bf16*)(wsp + WS_WPOOL))
#define H1 ((bf16*)(wsp + WS_H1))
#define MEM16 ((bf16*)(wsp + WS_MEM16))
#define A16 ((bf16*)(wsp + WS_A16))
#define P16 ((bf16*)(wsp + WS_P16))
#define M16 ((bf16*)(wsp + WS_M16))
#define H2 ((bf16*)(wsp + WS_A16))
#define Y16 ((bf16*)(wsp + WS_Y16))
#define KM ((bf16*)(wsp + WS_KM))
#define VM ((bf16*)(wsp + WS_VM))
#define MASKQ ((unsigned*)(wsp + WS_MASK))
#define X8 ((signed char*)(wsp + WS_BIG + O_X16))
#define WUP1q ((signed char*)(wsp + WS_BIG + O_WUP1))
#define WDN1q ((signed char*)(wsp + WS_BIG + O_WDN1))
#define G8 ((signed char*)(wsp + WS_BIG + O_G))
#define WUP2q ((signed char*)(wsp + WS_WUP2))
#define WDN2q ((signed char*)(wsp + WS_WDN2))
#define H2q ((signed char*)(wsp + WS_Y16))
#define G28 ((signed char*)(wsp + WS_BIG))
#define QS ((float*)(wsp + WS_QS))
#define SX1 ((float*)(wsp + WS_ROWQ))
#define GQ1 (SX1 + T)
#define SG1 (GQ1 + T)
#define SX2 (SG1 + T)
#define GQ2 (SX2 + T)
#define SG2 (GQ2 + T)
#define SXH (SG2 + T)
#define DQ0 (SXH + T)
#define DQ1 (DQ0 + T)
#define H1q ((signed char*)(wsp + WS_Y16))
#define WINq ((signed char*)(wsp + WS_WINQ))
#define R (ap->out)

    REP(0) if (IN(0)) { REPBAR(); WSP_DECL;
        LAS float* scr = (LAS float*)(L + RING_OFF + wave * 16384);
        const float s2u1 = fmaxf(sample_sigma2(ap->in[2], DM, NUP, lane), 1e-30f), s2d1 = fmaxf(sample_sigma2(ap->in[3], FF, DM, lane), 1e-30f);
        const float s2u2 = fmaxf(sample_sigma2(ap->in[17], DM, NUP, lane), 1e-30f), s2d2 = fmaxf(sample_sigma2(ap->in[18], FF, DM, lane), 1e-30f);
        const float qu1 = 127.f / (5.f * sqrtf(s2u1)), qd1 = 127.f / (5.f * sqrtf(s2d1)), qu2 = 127.f / (5.f * sqrtf(s2u2)), qd2 = 127.f / (5.f * sqrtf(s2d2));
        const float s2in = fmaxf(sample_sigma2(ap->in[6], DM, NIN, lane), 1e-30f), qin = 127.f / (5.f * sqrtf(s2in));
        if (gw == 0 && lane == 0) { QS[16] = qin; QS[17] = 1.f / qin; QS[0] = qu1; QS[1] = 1.f / qu1; QS[2] = s2u1; QS[3] = qd1; QS[4] = 1.f / qd1; QS[8] = qu2; QS[9] = 1.f / qu2; QS[10] = s2u2; QS[11] = qd2; QS[12] = 1.f / qd2; }
        constexpr int I_UP = (DM / 64) * (NUP / 32), I_DN = (FF / 64) * (DM / 32), I_IN = (DM / 64) * (NZB / 32), I_INQ = (DM / 64) * (NZQ / 32), I_MKV = (DM / 64) * (1024 / 32), I_BA = (1024 / 64) * (DM / 32),
                      I_BP = (512 / 64) * (DM / 32), I_OUT = (DM / 64) * (DM / 32), I_PL = (128 / 64) * (128 / 32);
        constexpr int NITEMS = 2 * I_UP + 2 * I_DN + I_IN + I_INQ + I_MKV + I_BA + 2 * I_BP + I_OUT + 4 * I_PL;
        for (int it = gw; it < NITEMS; it += NGW) {
            int r = it;
            if (r < I_UP) { p0_transpose_item_i8<1>(ap->in[2], DM, NUP, NUP, WUP1q, scr, r, lane, qu1); continue; } r -= I_UP;
            if (r < I_DN) { p0_transpose_item_i8<0>(ap->in[3], FF, DM, DM, WDN1q, scr, r, lane, qd1); continue; } r -= I_DN;
            if (r < I_IN) { p0_transpose_item<2>(ap->in[6], DM, NIN, NZB, WIN, scr, r, lane); continue; } r -= I_IN;
            if (r < I_INQ) { p0_transpose_item_i8<0>(ap->in[6] + 4176, DM, NIN, NZQ, WINq, scr, r, lane, qin); continue; } r -= I_INQ;
            if (r < I_MKV) { p0_transpose_item<0>(ap->in[8], DM, 1024, 1024, WMKV, scr, r, lane); continue; } r -= I_MKV;
            if (r < I_BA) { p0_transpose_item<0>(ap->in[11], 1024, DM, DM, WBA, scr, r, lane); continue; } r -= I_BA;
            if (r < I_BP) { p0_transpose_item<0>(ap->in[12], 512, DM, DM, WBP, scr, r, lane); continue; } r -= I_BP;
            if (r < I_BP) { p0_transpose_item<0>(ap->in[13], 512, DM, DM, WBM, scr, r, lane); continue; } r -= I_BP;
            if (r < I_OUT) { p0_transpose_item<0>(ap->in[14], DM, DM, DM, WOUT, scr, r, lane); continue; } r -= I_OUT;
            if (r < I_UP) { p0_transpose_item_i8<1>(ap->in[17], DM, NUP, NUP, WUP2q, scr, r, lane, qu2); continue; } r -= I_UP;
            if (r < I_DN) { p0_transpose_item_i8<0>(ap->in[18], FF, DM, DM, WDN2q, scr, r, lane, qd2); continue; } r -= I_DN;
            { const int g = r / I_PL; p0_transpose_item<0>(ap->in[9] + (size_t)g * 16384, 128, 128, 128, WPT + (size_t)g * 16384, scr, r % I_PL, lane); }
        }
        for (int m = gw; m < T; m += NGW) {
            f32x4 v[8];
#pragma unroll
            for (int j = 0; j < 8; ++j) v[j] = ((const GAS f32x4*)(XIN + (size_t)m * DM))[lane + 64 * j];
            quant_row_i8(v, X8 + (size_t)m * DM, SX1 + m, GQ1 + m, SG1 + m, s2u1, lane);
        }
        for (size_t i = (size_t)gw * 64 + lane; i < (size_t)512 * DM / 8; i += (size_t)NGW * 64) {
            const f32x4 a = ((const GAS f32x4*)MEMIN)[2 * i], c = ((const GAS f32x4*)MEMIN)[2 * i + 1];
            ((GAS v4u*)MEM16)[i] = (v4u){pk2(a.x, a.y), pk2(a.z, a.w), pk2(c.x, c.y), pk2(c.z, c.w)};
        }
    }
    SEAM(0);
    REP(1) if (IN(1)) { REPBAR(); WSP_DECL;
        pg8::Gemm g{(const bf16*)X8, (const bf16*)WUP1q, T, NUP, DM / 2}; pg8::StaticOrder S; S.init(T, NUP, G, bx);
        pg8::EpiSwigluI8 E{G8, FF, SX1, GQ1, QS + 1};
        pg8::gemm_phase<pg8::EpiSwigluI8, pg8::StaticOrder, true, true, true>(L + RING_OFF, g, S, E);
    }
    SEAM(1);
    REP(2) if (IN(2)) { REPBAR(); WSP_DECL;
        pg8::Gemm g{(const bf16*)G8, (const bf16*)WDN1q, T, DM, FF / 2}; pg8::StaticOrder S; S.init(T, DM, G, bx);
        pg8::EpiResI8<false> E{R, XIN, DM, ALPHA, 0.5f, SG1, QS + 4};
        pg8::gemm_phase<pg8::EpiResI8<false>, pg8::StaticOrder, true, true, true>(L + RING_OFF, g, S, E);
    }
    SEAM(2);
    REP(3) if (IN(3)) { REPBAR(); WSP_DECL; for (int m = gw; m < T; m += NGW) ln_row<true, true>(R + (size_t)m * DM, ap->in[4], ap->in[5], H1 + (size_t)m * DM, lane, H1q + (size_t)m * DM, SXH + m, DQ0 + m, DQ1 + m, 0.f); }
    SEAM(3);
    REP(4) if (IN(4)) { REPBAR(); WSP_DECL;
        { pg8::Gemm g{H1, WIN, T, NZB, DM}; pg8::OrderZ S; S.so.init(T, NZB, G, bx);
          pg8::EpiZ E{Q16, KI16, KM, WI};
          pg8::gemm_phase<pg8::EpiZ, pg8::OrderZ, true, true>(L + RING_OFF, g, S, E); }
        { pg8::Gemm g{(const bf16*)H1q, (const bf16*)WINq, T, NZQ, DM / 2}; pg8::OrderQ S; S.so.init(T, NZQ, G, bx); S.heavy = (32 * (NZB / 256) + 8) - 2 * G;
          pg8::EpiZq E{U16, ap->in[7], SXH, QS + 17};
          pg8::gemm_phase<pg8::EpiZq, pg8::OrderQ, true, true, true>(L + RING_OFF, g, S, E); }
    }
    SEAM(4);
    REP(5) if (IN(5)) { REPBAR(); WSP_DECL;
        for (int task = gw; task < 1024; task += NGW) pool_task(task, U16, WPT, ap->in[10], P16, lane);
        for (int pp = vcu; pp < 256; pp += G) {
            const int b = pp >> 7, p = pp & 127;
#pragma unroll 1
            for (int k2 = 0; k2 < 2; ++k2) indexer_unit(L + RING_OFF, b, k2 ? 255 - p : p, QI16, KI16, WI, MASKQ);
        }
        __syncthreads();
    }
    SEAM(5);
    REP(6) if (IN(6)) { REPBAR(); WSP_DECL;
        const int xcd = bx & 7, ix = bx >> 3;
        if (ix < 32) {
            const int bh = xcd * 2 + (ix >> 4), qb = ix & 15, b = bh >> 3, hh = bh & 7;
            const size_t rowbase = (size_t)b * SEQ;
            const float ah = exp2f(-(float)(hh + 1)) * 11.313708498984761f;
            att::attn_block<1024, true>((const att::bf16*)(Q16 + (rowbase + qb * 256) * 1024 + hh * 128), (const att::bf16*)(K16 + rowbase * 1024 + hh * 128),
                                        (const att::bf16*)(V16 + rowbase * 1024 + hh * 128), (att::bf16*)(A16 + (rowbase + qb * 256) * 1024 + hh * 128),
                                        4 * (qb + 1), qb * 256, MASKQ + rowbase * 128, ah, (char*)lds + RING_OFF);
            if (qb < 8) { const int mi = bh * 8 + qb;
                const int mb = mi >> 6, mh = (mi >> 4) & 3, mq = mi & 15; const size_t mrow = (size_t)mb * SEQ + mq * 256;
                att::attn_block<512, false>((const att::bf16*)(QM16 + mrow * 512 + mh * 128), (const att::bf16*)(KM + (size_t)mb * MEMLEN * 512 + mh * 128),
                                            (const att::bf16*)(VM + (size_t)mb * MEMLEN * 512 + mh * 128), (att::bf16*)(M16 + mrow * 512 + mh * 128),
                                            MEMLEN / 64, 0, nullptr, 0.f, (char*)lds + RING_OFF); }
        }
    }
    SEAM(6);
    REP(7) if (IN(7)) { REPBAR(); WSP_DECL;
        pg8::StaticOrder S; S.init(T, DM, G, bx);
        { pg8::Gemm g{A16, WBA, T, DM, 1024}; pg8::EpiBranch<0> E{R, Y16, GATE}; pg8::gemm_phase<pg8::EpiBranch<0>, pg8::StaticOrder, true, true>(L + RING_OFF, g, S, E); }
        { pg8::Gemm g{P16, WBP, T, DM, 512}; pg8::EpiBranch<1> E{R, Y16, GATE}; pg8::gemm_phase<pg8::EpiBranch<1>, pg8::StaticOrder, true, true>(L + RING_OFF, g, S, E); }
        { pg8::Gemm g{M16, WBM, T, DM, 512}; pg8::EpiBranch<2> E{R, Y16, GATE}; pg8::gemm_phase<pg8::EpiBranch<2>, pg8::StaticOrder, true, true>(L + RING_OFF, g, S, E); }
    }
    SEAM(7);
    REP(8) if (IN(8)) { REPBAR(); WSP_DECL;
        pg8::Gemm g{Y16, WOUT, T, DM, DM}; pg8::StaticOrder S; S.init(T, DM, G, bx);
        pg8::EpiRes<true> E{R, H1, DM, ALPHA, 1.0f};
        pg8::gemm_phase<pg8::EpiRes<true>, pg8::StaticOrder, true, true>(L + RING_OFF, g, S, E);
    }
    SEAM(8);
    REP(9) if (IN(9)) { REPBAR(); WSP_DECL; const float sig2 = QS[10]; for (int m = gw; m < T; m += NGW) ln_row<true, true>(R + (size_t)m * DM, ap->in[15], ap->in[16], H2 + (size_t)m * DM, lane, H2q + (size_t)m * DM, SX2 + m, GQ2 + m, SG2 + m, sig2); }
    SEAM(9);
    REP(10) if (IN(10)) { REPBAR(); WSP_DECL;
        pg8::Gemm g{(const bf16*)H2q, (const bf16*)WUP2q, T, NUP, DM / 2}; pg8::StaticOrder S; S.init(T, NUP, G, bx);
        pg8::EpiSwigluI8 E{G28, FF, SX2, GQ2, QS + 9};
        pg8::gemm_phase<pg8::EpiSwigluI8, pg8::StaticOrder, true, true, true>(L + RING_OFF, g, S, E);
    }
    SEAM(10);
    REP(11) if (IN(11)) { REPBAR(); WSP_DECL;
        pg8::Gemm g{(const bf16*)G28, (const bf16*)WDN2q, T, DM, FF / 2}; pg8::StaticOrder S; S.init(T, DM, G, bx);
        pg8::EpiResI8<true> E{R, H2, DM, ALPHA, 0.5f, SG2, QS + 12};
        pg8::gemm_phase<pg8::EpiResI8<true>, pg8::StaticOrder, true, true, true>(L + RING_OFF, g, S, E);
    }
    SEAM(11);
    REP(12) if (IN(12)) { REPBAR(); WSP_DECL; for (int m = gw; m < T; m += NGW) ln_row<false>(R + (size_t)m * DM, ap->in[19], ap->in[20], R + (size_t)m * DM, lane); }
#undef BIG
#undef X16
#undef WUP1
#undef WDN1
#undef Gb
#undef Q16
#undef K16
#undef V16
#undef QI16
#undef KI16
#undef WI
#undef U16
#undef QM16
#undef GATE
#undef WIN
#undef WMKV
#undef WBA
#undef WBP
#undef WBM
#undef WOUT
#undef WUP2
#undef WDN2
#undef WPT
#undef H1
#undef MEM16
#undef A16
#undef P16
#undef M16
#undef H2
#undef Y16
#undef KM
#undef VM
#undef MASKQ
#undef X8
#undef WUP1q
#undef WDN1q
#undef G8
#undef WUP2q
#undef WDN2q
#undef H2q
#undef G28
#undef QS
#undef SX1
#undef GQ1
#undef SG1
#undef SX2
#undef GQ2
#undef SG2
#undef SXH
#undef DQ0
#undef DQ1
#undef H1q
#undef WINq
#undef R
#undef XIN
#undef MEMIN
#undef WSP_DECL
#undef IN
#undef SEAM
}

extern "C" void kernel_launch(void* const* d_in, const int* in_sizes, int n_in, void* d_out, int out_size, void* d_ws, size_t ws_size, hipStream_t stream) {
    static int grid = 0;
    if (grid == 0) {
        if (n_in != 21 || in_sizes[0] != T * DM || out_size != T * DM || ws_size < WS_END) {
            fprintf(stderr, "kernel_launch: shape/workspace mismatch (n_in %d, in0 %d, out %d, ws %zu, need %zu); nothing launched\n", n_in, n_in > 0 ? in_sizes[0] : -1, out_size, ws_size, (size_t)WS_END);
            grid = -1; return; }
        int dev = 0, cus = 0;
        if (hipGetDevice(&dev) != hipSuccess || hipDeviceGetAttribute(&cus, hipDeviceAttributeMultiprocessorCount, dev) != hipSuccess) { grid = -1; return; }
        if (hipFuncSetAttribute((const void*)mk_fwd, hipFuncAttributeMaxDynamicSharedMemorySize, LDS_BYTES) != hipSuccess) { fprintf(stderr, "kernel_launch: hipFuncSetAttribute failed\n"); grid = -1; return; }
        (void)hipGetLastError();
        grid = cus;
        if (grid != 256) fprintf(stderr, "kernel_launch: %d CUs (built for 256)\n", grid);
    }
    if (grid < 0) return;
    if (hipMemsetAsync((char*)d_ws + WS_CTL, 0, CTL_ZERO_BYTES, stream) != hipSuccess) return;
    Args a{};
    for (int i = 0; i < 21; ++i) a.in[i] = (const float*)d_in[i];
    a.out = (float*)d_out; a.ws = (unsigned char*)d_ws;
#if MK_PER_PHASE
    for (int p = 0; p < N_PHASES; ++p) { a.ph_lo = p; a.ph_hi = p + 1; hipLaunchKernelGGL(mk_fwd, dim3(grid), dim3(NWAVES * 64), LDS_BYTES, stream, a); }
#else
    a.ph_lo = 0; a.ph_hi = N_PHASES;
    hipLaunchKernelGGL(mk_fwd, dim3(grid), dim3(NWAVES * 64), LDS_BYTES, stream, a);
#endif
}
```

```cpp
#include <hip/hip_runtime.h>
#include <hip/hip_bf16.h>
#include <cstdio>
#include <cstdint>

#ifndef MK_PER_PHASE
#define MK_PER_PHASE 0
#endif

namespace pg8 {
#define PG8_LAS __attribute__((address_space(3)))
typedef unsigned short bf16_t;
typedef short bf16x8 __attribute__((ext_vector_type(8)));
typedef float f32x4 __attribute__((ext_vector_type(4)));
typedef float f32x2 __attribute__((ext_vector_type(2)));
typedef unsigned u32x4 __attribute__((ext_vector_type(4)));
typedef unsigned u32x2 __attribute__((ext_vector_type(2)));
typedef int i32x4 __attribute__((ext_vector_type(4)));
template <bool I8> struct AccSel { typedef f32x4 type; };
template <> struct AccSel<true> { typedef i32x4 type; };
constexpr int BM = 256, BK = 64, HALF = 128, HTB = HALF * BK * 2, STAGE_BYTES = 8 * HTB, NXCD = 8, WGM = 8;

__host__ __device__ __forceinline__ int lds_byte(int r, int c) { const int st = (r >> 4) * 2 + (c >> 5), rr = r & 15, cc = c & 31, ob = rr * 64 + cc * 2; return st * 1024 + (ob ^ (((ob >> 9) & 1) << 5)); }
__host__ __device__ __forceinline__ void stage_rc(int b, int& R, int& C) { const int st = b / 1024, sb = b % 1024, swz = sb ^ (((sb >> 9) & 1) << 5); R = (st >> 1) * 16 + swz / 64; C = (st & 1) * 32 + (swz % 64) / 2; }
__host__ __device__ __forceinline__ int perm32(int rho) { const int n = rho >> 4, i = rho & 15; return 8 * (i >> 2) + 4 * n + (i & 3); }

struct Unit { int pm, pn, ko, nt, br; };
struct Gemm { const bf16_t* A; const bf16_t* Bt; int M, N, K; };

struct StaticOrder {
    int nM, nN, nwg, G, c;
    __host__ __device__ void init(int M, int N, int G_, int c_) { nM = M / BM; nN = N / BM; nwg = nM * nN; G = G_; c = c_; }
    __host__ __device__ bool next(int i, Unit& u) const {
        const long L = (long)i * G + c; if (L >= nwg) return false;
        int wgid = (int)L; { const int q = nwg / NXCD, r = nwg % NXCD, xcd = wgid % NXCD, off = wgid / NXCD; wgid = (xcd < r ? xcd * (q + 1) : r * (q + 1) + (xcd - r) * q) + off; }
        const int nig = WGM * nN, gid = wgid / nig, fm = gid * WGM, gsz = (nM - fm) < WGM ? (nM - fm) : WGM;
        u.pm = fm + ((wgid % nig) % gsz); u.pn = (wgid % nig) / gsz; u.ko = 0; u.nt = 0; u.br = 0; return true;
    }
    __device__ __forceinline__ void a_ready(const Unit&) const {}
    __device__ __forceinline__ void done(const Unit&) const {}
};
struct OrderZ {
    StaticOrder so;
    __device__ __forceinline__ bool next(int i, Unit& u) const {
        const long L = (long)i * so.G + so.c;
        if (L < so.nwg) return so.next(i, u);
        if (L < so.nwg + 8) { const int e = (int)(L - so.nwg); u.pm = 32 + (e >> 2); u.pn = so.nN + (e & 3); u.ko = 0; u.nt = 0; u.br = 0; return true; }
        return false;
    }
    __device__ __forceinline__ void a_ready(const Unit&) const {}
    __device__ __forceinline__ void done(const Unit&) const {}
};
struct OrderQ {
    StaticOrder so; int heavy;
    __device__ __forceinline__ bool next(int i, Unit& u) const {
        const int c = so.c, nl = so.G - heavy; long L;
        if (c >= heavy) { if (i >= 4) return false; L = (long)i * nl + (c - heavy); if (L >= 4L * nl) return false; }
        else { if (i >= 1) return false; L = 4L * nl + c; }
        if (L >= so.nwg) return false;
        int wgid = (int)L; { const int q = so.nwg / NXCD, r = so.nwg % NXCD, xcd = wgid % NXCD, off = wgid / NXCD; wgid = (xcd < r ? xcd * (q + 1) : r * (q + 1) + (xcd - r) * q) + off; }
        const int nig = WGM * so.nN, gid = wgid / nig, fm = gid * WGM, gsz = (so.nM - fm) < WGM ? (so.nM - fm) : WGM;
        u.pm = fm + ((wgid % nig) % gsz); u.pn = (wgid % nig) / gsz; u.ko = 0; u.nt = 0; u.br = 0; return true;
    }
    __device__ __forceinline__ void a_ready(const Unit&) const {}
    __device__ __forceinline__ void done(const Unit&) const {}
};
struct OrderBr {
    StaticOrder so;
    __device__ __forceinline__ bool next(int i, Unit& u) const {
        const int ti = i / 3, br = i - 3 * ti;
        if (!so.next(ti, u)) return false;
        u.br = br; u.ko = br == 0 ? 0 : (br == 1 ? 1024 : 1536); u.nt = br == 0 ? 16 : 8; return true;
    }
    __device__ __forceinline__ void a_ready(const Unit&) const {}
    __device__ __forceinline__ void done(const Unit&) const {}
};

__device__ __forceinline__ unsigned cvt_pk_bf16(float lo, float hi) { unsigned r; asm volatile("v_cvt_pk_bf16_f32 %0, %1, %2" : "=v"(r) : "v"(lo), "v"(hi)); return r; }
__device__ __forceinline__ float bf_lo(unsigned w) { return __uint_as_float(w << 16); }
__device__ __forceinline__ float bf_hi(unsigned w) { return __uint_as_float(w & 0xffff0000u); }
__device__ __forceinline__ float sigmoidf_(float x) { return __builtin_amdgcn_rcpf(1.0f + __builtin_amdgcn_exp2f(-1.4426950408889634f * x)); }

struct EpiSwiglu {
    static constexpr bool PERM = true, AFTER_DRAIN = false, CHAIN = false;
    bf16_t* G; int ldg;
    __device__ __forceinline__ void operator()(const f32x4 (&acc)[2][2][4][2], const Unit& u, int wr, int wc, int fr, int fq) const {
        const int row0 = u.pm * BM + wr * 64 + fr, col0 = u.pn * HALF + wc * 32 + 8 * fq;
#pragma unroll
        for (int ai = 0; ai < 2; ++ai)
#pragma unroll
            for (int m = 0; m < 4; ++m) {
                bf16_t* rowp = G + (size_t)(row0 + ai * HALF + m * 16) * ldg + col0;
                float g[8];
#pragma unroll
                for (int n = 0; n < 2; ++n)
#pragma unroll
                    for (int e = 0; e < 4; ++e) { const float a = acc[ai][0][m][n][e], uu = acc[ai][1][m][n][e]; g[n * 4 + e] = a * uu * sigmoidf_(a); }
                u32x4 w; w.x = cvt_pk_bf16(g[0], g[1]); w.y = cvt_pk_bf16(g[2], g[3]); w.z = cvt_pk_bf16(g[4], g[5]); w.w = cvt_pk_bf16(g[6], g[7]);
                *(u32x4*)rowp = w;
            }
    }
};
struct EpiSwigluI8 {
    static constexpr bool PERM = true, AFTER_DRAIN = false, CHAIN = false;
    signed char* G; int ldg; const float* sx; const float* gq; const float* wdq;
    __device__ __forceinline__ void operator()(const i32x4 (&acc)[2][2][4][2], const Unit& u, int wr, int wc, int fr, int fq) const {
        const int row0 = u.pm * BM + wr * 64 + fr, col0 = u.pn * HALF + wc * 32 + 8 * fq;
        const float wd = *wdq;
#pragma unroll
        for (int ai = 0; ai < 2; ++ai)
#pragma unroll
            for (int m = 0; m < 4; ++m) {
                const int row = row0 + ai * HALF + m * 16;
                const float sa = sx[row] * wd, gm = gq[row];
                unsigned w[2];
#pragma unroll
                for (int n = 0; n < 2; ++n) { int q[4];
#pragma unroll
                    for (int e = 0; e < 4; ++e) { const float a = (float)acc[ai][0][m][n][e] * sa, uu = (float)acc[ai][1][m][n][e] * sa; const float g = a * uu * sigmoidf_(a);
                        q[e] = (int)__builtin_rintf(fminf(fmaxf(g * gm, -127.f), 127.f)); }
                    w[n] = (unsigned)(q[0] & 255) | ((unsigned)(q[1] & 255) << 8) | ((unsigned)(q[2] & 255) << 16) | ((unsigned)q[3] << 24); }
                *(u32x2*)(G + (size_t)row * ldg + col0) = (u32x2){w[0], w[1]};
            }
    }
};
template <bool RESBF> struct EpiResI8 {
    static constexpr bool PERM = false, AFTER_DRAIN = false, CHAIN = false;
    float* out; const void* res; int ldc; float alpha, sc; const float* sg; const float* wdq;
    __device__ __forceinline__ void operator()(const i32x4 (&acc)[2][2][4][2], const Unit& u, int wr, int wc, int fr, int fq) const {
        const int row0 = u.pm * BM + wr * 64 + fr, col0 = u.pn * BM + wc * 32 + 4 * fq;
        const float wd = *wdq * sc;
#pragma unroll
        for (int ai = 0; ai < 2; ++ai)
#pragma unroll
            for (int m = 0; m < 4; ++m) { const int row = row0 + ai * HALF + m * 16; const size_t off = (size_t)row * ldc + col0; const float s = sg[row] * wd;
#pragma unroll
                for (int bj = 0; bj < 2; ++bj)
#pragma unroll
                    for (int n = 0; n < 2; ++n) { const size_t o = off + bj * HALF + n * 16; f32x4 r;
                        if (RESBF) { const u32x2 w = *(const u32x2*)((const bf16_t*)res + o); r = (f32x4){bf_lo(w.x), bf_hi(w.x), bf_lo(w.y), bf_hi(w.y)}; }
                        else r = *(const f32x4*)((const float*)res + o);
                        const i32x4 a = acc[ai][bj][m][n];
                        *(f32x4*)(out + o) = r * alpha + (f32x4){(float)a[0], (float)a[1], (float)a[2], (float)a[3]} * s; } }
    }
};
template <bool RESBF> struct EpiRes {
    static constexpr bool PERM = false, AFTER_DRAIN = false, CHAIN = false;
    float* out; const void* res; int ldc; float alpha, sc;
    __device__ __forceinline__ void operator()(const f32x4 (&acc)[2][2][4][2], const Unit& u, int wr, int wc, int fr, int fq) const {
        const int row0 = u.pm * BM + wr * 64 + fr, col0 = u.pn * BM + wc * 32 + 4 * fq;
#pragma unroll
        for (int ai = 0; ai < 2; ++ai)
#pragma unroll
            for (int m = 0; m < 4; ++m) { const size_t off = (size_t)(row0 + ai * HALF + m * 16) * ldc + col0;
#pragma unroll
                for (int bj = 0; bj < 2; ++bj)
#pragma unroll
                    for (int n = 0; n < 2; ++n) { const size_t o = off + bj * HALF + n * 16; f32x4 r;
                        if (RESBF) { const u32x2 w = *(const u32x2*)((const bf16_t*)res + o); r = (f32x4){bf_lo(w.x), bf_hi(w.x), bf_lo(w.y), bf_hi(w.y)}; }
                        else r = *(const f32x4*)((const float*)res + o);
                        *(f32x4*)(out + o) = r * alpha + acc[ai][bj][m][n] * sc; } }
    }
};
struct EpiBranch {
    static constexpr bool PERM = false, AFTER_DRAIN = false, CHAIN = true;
    bf16_t* Y16; const bf16_t* gate;
    __device__ __forceinline__ bool chain(f32x4 (&acc)[2][2][4][2], const Unit& u, int wr, int wc, int fr, int fq) const {
        const int row0 = u.pm * BM + wr * 64 + fr, col0 = u.pn * BM + wc * 32 + 4 * fq, br = u.br;
        const float FL = 8.673617379884035e-19f;
#pragma unroll
        for (int ai = 0; ai < 2; ++ai)
#pragma unroll
            for (int m = 0; m < 4; ++m) { const size_t row = (size_t)(row0 + ai * HALF + m * 16);
#pragma unroll
                for (int bj = 0; bj < 2; ++bj)
#pragma unroll
                    for (int n = 0; n < 2; ++n) { const int col = col0 + bj * HALF + n * 16;
                        const u32x2 w = *(const u32x2*)(gate + row * 6144 + br * 2048 + col);
                        f32x4 g = (f32x4){fmaxf(bf_lo(w.x), FL), fmaxf(bf_hi(w.x), FL), fmaxf(bf_lo(w.y), FL), fmaxf(bf_hi(w.y), FL)};
                        if (br < 2) { const u32x2 w2 = *(const u32x2*)(gate + row * 6144 + (br + 1) * 2048 + col);
                            g[0] *= __builtin_amdgcn_rcpf(fmaxf(bf_lo(w2.x), FL)); g[1] *= __builtin_amdgcn_rcpf(fmaxf(bf_hi(w2.x), FL));
                            g[2] *= __builtin_amdgcn_rcpf(fmaxf(bf_lo(w2.y), FL)); g[3] *= __builtin_amdgcn_rcpf(fmaxf(bf_hi(w2.y), FL));
                            acc[ai][bj][m][n] *= g; }
                        else { const f32x4 v = acc[ai][bj][m][n] * g; u32x2 o; o.x = cvt_pk_bf16(v[0], v[1]); o.y = cvt_pk_bf16(v[2], v[3]); *(u32x2*)(Y16 + row * 2048 + col) = o; } } }
        return br < 2;
    }
};
struct EpiZ {
    static constexpr bool PERM = true, AFTER_DRAIN = false, CHAIN = false;
    bf16_t *Q, *KI, *KM; float* WI;
    __device__ __forceinline__ void operator()(const f32x4 (&acc)[2][2][4][2], const Unit& u, int wr, int wc, int fr, int fq) const {
        const int pn = u.pn;
        bf16_t* base; int ld, ct = 0, mode = 0, rowoff = 0;
        if (pn < 16) { base = Q + (size_t)(pn >> 2) * ((size_t)8192 * 1024); ld = 1024; ct = pn & 3; }
        else if (pn == 16) { base = KI; ld = 64; mode = 2; }
        else { base = KM + (size_t)((pn - 17) >> 1) * (512 * 512); ld = 512; ct = (pn - 17) & 1; rowoff = 8192; }
        const int row0 = u.pm * BM + wr * 64 + fr - rowoff, cl = wc * 32 + 8 * fq;
        if (mode == 2) {
#pragma unroll
            for (int ai = 0; ai < 2; ++ai)
#pragma unroll
                for (int m = 0; m < 4; ++m) { const size_t row = (size_t)(row0 + ai * HALF + m * 16);
                    const f32x4 v0 = acc[ai][0][m][0], v1 = acc[ai][0][m][1];
                    if (cl < 64) { u32x4 w; w.x = cvt_pk_bf16(v0[0], v0[1]); w.y = cvt_pk_bf16(v0[2], v0[3]); w.z = cvt_pk_bf16(v1[0], v1[1]); w.w = cvt_pk_bf16(v1[2], v1[3]); *(u32x4*)(KI + row * 64 + cl) = w; }
                    else if (cl < 80) { const float s = 1.0f / 32.0f;
                        *(f32x4*)(WI + row * 16 + (cl - 64)) = v0 * s; *(f32x4*)(WI + row * 16 + (cl - 64) + 4) = v1 * s; } }
            return;
        }
        const int col0 = ct * BM + cl;
#pragma unroll
        for (int ai = 0; ai < 2; ++ai)
#pragma unroll
            for (int m = 0; m < 4; ++m) { bf16_t* rowp = base + (size_t)(row0 + ai * HALF + m * 16) * ld + col0;
#pragma unroll
                for (int bj = 0; bj < 2; ++bj) { const f32x4 v0 = acc[ai][bj][m][0], v1 = acc[ai][bj][m][1];
                    u32x4 w; w.x = cvt_pk_bf16(v0[0], v0[1]); w.y = cvt_pk_bf16(v0[2], v0[3]); w.z = cvt_pk_bf16(v1[0], v1[1]); w.w = cvt_pk_bf16(v1[2], v1[3]);
                    *(u32x4*)(rowp + bj * HALF) = w; } }
    }
};
struct EpiZq {
    static constexpr bool PERM = true, AFTER_DRAIN = false, CHAIN = false;
    bf16_t *U; const float* bgate; const float* sx; const float* wdq;
    __device__ __forceinline__ void operator()(const i32x4 (&acc)[2][2][4][2], const Unit& u, int wr, int wc, int fr, int fq) const {
        const int pn = u.pn; const bool gate = pn >= 4;
        bf16_t* base = U + (size_t)(gate ? 2 : (pn >> 1)) * ((size_t)8192 * 512);
        const int ld = gate ? 6144 : 512, ct = gate ? pn - 4 : (pn & 1);
        const int row0 = u.pm * BM + wr * 64 + fr, col0 = ct * BM + wc * 32 + 8 * fq;
        const float wd = *wdq;
        f32x4 bv[2][2];
#pragma unroll
        for (int bj = 0; bj < 2; ++bj)
#pragma unroll
            for (int n = 0; n < 2; ++n) bv[bj][n] = gate ? *(const f32x4*)(bgate + col0 + bj * HALF + 4 * n) : (f32x4){0.f, 0.f, 0.f, 0.f};
#pragma unroll
        for (int ai = 0; ai < 2; ++ai)
#pragma unroll
            for (int m = 0; m < 4; ++m) { const int row = row0 + ai * HALF + m * 16; bf16_t* rowp = base + (size_t)row * ld + col0; const float sa = sx[row] * wd;
#pragma unroll
                for (int bj = 0; bj < 2; ++bj) { const i32x4 a0 = acc[ai][bj][m][0], a1 = acc[ai][bj][m][1];
                    f32x4 v0 = (f32x4){(float)a0[0], (float)a0[1], (float)a0[2], (float)a0[3]} * sa + bv[bj][0], v1 = (f32x4){(float)a1[0], (float)a1[1], (float)a1[2], (float)a1[3]} * sa + bv[bj][1];
                    if (gate) {
#pragma unroll
                        for (int e = 0; e < 4; ++e) { v0[e] = sigmoidf_(v0[e]); v1[e] = sigmoidf_(v1[e]); } }
                    u32x4 w; w.x = cvt_pk_bf16(v0[0], v0[1]); w.y = cvt_pk_bf16(v0[2], v0[3]); w.z = cvt_pk_bf16(v1[0], v1[1]); w.w = cvt_pk_bf16(v1[2], v1[3]);
                    *(u32x4*)(rowp + bj * HALF) = w; } }
    }
};

template <class Epi, class Sched, bool ALIGN_EPI = false, bool SP2 = false, bool I8 = false>
__device__ __forceinline__ void gemm_phase(PG8_LAS unsigned char* lds, const Gemm g, const Sched& S, const Epi& E) {
    int tid_ = threadIdx.x; asm volatile("" : "+v"(tid_));
    const int tid = tid_, wid = __builtin_amdgcn_readfirstlane(tid >> 6), lane = tid & 63, wr = wid >> 2, wc = wid & 3, fr = lane & 15, fq = lane >> 4;
    const int K = g.K, nt = K / BK;
    unsigned voffA[2], voffB[2];
#pragma unroll
    for (int i = 0; i < 2; ++i) { int R, C; stage_rc(tid * 16 + i * 8192, R, C); const int Rb = Epi::PERM ? ((R & ~31) + perm32(R & 31)) : R;
        voffA[i] = (unsigned)(R * K + C) * 2u; voffB[i] = (unsigned)(Rb * K + C) * 2u; }
    const size_t kstep = (size_t)(BK * 2);
    const size_t hstep = (size_t)HALF * K * 2;
    const size_t tstep = 2 * hstep;
    const unsigned ldsw = (unsigned)wid * 1024u;
    const int aoff = lds_byte(wr * 64 + fr, fq * 8), boff = lds_byte(wc * 32 + fr, fq * 8);
#define PG8_SA(b, h) (((b) * 2 + (h)) * HTB)
#define PG8_SB(b, h) ((4 + (b) * 2 + (h)) * HTB)
#define PG8_STAGE(bufoff, gbase, voff) do { _Pragma("unroll") for (int _i = 0; _i < 2; ++_i) \
        __builtin_amdgcn_global_load_lds((const unsigned*)((const char*)(gbase) + (voff)[_i]), (PG8_LAS unsigned*)(lds + (bufoff) + ldsw + _i * 8192), 16, 0, 0); } while (0)
#define PG8_LDA(dst, b, h) do { _Pragma("unroll") for (int m = 0; m < 4; ++m) _Pragma("unroll") for (int k = 0; k < 2; ++k) dst[m][k] = *(const PG8_LAS bf16x8*)(lds + PG8_SA(b, h) + aoff + m * 2048 + k * 1024); } while (0)
#define PG8_LDB(dst, b, h) do { _Pragma("unroll") for (int n = 0; n < 2; ++n) _Pragma("unroll") for (int k = 0; k < 2; ++k) dst[n][k] = *(const PG8_LAS bf16x8*)(lds + PG8_SB(b, h) + boff + n * 2048 + k * 1024); } while (0)
#define PG8_MMA(ai, bj, At, Bt) do { __builtin_amdgcn_s_setprio(1); _Pragma("unroll") for (int m = 0; m < 4; ++m) _Pragma("unroll") for (int n = 0; n < 2; ++n) _Pragma("unroll") for (int k = 0; k < 2; ++k) \
        { if constexpr (I8) acc[ai][bj][m][n] = __builtin_amdgcn_mfma_i32_16x16x64_i8(__builtin_bit_cast(i32x4, Bt[n][k]), __builtin_bit_cast(i32x4, At[m][k]), acc[ai][bj][m][n], 0, 0, 0); \
          else acc[ai][bj][m][n] = __builtin_amdgcn_mfma_f32_16x16x32_bf16(Bt[n][k], At[m][k], acc[ai][bj][m][n], 0, 0, 0); } __builtin_amdgcn_s_setprio(0); } while (0)
#define PG8_WAIT_V(n) asm volatile("s_waitcnt vmcnt(" #n ")" ::: "memory")
#define PG8_WAIT_L(n) asm volatile("s_waitcnt lgkmcnt(" #n ")" ::: "memory")
#define PG8_BAR __builtin_amdgcn_s_barrier()
#define PG8_SCHED __builtin_amdgcn_sched_barrier(0)
    Unit cur, nxt; int ui = 0;
    if (!S.next(0, cur)) return;
    typedef typename AccSel<I8>::type acc_t;
    acc_t acc[2][2][4][2];
#pragma unroll
    for (int a = 0; a < 2; ++a)
#pragma unroll
        for (int b = 0; b < 2; ++b)
#pragma unroll
            for (int m = 0; m < 4; ++m)
#pragma unroll
                for (int n = 0; n < 2; ++n) acc[a][b][m][n] = acc_t{};
    bf16x8 At[4][2], B0[2][2], B1[2][2];
    const char* cA = (const char*)g.A + (size_t)cur.pm * tstep + (size_t)cur.ko * 2; const char* cB = (const char*)g.Bt + (size_t)cur.pn * tstep + (size_t)cur.ko * 2;
    int ntc = cur.nt ? cur.nt : nt;
    S.a_ready(cur);
    if constexpr (SP2) {
        PG8_STAGE(PG8_SB(0, 0), cB, voffB); PG8_STAGE(PG8_SB(0, 1), cB + hstep, voffB); PG8_STAGE(PG8_SA(0, 0), cA, voffA); PG8_STAGE(PG8_SA(0, 1), cA + hstep, voffA);
        if (wr == 1) PG8_BAR;
        PG8_WAIT_V(2); PG8_BAR;
        PG8_STAGE(PG8_SB(1, 0), cB + kstep, voffB); PG8_STAGE(PG8_SA(1, 0), cA + kstep, voffA); PG8_STAGE(PG8_SB(1, 1), cB + hstep + kstep, voffB);
        PG8_WAIT_V(6); PG8_BAR;
    } else {
        PG8_STAGE(PG8_SB(0, 0), cB, voffB); PG8_STAGE(PG8_SA(0, 0), cA, voffA); PG8_STAGE(PG8_SB(0, 1), cB + hstep, voffB); PG8_STAGE(PG8_SA(0, 1), cA + hstep, voffA);
        if (wr == 1) PG8_BAR;
        PG8_WAIT_V(4); PG8_BAR;
        PG8_STAGE(PG8_SB(1, 0), cB + kstep, voffB); PG8_STAGE(PG8_SA(1, 0), cA + kstep, voffA); PG8_STAGE(PG8_SB(1, 1), cB + hstep + kstep, voffB);
        PG8_WAIT_V(6); PG8_BAR;
    }
    for (;;) {
        const bool has_next = S.next(ui + 1, nxt);
        const char* nA = has_next ? (const char*)g.A + (size_t)nxt.pm * tstep + (size_t)nxt.ko * 2 : cA; const char* nB = has_next ? (const char*)g.Bt + (size_t)nxt.pn * tstep + (size_t)nxt.ko * 2 : cB;
        for (int t = 0; t < ntc; t += 2) {
            const bool last = (t == ntc - 2);
            const char* a1 = cA + (size_t)(t + 1) * kstep;
            const char* a2 = last ? nA : cA + (size_t)(t + 2) * kstep; const char* b2 = last ? nB : cB + (size_t)(t + 2) * kstep;
            const char* a3 = a2 + kstep; const char* b3 = b2 + kstep;
            if (last && has_next) S.a_ready(nxt);
            if constexpr (SP2) {
            PG8_LDB(B0, 0, 0); PG8_LDB(B1, 0, 1); PG8_SCHED; PG8_LDA(At, 0, 0); PG8_STAGE(PG8_SA(1, 1), a1 + hstep, voffA);
            PG8_WAIT_V(8); PG8_WAIT_L(0); PG8_BAR; PG8_MMA(0, 0, At, B0); PG8_MMA(0, 1, At, B1); PG8_BAR; PG8_SCHED;
            PG8_LDA(At, 0, 1); PG8_STAGE(PG8_SB(0, 0), b2, voffB); PG8_STAGE(PG8_SB(0, 1), b2 + hstep, voffB); PG8_STAGE(PG8_SA(0, 0), a2, voffA);
            PG8_WAIT_V(8); PG8_WAIT_L(0); PG8_BAR; PG8_MMA(1, 0, At, B0); PG8_MMA(1, 1, At, B1); PG8_BAR; PG8_SCHED;
            PG8_LDB(B0, 1, 0); PG8_LDB(B1, 1, 1); PG8_SCHED; PG8_LDA(At, 1, 0); PG8_STAGE(PG8_SA(0, 1), a2 + hstep, voffA);
            PG8_WAIT_V(8); PG8_WAIT_L(0); PG8_BAR; PG8_MMA(0, 0, At, B0); PG8_MMA(0, 1, At, B1); PG8_BAR; PG8_SCHED;
            PG8_LDA(At, 1, 1); PG8_STAGE(PG8_SB(1, 0), b3, voffB); PG8_STAGE(PG8_SB(1, 1), b3 + hstep, voffB); PG8_STAGE(PG8_SA(1, 0), a3, voffA);
            PG8_WAIT_V(8); PG8_WAIT_L(0); PG8_BAR; PG8_MMA(1, 0, At, B0); PG8_MMA(1, 1, At, B1); PG8_BAR; PG8_SCHED;
            } else {
            PG8_LDB(B0, 0, 0); PG8_SCHED; PG8_LDA(At, 0, 0); PG8_STAGE(PG8_SA(1, 1), a1 + hstep, voffA);
            PG8_WAIT_L(8); PG8_BAR; PG8_WAIT_L(0); PG8_MMA(0, 0, At, B0); PG8_BAR; PG8_SCHED;
            PG8_LDB(B1, 0, 1); PG8_STAGE(PG8_SB(0, 0), b2, voffB);
            PG8_BAR; PG8_WAIT_L(0); PG8_MMA(0, 1, At, B1); PG8_BAR;
            PG8_LDA(At, 0, 1); PG8_STAGE(PG8_SA(0, 0), a2, voffA);
            PG8_BAR; PG8_WAIT_L(0); PG8_MMA(1, 0, At, B0); PG8_BAR; PG8_SCHED;
            PG8_STAGE(PG8_SB(0, 1), b2 + hstep, voffB);
            PG8_WAIT_V(6); PG8_BAR; PG8_MMA(1, 1, At, B1); PG8_BAR;
            PG8_LDB(B0, 1, 0); PG8_SCHED; PG8_LDA(At, 1, 0); PG8_STAGE(PG8_SA(0, 1), a2 + hstep, voffA);
            PG8_WAIT_L(8); PG8_BAR; PG8_WAIT_L(0); PG8_MMA(0, 0, At, B0); PG8_BAR; PG8_SCHED;
            PG8_LDB(B1, 1, 1); PG8_STAGE(PG8_SB(1, 0), b3, voffB);
            PG8_BAR; PG8_WAIT_L(0); PG8_MMA(0, 1, At, B1); PG8_BAR;
            PG8_LDA(At, 1, 1); PG8_STAGE(PG8_SA(1, 0), a3, voffA);
            PG8_BAR; PG8_WAIT_L(0); PG8_MMA(1, 0, At, B0); PG8_BAR; PG8_SCHED;
            PG8_STAGE(PG8_SB(1, 1), b3 + hstep, voffB);
            PG8_WAIT_V(6); PG8_BAR; PG8_MMA(1, 1, At, B1); PG8_BAR;
            }
        }
        if constexpr (ALIGN_EPI) { if (wr == 0) PG8_BAR; }
        bool keep = false;
        if constexpr (Epi::CHAIN) { keep = E.chain(acc, cur, wr, wc, fr, fq); S.done(cur); }
        else if constexpr (!Epi::AFTER_DRAIN) { E(acc, cur, wr, wc, fr, fq); S.done(cur); }
        if (!has_next) break;
        if (!keep)
#pragma unroll
        for (int a = 0; a < 2; ++a)
#pragma unroll
            for (int b = 0; b < 2; ++b)
#pragma unroll
                for (int m = 0; m < 4; ++m)
#pragma unroll
                    for (int n = 0; n < 2; ++n) acc[a][b][m][n] = acc_t{};
        cur = nxt; cA = nA; cB = nB; ++ui; ntc = cur.nt ? cur.nt : nt;
        if constexpr (ALIGN_EPI) { if (wr == 1) PG8_BAR; }
    }
    PG8_WAIT_V(0);
    if constexpr (!ALIGN_EPI) { if (wr == 0) PG8_BAR; }
    PG8_BAR;
#undef PG8_SA
#undef PG8_SB
#undef PG8_STAGE
#undef PG8_LDA
#undef PG8_LDB
#undef PG8_MMA
#undef PG8_WAIT_V
#undef PG8_WAIT_L
#undef PG8_BAR
#undef PG8_SCHED
}
}

namespace att {
using bf16 = __hip_bfloat16;
typedef short bf16x8 __attribute__((ext_vector_type(8)));
typedef short s16x4 __attribute__((ext_vector_type(4)));
typedef float f32x16 __attribute__((ext_vector_type(16)));
typedef float f32x4 __attribute__((ext_vector_type(4)));
typedef unsigned u32x4 __attribute__((ext_vector_type(4)));
typedef unsigned u32x2 __attribute__((ext_vector_type(2)));
constexpr int D = 128;
constexpr float SCALE = 0.08838834764831845f;
constexpr float THR = 8.f;
constexpr int NW = 8, QBLK = 32, KVBLK = 64, QB = NW * QBLK;
constexpr int SHM_V = KVBLK * D * 2, SHM_K = KVBLK * D * 2;
constexpr int LDS_BYTES = 2 * SHM_V + 2 * SHM_K + NW * 64 * 4;
#define KSWZ(row, colB) ((row) * 256 + ((colB) ^ (((row) & 7) << 4)))
#define SBAR() __builtin_amdgcn_sched_barrier(0)
__device__ __forceinline__ int v_st(int k, int c) { const int kk = (k & ~0xC) | ((k & 4) << 1) | ((k & 8) >> 1); return ((kk >> 3) * 4 + (c >> 5)) * 512 + ((kk & 7) * 32 + (c & 31)) * 2; }
__device__ __forceinline__ int v_rd_base(int lane) { return ((lane & 3) << 3) | (((lane >> 2) & 3) << 6) | (((lane >> 4) & 1) << 5) | (((lane >> 5) & 1) << 8); }
constexpr int v_rd_off(int d0, int ks, int half) { return d0 * 512 + ks * 4096 + half * 2048; }
__device__ __forceinline__ int crow(int r, int hi) { return (r & 3) + 8 * (r >> 2) + 4 * hi; }
__device__ __forceinline__ unsigned cvtpk(float lo, float hi) { unsigned r; asm volatile("v_cvt_pk_bf16_f32 %0, %1, %2" : "=v"(r) : "v"(lo), "v"(hi)); return r; }
__device__ __forceinline__ bf16x8 load8(const bf16* p) { return *reinterpret_cast<const bf16x8*>(p); }
__device__ __forceinline__ void mask_alibi(f32x16& p0, f32x16& p1, u32x2 mw, int dq, int hi, float ah) {
    const float NEG = -__builtin_inff();
    const unsigned w0 = mw.x >> (4 * hi), w1 = mw.y >> (4 * hi);
    const float dqf = (float)dq;
#pragma unroll
    for (int r = 0; r < 16; ++r) {
        const int c = (r & 3) + 8 * (r >> 2);
        p0[r] = ((w0 >> c) & 1u) ? fmaf(ah, (float)c - dqf, p0[r]) : NEG;
        p1[r] = ((w1 >> c) & 1u) ? fmaf(ah, (float)(c + 32) - dqf, p1[r]) : NEG;
    }
}
__device__ __forceinline__ void partialSM(f32x16& p0, f32x16& p1, float& m_reg, float& mn, float& alpha) {
    float pmax = p0[0];
#pragma unroll
    for (int r = 1; r < 16; ++r) pmax = fmaxf(pmax, p0[r]);
#pragma unroll
    for (int r = 0; r < 16; ++r) pmax = fmaxf(pmax, p1[r]);
    { auto rr = __builtin_amdgcn_permlane32_swap(__float_as_uint(pmax), __float_as_uint(pmax), false, false);
      pmax = fmaxf(__uint_as_float(rr[0]), __uint_as_float(rr[1])); }
    constexpr float C2 = 1.4426950408889634f * SCALE;
    if (__builtin_expect(__all((pmax - m_reg) * SCALE <= THR), 1)) { mn = m_reg; alpha = 1.f; }
    else { mn = fmaxf(m_reg, pmax); alpha = __builtin_amdgcn_exp2f((m_reg - mn) * C2); m_reg = mn; }
    const float mnL = -mn * C2;
#pragma unroll
    for (int r = 0; r < 16; ++r) p0[r] = fmaf(p0[r], C2, mnL);
#pragma unroll
    for (int r = 0; r < 16; ++r) p1[r] = fmaf(p1[r], C2, mnL);
#pragma unroll
    for (int r = 0; r < 16; ++r) p0[r] = __builtin_amdgcn_exp2f(p0[r]);
}
__device__ __forceinline__ void finishSM(f32x16& p0, f32x16& p1, float alpha, float& l_reg, bf16x8& pa0, bf16x8& pa1, bf16x8& pa2, bf16x8& pa3) {
#pragma unroll
    for (int r = 0; r < 16; ++r) p1[r] = __builtin_amdgcn_exp2f(p1[r]);
    float ps = 0;
#pragma unroll
    for (int r = 0; r < 16; ++r) ps += p0[r];
#pragma unroll
    for (int r = 0; r < 16; ++r) ps += p1[r];
    { auto rr = __builtin_amdgcn_permlane32_swap(__float_as_uint(ps), __float_as_uint(ps), false, false);
      ps = __uint_as_float(rr[0]) + __uint_as_float(rr[1]); }
    l_reg = l_reg * alpha + ps;
#define PK4(P, B_, OUT) do { unsigned a0 = cvtpk(P[B_+0], P[B_+1]), a1 = cvtpk(P[B_+2], P[B_+3]);                          \
        unsigned b0 = cvtpk(P[B_+4], P[B_+5]), b1 = cvtpk(P[B_+6], P[B_+7]);                                             \
        auto r0 = __builtin_amdgcn_permlane32_swap(a0, b0, false, false); auto r1 = __builtin_amdgcn_permlane32_swap(a1, b1, false, false); \
        u32x4 w = {r0[0], r1[0], r0[1], r1[1]}; OUT = *reinterpret_cast<bf16x8*>(&w); } while (0)
    PK4(p0, 0, pa0); PK4(p0, 8, pa1); PK4(p1, 0, pa2); PK4(p1, 8, pa3);
#undef PK4
}
template <int KB>
__device__ __forceinline__ void qkt(f32x16& p0, f32x16& p1, const char* K_lds, int r32, int hi, const bf16x8* qr) {
    p0 = f32x16{}; p1 = f32x16{};
    const char* kb[4];
#pragma unroll
    for (int dd = 0; dd < 4; ++dd) kb[dd] = K_lds + KB * SHM_K + KSWZ(r32, (dd * 16 + hi * 8) * 2);
#pragma unroll
    for (int d0 = 0; d0 < 8; ++d0) { const char* a = kb[d0 & 3] + (d0 >> 2) * 128;
        bf16x8 b0 = *reinterpret_cast<const bf16x8*>(a);
        bf16x8 b1 = *reinterpret_cast<const bf16x8*>(a + 32 * 256);
        p0 = __builtin_amdgcn_mfma_f32_32x32x16_bf16(b0, qr[d0], p0, 0, 0, 0);
        p1 = __builtin_amdgcn_mfma_f32_32x32x16_bf16(b1, qr[d0], p1, 0, 0, 0); }
}
template <int VB>
__device__ __forceinline__ void pv_tile(f32x16* o, int vb0, bf16x8 pa0, bf16x8 pa1, bf16x8 pa2, bf16x8 pa3) {
#define TRRD(dst, off) asm volatile("ds_read_b64_tr_b16 %0, %1 offset:%2" : "=&v"(dst) : "v"(vb0), "i"(off) : "memory")
#define PV_D0(d0) do { s16x4 l0, l1, l2, l3, h0, h1, h2, h3; constexpr int b_ = VB * SHM_V + v_rd_off(d0, 0, 0); \
        TRRD(l0, b_); TRRD(h0, b_ + 2048); TRRD(l1, b_ + 4096); TRRD(h1, b_ + 6144); TRRD(l2, b_ + 8192); TRRD(h2, b_ + 10240); TRRD(l3, b_ + 12288); TRRD(h3, b_ + 14336); \
        asm volatile("s_waitcnt lgkmcnt(0)" ::: "memory"); SBAR();   \
        o[d0] = __builtin_amdgcn_mfma_f32_32x32x16_bf16(pa0, (bf16x8){l0[0], l0[1], l0[2], l0[3], h0[0], h0[1], h0[2], h0[3]}, o[d0], 0, 0, 0);   \
        o[d0] = __builtin_amdgcn_mfma_f32_32x32x16_bf16(pa1, (bf16x8){l1[0], l1[1], l1[2], l1[3], h1[0], h1[1], h1[2], h1[3]}, o[d0], 0, 0, 0);   \
        o[d0] = __builtin_amdgcn_mfma_f32_32x32x16_bf16(pa2, (bf16x8){l2[0], l2[1], l2[2], l2[3], h2[0], h2[1], h2[2], h2[3]}, o[d0], 0, 0, 0);   \
        o[d0] = __builtin_amdgcn_mfma_f32_32x32x16_bf16(pa3, (bf16x8){l3[0], l3[1], l3[2], l3[3], h3[0], h3[1], h3[2], h3[3]}, o[d0], 0, 0, 0); } while (0)
    PV_D0(0); PV_D0(1); PV_D0(2); PV_D0(3);
#undef PV_D0
#undef TRRD
}
template <int LD, int LDO, bool MASKED>
__device__ __forceinline__ void attn_block(const bf16* Q, const bf16* Kh, const bf16* Vh, bf16* O, int NT, int P0, const unsigned* maskbase, float ah, char* lds) {
    int tid_ = threadIdx.x; asm volatile("" : "+v"(tid_));
    const int tid = tid_, wid = __builtin_amdgcn_readfirstlane(tid >> 6), lane = tid & 63, r32 = lane & 31, hi = lane >> 5;
    const int qlo = P0 + wid * QBLK, qm = qlo + r32 - 4 * hi;
    char* V_lds = lds; char* K_lds = lds + 2 * SHM_V;
    float* ws = (float*)(lds + 2 * SHM_V + 2 * SHM_K) + wid * 64; float* li_l = ws, * al_l = ws + 32;
    float m_reg = -1e30f, l_reg = 0; f32x16 o[4] = {};
    const int sr = tid >> 4, sc = (tid & 15) * 8, vst0 = v_st(sr, sc), vst1 = v_st(32 + sr, sc), kws = KSWZ(sr, sc * 2);
    const int vb0 = (int)(uintptr_t)V_lds + v_rd_base(lane);
    const unsigned* mrow = MASKED ? maskbase + (size_t)(qlo + r32) * 128 : nullptr;
    bf16x8 qr[8], st_v0, st_v1, st_k0, st_k1;
#define ROW(p, k0, rr) ((p) + (size_t)((k0) + (rr)) * LD + sc)
#define VMW() asm volatile("s_waitcnt vmcnt(0)" ::: "memory")
#define SLOAD_H(k0) do { st_v0 = load8(ROW(Vh, k0, sr)); st_v1 = load8(ROW(Vh, k0, 32 + sr)); st_k0 = load8(ROW(Kh, k0, sr)); st_k1 = load8(ROW(Kh, k0, 32 + sr)); } while (0)
#define SWRITE_HK(bf) do { *(bf16x8*)(K_lds + (bf) * SHM_K + kws) = st_k0; *(bf16x8*)(K_lds + (bf) * SHM_K + kws + 32 * 256) = st_k1; } while (0)
#define SWRITE_HV(bf) do { *(bf16x8*)(V_lds + (bf) * SHM_V + vst0) = st_v0; *(bf16x8*)(V_lds + (bf) * SHM_V + vst1) = st_v1; } while (0)
#define SWRITE_H(bf) do { SWRITE_HV(bf); SWRITE_HK(bf); } while (0)
#define RESC(a) do { if (__any((a) < 1.f)) { if (hi == 0) al_l[r32] = (a); asm volatile("s_waitcnt lgkmcnt(0)" ::: "memory");              \
                     for (int d_ = 0; d_ < 4; ++d_) for (int r = 0; r < 16; ++r) o[d_][r] *= al_l[crow(r, hi)]; } } while (0)
#define KBASE(t) ((t) * KVBLK)
#define MLOAD(dst, t) do { if (MASKED) dst = *(const u32x2*)(mrow + 2 * (t)); } while (0)
#define MASKT(P0_, P1_, mw_, t) do { if (MASKED) mask_alibi(P0_, P1_, mw_, qm - KBASE(t), hi, ah); } while (0)
#pragma unroll
    for (int d0 = 0; d0 < 8; ++d0) qr[d0] = load8(Q + (size_t)(wid * QBLK + r32) * LD + d0 * 16 + hi * 8);
    SLOAD_H(0); VMW(); SWRITE_HK(0);
    __syncthreads();
    f32x16 pA0, pA1, pB0, pB1; float mnA, mnB, alA, alB; bf16x8 pa0, pa1, pa2, pa3;
    u32x2 mwA = {0u, 0u}, mwB = {0u, 0u};
    SWRITE_HV(0); SBAR();
    MLOAD(mwA, 0);
    if (NT > 1) SLOAD_H(KBASE(1));
    SBAR(); qkt<0>(pA0, pA1, K_lds, r32, hi, qr);
    MASKT(pA0, pA1, mwA, 0); partialSM(pA0, pA1, m_reg, mnA, alA);
    if (NT > 1) { VMW(); SWRITE_H(1); }
    __syncthreads();
#define HALF_STEP(PX0, PX1, mwX, mnX, alX, PY0, PY1, alY, t, KB, VB, SB) do {                                                 \
        SBAR(); MLOAD(mwX, t); qkt<KB>(PX0, PX1, K_lds, r32, hi, qr);                                                         \
        finishSM(PY0, PY1, alY, l_reg, pa0, pa1, pa2, pa3); SBAR();                                                           \
        if ((t) + 1 < NT) { SLOAD_H(KBASE((t) + 1)); SBAR(); }                                                                \
        pv_tile<VB>(o, vb0, pa0, pa1, pa2, pa3); MASKT(PX0, PX1, mwX, (t)); partialSM(PX0, PX1, m_reg, mnX, alX);             \
        __syncthreads();                                                                                                      \
        if ((t) + 1 < NT) { VMW(); SWRITE_H(SB); }                                                                            \
        RESC(alX); __syncthreads(); } while (0)
    for (int t = 1; t + 1 < NT; t += 2) {
        HALF_STEP(pB0, pB1, mwB, mnB, alB, pA0, pA1, alA, t, 1, 0, 0);
        HALF_STEP(pA0, pA1, mwA, mnA, alA, pB0, pB1, alB, t + 1, 0, 1, 1);
    }
    const bool even = (NT & 1) == 0;
    if (even) { SBAR(); MLOAD(mwB, NT - 1); qkt<1>(pB0, pB1, K_lds, r32, hi, qr); SBAR(); }
    finishSM(pA0, pA1, alA, l_reg, pa0, pa1, pa2, pa3); SBAR();
    pv_tile<0>(o, vb0, pa0, pa1, pa2, pa3);
    if (even) { MASKT(pB0, pB1, mwB, NT - 1); partialSM(pB0, pB1, m_reg, mnB, alB); __syncthreads(); RESC(alB);
        finishSM(pB0, pB1, alB, l_reg, pa0, pa1, pa2, pa3); SBAR(); pv_tile<1>(o, vb0, pa0, pa1, pa2, pa3); }
    SBAR();
    if (hi == 0) li_l[r32] = l_reg; asm volatile("s_waitcnt lgkmcnt(0)" ::: "memory");
    float rli[16];
#pragma unroll
    for (int r = 0; r < 16; ++r) rli[r] = __builtin_amdgcn_rcpf(li_l[crow(r, hi)]);
    bf16* Ow = O + (size_t)(wid * QBLK) * LDO;
#pragma unroll
    for (int r = 0; r < 16; ++r) { const int orow = crow(r, hi);
#pragma unroll
        for (int d0 = 0; d0 < 4; ++d0) { const float v = o[d0][r] * rli[r];
            const float vn = __shfl_xor(v, 1);
            if ((r32 & 1) == 0) *(unsigned*)(Ow + (size_t)orow * LDO + d0 * 32 + r32) = cvtpk(v, vn); } }
    __syncthreads();
#undef ROW
#undef VMW
#undef SLOAD_H
#undef SWRITE_HK
#undef SWRITE_HV
#undef SWRITE_H
#undef RESC
#undef KBASE
#undef MLOAD
#undef MASKT
#undef HALF_STEP
}
#undef KSWZ
#undef SBAR
}

constexpr int NWAVES = 8;
constexpr int BATCH = 2, SEQ = 4096, DM = 2048, T = BATCH * SEQ, FF = 5632, NUP = 2 * FF;
constexpr int NIN = 11344, NIN_PAD = 11520;
constexpr int MEMLEN = 256, TOPK = 256;
constexpr float ALPHA = 1.189207115002721f;
constexpr float LN_EPS = 1e-5f;
constexpr int N_PHASES = 13;

constexpr size_t WS_CTL = 0, CTL_ZERO_BYTES = 1u << 20;
constexpr size_t WS_BIG = 1u << 20;
constexpr size_t O_X16 = 0, O_WUP1 = O_X16 + (size_t)T * DM * 2, O_WDN1 = O_WUP1 + (size_t)NUP * DM * 2, O_G = O_WDN1 + (size_t)DM * FF * 2, BIG_BYTES = O_G + (size_t)T * FF * 2;
constexpr size_t O_Q = 0, O_K = O_Q + (size_t)T * 1024 * 2, O_V = O_K + (size_t)T * 1024 * 2, O_QI = O_V + (size_t)T * 1024 * 2, O_KI = O_QI + (size_t)T * 1024 * 2,
                 O_WI = O_KI + (size_t)T * 64 * 2, O_U = O_WI + (size_t)T * 16 * 4, O_QM = O_U + (size_t)T * 512 * 2, O_GATE = O_QM + (size_t)T * 512 * 2, O_MIXEND = O_GATE + (size_t)T * 6144 * 2;
static_assert(O_MIXEND <= BIG_BYTES, "mixer view fits");
constexpr size_t WS_WIN = WS_BIG + BIG_BYTES;
constexpr int NZB = 4352, NZQ = NIN_PAD - NZB;
constexpr size_t WS_WMKV = WS_WIN + (size_t)NZB * DM * 2;
constexpr size_t WS_WINQ = WS_WMKV + (size_t)1024 * DM * 2;
constexpr size_t WS_WBA = WS_WIN + (size_t)NIN_PAD * DM * 2 + (size_t)1024 * DM * 2;
constexpr size_t WS_WBP = WS_WBA + (size_t)DM * 1024 * 2;
constexpr size_t WS_WBM = WS_WBP + (size_t)DM * 512 * 2;
constexpr size_t WS_WOUT = WS_WBM + (size_t)DM * 512 * 2;
constexpr size_t WS_WUP2 = WS_WOUT + (size_t)DM * DM * 2;
constexpr size_t WS_WDN2 = WS_WUP2 + (size_t)NUP * DM * 2;
constexpr size_t WS_WPOOL = WS_WDN2 + (size_t)DM * FF * 2;
constexpr size_t WS_H1 = WS_WPOOL + (size_t)4 * 128 * 128 * 2;
constexpr size_t WS_MEM16 = WS_H1 + (size_t)T * DM * 2;
constexpr size_t WS_A16 = WS_MEM16 + (size_t)512 * DM * 2;
constexpr size_t WS_P16 = WS_A16 + (size_t)T * 1024 * 2;
constexpr size_t WS_M16 = WS_P16 + (size_t)T * 512 * 2;
constexpr size_t WS_Y16 = WS_M16 + (size_t)T * 512 * 2;
constexpr size_t WS_KM = WS_Y16 + (size_t)T * DM * 2;
constexpr size_t WS_VM = WS_KM + (size_t)512 * 512 * 2;
constexpr size_t WS_MASK = WS_VM + (size_t)512 * 512 * 2;
constexpr size_t WS_END = WS_MASK + (size_t)T * 128 * 4;
constexpr int CW_BAR = 4096;
constexpr size_t WS_QS = 65536;
constexpr size_t WS_ROWQ = 131072;
static_assert(WS_ROWQ + (size_t)9 * 8192 * 4 <= (1u << 20), "control region");

constexpr int RING_OFF = 0, RING_BYTES = 131072;
constexpr int LDSCTL_OFF = RING_BYTES, MISC_OFF = LDSCTL_OFF + 320;
constexpr int LDS_BYTES = 147456;

#define GAS __attribute__((address_space(1)))
#define LAS __attribute__((address_space(3)))
typedef unsigned short bf16;
typedef unsigned v4u __attribute__((ext_vector_type(4)));
typedef unsigned v2u __attribute__((ext_vector_type(2)));
typedef float f32x4 __attribute__((ext_vector_type(4)));
typedef float f32x16 __attribute__((ext_vector_type(16)));
typedef short bf16x8 __attribute__((ext_vector_type(8)));
#define LDS_WAIT() asm volatile("s_waitcnt lgkmcnt(0)" ::: "memory")
__device__ __forceinline__ unsigned f2bf(float f) { unsigned u = __builtin_bit_cast(unsigned, f); return (u + 0x7fffu + ((u >> 16) & 1u)) >> 16; }
__device__ __forceinline__ unsigned pk2(float lo, float hi) { return f2bf(lo) | (f2bf(hi) << 16); }

#define XB_TMO      128
#define XB_XCNT(j)  (256  + 64 * (j))
#define XB_XSUB(j)  (1280 + 64 * (j))
#define XB_XGEN(j)  (2304 + 64 * (j))
#define XB_TOP      3328
#define XB_TOPGEN   3392
#define XCD_BAR_WORDS 3456
#define XB_SPIN_CAP (1u << 22)
__device__ __forceinline__ unsigned xb_ld(unsigned* p)              { return __hip_atomic_load(p, __ATOMIC_RELAXED, __HIP_MEMORY_SCOPE_AGENT); }
__device__ __forceinline__ unsigned xb_add(unsigned* p, unsigned v) { return __hip_atomic_fetch_add(p, v, __ATOMIC_RELAXED, __HIP_MEMORY_SCOPE_AGENT); }
__device__ __forceinline__ unsigned xb_xcc_id() { return (unsigned)__builtin_amdgcn_s_getreg((3 << 11) | 20) & 0xFu; }
#define XB_SPIN(cond, bar) do { unsigned _sp = 0; while (cond) { __builtin_amdgcn_s_sleep(1); \
    if ((++_sp & 255u) == 0u) { if (xb_ld(&(bar)[XB_TMO])) break; if (_sp > XB_SPIN_CAP) { atomicAdd(&(bar)[XB_TMO], 1u); break; } } } } while (0)
struct XcdBarrier { unsigned* bar; unsigned x; volatile LAS unsigned* st; };
__device__ __forceinline__ XcdBarrier xcd_barrier_post(unsigned* bar, volatile LAS unsigned* st) {
    XcdBarrier b; b.bar = bar; b.x = xb_xcc_id(); b.st = st;
    if (threadIdx.x == 0) (void)xb_add(&bar[XB_XCNT(b.x)], 1u);
    return b;
}
__device__ __forceinline__ void xcd_barrier_complete(unsigned* bar, unsigned x, unsigned& nloc, unsigned& nx) {
    const unsigned G = gridDim.x * gridDim.y * gridDim.z;
    unsigned sum, cnt, mine, sp = 0u;
    for (;;) {
        sum = 0u; cnt = 0u; mine = 0u;
#pragma unroll
        for (unsigned j = 0; j < 16; ++j) { const unsigned c = xb_ld(&bar[XB_XCNT(j)]); sum += c; cnt += (c > 0u) ? 1u : 0u; mine = (j == x) ? c : mine; }
        if (sum == G) break;
        __builtin_amdgcn_s_sleep(1);
        if ((++sp & 255u) == 0u) { if (xb_ld(&bar[XB_TMO])) break; if (sp > XB_SPIN_CAP) { atomicAdd(&bar[XB_TMO], 1u); break; } }
    }
    nloc = mine > 0u ? mine : 1u; nx = cnt > 0u ? cnt : 1u;
}
__device__ __forceinline__ void xcd_barrier(const XcdBarrier& b) {
    asm volatile("s_waitcnt vmcnt(0)" ::: "memory");
    __syncthreads();
    if (threadIdx.x == 0) {
        unsigned* bar = b.bar;
        __builtin_amdgcn_s_waitcnt(0);
        unsigned nloc = b.st[0], nx = b.st[1];
        if (nloc == 0u) { xcd_barrier_complete(bar, b.x, nloc, nx); b.st[0] = nloc; b.st[1] = nx; }
        const unsigned old = xb_add(&bar[XB_XSUB(b.x)], 1u);
        const unsigned gen = old / nloc;
        if (old + 1u == (gen + 1u) * nloc) {
            __builtin_amdgcn_fence(__ATOMIC_RELEASE, "agent");
            asm volatile("s_waitcnt vmcnt(0)" ::: "memory");
            const unsigned og = xb_add(&bar[XB_TOP], 1u);
            const unsigned tg = og / nx;
            if (og + 1u == (tg + 1u) * nx) xb_add(&bar[XB_TOPGEN], 1u);
            else XB_SPIN(xb_ld(&bar[XB_TOPGEN]) == tg, bar);
            __builtin_amdgcn_fence(__ATOMIC_ACQUIRE, "agent");
            xb_add(&bar[XB_XGEN(b.x)], 1u);
            asm volatile("s_waitcnt vmcnt(0)" ::: "memory");
        } else {
            XB_SPIN(xb_ld(&bar[XB_XGEN(b.x)]) == gen, bar);
            __builtin_amdgcn_fence(__ATOMIC_ACQUIRE, "agent");
            asm volatile("s_waitcnt vmcnt(0)" ::: "memory");
        }
    }
    __syncthreads();
}

__device__ __forceinline__ float wave_sum(float v) {
#pragma unroll
    for (int o = 1; o < 64; o <<= 1) v += __shfl_xor(v, o);
    return v;
}
template <int MAP>
__device__ __forceinline__ void p0_transpose_item(const float* W, int K, int N, int NP, bf16* WT, LAS float* scr, int item, int lane, int ldw = 0) {
    if (ldw == 0) ldw = K;
    const int nblk = NP / 32, kb = item / nblk, nb = item % nblk, k0 = 64 * kb, np0 = 32 * nb;
    int n0 = np0; int nvalid = 32;
    if (MAP == 1) n0 = ((np0 >> 7) & 1) * FF + (np0 >> 8) * 128 + (np0 & 127);
    if (MAP == 2) { if (np0 < 4096) n0 = np0; else if (np0 < 4352) { n0 = np0; nvalid = 4176 - np0; nvalid = nvalid < 0 ? 0 : (nvalid > 32 ? 32 : nvalid); } else n0 = np0 - 176; }
    float v[32];
    const bool ok = (lane & 31) < nvalid;
#pragma unroll
    for (int i = 0; i < 32; ++i) { const int kk = 2 * i + (lane >> 5); v[i] = ok ? W[(size_t)(k0 + kk) * N + n0 + (lane & 31)] : 0.f; }
#pragma unroll
    for (int i = 0; i < 32; ++i) { const int kk = 2 * i + (lane >> 5); scr[kk * 33 + (lane & 31)] = v[i]; }
    LDS_WAIT(); asm volatile("" ::: "memory");
    const int c = lane & 7;
#pragma unroll
    for (int j = 0; j < 4; ++j) { const int n = (lane >> 3) + 8 * j; const LAS float* s = scr + (8 * c) * 33 + n;
        v4u o; o.x = pk2(s[0 * 33], s[1 * 33]); o.y = pk2(s[2 * 33], s[3 * 33]); o.z = pk2(s[4 * 33], s[5 * 33]); o.w = pk2(s[6 * 33], s[7 * 33]);
        *(GAS v4u*)(WT + (size_t)(np0 + n) * ldw + k0 + 8 * c) = o; }
    LDS_WAIT(); asm volatile("" ::: "memory");
}
__device__ __forceinline__ unsigned q8(float v, float qw) { return (unsigned)((int)__builtin_rintf(fminf(fmaxf(v * qw, -127.f), 127.f)) & 255); }
template <int MAP>
__device__ __forceinline__ void p0_transpose_item_i8(const float* W, int K, int N, int NP, signed char* WT, LAS float* scr, int item, int lane, float qw) {
    const int nblk = NP / 32, kb = item / nblk, nb = item % nblk, k0 = 64 * kb, np0 = 32 * nb;
    int n0 = np0;
    if (MAP == 1) n0 = ((np0 >> 7) & 1) * FF + (np0 >> 8) * 128 + (np0 & 127);
    float v[32];
#pragma unroll
    for (int i = 0; i < 32; ++i) { const int kk = 2 * i + (lane >> 5); v[i] = W[(size_t)(k0 + kk) * N + n0 + (lane & 31)]; }
#pragma unroll
    for (int i = 0; i < 32; ++i) { const int kk = 2 * i + (lane >> 5); scr[kk * 33 + (lane & 31)] = v[i]; }
    LDS_WAIT(); asm volatile("" ::: "memory");
#pragma unroll
    for (int j = 0; j < 2; ++j) { const int id = lane + 64 * j, n = id >> 2, c = id & 3; const LAS float* sp = scr + (16 * c) * 33 + n;
        v4u o;
        o.x = q8(sp[0 * 33], qw) | (q8(sp[1 * 33], qw) << 8) | (q8(sp[2 * 33], qw) << 16) | (q8(sp[3 * 33], qw) << 24);
        o.y = q8(sp[4 * 33], qw) | (q8(sp[5 * 33], qw) << 8) | (q8(sp[6 * 33], qw) << 16) | (q8(sp[7 * 33], qw) << 24);
        o.z = q8(sp[8 * 33], qw) | (q8(sp[9 * 33], qw) << 8) | (q8(sp[10 * 33], qw) << 16) | (q8(sp[11 * 33], qw) << 24);
        o.w = q8(sp[12 * 33], qw) | (q8(sp[13 * 33], qw) << 8) | (q8(sp[14 * 33], qw) << 16) | (q8(sp[15 * 33], qw) << 24);
        *(GAS v4u*)(WT + (size_t)(np0 + n) * K + k0 + 16 * c) = o; }
    LDS_WAIT(); asm volatile("" ::: "memory");
}
__device__ __forceinline__ float sample_sigma2(const float* W, int K, int N, int lane) {
    float s = 0.f;
#pragma unroll
    for (int j = 0; j < 4; ++j) { const f32x4 v = *(const GAS f32x4*)(W + (size_t)(j * (K / 4)) * N + lane * 4); s += (v.x * v.x + v.y * v.y) + (v.z * v.z + v.w * v.w); }
    return wave_sum(s) * (1.0f / 1024.0f);
}
__device__ __forceinline__ void quant_row_i8(const f32x4 (&v)[8], signed char* qrow, float* sx, float* gq, float* sg, float sig2, int lane) {
    float mx = 0.f, ss = 0.f;
#pragma unroll
    for (int j = 0; j < 8; ++j) { mx = fmaxf(mx, fmaxf(fmaxf(fabsf(v[j].x), fabsf(v[j].y)), fmaxf(fabsf(v[j].z), fabsf(v[j].w)))); ss += (v[j].x * v[j].x + v[j].y * v[j].y) + (v[j].z * v[j].z + v[j].w * v[j].w); }
#pragma unroll
    for (int o = 1; o < 64; o <<= 1) mx = fmaxf(mx, __shfl_xor(mx, o));
    ss = wave_sum(ss);
    const float m = fmaxf(mx, 1e-20f), qm = 127.f / m;
#pragma unroll
    for (int j = 0; j < 8; ++j) ((GAS unsigned*)qrow)[lane + 64 * j] = q8(v[j].x, qm) | (q8(v[j].y, qm) << 8) | (q8(v[j].z, qm) << 16) | (q8(v[j].w, qm) << 24);
    if (lane == 0) { const float clip = fmaxf(8.f * ss * sig2, 1e-20f);
        *sx = m * (1.0f / 127.f); *gq = 127.f / clip; *sg = clip * (1.0f / 127.f); }
}
template <bool OUT_BF16, bool Q8 = false>
__device__ __forceinline__ void ln_row(const float* xrow, const float* gam, const float* bet, void* orow, int lane, signed char* qrow = nullptr, float* sx = nullptr, float* gq = nullptr, float* sg = nullptr, float sig2 = 0.f) {
    const GAS f32x4* xr = (const GAS f32x4*)xrow + lane;
    f32x4 v[8]; float s = 0.f;
#pragma unroll
    for (int j = 0; j < 8; ++j) { v[j] = xr[64 * j]; s += (v[j].x + v[j].y) + (v[j].z + v[j].w); }
    const float mean = wave_sum(s) * (1.f / DM); float s2 = 0.f;
#pragma unroll
    for (int j = 0; j < 8; ++j) { v[j] = v[j] - mean; s2 += (v[j].x * v[j].x + v[j].y * v[j].y) + (v[j].z * v[j].z + v[j].w * v[j].w); }
    const float rstd = 1.f / sqrtf(wave_sum(s2) * (1.f / DM) + LN_EPS);
#pragma unroll
    for (int j = 0; j < 8; ++j) {
        const f32x4 gg = ((const GAS f32x4*)gam)[lane + 64 * j], bb = ((const GAS f32x4*)bet)[lane + 64 * j];
        const f32x4 y = v[j] * rstd * gg + bb;
        if (OUT_BF16) { ((GAS v2u*)orow)[lane + 64 * j] = (v2u){pk2(y.x, y.y), pk2(y.z, y.w)}; }
        else ((GAS f32x4*)orow)[lane + 64 * j] = y;
        if (Q8) v[j] = y;
    }
    if (Q8) quant_row_i8(v, qrow, sx, gq, sg, sig2, lane);
}

__device__ __forceinline__ unsigned ordkey(float s) { const unsigned u = __float_as_uint(s); return u ^ ((unsigned)((int)u >> 31) | 0x80000000u); }
__device__ __forceinline__ void indexer_unit(LAS unsigned char* lds, int b, int uidx, const bf16* QI16, const bf16* KI16, const float* WI, unsigned* MASKQ) {
    int tid_ = threadIdx.x; asm volatile("" : "+v"(tid_));
    const int tid = tid_, lane = tid & 63, wid = __builtin_amdgcn_readfirstlane(tid >> 6), r = lane & 31, h = lane >> 5;
    const int q0 = uidx * 16 + 2 * wid, tq = q0 + h;
    const int nchunk = ((uidx * 16 + 15) >> 8) + 1;
    bf16x8 aq[4];
    { const int qa = q0 + ((r >> 2) & 1), head = (r & 3) + 4 * (r >> 3);
      const bf16* qp = QI16 + (size_t)(b * SEQ + qa) * 1024 + head * 64 + 8 * h;
#pragma unroll
      for (int ks = 0; ks < 4; ++ks) aq[ks] = *(const GAS bf16x8*)(qp + ks * 16); }
    float w[16];
    { const GAS f32x4* wp = (const GAS f32x4*)(WI + (size_t)(b * SEQ + tq) * 16);
#pragma unroll
      for (int i = 0; i < 4; ++i) { const f32x4 t = wp[i]; w[4 * i] = t.x; w[4 * i + 1] = t.y; w[4 * i + 2] = t.z; w[4 * i + 3] = t.w; } }
    unsigned key[128];
    const char* kbase = (const char*)(KI16 + (size_t)(b * SEQ) * 64);
    unsigned soff[4];
#pragma unroll
    for (int i = 0; i < 4; ++i) { const int kk = (wid * 4 + i) * 8 + (lane >> 3), cs = lane & 7; soff[i] = (unsigned)(kk * 128 + ((cs ^ ((kk >> 1) & 7)) << 4)); }
#define IDX_STAGE(c_) do { _Pragma("unroll") for (int i = 0; i < 4; ++i) \
        __builtin_amdgcn_global_load_lds((const unsigned*)(kbase + (size_t)(c_) * 32768 + soff[i]), (LAS unsigned*)(lds + ((c_) & 1) * 32768 + (wid * 4 + i) * 1024), 16, 0, 0); } while (0)
    const int x = (r >> 1) & 7;
    int roff[4];
#pragma unroll
    for (int ks = 0; ks < 4; ++ks) roff[ks] = r * 128 + (((2 * ks + h) ^ x) << 4);
    __syncthreads();
    IDX_STAGE(0);
#pragma unroll
    for (int c = 0; c < 16; ++c) {
        if (c < nchunk) {
            asm volatile("s_waitcnt vmcnt(0)" ::: "memory");
            __syncthreads();
            if (c + 1 < nchunk) IDX_STAGE(c + 1);
#pragma unroll
            for (int jj = 0; jj < 8; ++jj) {
                const int j = c * 8 + jj;
                f32x16 acc = {};
#pragma unroll
                for (int ks = 0; ks < 4; ++ks) { const bf16x8 bk = *(const LAS bf16x8*)(lds + (c & 1) * 32768 + jj * 4096 + roff[ks]);
                    acc = __builtin_amdgcn_mfma_f32_32x32x16_bf16(aq[ks], bk, acc, 0, 0, 0); }
                float s = 0.f;
#pragma unroll
                for (int i = 0; i < 16; ++i) s = fmaf(w[i], fmaxf(acc[i], 0.f), s);
                unsigned kj = (j * 32 + r <= tq) ? ordkey(s) : 0u;
                asm volatile("" : "+v"(kj));
                key[j] = kj;
                __builtin_amdgcn_sched_barrier(0);
            }
        } else {
#pragma unroll
            for (int jj = 0; jj < 8; ++jj) key[c * 8 + jj] = 0u;
        }
    }
#undef IDX_STAGE
    unsigned thr = 1u;
    {
        unsigned lo = 0u, hi = 0xFFFFFFFFu; bool done = (tq + 1 <= TOPK);
        while (!__all(done)) {
            const unsigned mid = lo + ((hi - lo) >> 1);
            int cnt = 0;
#pragma unroll
            for (int j = 0; j < 128; ++j) cnt += (key[j] >= mid) ? 1 : 0;
#pragma unroll
            for (int o = 1; o < 32; o <<= 1) cnt += __shfl_xor(cnt, o);
            if (!done) {
                if (cnt >= TOPK) lo = mid; else hi = mid;
                if (cnt == TOPK) { thr = mid; done = true; }
                else if (hi - lo <= 1u) { thr = lo; done = true; }
            }
        }
    }
    LAS unsigned* mb = (LAS unsigned*)(lds + 65536) + wid * 256;
#pragma unroll
    for (int j = 0; j < 128; ++j) {
        const unsigned long long bal = __ballot(key[j] >= thr);
        const unsigned val = h ? (unsigned)(bal >> 32) : (unsigned)bal;
        if (r == 0) mb[h * 128 + j] = val;
        asm volatile("" ::: "memory");
    }
    LDS_WAIT(); asm volatile("" ::: "memory");
    GAS unsigned* mp = (GAS unsigned*)(MASKQ + (size_t)(b * SEQ + q0) * 128);
#pragma unroll
    for (int i = 0; i < 4; ++i) mp[64 * i + lane] = mb[64 * i + lane];
    LDS_WAIT(); asm volatile("" ::: "memory");
}

__device__ __forceinline__ void pool_task(int task, const bf16* U16, const bf16* WPT, const float* pscale, bf16* P16, int lane) {
    asm volatile("" : "+v"(lane));
    const int tile = task >> 2, g = task & 3, r = lane & 31, h = lane >> 5;
    const int tk = tile * 32 + r, pos = tk & (SEQ - 1), wlen = 2 << g;
    const int cnt = (pos + 1 < wlen) ? pos + 1 : wlen;
    const float rc = 1.0f / (float)cnt;
    bf16x8 pa[8];
#pragma unroll
    for (int ks = 0; ks < 8; ++ks) {
        const bf16* up = U16 + (size_t)tk * 512 + g * 128 + ks * 16 + 8 * h;
        float sum[8], self[8];
#pragma unroll
        for (int e = 0; e < 8; ++e) sum[e] = 0.f;
        for (int i = 0; i < wlen; ++i) {
            if (i < cnt) { const v4u t = *(const GAS v4u*)(up - (size_t)i * 512);
                const float f0 = pg8::bf_lo(t.x), f1 = pg8::bf_hi(t.x), f2 = pg8::bf_lo(t.y), f3 = pg8::bf_hi(t.y), f4 = pg8::bf_lo(t.z), f5 = pg8::bf_hi(t.z), f6 = pg8::bf_lo(t.w), f7 = pg8::bf_hi(t.w);
                if (i == 0) { self[0] = f0; self[1] = f1; self[2] = f2; self[3] = f3; self[4] = f4; self[5] = f5; self[6] = f6; self[7] = f7; }
                sum[0] += f0; sum[1] += f1; sum[2] += f2; sum[3] += f3; sum[4] += f4; sum[5] += f5; sum[6] += f6; sum[7] += f7; }
        }
        v4u o; o.x = pk2(sum[0] * rc - self[0], sum[1] * rc - self[1]); o.y = pk2(sum[2] * rc - self[2], sum[3] * rc - self[3]);
        o.z = pk2(sum[4] * rc - self[4], sum[5] * rc - self[5]); o.w = pk2(sum[6] * rc - self[6], sum[7] * rc - self[7]);
        pa[ks] = __builtin_bit_cast(bf16x8, o);
    }
#pragma unroll
    for (int nb = 0; nb < 4; ++nb) {
        f32x16 acc = {};
        const bf16* wp = WPT + (size_t)g * 16384 + (size_t)(nb * 32 + r) * 128 + 8 * h;
#pragma unroll
        for (int ks = 0; ks < 8; ++ks) { const bf16x8 bk = *(const GAS bf16x8*)(wp + ks * 16); acc = __builtin_amdgcn_mfma_f32_32x32x16_bf16(pa[ks], bk, acc, 0, 0, 0); }
        const int col = g * 128 + nb * 32 + r; const float ps = pscale[col];
#pragma unroll
        for (int i = 0; i < 16; ++i) { const int tok = tile * 32 + (i & 3) + 8 * (i >> 2) + 4 * h; P16[(size_t)tok * 2048 + col] = (bf16)f2bf(acc[i] * ps); }
    }
}

struct Args { const float* in[21]; float* out; unsigned char* ws; int ph_lo, ph_hi; };
__global__ void __launch_bounds__(NWAVES * 64, 2) mk_fwd(Args args) {
    extern __shared__ __attribute__((aligned(16))) unsigned char lds[];
    LAS unsigned char* L = (LAS unsigned char*)lds;
    volatile LAS unsigned* MISC = (volatile LAS unsigned*)(L + MISC_OFF);
    const int tid = threadIdx.x, lane = tid & 63, wave = __builtin_amdgcn_readfirstlane(tid >> 6);
    const int G = gridDim.x, bx = blockIdx.x;
    const int vcu = (G % 8 == 0) ? (bx % 8) * (G / 8) + bx / 8 : bx;
    const int gw = vcu * NWAVES + wave, NGW = G * NWAVES;
    unsigned char* ws = args.ws;
    for (int u = tid; u < (LDS_BYTES - LDSCTL_OFF) / 4; u += NWAVES * 64) ((LAS unsigned*)(L + LDSCTL_OFF))[u] = 0u;
    __syncthreads();
    XcdBarrier bar; bar.bar = (unsigned*)(ws + WS_CTL) + CW_BAR; bar.x = 0; bar.st = nullptr;
    if (!MK_PER_PHASE) bar = xcd_barrier_post((unsigned*)(ws + WS_CTL) + CW_BAR, MISC + 8);
    const int lo = args.ph_lo, hi = args.ph_hi;
#ifndef PH_MASK
#define PH_MASK 0x1FFF
#endif
#ifndef REP_MASK
#define REP_MASK 0x0
#endif
#define REP(k) for (int rep_ = 0; rep_ <= ((REP_MASK >> (k)) & 1); ++rep_)
#define REPBAR() do { if (rep_) xcd_barrier(bar); } while (0)
#define IN(k) (((PH_MASK >> (k)) & 1) && lo <= (k) && (k) < hi)
#define SEAM(k) do { if (IN(k) && IN((k) + 1)) xcd_barrier(bar); } while (0)
#define XIN (ap->in[0])
#define MEMIN (ap->in[1])
#define WSP_DECL unsigned char* wsp = args.ws; asm volatile("" : "+s"(wsp)); const __attribute__((address_space(4))) Args* ap = (const __attribute__((address_space(4))) Args*)__builtin_amdgcn_kernarg_segment_ptr(); asm volatile("" : "+s"(ap)); (void)wsp; (void)ap
#define BIG ((bf16*)(wsp + WS_BIG))
#define X16 ((bf16*)(wsp + WS_BIG + O_X16))
#define WUP1 ((bf16*)(wsp + WS_BIG + O_WUP1))
#define WDN1 ((bf16*)(wsp + WS_BIG + O_WDN1))
#define Gb ((bf16*)(wsp + WS_BIG + O_G))
#define Q16 ((bf16*)(wsp + WS_BIG + O_Q))
#define K16 ((bf16*)(wsp + WS_BIG + O_K))
#define V16 ((bf16*)(wsp + WS_BIG + O_V))
#define QI16 ((bf16*)(wsp + WS_BIG + O_QI))
#define KI16 ((bf16*)(wsp + WS_BIG + O_KI))
#define WI ((float*)(wsp + WS_BIG + O_WI))
#define U16 ((bf16*)(wsp + WS_BIG + O_U))
#define QM16 ((bf16*)(wsp + WS_BIG + O_QM))
#define GATE ((bf16*)(wsp + WS_BIG + O_GATE))
#define WIN ((bf16*)(wsp + WS_WIN))
#define WMKV ((bf16*)(wsp + WS_WMKV))
#define WBA ((bf16*)(wsp + WS_WBA))
#define WBP ((bf16*)(wsp + WS_WBP))
#define WBM ((bf16*)(wsp + WS_WBM))
#define WOUT ((bf16*)(wsp + WS_WOUT))
#define WUP2 ((bf16*)(wsp + WS_WUP2))
#define WDN2 ((bf16*)(wsp + WS_WDN2))
#define WPT ((bf16*)(wsp + WS_WPOOL))
#define H1 ((bf16*)(wsp + WS_H1))
#define MEM16 ((bf16*)(wsp + WS_MEM16))
#define A16 ((bf16*)(wsp + WS_A16))
#define P16 ((bf16*)(wsp + WS_A16) + 1024)
#define M16 ((bf16*)(wsp + WS_A16) + 1536)
#define H2 ((bf16*)(wsp + WS_A16))
#define Y16 ((bf16*)(wsp + WS_Y16))
#define KM ((bf16*)(wsp + WS_KM))
#define VM ((bf16*)(wsp + WS_VM))
#define MASKQ ((unsigned*)(wsp + WS_MASK))
#define X8 ((signed char*)(wsp + WS_BIG + O_X16))
#define WUP1q ((signed char*)(wsp + WS_BIG + O_WUP1))
#define WDN1q ((signed char*)(wsp + WS_BIG + O_WDN1))
#define G8 ((signed char*)(wsp + WS_BIG + O_G))
#define WUP2q ((signed char*)(wsp + WS_WUP2))
#define WDN2q ((signed char*)(wsp + WS_WDN2))
#define H2q ((signed char*)(wsp + WS_Y16))
#define G28 ((signed char*)(wsp + WS_BIG))
#define QS ((float*)(wsp + WS_QS))
#define SX1 ((float*)(wsp + WS_ROWQ))
#define GQ1 (SX1 + T)
#define SG1 (GQ1 + T)
#define SX2 (SG1 + T)
#define GQ2 (SX2 + T)
#define SG2 (GQ2 + T)
#define SXH (SG2 + T)
#define DQ0 (SXH + T)
#define DQ1 (DQ0 + T)
#define H1q ((signed char*)(wsp + WS_Y16))
#define WINq ((signed char*)(wsp + WS_WINQ))
#define R (ap->out)

    REP(0) if (IN(0)) { REPBAR(); WSP_DECL;
        LAS float* scr = (LAS float*)(L + RING_OFF + wave * 16384);
        const float s2u1 = fmaxf(sample_sigma2(ap->in[2], DM, NUP, lane), 1e-30f), s2d1 = fmaxf(sample_sigma2(ap->in[3], FF, DM, lane), 1e-30f);
        const float s2u2 = fmaxf(sample_sigma2(ap->in[17], DM, NUP, lane), 1e-30f), s2d2 = fmaxf(sample_sigma2(ap->in[18], FF, DM, lane), 1e-30f);
        const float qu1 = 127.f / (5.f * sqrtf(s2u1)), qd1 = 127.f / (5.f * sqrtf(s2d1)), qu2 = 127.f / (5.f * sqrtf(s2u2)), qd2 = 127.f / (5.f * sqrtf(s2d2));
        const float s2in = fmaxf(sample_sigma2(ap->in[6], DM, NIN, lane), 1e-30f), qin = 127.f / (5.f * sqrtf(s2in));
        if (gw == 0 && lane == 0) { QS[16] = qin; QS[17] = 1.f / qin; QS[0] = qu1; QS[1] = 1.f / qu1; QS[2] = s2u1; QS[3] = qd1; QS[4] = 1.f / qd1; QS[8] = qu2; QS[9] = 1.f / qu2; QS[10] = s2u2; QS[11] = qd2; QS[12] = 1.f / qd2; }
        constexpr int I_UP = (DM / 64) * (NUP / 32), I_DN = (FF / 64) * (DM / 32), I_IN = (DM / 64) * (NZB / 32), I_INQ = (DM / 64) * (NZQ / 32), I_MKV = (DM / 64) * (1024 / 32), I_BA = (1024 / 64) * (DM / 32),
                      I_BP = (512 / 64) * (DM / 32), I_OUT = (DM / 64) * (DM / 32), I_PL = (128 / 64) * (128 / 32);
        constexpr int NITEMS = 2 * I_UP + 2 * I_DN + I_IN + I_INQ + I_MKV + I_BA + 2 * I_BP + I_OUT + 4 * I_PL;
        for (int it = gw; it < NITEMS; it += NGW) {
            int r = it;
            if (r < I_UP) { p0_transpose_item_i8<1>(ap->in[2], DM, NUP, NUP, WUP1q, scr, r, lane, qu1); continue; } r -= I_UP;
            if (r < I_DN) { p0_transpose_item_i8<0>(ap->in[3], FF, DM, DM, WDN1q, scr, r, lane, qd1); continue; } r -= I_DN;
            if (r < I_IN) { p0_transpose_item<2>(ap->in[6], DM, NIN, NZB, WIN, scr, r, lane); continue; } r -= I_IN;
            if (r < I_INQ) { p0_transpose_item_i8<0>(ap->in[6] + 4176, DM, NIN, NZQ, WINq, scr, r, lane, qin); continue; } r -= I_INQ;
            if (r < I_MKV) { p0_transpose_item<0>(ap->in[8], DM, 1024, 1024, WMKV, scr, r, lane); continue; } r -= I_MKV;
            if (r < I_BA) { p0_transpose_item<0>(ap->in[11], 1024, DM, DM, WBA, scr, r, lane, DM); continue; } r -= I_BA;
            if (r < I_BP) { p0_transpose_item<0>(ap->in[12], 512, DM, DM, WBA + 1024, scr, r, lane, DM); continue; } r -= I_BP;
            if (r < I_BP) { p0_transpose_item<0>(ap->in[13], 512, DM, DM, WBA + 1536, scr, r, lane, DM); continue; } r -= I_BP;
            if (r < I_OUT) { p0_transpose_item<0>(ap->in[14], DM, DM, DM, WOUT, scr, r, lane); continue; } r -= I_OUT;
            if (r < I_UP) { p0_transpose_item_i8<1>(ap->in[17], DM, NUP, NUP, WUP2q, scr, r, lane, qu2); continue; } r -= I_UP;
            if (r < I_DN) { p0_transpose_item_i8<0>(ap->in[18], FF, DM, DM, WDN2q, scr, r, lane, qd2); continue; } r -= I_DN;
            { const int g = r / I_PL; p0_transpose_item<0>(ap->in[9] + (size_t)g * 16384, 128, 128, 128, WPT + (size_t)g * 16384, scr, r % I_PL, lane); }
        }
        for (int m = gw; m < T; m += NGW) {
            f32x4 v[8];
#pragma unroll
            for (int j = 0; j < 8; ++j) v[j] = ((const GAS f32x4*)(XIN + (size_t)m * DM))[lane + 64 * j];
            quant_row_i8(v, X8 + (size_t)m * DM, SX1 + m, GQ1 + m, SG1 + m, s2u1, lane);
        }
        for (size_t i = (size_t)gw * 64 + lane; i < (size_t)512 * DM / 8; i += (size_t)NGW * 64) {
            const f32x4 a = ((const GAS f32x4*)MEMIN)[2 * i], c = ((const GAS f32x4*)MEMIN)[2 * i + 1];
            ((GAS v4u*)MEM16)[i] = (v4u){pk2(a.x, a.y), pk2(a.z, a.w), pk2(c.x, c.y), pk2(c.z, c.w)};
        }
    }
    SEAM(0);
    REP(1) if (IN(1)) { REPBAR(); WSP_DECL;
        pg8::Gemm g{(const bf16*)X8, (const bf16*)WUP1q, T, NUP, DM / 2}; pg8::StaticOrder S; S.init(T, NUP, G, bx);
        pg8::EpiSwigluI8 E{G8, FF, SX1, GQ1, QS + 1};
        pg8::gemm_phase<pg8::EpiSwigluI8, pg8::StaticOrder, true, true, true>(L + RING_OFF, g, S, E);
    }
    SEAM(1);
    REP(2) if (IN(2)) { REPBAR(); WSP_DECL;
        pg8::Gemm g{(const bf16*)G8, (const bf16*)WDN1q, T, DM, FF / 2}; pg8::StaticOrder S; S.init(T, DM, G, bx);
        pg8::EpiResI8<false> E{R, XIN, DM, ALPHA, 0.5f, SG1, QS + 4};
        pg8::gemm_phase<pg8::EpiResI8<false>, pg8::StaticOrder, true, true, true>(L + RING_OFF, g, S, E);
    }
    SEAM(2);
    REP(3) if (IN(3)) { REPBAR(); WSP_DECL; for (int m = gw; m < T; m += NGW) ln_row<true, true>(R + (size_t)m * DM, ap->in[4], ap->in[5], H1 + (size_t)m * DM, lane, H1q + (size_t)m * DM, SXH + m, DQ0 + m, DQ1 + m, 0.f); }
    SEAM(3);
    REP(4) if (IN(4)) { REPBAR(); WSP_DECL;
        { pg8::Gemm g{H1, WIN, T, NZB, DM}; pg8::OrderZ S; S.so.init(T, NZB, G, bx);
          pg8::EpiZ E{Q16, KI16, KM, WI};
          pg8::gemm_phase<pg8::EpiZ, pg8::OrderZ, true, true>(L + RING_OFF, g, S, E); }
        { pg8::Gemm g{(const bf16*)H1q, (const bf16*)WINq, T, NZQ, DM / 2}; pg8::OrderQ S; S.so.init(T, NZQ, G, bx); S.heavy = (32 * (NZB / 256) + 8) - 2 * G;
          pg8::EpiZq E{U16, ap->in[7], SXH, QS + 17};
          pg8::gemm_phase<pg8::EpiZq, pg8::OrderQ, true, true, true>(L + RING_OFF, g, S, E); }
    }
    SEAM(4);
    REP(5) if (IN(5)) { REPBAR(); WSP_DECL;
        for (int task = gw; task < 1024; task += NGW) pool_task(task, U16, WPT, ap->in[10], P16, lane);
        for (int pp = vcu; pp < 256; pp += G) {
            const int b = pp >> 7, p = pp & 127;
#pragma unroll 1
            for (int k2 = 0; k2 < 2; ++k2) indexer_unit(L + RING_OFF, b, k2 ? 255 - p : p, QI16, KI16, WI, MASKQ);
        }
        __syncthreads();
    }
    SEAM(5);
    REP(6) if (IN(6)) { REPBAR(); WSP_DECL;
        const int xcd = bx & 7, ix = bx >> 3;
        if (ix < 32) {
            const int bh = xcd * 2 + (ix >> 4), qb = ix & 15, b = bh >> 3, hh = bh & 7;
            const size_t rowbase = (size_t)b * SEQ;
            const float ah = exp2f(-(float)(hh + 1)) * 11.313708498984761f;
            att::attn_block<1024, 2048, true>((const att::bf16*)(Q16 + (rowbase + qb * 256) * 1024 + hh * 128), (const att::bf16*)(K16 + rowbase * 1024 + hh * 128),
                                        (const att::bf16*)(V16 + rowbase * 1024 + hh * 128), (att::bf16*)(A16 + (rowbase + qb * 256) * 2048 + hh * 128),
                                        4 * (qb + 1), qb * 256, MASKQ + rowbase * 128, ah, (char*)lds + RING_OFF);
            if (qb < 8) { const int mi = bh * 8 + qb;
                const int mb = mi >> 6, mh = (mi >> 4) & 3, mq = mi & 15; const size_t mrow = (size_t)mb * SEQ + mq * 256;
                att::attn_block<512, 2048, false>((const att::bf16*)(QM16 + mrow * 512 + mh * 128), (const att::bf16*)(KM + (size_t)mb * MEMLEN * 512 + mh * 128),
                                            (const att::bf16*)(VM + (size_t)mb * MEMLEN * 512 + mh * 128), (att::bf16*)(M16 + mrow * 2048 + mh * 128),
                                            MEMLEN / 64, 0, nullptr, 0.f, (char*)lds + RING_OFF); }
        }
    }
    SEAM(6);
    REP(7) if (IN(7)) { REPBAR(); WSP_DECL;
        pg8::StaticOrder S; S.init(T, DM, G, bx);
        { pg8::Gemm g{A16, WBA, T, DM, DM}; pg8::OrderBr SB; SB.so = S; pg8::EpiBranch E{Y16, GATE}; pg8::gemm_phase<pg8::EpiBranch, pg8::OrderBr, true, true>(L + RING_OFF, g, SB, E); }
    }
    SEAM(7);
    REP(8) if (IN(8)) { REPBAR(); WSP_DECL;
        pg8::Gemm g{Y16, WOUT, T, DM, DM}; pg8::StaticOrder S; S.init(T, DM, G, bx);
        pg8::EpiRes<true> E{R, H1, DM, ALPHA, 1.0f};
        pg8::gemm_phase<pg8::EpiRes<true>, pg8::StaticOrder, true, true>(L + RING_OFF, g, S, E);
    }
    SEAM(8);
    REP(9) if (IN(9)) { REPBAR(); WSP_DECL; const float sig2 = QS[10]; for (int m = gw; m < T; m += NGW) ln_row<true, true>(R + (size_t)m * DM, ap->in[15], ap->in[16], H2 + (size_t)m * DM, lane, H2q + (size_t)m * DM, SX2 + m, GQ2 + m, SG2 + m, sig2); }
    SEAM(9);
    REP(10) if (IN(10)) { REPBAR(); WSP_DECL;
        pg8::Gemm g{(const bf16*)H2q, (const bf16*)WUP2q, T, NUP, DM / 2}; pg8::StaticOrder S; S.init(T, NUP, G, bx);
        pg8::EpiSwigluI8 E{G28, FF, SX2, GQ2, QS + 9};
        pg8::gemm_phase<pg8::EpiSwigluI8, pg8::StaticOrder, true, true, true>(L + RING_OFF, g, S, E);
    }
    SEAM(10);
    REP(11) if (IN(11)) { REPBAR(); WSP_DECL;
        pg8::Gemm g{(const bf16*)G28, (const bf16*)WDN2q, T, DM, FF / 2}; pg8::StaticOrder S; S.init(T, DM, G, bx);
        pg8::EpiResI8<true> E{R, H2, DM, ALPHA, 0.5f, SG2, QS + 12};
        pg8::gemm_phase<pg8::EpiResI8<true>, pg8::StaticOrder, true, true, true>(L + RING_OFF, g, S, E);
    }
    SEAM(11);
    REP(12) if (IN(12)) { REPBAR(); WSP_DECL; for (int m = gw; m < T; m += NGW) ln_row<false>(R + (size_t)m * DM, ap->in[19], ap->in[20], R + (size_t)m * DM, lane); }
#undef BIG
#undef X16
#undef WUP1
#undef WDN1
#undef Gb
#undef Q16
#undef K16
#undef V16
#undef QI16
#undef KI16
#undef WI
#undef U16
#undef QM16
#undef GATE
#undef WIN
#undef WMKV
#undef WBA
#undef WBP
#undef WBM
#undef WOUT
#undef WUP2
#undef WDN2
#undef WPT
#undef H1
#undef MEM16
#undef A16
#undef P16
#undef M16
#undef H2
#undef Y16
#undef KM
#undef VM
#undef MASKQ
#undef X8
#undef WUP1q
#undef WDN1q
#undef G8
#undef WUP2q
#undef WDN2q
#undef H2q
#undef G28
#undef QS
#undef SX1
#undef GQ1
#undef SG1
#undef SX2
#undef GQ2
#undef SG2
#undef SXH
#undef DQ0
#undef DQ1
#undef H1q
#undef WINq
#undef R
#undef XIN
#undef MEMIN
#undef WSP_DECL
#undef IN
#undef SEAM
}

extern "C" void kernel_launch(void* const* d_in, const int* in_sizes, int n_in, void* d_out, int out_size, void* d_ws, size_t ws_size, hipStream_t stream) {
    static int grid = 0;
    if (grid == 0) {
        if (n_in != 21 || in_sizes[0] != T * DM || out_size != T * DM || ws_size < WS_END) {
            fprintf(stderr, "kernel_launch: shape/workspace mismatch (n_in %d, in0 %d, out %d, ws %zu, need %zu); nothing launched\n", n_in, n_in > 0 ? in_sizes[0] : -1, out_size, ws_size, (size_t)WS_END);
            grid = -1; return; }
        int dev = 0, cus = 0;
        if (hipGetDevice(&dev) != hipSuccess || hipDeviceGetAttribute(&cus, hipDeviceAttributeMultiprocessorCount, dev) != hipSuccess) { grid = -1; return; }
        if (hipFuncSetAttribute((const void*)mk_fwd, hipFuncAttributeMaxDynamicSharedMemorySize, LDS_BYTES) != hipSuccess) { fprintf(stderr, "kernel_launch: hipFuncSetAttribute failed\n"); grid = -1; return; }
        (void)hipGetLastError();
        grid = cus;
        if (grid != 256) fprintf(stderr, "kernel_launch: %d CUs (built for 256)\n", grid);
    }
    if (grid < 0) return;
    if (hipMemsetAsync((char*)d_ws + WS_CTL, 0, CTL_ZERO_BYTES, stream) != hipSuccess) return;
    Args a{};
    for (int i = 0; i < 21; ++i) a.in[i] = (const float*)d_in[i];
    a.out = (float*)d_out; a.ws = (unsigned char*)d_ws;
#if MK_PER_PHASE
    for (int p = 0; p < N_PHASES; ++p) { a.ph_lo = p; a.ph_hi = p + 1; hipLaunchKernelGGL(mk_fwd, dim3(grid), dim3(NWAVES * 64), LDS_BYTES, stream, a); }
#else
    a.ph_lo = 0; a.ph_hi = N_PHASES;
    hipLaunchKernelGGL(mk_fwd, dim3(grid), dim3(NWAVES * 64), LDS_BYTES, stream, a);
#endif
}
```

```cpp
#include <hip/hip_runtime.h>
#include <hip/hip_bf16.h>
#include <cstdio>
#include <cstdint>

#ifndef MK_PER_PHASE
#define MK_PER_PHASE 0
#endif

namespace pg8 {
#define PG8_LAS __attribute__((address_space(3)))
typedef unsigned short bf16_t;
typedef short bf16x8 __attribute__((ext_vector_type(8)));
typedef float f32x4 __attribute__((ext_vector_type(4)));
typedef float f32x2 __attribute__((ext_vector_type(2)));
typedef unsigned u32x4 __attribute__((ext_vector_type(4)));
typedef unsigned u32x2 __attribute__((ext_vector_type(2)));
typedef int i32x4 __attribute__((ext_vector_type(4)));
template <bool I8> struct AccSel { typedef f32x4 type; };
template <> struct AccSel<true> { typedef i32x4 type; };
constexpr int BM = 256, BK = 64, HALF = 128, HTB = HALF * BK * 2, STAGE_BYTES = 8 * HTB, NXCD = 8, WGM = 8;

__host__ __device__ __forceinline__ int lds_byte(int r, int c) { const int st = (r >> 4) * 2 + (c >> 5), rr = r & 15, cc = c & 31, ob = rr * 64 + cc * 2; return st * 1024 + (ob ^ (((ob >> 9) & 1) << 5)); }
__host__ __device__ __forceinline__ void stage_rc(int b, int& R, int& C) { const int st = b / 1024, sb = b % 1024, swz = sb ^ (((sb >> 9) & 1) << 5); R = (st >> 1) * 16 + swz / 64; C = (st & 1) * 32 + (swz % 64) / 2; }
__host__ __device__ __forceinline__ int perm32(int rho) { const int n = rho >> 4, i = rho & 15; return 8 * (i >> 2) + 4 * n + (i & 3); }

struct Unit { int pm, pn, ko, nt, br; };
struct Gemm { const bf16_t* A; const bf16_t* Bt; int M, N, K; };

struct StaticOrder {
    int nM, nN, nwg, G, c;
    __host__ __device__ void init(int M, int N, int G_, int c_) { nM = M / BM; nN = N / BM; nwg = nM * nN; G = G_; c = c_; }
    __host__ __device__ bool next(int i, Unit& u) const {
        const long L = (long)i * G + c; if (L >= nwg) return false;
        int wgid = (int)L; { const int q = nwg / NXCD, r = nwg % NXCD, xcd = wgid % NXCD, off = wgid / NXCD; wgid = (xcd < r ? xcd * (q + 1) : r * (q + 1) + (xcd - r) * q) + off; }
        const int nig = WGM * nN, gid = wgid / nig, fm = gid * WGM, gsz = (nM - fm) < WGM ? (nM - fm) : WGM;
        u.pm = fm + ((wgid % nig) % gsz); u.pn = (wgid % nig) / gsz; u.ko = 0; u.nt = 0; u.br = 0; return true;
    }
    __device__ __forceinline__ void a_ready(const Unit&) const {}
    __device__ __forceinline__ void done(const Unit&) const {}
};
struct OrderZ {
    StaticOrder so;
    __device__ __forceinline__ bool next(int i, Unit& u) const {
        const long L = (long)i * so.G + so.c;
        if (L < so.nwg) return so.next(i, u);
        if (L < so.nwg + 8) { const int e = (int)(L - so.nwg); u.pm = 32 + (e >> 2); u.pn = so.nN + (e & 3); u.ko = 0; u.nt = 0; u.br = 0; return true; }
        return false;
    }
    __device__ __forceinline__ void a_ready(const Unit&) const {}
    __device__ __forceinline__ void done(const Unit&) const {}
};
struct OrderQ {
    StaticOrder so; int heavy;
    __device__ __forceinline__ bool next(int i, Unit& u) const {
        const int c = so.c, nl = so.G - heavy; long L;
        if (c >= heavy) { if (i >= 4) return false; L = (long)i * nl + (c - heavy); if (L >= 4L * nl) return false; }
        else { if (i >= 1) return false; L = 4L * nl + c; }
        if (L >= so.nwg) return false;
        int wgid = (int)L; { const int q = so.nwg / NXCD, r = so.nwg % NXCD, xcd = wgid % NXCD, off = wgid / NXCD; wgid = (xcd < r ? xcd * (q + 1) : r * (q + 1) + (xcd - r) * q) + off; }
        const int nig = WGM * so.nN, gid = wgid / nig, fm = gid * WGM, gsz = (so.nM - fm) < WGM ? (so.nM - fm) : WGM;
        u.pm = fm + ((wgid % nig) % gsz); u.pn = (wgid % nig) / gsz; u.ko = 0; u.nt = 0; u.br = 0; return true;
    }
    __device__ __forceinline__ void a_ready(const Unit&) const {}
    __device__ __forceinline__ void done(const Unit&) const {}
};
struct OrderBr {
    StaticOrder so;
    __device__ __forceinline__ bool next(int i, Unit& u) const {
        const int ti = i / 3, br = i - 3 * ti;
        if (!so.next(ti, u)) return false;
        u.br = br; u.ko = br == 0 ? 0 : (br == 1 ? 1024 : 1536); u.nt = br == 0 ? 16 : 8; return true;
    }
    __device__ __forceinline__ void a_ready(const Unit&) const {}
    __device__ __forceinline__ void done(const Unit&) const {}
};

__device__ __forceinline__ unsigned cvt_pk_bf16(float lo, float hi) { unsigned r; asm volatile("v_cvt_pk_bf16_f32 %0, %1, %2" : "=v"(r) : "v"(lo), "v"(hi)); return r; }
__device__ __forceinline__ float bf_lo(unsigned w) { return __uint_as_float(w << 16); }
__device__ __forceinline__ float bf_hi(unsigned w) { return __uint_as_float(w & 0xffff0000u); }
__device__ __forceinline__ float sigmoidf_(float x) { return __builtin_amdgcn_rcpf(1.0f + __builtin_amdgcn_exp2f(-1.4426950408889634f * x)); }

struct EpiSwiglu {
    static constexpr bool PERM = true, AFTER_DRAIN = false, CHAIN = false;
    bf16_t* G; int ldg;
    __device__ __forceinline__ void operator()(const f32x4 (&acc)[2][2][4][2], const Unit& u, int wr, int wc, int fr, int fq) const {
        const int row0 = u.pm * BM + wr * 64 + fr, col0 = u.pn * HALF + wc * 32 + 8 * fq;
#pragma unroll
        for (int ai = 0; ai < 2; ++ai)
#pragma unroll
            for (int m = 0; m < 4; ++m) {
                bf16_t* rowp = G + (size_t)(row0 + ai * HALF + m * 16) * ldg + col0;
                float g[8];
#pragma unroll
                for (int n = 0; n < 2; ++n)
#pragma unroll
                    for (int e = 0; e < 4; ++e) { const float a = acc[ai][0][m][n][e], uu = acc[ai][1][m][n][e]; g[n * 4 + e] = a * uu * sigmoidf_(a); }
                u32x4 w; w.x = cvt_pk_bf16(g[0], g[1]); w.y = cvt_pk_bf16(g[2], g[3]); w.z = cvt_pk_bf16(g[4], g[5]); w.w = cvt_pk_bf16(g[6], g[7]);
                *(u32x4*)rowp = w;
            }
    }
};
struct EpiSwigluI8 {
    static constexpr bool PERM = true, AFTER_DRAIN = false, CHAIN = false;
    signed char* G; int ldg; const float* sx; const float* gq; const float* wdq;
    __device__ __forceinline__ void operator()(const i32x4 (&acc)[2][2][4][2], const Unit& u, int wr, int wc, int fr, int fq) const {
        const int row0 = u.pm * BM + wr * 64 + fr, col0 = u.pn * HALF + wc * 32 + 8 * fq;
        const float wd = *wdq;
#pragma unroll
        for (int ai = 0; ai < 2; ++ai)
#pragma unroll
            for (int m = 0; m < 4; ++m) {
                const int row = row0 + ai * HALF + m * 16;
                const float sa = sx[row] * wd, gm = gq[row];
                unsigned w[2];
#pragma unroll
                for (int n = 0; n < 2; ++n) { int q[4];
#pragma unroll
                    for (int e = 0; e < 4; ++e) { const float a = (float)acc[ai][0][m][n][e] * sa, uu = (float)acc[ai][1][m][n][e] * sa; const float g = a * uu * sigmoidf_(a);
                        q[e] = (int)__builtin_rintf(fminf(fmaxf(g * gm, -127.f), 127.f)); }
                    w[n] = (unsigned)(q[0] & 255) | ((unsigned)(q[1] & 255) << 8) | ((unsigned)(q[2] & 255) << 16) | ((unsigned)q[3] << 24); }
                *(u32x2*)(G + (size_t)row * ldg + col0) = (u32x2){w[0], w[1]};
            }
    }
};
template <bool RESBF> struct EpiResI8 {
    static constexpr bool PERM = false, AFTER_DRAIN = false, CHAIN = false;
    float* out; const void* res; int ldc; float alpha, sc; const float* sg; const float* wdq;
    __device__ __forceinline__ void operator()(const i32x4 (&acc)[2][2][4][2], const Unit& u, int wr, int wc, int fr, int fq) const {
        const int row0 = u.pm * BM + wr * 64 + fr, col0 = u.pn * BM + wc * 32 + 4 * fq;
        const float wd = *wdq * sc;
#pragma unroll
        for (int ai = 0; ai < 2; ++ai)
#pragma unroll
            for (int m = 0; m < 4; ++m) { const int row = row0 + ai * HALF + m * 16; const size_t off = (size_t)row * ldc + col0; const float s = sg[row] * wd;
#pragma unroll
                for (int bj = 0; bj < 2; ++bj)
#pragma unroll
                    for (int n = 0; n < 2; ++n) { const size_t o = off + bj * HALF + n * 16; f32x4 r;
                        if (RESBF) { const u32x2 w = *(const u32x2*)((const bf16_t*)res + o); r = (f32x4){bf_lo(w.x), bf_hi(w.x), bf_lo(w.y), bf_hi(w.y)}; }
                        else r = *(const f32x4*)((const float*)res + o);
                        const i32x4 a = acc[ai][bj][m][n];
                        *(f32x4*)(out + o) = r * alpha + (f32x4){(float)a[0], (float)a[1], (float)a[2], (float)a[3]} * s; } }
    }
};
template <bool RESBF> struct EpiRes {
    static constexpr bool PERM = false, AFTER_DRAIN = false, CHAIN = false;
    float* out; const void* res; int ldc; float alpha, sc;
    __device__ __forceinline__ void operator()(const f32x4 (&acc)[2][2][4][2], const Unit& u, int wr, int wc, int fr, int fq) const {
        const int row0 = u.pm * BM + wr * 64 + fr, col0 = u.pn * BM + wc * 32 + 4 * fq;
#pragma unroll
        for (int ai = 0; ai < 2; ++ai)
#pragma unroll
            for (int m = 0; m < 4; ++m) { const size_t off = (size_t)(row0 + ai * HALF + m * 16) * ldc + col0;
#pragma unroll
                for (int bj = 0; bj < 2; ++bj)
#pragma unroll
                    for (int n = 0; n < 2; ++n) { const size_t o = off + bj * HALF + n * 16; f32x4 r;
                        if (RESBF) { const u32x2 w = *(const u32x2*)((const bf16_t*)res + o); r = (f32x4){bf_lo(w.x), bf_hi(w.x), bf_lo(w.y), bf_hi(w.y)}; }
                        else r = *(const f32x4*)((const float*)res + o);
                        *(f32x4*)(out + o) = r * alpha + acc[ai][bj][m][n] * sc; } }
    }
};
struct EpiBranch {
    static constexpr bool PERM = false, AFTER_DRAIN = false, CHAIN = true;
    bf16_t* Y16; const bf16_t* gate;
    __device__ __forceinline__ bool chain(f32x4 (&acc)[2][2][4][2], const Unit& u, int wr, int wc, int fr, int fq) const {
        const int row0 = u.pm * BM + wr * 64 + fr, col0 = u.pn * BM + wc * 32 + 4 * fq, br = u.br;
        const float FL = 8.673617379884035e-19f;
#pragma unroll
        for (int ai = 0; ai < 2; ++ai)
#pragma unroll
            for (int m = 0; m < 4; ++m) { const size_t row = (size_t)(row0 + ai * HALF + m * 16);
#pragma unroll
                for (int bj = 0; bj < 2; ++bj)
#pragma unroll
                    for (int n = 0; n < 2; ++n) { const int col = col0 + bj * HALF + n * 16;
                        const u32x2 w = *(const u32x2*)(gate + row * 6144 + br * 2048 + col);
                        f32x4 g = (f32x4){fmaxf(bf_lo(w.x), FL), fmaxf(bf_hi(w.x), FL), fmaxf(bf_lo(w.y), FL), fmaxf(bf_hi(w.y), FL)};
                        if (br < 2) { const u32x2 w2 = *(const u32x2*)(gate + row * 6144 + (br + 1) * 2048 + col);
                            g[0] *= __builtin_amdgcn_rcpf(fmaxf(bf_lo(w2.x), FL)); g[1] *= __builtin_amdgcn_rcpf(fmaxf(bf_hi(w2.x), FL));
                            g[2] *= __builtin_amdgcn_rcpf(fmaxf(bf_lo(w2.y), FL)); g[3] *= __builtin_amdgcn_rcpf(fmaxf(bf_hi(w2.y), FL));
                            acc[ai][bj][m][n] *= g; }
                        else { const f32x4 v = acc[ai][bj][m][n] * g; u32x2 o; o.x = cvt_pk_bf16(v[0], v[1]); o.y = cvt_pk_bf16(v[2], v[3]); *(u32x2*)(Y16 + row * 2048 + col) = o; } } }
        return br < 2;
    }
};
struct EpiZ {
    static constexpr bool PERM = true, AFTER_DRAIN = false, CHAIN = false;
    bf16_t *Q, *KI, *KM; float* WI;
    __device__ __forceinline__ void operator()(const f32x4 (&acc)[2][2][4][2], const Unit& u, int wr, int wc, int fr, int fq) const {
        const int pn = u.pn;
        bf16_t* base; int ld, ct = 0, mode = 0, rowoff = 0;
        if (pn < 16) { base = Q + (size_t)(pn >> 2) * ((size_t)8192 * 1024); ld = 1024; ct = pn & 3; }
        else if (pn == 16) { base = KI; ld = 64; mode = 2; }
        else { base = KM + (size_t)((pn - 17) >> 1) * (512 * 512); ld = 512; ct = (pn - 17) & 1; rowoff = 8192; }
        const int row0 = u.pm * BM + wr * 64 + fr - rowoff, cl = wc * 32 + 8 * fq;
        if (mode == 2) {
#pragma unroll
            for (int ai = 0; ai < 2; ++ai)
#pragma unroll
                for (int m = 0; m < 4; ++m) { const size_t row = (size_t)(row0 + ai * HALF + m * 16);
                    const f32x4 v0 = acc[ai][0][m][0], v1 = acc[ai][0][m][1];
                    if (cl < 64) { u32x4 w; w.x = cvt_pk_bf16(v0[0], v0[1]); w.y = cvt_pk_bf16(v0[2], v0[3]); w.z = cvt_pk_bf16(v1[0], v1[1]); w.w = cvt_pk_bf16(v1[2], v1[3]); *(u32x4*)(KI + row * 64 + cl) = w; }
                    else if (cl < 80) { const float s = 1.0f / 32.0f;
                        *(f32x4*)(WI + row * 16 + (cl - 64)) = v0 * s; *(f32x4*)(WI + row * 16 + (cl - 64) + 4) = v1 * s; } }
            return;
        }
        const int col0 = ct * BM + cl;
#pragma unroll
        for (int ai = 0; ai < 2; ++ai)
#pragma unroll
            for (int m = 0; m < 4; ++m) { bf16_t* rowp = base + (size_t)(row0 + ai * HALF + m * 16) * ld + col0;
#pragma unroll
                for (int bj = 0; bj < 2; ++bj) { const f32x4 v0 = acc[ai][bj][m][0], v1 = acc[ai][bj][m][1];
                    u32x4 w; w.x = cvt_pk_bf16(v0[0], v0[1]); w.y = cvt_pk_bf16(v0[2], v0[3]); w.z = cvt_pk_bf16(v1[0], v1[1]); w.w = cvt_pk_bf16(v1[2], v1[3]);
                    *(u32x4*)(rowp + bj * HALF) = w; } }
    }
};
struct EpiZq {
    static constexpr bool PERM = true, AFTER_DRAIN = false, CHAIN = false;
    bf16_t *U; const float* bgate; const float* sx; const float* wdq;
    __device__ __forceinline__ void operator()(const i32x4 (&acc)[2][2][4][2], const Unit& u, int wr, int wc, int fr, int fq) const {
        const int pn = u.pn; const bool gate = pn >= 4;
        bf16_t* base = U + (size_t)(gate ? 2 : (pn >> 1)) * ((size_t)8192 * 512);
        const int ld = gate ? 6144 : 512, ct = gate ? pn - 4 : (pn & 1);
        const int row0 = u.pm * BM + wr * 64 + fr, col0 = ct * BM + wc * 32 + 8 * fq;
        const float wd = *wdq;
        f32x4 bv[2][2];
#pragma unroll
        for (int bj = 0; bj < 2; ++bj)
#pragma unroll
            for (int n = 0; n < 2; ++n) bv[bj][n] = gate ? *(const f32x4*)(bgate + col0 + bj * HALF + 4 * n) : (f32x4){0.f, 0.f, 0.f, 0.f};
#pragma unroll
        for (int ai = 0; ai < 2; ++ai)
#pragma unroll
            for (int m = 0; m < 4; ++m) { const int row = row0 + ai * HALF + m * 16; bf16_t* rowp = base + (size_t)row * ld + col0; const float sa = sx[row] * wd;
#pragma unroll
                for (int bj = 0; bj < 2; ++bj) { const i32x4 a0 = acc[ai][bj][m][0], a1 = acc[ai][bj][m][1];
                    f32x4 v0 = (f32x4){(float)a0[0], (float)a0[1], (float)a0[2], (float)a0[3]} * sa + bv[bj][0], v1 = (f32x4){(float)a1[0], (float)a1[1], (float)a1[2], (float)a1[3]} * sa + bv[bj][1];
                    if (gate) {
#pragma unroll
                        for (int e = 0; e < 4; ++e) { v0[e] = sigmoidf_(v0[e]); v1[e] = sigmoidf_(v1[e]); } }
                    u32x4 w; w.x = cvt_pk_bf16(v0[0], v0[1]); w.y = cvt_pk_bf16(v0[2], v0[3]); w.z = cvt_pk_bf16(v1[0], v1[1]); w.w = cvt_pk_bf16(v1[2], v1[3]);
                    *(u32x4*)(rowp + bj * HALF) = w; } }
    }
};

template <class Epi, class Sched, bool ALIGN_EPI = false, bool SP2 = false, bool I8 = false>
__device__ __forceinline__ void gemm_phase(PG8_LAS unsigned char* lds, const Gemm g, const Sched& S, const Epi& E) {
    int tid_ = threadIdx.x; asm volatile("" : "+v"(tid_));
    const int tid = tid_, wid = __builtin_amdgcn_readfirstlane(tid >> 6), lane = tid & 63, wr = wid >> 2, wc = wid & 3, fr = lane & 15, fq = lane >> 4;
    const int K = g.K, nt = K / BK;
    unsigned voffA[2], voffB[2];
#pragma unroll
    for (int i = 0; i < 2; ++i) { int R, C; stage_rc(tid * 16 + i * 8192, R, C); const int Rb = Epi::PERM ? ((R & ~31) + perm32(R & 31)) : R;
        voffA[i] = (unsigned)(R * K + C) * 2u; voffB[i] = (unsigned)(Rb * K + C) * 2u; }
    const size_t kstep = (size_t)(BK * 2);
    const size_t hstep = (size_t)HALF * K * 2;
    const size_t tstep = 2 * hstep;
    const unsigned ldsw = (unsigned)wid * 1024u;
    const int aoff = lds_byte(wr * 64 + fr, fq * 8), boff = lds_byte(wc * 32 + fr, fq * 8);
#define PG8_SA(b, h) (((b) * 2 + (h)) * HTB)
#define PG8_SB(b, h) ((4 + (b) * 2 + (h)) * HTB)
#define PG8_STAGE(bufoff, gbase, voff) do { _Pragma("unroll") for (int _i = 0; _i < 2; ++_i) \
        __builtin_amdgcn_global_load_lds((const unsigned*)((const char*)(gbase) + (voff)[_i]), (PG8_LAS unsigned*)(lds + (bufoff) + ldsw + _i * 8192), 16, 0, 0); } while (0)
#define PG8_LDA(dst, b, h) do { _Pragma("unroll") for (int m = 0; m < 4; ++m) _Pragma("unroll") for (int k = 0; k < 2; ++k) dst[m][k] = *(const PG8_LAS bf16x8*)(lds + PG8_SA(b, h) + aoff + m * 2048 + k * 1024); } while (0)
#define PG8_LDB(dst, b, h) do { _Pragma("unroll") for (int n = 0; n < 2; ++n) _Pragma("unroll") for (int k = 0; k < 2; ++k) dst[n][k] = *(const PG8_LAS bf16x8*)(lds + PG8_SB(b, h) + boff + n * 2048 + k * 1024); } while (0)
#define PG8_MMA(ai, bj, At, Bt) do { __builtin_amdgcn_s_setprio(1); _Pragma("unroll") for (int m = 0; m < 4; ++m) _Pragma("unroll") for (int n = 0; n < 2; ++n) _Pragma("unroll") for (int k = 0; k < 2; ++k) \
        { if constexpr (I8) acc[ai][bj][m][n] = __builtin_amdgcn_mfma_i32_16x16x64_i8(__builtin_bit_cast(i32x4, Bt[n][k]), __builtin_bit_cast(i32x4, At[m][k]), acc[ai][bj][m][n], 0, 0, 0); \
          else acc[ai][bj][m][n] = __builtin_amdgcn_mfma_f32_16x16x32_bf16(Bt[n][k], At[m][k], acc[ai][bj][m][n], 0, 0, 0); } __builtin_amdgcn_s_setprio(0); } while (0)
#define PG8_WAIT_V(n) asm volatile("s_waitcnt vmcnt(" #n ")" ::: "memory")
#define PG8_WAIT_L(n) asm volatile("s_waitcnt lgkmcnt(" #n ")" ::: "memory")
#define PG8_BAR __builtin_amdgcn_s_barrier()
#define PG8_SCHED __builtin_amdgcn_sched_barrier(0)
    Unit cur, nxt; int ui = 0;
    if (!S.next(0, cur)) return;
    typedef typename AccSel<I8>::type acc_t;
    acc_t acc[2][2][4][2];
#pragma unroll
    for (int a = 0; a < 2; ++a)
#pragma unroll
        for (int b = 0; b < 2; ++b)
#pragma unroll
            for (int m = 0; m < 4; ++m)
#pragma unroll
                for (int n = 0; n < 2; ++n) acc[a][b][m][n] = acc_t{};
    bf16x8 At[4][2], B0[2][2], B1[2][2];
    const char* cA = (const char*)g.A + (size_t)cur.pm * tstep + (size_t)cur.ko * 2; const char* cB = (const char*)g.Bt + (size_t)cur.pn * tstep + (size_t)cur.ko * 2;
    int ntc = cur.nt ? cur.nt : nt;
    S.a_ready(cur);
    if constexpr (SP2) {
        PG8_STAGE(PG8_SB(0, 0), cB, voffB); PG8_STAGE(PG8_SB(0, 1), cB + hstep, voffB); PG8_STAGE(PG8_SA(0, 0), cA, voffA); PG8_STAGE(PG8_SA(0, 1), cA + hstep, voffA);
        if (wr == 1) PG8_BAR;
        PG8_WAIT_V(2); PG8_BAR;
        PG8_STAGE(PG8_SB(1, 0), cB + kstep, voffB); PG8_STAGE(PG8_SA(1, 0), cA + kstep, voffA); PG8_STAGE(PG8_SB(1, 1), cB + hstep + kstep, voffB);
        PG8_WAIT_V(6); PG8_BAR;
    } else {
        PG8_STAGE(PG8_SB(0, 0), cB, voffB); PG8_STAGE(PG8_SA(0, 0), cA, voffA); PG8_STAGE(PG8_SB(0, 1), cB + hstep, voffB); PG8_STAGE(PG8_SA(0, 1), cA + hstep, voffA);
        if (wr == 1) PG8_BAR;
        PG8_WAIT_V(4); PG8_BAR;
        PG8_STAGE(PG8_SB(1, 0), cB + kstep, voffB); PG8_STAGE(PG8_SA(1, 0), cA + kstep, voffA); PG8_STAGE(PG8_SB(1, 1), cB + hstep + kstep, voffB);
        PG8_WAIT_V(6); PG8_BAR;
    }
    for (;;) {
        const bool has_next = S.next(ui + 1, nxt);
        const char* nA = has_next ? (const char*)g.A + (size_t)nxt.pm * tstep + (size_t)nxt.ko * 2 : cA; const char* nB = has_next ? (const char*)g.Bt + (size_t)nxt.pn * tstep + (size_t)nxt.ko * 2 : cB;
        for (int t = 0; t < ntc; t += 2) {
            const bool last = (t == ntc - 2);
            const char* a1 = cA + (size_t)(t + 1) * kstep;
            const char* a2 = last ? nA : cA + (size_t)(t + 2) * kstep; const char* b2 = last ? nB : cB + (size_t)(t + 2) * kstep;
            const char* a3 = a2 + kstep; const char* b3 = b2 + kstep;
            if (last && has_next) S.a_ready(nxt);
            if constexpr (SP2) {
            PG8_LDB(B0, 0, 0); PG8_LDB(B1, 0, 1); PG8_SCHED; PG8_LDA(At, 0, 0); PG8_STAGE(PG8_SA(1, 1), a1 + hstep, voffA);
            PG8_WAIT_V(8); PG8_WAIT_L(0); PG8_BAR; PG8_MMA(0, 0, At, B0); PG8_MMA(0, 1, At, B1); PG8_BAR; PG8_SCHED;
            PG8_LDA(At, 0, 1); PG8_STAGE(PG8_SB(0, 0), b2, voffB); PG8_STAGE(PG8_SB(0, 1), b2 + hstep, voffB); PG8_STAGE(PG8_SA(0, 0), a2, voffA);
            PG8_WAIT_V(8); PG8_WAIT_L(0); PG8_BAR; PG8_MMA(1, 0, At, B0); PG8_MMA(1, 1, At, B1); PG8_BAR; PG8_SCHED;
            PG8_LDB(B0, 1, 0); PG8_LDB(B1, 1, 1); PG8_SCHED; PG8_LDA(At, 1, 0); PG8_STAGE(PG8_SA(0, 1), a2 + hstep, voffA);
            PG8_WAIT_V(8); PG8_WAIT_L(0); PG8_BAR; PG8_MMA(0, 0, At, B0); PG8_MMA(0, 1, At, B1); PG8_BAR; PG8_SCHED;
            PG8_LDA(At, 1, 1); PG8_STAGE(PG8_SB(1, 0), b3, voffB); PG8_STAGE(PG8_SB(1, 1), b3 + hstep, voffB); PG8_STAGE(PG8_SA(1, 0), a3, voffA);
            PG8_WAIT_V(8); PG8_WAIT_L(0); PG8_BAR; PG8_MMA(1, 0, At, B0); PG8_MMA(1, 1, At, B1); PG8_BAR; PG8_SCHED;
            } else {
            PG8_LDB(B0, 0, 0); PG8_SCHED; PG8_LDA(At, 0, 0); PG8_STAGE(PG8_SA(1, 1), a1 + hstep, voffA);
            PG8_WAIT_L(8); PG8_BAR; PG8_WAIT_L(0); PG8_MMA(0, 0, At, B0); PG8_BAR; PG8_SCHED;
            PG8_LDB(B1, 0, 1); PG8_STAGE(PG8_SB(0, 0), b2, voffB);
            PG8_BAR; PG8_WAIT_L(0); PG8_MMA(0, 1, At, B1); PG8_BAR;
            PG8_LDA(At, 0, 1); PG8_STAGE(PG8_SA(0, 0), a2, voffA);
            PG8_BAR; PG8_WAIT_L(0); PG8_MMA(1, 0, At, B0); PG8_BAR; PG8_SCHED;
            PG8_STAGE(PG8_SB(0, 1), b2 + hstep, voffB);
            PG8_WAIT_V(6); PG8_BAR; PG8_MMA(1, 1, At, B1); PG8_BAR;
            PG8_LDB(B0, 1, 0); PG8_SCHED; PG8_LDA(At, 1, 0); PG8_STAGE(PG8_SA(0, 1), a2 + hstep, voffA);
            PG8_WAIT_L(8); PG8_BAR; PG8_WAIT_L(0); PG8_MMA(0, 0, At, B0); PG8_BAR; PG8_SCHED;
            PG8_LDB(B1, 1, 1); PG8_STAGE(PG8_SB(1, 0), b3, voffB);
            PG8_BAR; PG8_WAIT_L(0); PG8_MMA(0, 1, At, B1); PG8_BAR;
            PG8_LDA(At, 1, 1); PG8_STAGE(PG8_SA(1, 0), a3, voffA);
            PG8_BAR; PG8_WAIT_L(0); PG8_MMA(1, 0, At, B0); PG8_BAR; PG8_SCHED;
            PG8_STAGE(PG8_SB(1, 1), b3 + hstep, voffB);
            PG8_WAIT_V(6); PG8_BAR; PG8_MMA(1, 1, At, B1); PG8_BAR;
            }
        }
        if constexpr (ALIGN_EPI) { if (wr == 0) PG8_BAR; }
        bool keep = false;
        if constexpr (Epi::CHAIN) { keep = E.chain(acc, cur, wr, wc, fr, fq); S.done(cur); }
        else if constexpr (!Epi::AFTER_DRAIN) { E(acc, cur, wr, wc, fr, fq); S.done(cur); }
        if (!has_next) break;
        if (!keep)
#pragma unroll
        for (int a = 0; a < 2; ++a)
#pragma unroll
            for (int b = 0; b < 2; ++b)
#pragma unroll
                for (int m = 0; m < 4; ++m)
#pragma unroll
                    for (int n = 0; n < 2; ++n) acc[a][b][m][n] = acc_t{};
        cur = nxt; cA = nA; cB = nB; ++ui; ntc = cur.nt ? cur.nt : nt;
        if constexpr (ALIGN_EPI) { if (wr == 1) PG8_BAR; }
    }
    PG8_WAIT_V(0);
    if constexpr (!ALIGN_EPI) { if (wr == 0) PG8_BAR; }
    PG8_BAR;
#undef PG8_SA
#undef PG8_SB
#undef PG8_STAGE
#undef PG8_LDA
#undef PG8_LDB
#undef PG8_MMA
#undef PG8_WAIT_V
#undef PG8_WAIT_L
#undef PG8_BAR
#undef PG8_SCHED
}
}

namespace att {
using bf16 = __hip_bfloat16;
typedef short bf16x8 __attribute__((ext_vector_type(8)));
typedef short s16x4 __attribute__((ext_vector_type(4)));
typedef float f32x16 __attribute__((ext_vector_type(16)));
typedef float f32x4 __attribute__((ext_vector_type(4)));
typedef unsigned u32x4 __attribute__((ext_vector_type(4)));
typedef unsigned u32x2 __attribute__((ext_vector_type(2)));
constexpr int D = 128;
constexpr float SCALE = 0.08838834764831845f;
constexpr float THR = 8.f;
constexpr int NW = 8, QBLK = 32, KVBLK = 64, QB = NW * QBLK;
constexpr int SHM_V = KVBLK * D * 2, SHM_K = KVBLK * D * 2;
constexpr int LDS_BYTES = 2 * SHM_V + 2 * SHM_K + NW * 64 * 4;
#define KSWZ(row, colB) ((row) * 256 + ((colB) ^ (((row) & 7) << 4)))
#define SBAR() __builtin_amdgcn_sched_barrier(0)
__device__ __forceinline__ int v_st(int k, int c) { const int kk = (k & ~0xC) | ((k & 4) << 1) | ((k & 8) >> 1); return ((kk >> 3) * 4 + (c >> 5)) * 512 + ((kk & 7) * 32 + (c & 31)) * 2; }
__device__ __forceinline__ int v_rd_base(int lane) { return ((lane & 3) << 3) | (((lane >> 2) & 3) << 6) | (((lane >> 4) & 1) << 5) | (((lane >> 5) & 1) << 8); }
constexpr int v_rd_off(int d0, int ks, int half) { return d0 * 512 + ks * 4096 + half * 2048; }
__device__ __forceinline__ int crow(int r, int hi) { return (r & 3) + 8 * (r >> 2) + 4 * hi; }
__device__ __forceinline__ unsigned cvtpk(float lo, float hi) { unsigned r; asm volatile("v_cvt_pk_bf16_f32 %0, %1, %2" : "=v"(r) : "v"(lo), "v"(hi)); return r; }
__device__ __forceinline__ bf16x8 load8(const bf16* p) { return *reinterpret_cast<const bf16x8*>(p); }
__device__ __forceinline__ void mask_alibi(f32x16& p0, f32x16& p1, u32x2 mw, int dq, int hi, float ah) {
    const float NEG = -__builtin_inff();
    const unsigned w0 = mw.x >> (4 * hi), w1 = mw.y >> (4 * hi);
    const float dqf = (float)dq;
#pragma unroll
    for (int r = 0; r < 16; ++r) {
        const int c = (r & 3) + 8 * (r >> 2);
        p0[r] = ((w0 >> c) & 1u) ? fmaf(ah, (float)c - dqf, p0[r]) : NEG;
        p1[r] = ((w1 >> c) & 1u) ? fmaf(ah, (float)(c + 32) - dqf, p1[r]) : NEG;
    }
}
__device__ __forceinline__ void partialSM(f32x16& p0, f32x16& p1, float& m_reg, float& mn, float& alpha) {
    float pmax = p0[0];
#pragma unroll
    for (int r = 1; r < 16; ++r) pmax = fmaxf(pmax, p0[r]);
#pragma unroll
    for (int r = 0; r < 16; ++r) pmax = fmaxf(pmax, p1[r]);
    { auto rr = __builtin_amdgcn_permlane32_swap(__float_as_uint(pmax), __float_as_uint(pmax), false, false);
      pmax = fmaxf(__uint_as_float(rr[0]), __uint_as_float(rr[1])); }
    constexpr float C2 = 1.4426950408889634f * SCALE;
    if (__builtin_expect(__all((pmax - m_reg) * SCALE <= THR), 1)) { mn = m_reg; alpha = 1.f; }
    else { mn = fmaxf(m_reg, pmax); alpha = __builtin_amdgcn_exp2f((m_reg - mn) * C2); m_reg = mn; }
    const float mnL = -mn * C2;
#pragma unroll
    for (int r = 0; r < 16; ++r) p0[r] = fmaf(p0[r], C2, mnL);
#pragma unroll
    for (int r = 0; r < 16; ++r) p1[r] = fmaf(p1[r], C2, mnL);
#pragma unroll
    for (int r = 0; r < 16; ++r) p0[r] = __builtin_amdgcn_exp2f(p0[r]);
}
__device__ __forceinline__ void finishSM(f32x16& p0, f32x16& p1, float alpha, float& l_reg, bf16x8& pa0, bf16x8& pa1, bf16x8& pa2, bf16x8& pa3) {
#pragma unroll
    for (int r = 0; r < 16; ++r) p1[r] = __builtin_amdgcn_exp2f(p1[r]);
    float ps = 0;
#pragma unroll
    for (int r = 0; r < 16; ++r) ps += p0[r];
#pragma unroll
    for (int r = 0; r < 16; ++r) ps += p1[r];
    { auto rr = __builtin_amdgcn_permlane32_swap(__float_as_uint(ps), __float_as_uint(ps), false, false);
      ps = __uint_as_float(rr[0]) + __uint_as_float(rr[1]); }
    l_reg = l_reg * alpha + ps;
#define PK4(P, B_, OUT) do { unsigned a0 = cvtpk(P[B_+0], P[B_+1]), a1 = cvtpk(P[B_+2], P[B_+3]);                          \
        unsigned b0 = cvtpk(P[B_+4], P[B_+5]), b1 = cvtpk(P[B_+6], P[B_+7]);                                             \
        auto r0 = __builtin_amdgcn_permlane32_swap(a0, b0, false, false); auto r1 = __builtin_amdgcn_permlane32_swap(a1, b1, false, false); \
        u32x4 w = {r0[0], r1[0], r0[1], r1[1]}; OUT = *reinterpret_cast<bf16x8*>(&w); } while (0)
    PK4(p0, 0, pa0); PK4(p0, 8, pa1); PK4(p1, 0, pa2); PK4(p1, 8, pa3);
#undef PK4
}
template <int KB>
__device__ __forceinline__ void qkt(f32x16& p0, f32x16& p1, const char* K_lds, int r32, int hi, const bf16x8* qr) {
    p0 = f32x16{}; p1 = f32x16{};
    const char* kb[4];
#pragma unroll
    for (int dd = 0; dd < 4; ++dd) kb[dd] = K_lds + KB * SHM_K + KSWZ(r32, (dd * 16 + hi * 8) * 2);
#pragma unroll
    for (int d0 = 0; d0 < 8; ++d0) { const char* a = kb[d0 & 3] + (d0 >> 2) * 128;
        bf16x8 b0 = *reinterpret_cast<const bf16x8*>(a);
        bf16x8 b1 = *reinterpret_cast<const bf16x8*>(a + 32 * 256);
        p0 = __builtin_amdgcn_mfma_f32_32x32x16_bf16(b0, qr[d0], p0, 0, 0, 0);
        p1 = __builtin_amdgcn_mfma_f32_32x32x16_bf16(b1, qr[d0], p1, 0, 0, 0); }
}
template <int VB>
__device__ __forceinline__ void pv_tile(f32x16* o, int vb0, bf16x8 pa0, bf16x8 pa1, bf16x8 pa2, bf16x8 pa3) {
#define TRRD(dst, off) asm volatile("ds_read_b64_tr_b16 %0, %1 offset:%2" : "=&v"(dst) : "v"(vb0), "i"(off) : "memory")
#define PV_D0(d0) do { s16x4 l0, l1, l2, l3, h0, h1, h2, h3; constexpr int b_ = VB * SHM_V + v_rd_off(d0, 0, 0); \
        TRRD(l0, b_); TRRD(h0, b_ + 2048); TRRD(l1, b_ + 4096); TRRD(h1, b_ + 6144); TRRD(l2, b_ + 8192); TRRD(h2, b_ + 10240); TRRD(l3, b_ + 12288); TRRD(h3, b_ + 14336); \
        asm volatile("s_waitcnt lgkmcnt(0)" ::: "memory"); SBAR();   \
        o[d0] = __builtin_amdgcn_mfma_f32_32x32x16_bf16(pa0, (bf16x8){l0[0], l0[1], l0[2], l0[3], h0[0], h0[1], h0[2], h0[3]}, o[d0], 0, 0, 0);   \
        o[d0] = __builtin_amdgcn_mfma_f32_32x32x16_bf16(pa1, (bf16x8){l1[0], l1[1], l1[2], l1[3], h1[0], h1[1], h1[2], h1[3]}, o[d0], 0, 0, 0);   \
        o[d0] = __builtin_amdgcn_mfma_f32_32x32x16_bf16(pa2, (bf16x8){l2[0], l2[1], l2[2], l2[3], h2[0], h2[1], h2[2], h2[3]}, o[d0], 0, 0, 0);   \
        o[d0] = __builtin_amdgcn_mfma_f32_32x32x16_bf16(pa3, (bf16x8){l3[0], l3[1], l3[2], l3[3], h3[0], h3[1], h3[2], h3[3]}, o[d0], 0, 0, 0); } while (0)
    PV_D0(0); PV_D0(1); PV_D0(2); PV_D0(3);
#undef PV_D0
#undef TRRD
}
template <int LD, int LDO, bool MASKED>
__device__ __forceinline__ void attn_block(const bf16* Q, const bf16* Kh, const bf16* Vh, bf16* O, int NT, int P0, const unsigned* maskbase, float ah, char* lds) {
    int tid_ = threadIdx.x; asm volatile("" : "+v"(tid_));
    const int tid = tid_, wid = __builtin_amdgcn_readfirstlane(tid >> 6), lane = tid & 63, r32 = lane & 31, hi = lane >> 5;
    const int qlo = P0 + wid * QBLK, qm = qlo + r32 - 4 * hi;
    char* V_lds = lds; char* K_lds = lds + 2 * SHM_V;
    float* ws = (float*)(lds + 2 * SHM_V + 2 * SHM_K) + wid * 64; float* li_l = ws, * al_l = ws + 32;
    float m_reg = -1e30f, l_reg = 0; f32x16 o[4] = {};
    const int sr = tid >> 4, sc = (tid & 15) * 8, vst0 = v_st(sr, sc), vst1 = v_st(32 + sr, sc), kws = KSWZ(sr, sc * 2);
    const int vb0 = (int)(uintptr_t)V_lds + v_rd_base(lane);
    const unsigned* mrow = MASKED ? maskbase + (size_t)(qlo + r32) * 128 : nullptr;
    bf16x8 qr[8], st_v0, st_v1, st_k0, st_k1;
#define ROW(p, k0, rr) ((p) + (size_t)((k0) + (rr)) * LD + sc)
#define VMW() asm volatile("s_waitcnt vmcnt(0)" ::: "memory")
#define SLOAD_H(k0) do { st_v0 = load8(ROW(Vh, k0, sr)); st_v1 = load8(ROW(Vh, k0, 32 + sr)); st_k0 = load8(ROW(Kh, k0, sr)); st_k1 = load8(ROW(Kh, k0, 32 + sr)); } while (0)
#define SWRITE_HK(bf) do { *(bf16x8*)(K_lds + (bf) * SHM_K + kws) = st_k0; *(bf16x8*)(K_lds + (bf) * SHM_K + kws + 32 * 256) = st_k1; } while (0)
#define SWRITE_HV(bf) do { *(bf16x8*)(V_lds + (bf) * SHM_V + vst0) = st_v0; *(bf16x8*)(V_lds + (bf) * SHM_V + vst1) = st_v1; } while (0)
#define SWRITE_H(bf) do { SWRITE_HV(bf); SWRITE_HK(bf); } while (0)
#define RESC(a) do { if (__any((a) < 1.f)) { if (hi == 0) al_l[r32] = (a); asm volatile("s_waitcnt lgkmcnt(0)" ::: "memory");              \
                     for (int d_ = 0; d_ < 4; ++d_) for (int r = 0; r < 16; ++r) o[d_][r] *= al_l[crow(r, hi)]; } } while (0)
#define KBASE(t) ((t) * KVBLK)
#define MLOAD(dst, t) do { if (MASKED) dst = *(const u32x2*)(mrow + 2 * (t)); } while (0)
#define MASKT(P0_, P1_, mw_, t) do { if (MASKED) mask_alibi(P0_, P1_, mw_, qm - KBASE(t), hi, ah); } while (0)
#pragma unroll
    for (int d0 = 0; d0 < 8; ++d0) qr[d0] = load8(Q + (size_t)(wid * QBLK + r32) * LD + d0 * 16 + hi * 8);
    SLOAD_H(0); VMW(); SWRITE_HK(0);
    __syncthreads();
    f32x16 pA0, pA1, pB0, pB1; float mnA, mnB, alA, alB; bf16x8 pa0, pa1, pa2, pa3;
    u32x2 mwA = {0u, 0u}, mwB = {0u, 0u};
    SWRITE_HV(0); SBAR();
    MLOAD(mwA, 0);
    if (NT > 1) SLOAD_H(KBASE(1));
    SBAR(); qkt<0>(pA0, pA1, K_lds, r32, hi, qr);
    MASKT(pA0, pA1, mwA, 0); partialSM(pA0, pA1, m_reg, mnA, alA);
    if (NT > 1) { VMW(); SWRITE_H(1); }
    __syncthreads();
#define HALF_STEP(PX0, PX1, mwX, mnX, alX, PY0, PY1, alY, t, KB, VB, SB) do {                                                 \
        SBAR(); MLOAD(mwX, t); qkt<KB>(PX0, PX1, K_lds, r32, hi, qr);                                                         \
        finishSM(PY0, PY1, alY, l_reg, pa0, pa1, pa2, pa3); SBAR();                                                           \
        if ((t) + 1 < NT) { SLOAD_H(KBASE((t) + 1)); SBAR(); }                                                                \
        pv_tile<VB>(o, vb0, pa0, pa1, pa2, pa3); MASKT(PX0, PX1, mwX, (t)); partialSM(PX0, PX1, m_reg, mnX, alX);             \
        __syncthreads();                                                                                                      \
        if ((t) + 1 < NT) { VMW(); SWRITE_H(SB); }                                                                            \
        RESC(alX); __syncthreads(); } while (0)
    for (int t = 1; t + 1 < NT; t += 2) {
        HALF_STEP(pB0, pB1, mwB, mnB, alB, pA0, pA1, alA, t, 1, 0, 0);
        HALF_STEP(pA0, pA1, mwA, mnA, alA, pB0, pB1, alB, t + 1, 0, 1, 1);
    }
    const bool even = (NT & 1) == 0;
    if (even) { SBAR(); MLOAD(mwB, NT - 1); qkt<1>(pB0, pB1, K_lds, r32, hi, qr); SBAR(); }
    finishSM(pA0, pA1, alA, l_reg, pa0, pa1, pa2, pa3); SBAR();
    pv_tile<0>(o, vb0, pa0, pa1, pa2, pa3);
    if (even) { MASKT(pB0, pB1, mwB, NT - 1); partialSM(pB0, pB1, m_reg, mnB, alB); __syncthreads(); RESC(alB);
        finishSM(pB0, pB1, alB, l_reg, pa0, pa1, pa2, pa3); SBAR(); pv_tile<1>(o, vb0, pa0, pa1, pa2, pa3); }
    SBAR();
    if (hi == 0) li_l[r32] = l_reg; asm volatile("s_waitcnt lgkmcnt(0)" ::: "memory");
    float rli[16];
#pragma unroll
    for (int r = 0; r < 16; ++r) rli[r] = __builtin_amdgcn_rcpf(li_l[crow(r, hi)]);
    bf16* Ow = O + (size_t)(wid * QBLK) * LDO;
#pragma unroll
    for (int r = 0; r < 16; ++r) { const int orow = crow(r, hi);
#pragma unroll
        for (int d0 = 0; d0 < 4; ++d0) { const float v = o[d0][r] * rli[r];
            const float vn = __shfl_xor(v, 1);
            if ((r32 & 1) == 0) *(unsigned*)(Ow + (size_t)orow * LDO + d0 * 32 + r32) = cvtpk(v, vn); } }
    __syncthreads();
#undef ROW
#undef VMW
#undef SLOAD_H
#undef SWRITE_HK
#undef SWRITE_HV
#undef SWRITE_H
#undef RESC
#undef KBASE
#undef MLOAD
#undef MASKT
#undef HALF_STEP
}
#undef KSWZ
#undef SBAR
}

constexpr int NWAVES = 8;
constexpr int BATCH = 2, SEQ = 4096, DM = 2048, T = BATCH * SEQ, FF = 5632, NUP = 2 * FF;
constexpr int NIN = 11344, NIN_PAD = 11520;
constexpr int MEMLEN = 256, TOPK = 256;
constexpr float ALPHA = 1.189207115002721f;
constexpr float LN_EPS = 1e-5f;
constexpr int N_PHASES = 13;

constexpr size_t WS_CTL = 0, CTL_ZERO_BYTES = 1u << 20;
constexpr size_t WS_BIG = 1u << 20;
constexpr size_t O_X16 = 0, O_WUP1 = O_X16 + (size_t)T * DM * 2, O_WDN1 = O_WUP1 + (size_t)NUP * DM * 2, O_G = O_WDN1 + (size_t)DM * FF * 2, BIG_BYTES = O_G + (size_t)T * FF * 2;
constexpr size_t O_Q = 0, O_K = O_Q + (size_t)T * 1024 * 2, O_V = O_K + (size_t)T * 1024 * 2, O_QI = O_V + (size_t)T * 1024 * 2, O_KI = O_QI + (size_t)T * 1024 * 2,
                 O_WI = O_KI + (size_t)T * 64 * 2, O_U = O_WI + (size_t)T * 16 * 4, O_QM = O_U + (size_t)T * 512 * 2, O_GATE = O_QM + (size_t)T * 512 * 2, O_MIXEND = O_GATE + (size_t)T * 6144 * 2;
static_assert(O_MIXEND <= BIG_BYTES, "mixer view fits");
constexpr size_t WS_WIN = WS_BIG + BIG_BYTES;
constexpr int NZB = 4352, NZQ = NIN_PAD - NZB;
constexpr size_t WS_WMKV = WS_WIN + (size_t)NZB * DM * 2;
constexpr size_t WS_WINQ = WS_WMKV + (size_t)1024 * DM * 2;
constexpr size_t WS_WBA = WS_WIN + (size_t)NIN_PAD * DM * 2 + (size_t)1024 * DM * 2;
constexpr size_t WS_WBP = WS_WBA + (size_t)DM * 1024 * 2;
constexpr size_t WS_WBM = WS_WBP + (size_t)DM * 512 * 2;
constexpr size_t WS_WOUT = WS_WBM + (size_t)DM * 512 * 2;
constexpr size_t WS_WUP2 = WS_WOUT + (size_t)DM * DM * 2;
constexpr size_t WS_WDN2 = WS_WUP2 + (size_t)NUP * DM * 2;
constexpr size_t WS_WPOOL = WS_WDN2 + (size_t)DM * FF * 2;
constexpr size_t WS_H1 = WS_WPOOL + (size_t)4 * 128 * 128 * 2;
constexpr size_t WS_MEM16 = WS_H1 + (size_t)T * DM * 2;
constexpr size_t WS_A16 = WS_MEM16 + (size_t)512 * DM * 2;
constexpr size_t WS_P16 = WS_A16 + (size_t)T * 1024 * 2;
constexpr size_t WS_M16 = WS_P16 + (size_t)T * 512 * 2;
constexpr size_t WS_Y16 = WS_M16 + (size_t)T * 512 * 2;
constexpr size_t WS_KM = WS_Y16 + (size_t)T * DM * 2;
constexpr size_t WS_VM = WS_KM + (size_t)512 * 512 * 2;
constexpr size_t WS_MASK = WS_VM + (size_t)512 * 512 * 2;
constexpr size_t WS_END = WS_MASK + (size_t)T * 128 * 4;
constexpr int CW_BAR = 4096;
constexpr size_t WS_QS = 65536;
constexpr size_t WS_ROWQ = 131072;
static_assert(WS_ROWQ + (size_t)9 * 8192 * 4 <= (1u << 20), "control region");

constexpr int RING_OFF = 0, RING_BYTES = 131072;
constexpr int LDSCTL_OFF = RING_BYTES, MISC_OFF = LDSCTL_OFF + 320;
constexpr int LDS_BYTES = 147456;

#define GAS __attribute__((address_space(1)))
#define LAS __attribute__((address_space(3)))
typedef unsigned short bf16;
typedef unsigned v4u __attribute__((ext_vector_type(4)));
typedef unsigned v2u __attribute__((ext_vector_type(2)));
typedef float f32x4 __attribute__((ext_vector_type(4)));
typedef float f32x16 __attribute__((ext_vector_type(16)));
typedef short bf16x8 __attribute__((ext_vector_type(8)));
#define LDS_WAIT() asm volatile("s_waitcnt lgkmcnt(0)" ::: "memory")
__device__ __forceinline__ unsigned f2bf(float f) { unsigned u = __builtin_bit_cast(unsigned, f); return (u + 0x7fffu + ((u >> 16) & 1u)) >> 16; }
__device__ __forceinline__ unsigned pk2(float lo, float hi) { return f2bf(lo) | (f2bf(hi) << 16); }

#define XB_TMO      128
#define XB_XCNT(j)  (256  + 64 * (j))
#define XB_XSUB(j)  (1280 + 64 * (j))
#define XB_XGEN(j)  (2304 + 64 * (j))
#define XB_TOP      3328
#define XB_TOPGEN   3392
#define XCD_BAR_WORDS 3456
#define XB_SPIN_CAP (1u << 22)
__device__ __forceinline__ unsigned xb_ld(unsigned* p)              { return __hip_atomic_load(p, __ATOMIC_RELAXED, __HIP_MEMORY_SCOPE_AGENT); }
__device__ __forceinline__ unsigned xb_add(unsigned* p, unsigned v) { return __hip_atomic_fetch_add(p, v, __ATOMIC_RELAXED, __HIP_MEMORY_SCOPE_AGENT); }
__device__ __forceinline__ unsigned xb_xcc_id() { return (unsigned)__builtin_amdgcn_s_getreg((3 << 11) | 20) & 0xFu; }
#define XB_SPIN(cond, bar) do { unsigned _sp = 0; while (cond) { __builtin_amdgcn_s_sleep(1); \
    if ((++_sp & 255u) == 0u) { if (xb_ld(&(bar)[XB_TMO])) break; if (_sp > XB_SPIN_CAP) { atomicAdd(&(bar)[XB_TMO], 1u); break; } } } } while (0)
struct XcdBarrier { unsigned* bar; unsigned x; volatile LAS unsigned* st; };
__device__ __forceinline__ XcdBarrier xcd_barrier_post(unsigned* bar, volatile LAS unsigned* st) {
    XcdBarrier b; b.bar = bar; b.x = xb_xcc_id(); b.st = st;
    if (threadIdx.x == 0) (void)xb_add(&bar[XB_XCNT(b.x)], 1u);
    return b;
}
__device__ __forceinline__ void xcd_barrier_complete(unsigned* bar, unsigned x, unsigned& nloc, unsigned& nx) {
    const unsigned G = gridDim.x * gridDim.y * gridDim.z;
    unsigned sum, cnt, mine, sp = 0u;
    for (;;) {
        sum = 0u; cnt = 0u; mine = 0u;
#pragma unroll
        for (unsigned j = 0; j < 16; ++j) { const unsigned c = xb_ld(&bar[XB_XCNT(j)]); sum += c; cnt += (c > 0u) ? 1u : 0u; mine = (j == x) ? c : mine; }
        if (sum == G) break;
        __builtin_amdgcn_s_sleep(1);
        if ((++sp & 255u) == 0u) { if (xb_ld(&bar[XB_TMO])) break; if (sp > XB_SPIN_CAP) { atomicAdd(&bar[XB_TMO], 1u); break; } }
    }
    nloc = mine > 0u ? mine : 1u; nx = cnt > 0u ? cnt : 1u;
}
__device__ __forceinline__ void xcd_barrier(const XcdBarrier& b) {
    asm volatile("s_waitcnt vmcnt(0)" ::: "memory");
    __syncthreads();
    if (threadIdx.x == 0) {
        unsigned* bar = b.bar;
        __builtin_amdgcn_s_waitcnt(0);
        unsigned nloc = b.st[0], nx = b.st[1];
        if (nloc == 0u) { xcd_barrier_complete(bar, b.x, nloc, nx); b.st[0] = nloc; b.st[1] = nx; }
        const unsigned old = xb_add(&bar[XB_XSUB(b.x)], 1u);
        const unsigned gen = old / nloc;
        if (old + 1u == (gen + 1u) * nloc) {
            __builtin_amdgcn_fence(__ATOMIC_RELEASE, "agent");
            asm volatile("s_waitcnt vmcnt(0)" ::: "memory");
            const unsigned og = xb_add(&bar[XB_TOP], 1u);
            const unsigned tg = og / nx;
            if (og + 1u == (tg + 1u) * nx) xb_add(&bar[XB_TOPGEN], 1u);
            else XB_SPIN(xb_ld(&bar[XB_TOPGEN]) == tg, bar);
            __builtin_amdgcn_fence(__ATOMIC_ACQUIRE, "agent");
            xb_add(&bar[XB_XGEN(b.x)], 1u);
            asm volatile("s_waitcnt vmcnt(0)" ::: "memory");
        } else {
            XB_SPIN(xb_ld(&bar[XB_XGEN(b.x)]) == gen, bar);
            __builtin_amdgcn_fence(__ATOMIC_ACQUIRE, "agent");
            asm volatile("s_waitcnt vmcnt(0)" ::: "memory");
        }
    }
    __syncthreads();
}

__device__ __forceinline__ float wave_sum(float v) {
#pragma unroll
    for (int o = 1; o < 64; o <<= 1) v += __shfl_xor(v, o);
    return v;
}
template <int MAP>
__device__ __forceinline__ void p0_transpose_item(const float* W, int K, int N, int NP, bf16* WT, LAS float* scr, int item, int lane, int ldw = 0) {
    if (ldw == 0) ldw = K;
    const int nblk = NP / 32, kb = item / nblk, nb = item % nblk, k0 = 64 * kb, np0 = 32 * nb;
    int n0 = np0; int nvalid = 32;
    if (MAP == 1) n0 = ((np0 >> 7) & 1) * FF + (np0 >> 8) * 128 + (np0 & 127);
    if (MAP == 2) { if (np0 < 4096) n0 = np0; else if (np0 < 4352) { n0 = np0; nvalid = 4176 - np0; nvalid = nvalid < 0 ? 0 : (nvalid > 32 ? 32 : nvalid); } else n0 = np0 - 176; }
    float v[32];
    const bool ok = (lane & 31) < nvalid;
#pragma unroll
    for (int i = 0; i < 32; ++i) { const int kk = 2 * i + (lane >> 5); v[i] = ok ? W[(size_t)(k0 + kk) * N + n0 + (lane & 31)] : 0.f; }
#pragma unroll
    for (int i = 0; i < 32; ++i) { const int kk = 2 * i + (lane >> 5); scr[kk * 33 + (lane & 31)] = v[i]; }
    LDS_WAIT(); asm volatile("" ::: "memory");
    const int c = lane & 7;
#pragma unroll
    for (int j = 0; j < 4; ++j) { const int n = (lane >> 3) + 8 * j; const LAS float* s = scr + (8 * c) * 33 + n;
        v4u o; o.x = pk2(s[0 * 33], s[1 * 33]); o.y = pk2(s[2 * 33], s[3 * 33]); o.z = pk2(s[4 * 33], s[5 * 33]); o.w = pk2(s[6 * 33], s[7 * 33]);
        *(GAS v4u*)(WT + (size_t)(np0 + n) * ldw + k0 + 8 * c) = o; }
    LDS_WAIT(); asm volatile("" ::: "memory");
}
__device__ __forceinline__ unsigned q8(float v, float qw) { return (unsigned)((int)__builtin_rintf(fminf(fmaxf(v * qw, -127.f), 127.f)) & 255); }
template <int MAP>
__device__ __forceinline__ void p0_transpose_item_i8(const float* W, int K, int N, int NP, signed char* WT, LAS float* scr, int item, int lane, float qw) {
    const int nblk = NP / 32, kb = item / nblk, nb = item % nblk, k0 = 64 * kb, np0 = 32 * nb;
    int n0 = np0;
    if (MAP == 1) n0 = ((np0 >> 7) & 1) * FF + (np0 >> 8) * 128 + (np0 & 127);
    float v[32];
#pragma unroll
    for (int i = 0; i < 32; ++i) { const int kk = 2 * i + (lane >> 5); v[i] = W[(size_t)(k0 + kk) * N + n0 + (lane & 31)]; }
#pragma unroll
    for (int i = 0; i < 32; ++i) { const int kk = 2 * i + (lane >> 5); scr[kk * 33 + (lane & 31)] = v[i]; }
    LDS_WAIT(); asm volatile("" ::: "memory");
#pragma unroll
    for (int j = 0; j < 2; ++j) { const int id = lane + 64 * j, n = id >> 2, c = id & 3; const LAS float* sp = scr + (16 * c) * 33 + n;
        v4u o;
        o.x = q8(sp[0 * 33], qw) | (q8(sp[1 * 33], qw) << 8) | (q8(sp[2 * 33], qw) << 16) | (q8(sp[3 * 33], qw) << 24);
        o.y = q8(sp[4 * 33], qw) | (q8(sp[5 * 33], qw) << 8) | (q8(sp[6 * 33], qw) << 16) | (q8(sp[7 * 33], qw) << 24);
        o.z = q8(sp[8 * 33], qw) | (q8(sp[9 * 33], qw) << 8) | (q8(sp[10 * 33], qw) << 16) | (q8(sp[11 * 33], qw) << 24);
        o.w = q8(sp[12 * 33], qw) | (q8(sp[13 * 33], qw) << 8) | (q8(sp[14 * 33], qw) << 16) | (q8(sp[15 * 33], qw) << 24);
        *(GAS v4u*)(WT + (size_t)(np0 + n) * K + k0 + 16 * c) = o; }
    LDS_WAIT(); asm volatile("" ::: "memory");
}
__device__ __forceinline__ float sample_sigma2(const float* W, int K, int N, int lane) {
    float s = 0.f;
#pragma unroll
    for (int j = 0; j < 4; ++j) { const f32x4 v = *(const GAS f32x4*)(W + (size_t)(j * (K / 4)) * N + lane * 4); s += (v.x * v.x + v.y * v.y) + (v.z * v.z + v.w * v.w); }
    return wave_sum(s) * (1.0f / 1024.0f);
}
__device__ __forceinline__ void quant_row_i8(const f32x4 (&v)[8], signed char* qrow, float* sx, float* gq, float* sg, float sig2, int lane) {
    float mx = 0.f, ss = 0.f;
#pragma unroll
    for (int j = 0; j < 8; ++j) { mx = fmaxf(mx, fmaxf(fmaxf(fabsf(v[j].x), fabsf(v[j].y)), fmaxf(fabsf(v[j].z), fabsf(v[j].w)))); ss += (v[j].x * v[j].x + v[j].y * v[j].y) + (v[j].z * v[j].z + v[j].w * v[j].w); }
#pragma unroll
    for (int o = 1; o < 64; o <<= 1) mx = fmaxf(mx, __shfl_xor(mx, o));
    ss = wave_sum(ss);
    const float m = fmaxf(mx, 1e-20f), qm = 127.f / m;
#pragma unroll
    for (int j = 0; j < 8; ++j) ((GAS unsigned*)qrow)[lane + 64 * j] = q8(v[j].x, qm) | (q8(v[j].y, qm) << 8) | (q8(v[j].z, qm) << 16) | (q8(v[j].w, qm) << 24);
    if (lane == 0) { const float clip = fmaxf(8.f * ss * sig2, 1e-20f);
        *sx = m * (1.0f / 127.f); *gq = 127.f / clip; *sg = clip * (1.0f / 127.f); }
}
template <bool OUT_BF16, bool Q8 = false>
__device__ __forceinline__ void ln_row(const float* xrow, const float* gam, const float* bet, void* orow, int lane, signed char* qrow = nullptr, float* sx = nullptr, float* gq = nullptr, float* sg = nullptr, float sig2 = 0.f) {
    const GAS f32x4* xr = (const GAS f32x4*)xrow + lane;
    f32x4 v[8]; float s = 0.f;
#pragma unroll
    for (int j = 0; j < 8; ++j) { v[j] = xr[64 * j]; s += (v[j].x + v[j].y) + (v[j].z + v[j].w); }
    const float mean = wave_sum(s) * (1.f / DM); float s2 = 0.f;
#pragma unroll
    for (int j = 0; j < 8; ++j) { v[j] = v[j] - mean; s2 += (v[j].x * v[j].x + v[j].y * v[j].y) + (v[j].z * v[j].z + v[j].w * v[j].w); }
    const float rstd = 1.f / sqrtf(wave_sum(s2) * (1.f / DM) + LN_EPS);
#pragma unroll
    for (int j = 0; j < 8; ++j) {
        const f32x4 gg = ((const GAS f32x4*)gam)[lane + 64 * j], bb = ((const GAS f32x4*)bet)[lane + 64 * j];
        const f32x4 y = v[j] * rstd * gg + bb;
        if (OUT_BF16) { ((GAS v2u*)orow)[lane + 64 * j] = (v2u){pk2(y.x, y.y), pk2(y.z, y.w)}; }
        else ((GAS f32x4*)orow)[lane + 64 * j] = y;
        if (Q8) v[j] = y;
    }
    if (Q8) quant_row_i8(v, qrow, sx, gq, sg, sig2, lane);
}

__device__ __forceinline__ unsigned ordkey(float s) { const unsigned u = __float_as_uint(s); return u ^ ((unsigned)((int)u >> 31) | 0x80000000u); }
__device__ __forceinline__ float keyf(unsigned k) { return __uint_as_float((k & 0x80000000u) ? (k ^ 0x80000000u) : ~k); }
template <int CTRL> __device__ __forceinline__ unsigned dpp_u(unsigned v) { return (unsigned)__builtin_amdgcn_update_dpp(0, (int)v, CTRL, 0xf, 0xf, true); }
__device__ __forceinline__ unsigned umin_(unsigned a, unsigned b) { return a < b ? a : b; }
__device__ __forceinline__ unsigned umax_(unsigned a, unsigned b) { return a > b ? a : b; }
__device__ __forceinline__ unsigned uadd_(unsigned a, unsigned b) { return a + b; }
#define HALF_REDUCE(v, OP) do { v = OP(v, dpp_u<0xB1>(v)); v = OP(v, dpp_u<0x4E>(v)); v = OP(v, dpp_u<0x141>(v)); v = OP(v, dpp_u<0x140>(v)); v = OP(v, (unsigned)__shfl_xor((int)v, 16)); } while (0)
typedef float f32x2_t __attribute__((ext_vector_type(2)));
__device__ __forceinline__ void indexer_unit(LAS unsigned char* lds, int b, int uidx, const bf16* QI16, const bf16* KI16, const float* WI, unsigned* MASKQ) {
    int tid_ = threadIdx.x; asm volatile("" : "+v"(tid_));
    const int tid = tid_, lane = tid & 63, wid = __builtin_amdgcn_readfirstlane(tid >> 6), r = lane & 31, h = lane >> 5;
    const int q0 = uidx * 16 + 2 * wid, tq = q0 + h;
    const int nchunk = ((uidx * 16 + 15) >> 8) + 1;
    bf16x8 aq[4];
    { const int qa = q0 + ((r >> 2) & 1), head = (r & 3) + 4 * (r >> 3);
      const bf16* qp = QI16 + (size_t)(b * SEQ + qa) * 1024 + head * 64 + 8 * h;
#pragma unroll
      for (int ks = 0; ks < 4; ++ks) aq[ks] = *(const GAS bf16x8*)(qp + ks * 16); }
    f32x2_t w2[8];
    { const GAS f32x4* wp = (const GAS f32x4*)(WI + (size_t)(b * SEQ + tq) * 16);
#pragma unroll
      for (int i = 0; i < 4; ++i) { const f32x4 t = wp[i]; w2[2 * i] = (f32x2_t){t.x, t.y}; w2[2 * i + 1] = (f32x2_t){t.z, t.w}; } }
    unsigned key[128]; unsigned kmn = 0xFFFFFFFFu, kmx = 0u;
    const char* kbase = (const char*)(KI16 + (size_t)(b * SEQ) * 64);
    unsigned soff[4];
#pragma unroll
    for (int i = 0; i < 4; ++i) { const int kk = (wid * 4 + i) * 8 + (lane >> 3), cs = lane & 7; soff[i] = (unsigned)(kk * 128 + ((cs ^ ((kk >> 1) & 7)) << 4)); }
#define IDX_STAGE(c_) do { _Pragma("unroll") for (int i = 0; i < 4; ++i) \
        __builtin_amdgcn_global_load_lds((const unsigned*)(kbase + (size_t)(c_) * 32768 + soff[i]), (LAS unsigned*)(lds + ((c_) % 3) * 32768 + (wid * 4 + i) * 1024), 16, 0, 0); } while (0)
    const int x = (r >> 1) & 7;
    int roff[4];
#pragma unroll
    for (int ks = 0; ks < 4; ++ks) roff[ks] = r * 128 + (((2 * ks + h) ^ x) << 4);
    __syncthreads();
    IDX_STAGE(0);
    if (nchunk > 1) IDX_STAGE(1);
#pragma unroll
    for (int c = 0; c < 16; ++c) {
        if (c < nchunk) {
            if (c + 1 < nchunk) asm volatile("s_waitcnt vmcnt(4)" ::: "memory"); else asm volatile("s_waitcnt vmcnt(0)" ::: "memory");
            __builtin_amdgcn_s_barrier(); asm volatile("" ::: "memory");
            if (c + 2 < nchunk) IDX_STAGE(c + 2);
#pragma unroll
            for (int jj = 0; jj < 8; ++jj) {
                const int j = c * 8 + jj;
                f32x16 acc = {};
#pragma unroll
                for (int ks = 0; ks < 4; ++ks) { const bf16x8 bk = *(const LAS bf16x8*)(lds + (c % 3) * 32768 + jj * 4096 + roff[ks]);
                    acc = __builtin_amdgcn_mfma_f32_32x32x16_bf16(aq[ks], bk, acc, 0, 0, 0); }
                f32x2_t s2 = {0.f, 0.f};
#pragma unroll
                for (int i = 0; i < 8; ++i) { const int a0 = __float_as_int(acc[2 * i]), a1 = __float_as_int(acc[2 * i + 1]);
                    const f32x2_t a = {__int_as_float(a0 > 0 ? a0 : 0), __int_as_float(a1 > 0 ? a1 : 0)}; s2 = a * w2[i] + s2; }
                const float s = s2.x + s2.y;
                const bool valid = (j * 32 + r <= tq);
                unsigned kj = valid ? ordkey(s) : 0u;
                asm volatile("" : "+v"(kj));
                key[j] = kj; kmx = umax_(kmx, kj); kmn = umin_(kmn, valid ? kj : 0xFFFFFFFFu);
                __builtin_amdgcn_sched_barrier(0);
            }
        } else {
#pragma unroll
            for (int jj = 0; jj < 8; ++jj) key[c * 8 + jj] = 0u;
        }
    }
#undef IDX_STAGE
    unsigned thr = 1u;
    {
        HALF_REDUCE(kmn, umin_); HALF_REDUCE(kmx, umax_);
        bool done = (tq + 1 <= TOPK);
        unsigned lo = kmn, hi = kmx + 1u;
        int clo = tq + 1, chi = 0, it = 0;
        if (!done && hi - lo <= 1u) { thr = lo; done = true; }
        while (!__all(done)) {
            unsigned mid;
            { const float lof = keyf(lo), hif = keyf(hi - 1u);
              float frac = ((float)clo - ((float)TOPK - 0.5f)) / (float)(clo - chi);
              frac = fminf(fmaxf(frac, 0.0625f), 0.9375f);
              if ((it & 3) == 3) frac = 0.5f;
              mid = ordkey(fmaf(hif - lof, frac, lof)); mid = mid <= lo ? lo + 1u : mid; mid = mid >= hi ? hi - 1u : mid; }
            unsigned c0 = 0, c1 = 0, c2 = 0, c3 = 0;
#pragma unroll
            for (int j = 0; j < 128; j += 4) { c0 += (key[j] >= mid) ? 1u : 0u; c1 += (key[j + 1] >= mid) ? 1u : 0u; c2 += (key[j + 2] >= mid) ? 1u : 0u; c3 += (key[j + 3] >= mid) ? 1u : 0u; }
            unsigned cu = (c0 + c1) + (c2 + c3);
            HALF_REDUCE(cu, uadd_);
            const int cnt = (int)cu;
            if (!done) {
                if (cnt == TOPK) { thr = mid; done = true; }
                else if (cnt > TOPK) { lo = mid; clo = cnt; } else { hi = mid; chi = cnt; }
                if (!done && hi - lo <= 1u) { thr = lo; done = true; }
            }
            ++it;
        }
    }
    LAS unsigned* mb = (LAS unsigned*)(lds + 98304) + wid * 256;
#pragma unroll
    for (int j = 0; j < 128; ++j) {
        const unsigned long long bal = __ballot(key[j] >= thr);
        const unsigned val = h ? (unsigned)(bal >> 32) : (unsigned)bal;
        if (r == 0) mb[h * 128 + j] = val;
        asm volatile("" ::: "memory");
    }
    LDS_WAIT(); asm volatile("" ::: "memory");
    GAS unsigned* mp = (GAS unsigned*)(MASKQ + (size_t)(b * SEQ + q0) * 128);
#pragma unroll
    for (int i = 0; i < 4; ++i) mp[64 * i + lane] = mb[64 * i + lane];
    LDS_WAIT(); asm volatile("" ::: "memory");
}
#undef HALF_REDUCE

__device__ __forceinline__ void pool_task(int task, const bf16* U16, const bf16* WPT, const float* pscale, bf16* P16, int lane) {
    asm volatile("" : "+v"(lane));
    const int tile = task >> 2, g = task & 3, r = lane & 31, h = lane >> 5;
    const int tk = tile * 32 + r, pos = tk & (SEQ - 1), wlen = 2 << g;
    const int cnt = (pos + 1 < wlen) ? pos + 1 : wlen;
    const float rc = 1.0f / (float)cnt;
    bf16x8 pa[8];
#pragma unroll
    for (int ks = 0; ks < 8; ++ks) {
        const bf16* up = U16 + (size_t)tk * 512 + g * 128 + ks * 16 + 8 * h;
        float sum[8], self[8];
#pragma unroll
        for (int e = 0; e < 8; ++e) sum[e] = 0.f;
        for (int i = 0; i < wlen; ++i) {
            if (i < cnt) { const v4u t = *(const GAS v4u*)(up - (size_t)i * 512);
                const float f0 = pg8::bf_lo(t.x), f1 = pg8::bf_hi(t.x), f2 = pg8::bf_lo(t.y), f3 = pg8::bf_hi(t.y), f4 = pg8::bf_lo(t.z), f5 = pg8::bf_hi(t.z), f6 = pg8::bf_lo(t.w), f7 = pg8::bf_hi(t.w);
                if (i == 0) { self[0] = f0; self[1] = f1; self[2] = f2; self[3] = f3; self[4] = f4; self[5] = f5; self[6] = f6; self[7] = f7; }
                sum[0] += f0; sum[1] += f1; sum[2] += f2; sum[3] += f3; sum[4] += f4; sum[5] += f5; sum[6] += f6; sum[7] += f7; }
        }
        v4u o; o.x = pk2(sum[0] * rc - self[0], sum[1] * rc - self[1]); o.y = pk2(sum[2] * rc - self[2], sum[3] * rc - self[3]);
        o.z = pk2(sum[4] * rc - self[4], sum[5] * rc - self[5]); o.w = pk2(sum[6] * rc - self[6], sum[7] * rc - self[7]);
        pa[ks] = __builtin_bit_cast(bf16x8, o);
    }
#pragma unroll
    for (int nb = 0; nb < 4; ++nb) {
        f32x16 acc = {};
        const bf16* wp = WPT + (size_t)g * 16384 + (size_t)(nb * 32 + r) * 128 + 8 * h;
#pragma unroll
        for (int ks = 0; ks < 8; ++ks) { const bf16x8 bk = *(const GAS bf16x8*)(wp + ks * 16); acc = __builtin_amdgcn_mfma_f32_32x32x16_bf16(pa[ks], bk, acc, 0, 0, 0); }
        const int col = g * 128 + nb * 32 + r; const float ps = pscale[col];
#pragma unroll
        for (int i = 0; i < 16; ++i) { const int tok = tile * 32 + (i & 3) + 8 * (i >> 2) + 4 * h; P16[(size_t)tok * 2048 + col] = (bf16)f2bf(acc[i] * ps); }
    }
}

struct Args { const float* in[21]; float* out; unsigned char* ws; int ph_lo, ph_hi; };
__global__ void __launch_bounds__(NWAVES * 64, 2) mk_fwd(Args args) {
    extern __shared__ __attribute__((aligned(16))) unsigned char lds[];
    LAS unsigned char* L = (LAS unsigned char*)lds;
    volatile LAS unsigned* MISC = (volatile LAS unsigned*)(L + MISC_OFF);
    const int tid = threadIdx.x, lane = tid & 63, wave = __builtin_amdgcn_readfirstlane(tid >> 6);
    const int G = gridDim.x, bx = blockIdx.x;
    const int vcu = (G % 8 == 0) ? (bx % 8) * (G / 8) + bx / 8 : bx;
    const int gw = vcu * NWAVES + wave, NGW = G * NWAVES;
    unsigned char* ws = args.ws;
    for (int u = tid; u < (LDS_BYTES - LDSCTL_OFF) / 4; u += NWAVES * 64) ((LAS unsigned*)(L + LDSCTL_OFF))[u] = 0u;
    __syncthreads();
    XcdBarrier bar; bar.bar = (unsigned*)(ws + WS_CTL) + CW_BAR; bar.x = 0; bar.st = nullptr;
    if (!MK_PER_PHASE) bar = xcd_barrier_post((unsigned*)(ws + WS_CTL) + CW_BAR, MISC + 8);
    const int lo = args.ph_lo, hi = args.ph_hi;
#ifndef PH_MASK
#define PH_MASK 0x1FFF
#endif
#ifndef REP_MASK
#define REP_MASK 0x0
#endif
#define REP(k) for (int rep_ = 0; rep_ <= ((REP_MASK >> (k)) & 1); ++rep_)
#define REPBAR() do { if (rep_) xcd_barrier(bar); } while (0)
#define IN(k) (((PH_MASK >> (k)) & 1) && lo <= (k) && (k) < hi)
#define SEAM(k) do { if (IN(k) && IN((k) + 1)) xcd_barrier(bar); } while (0)
#define XIN (ap->in[0])
#define MEMIN (ap->in[1])
#define WSP_DECL unsigned char* wsp = args.ws; asm volatile("" : "+s"(wsp)); const __attribute__((address_space(4))) Args* ap = (const __attribute__((address_space(4))) Args*)__builtin_amdgcn_kernarg_segment_ptr(); asm volatile("" : "+s"(ap)); (void)wsp; (void)ap
#define BIG ((bf16*)(wsp + WS_BIG))
#define X16 ((bf16*)(wsp + WS_BIG + O_X16))
#define WUP1 ((bf16*)(wsp + WS_BIG + O_WUP1))
#define WDN1 ((bf16*)(wsp + WS_BIG + O_WDN1))
#define Gb ((bf16*)(wsp + WS_BIG + O_G))
#define Q16 ((bf16*)(wsp + WS_BIG + O_Q))
#define K16 ((bf16*)(wsp + WS_BIG + O_K))
#define V16 ((bf16*)(wsp + WS_BIG + O_V))
#define QI16 ((bf16*)(wsp + WS_BIG + O_QI))
#define KI16 ((bf16*)(wsp + WS_BIG + O_KI))
#define WI ((float*)(wsp + WS_BIG + O_WI))
#define U16 ((bf16*)(wsp + WS_BIG + O_U))
#define QM16 ((bf16*)(wsp + WS_BIG + O_QM))
#define GATE ((bf16*)(wsp + WS_BIG + O_GATE))
#define WIN ((bf16*)(wsp + WS_WIN))
#define WMKV ((bf16*)(wsp + WS_WMKV))
#define WBA ((bf16*)(wsp + WS_WBA))
#define WBP ((bf16*)(wsp + WS_WBP))
#define WBM ((bf16*)(wsp + WS_WBM))
#define WOUT ((bf16*)(wsp + WS_WOUT))
#define WUP2 ((bf16*)(wsp + WS_WUP2))
#define WDN2 ((bf16*)(wsp + WS_WDN2))
#define WPT ((bf16*)(wsp + WS_WPOOL))
#define H1 ((bf16*)(wsp + WS_H1))
#define MEM16 ((bf16*)(wsp + WS_MEM16))
#define A16 ((bf16*)(wsp + WS_A16))
#define P16 ((bf16*)(wsp + WS_A16) + 1024)
#define M16 ((bf16*)(wsp + WS_A16) + 1536)
#define H2 ((bf16*)(wsp + WS_A16))
#define Y16 ((bf16*)(wsp + WS_Y16))
#define KM ((bf16*)(wsp + WS_KM))
#define VM ((bf16*)(wsp + WS_VM))
#define MASKQ ((unsigned*)(wsp + WS_MASK))
#define X8 ((signed char*)(wsp + WS_BIG + O_X16))
#define WUP1q ((signed char*)(wsp + WS_BIG + O_WUP1))
#define WDN1q ((signed char*)(wsp + WS_BIG + O_WDN1))
#define G8 ((signed char*)(wsp + WS_BIG + O_G))
#define WUP2q ((signed char*)(wsp + WS_WUP2))
#define WDN2q ((signed char*)(wsp + WS_WDN2))
#define H2q ((signed char*)(wsp + WS_Y16))
#define G28 ((signed char*)(wsp + WS_BIG))
#define QS ((float*)(wsp + WS_QS))
#define SX1 ((float*)(wsp + WS_ROWQ))
#define GQ1 (SX1 + T)
#define SG1 (GQ1 + T)
#define SX2 (SG1 + T)
#define GQ2 (SX2 + T)
#define SG2 (GQ2 + T)
#define SXH (SG2 + T)
#define DQ0 (SXH + T)
#define DQ1 (DQ0 + T)
#define H1q ((signed char*)(wsp + WS_Y16))
#define WINq ((signed char*)(wsp + WS_WINQ))
#define R (ap->out)

    REP(0) if (IN(0)) { REPBAR(); WSP_DECL;
        LAS float* scr = (LAS float*)(L + RING_OFF + wave * 16384);
        const float s2u1 = fmaxf(sample_sigma2(ap->in[2], DM, NUP, lane), 1e-30f), s2d1 = fmaxf(sample_sigma2(ap->in[3], FF, DM, lane), 1e-30f);
        const float s2u2 = fmaxf(sample_sigma2(ap->in[17], DM, NUP, lane), 1e-30f), s2d2 = fmaxf(sample_sigma2(ap->in[18], FF, DM, lane), 1e-30f);
        const float qu1 = 127.f / (5.f * sqrtf(s2u1)), qd1 = 127.f / (5.f * sqrtf(s2d1)), qu2 = 127.f / (5.f * sqrtf(s2u2)), qd2 = 127.f / (5.f * sqrtf(s2d2));
        const float s2in = fmaxf(sample_sigma2(ap->in[6], DM, NIN, lane), 1e-30f), qin = 127.f / (5.f * sqrtf(s2in));
        if (gw == 0 && lane == 0) { QS[16] = qin; QS[17] = 1.f / qin; QS[0] = qu1; QS[1] = 1.f / qu1; QS[2] = s2u1; QS[3] = qd1; QS[4] = 1.f / qd1; QS[8] = qu2; QS[9] = 1.f / qu2; QS[10] = s2u2; QS[11] = qd2; QS[12] = 1.f / qd2; }
        constexpr int I_UP = (DM / 64) * (NUP / 32), I_DN = (FF / 64) * (DM / 32), I_IN = (DM / 64) * (NZB / 32), I_INQ = (DM / 64) * (NZQ / 32), I_MKV = (DM / 64) * (1024 / 32), I_BA = (1024 / 64) * (DM / 32),
                      I_BP = (512 / 64) * (DM / 32), I_OUT = (DM / 64) * (DM / 32), I_PL = (128 / 64) * (128 / 32);
        constexpr int NITEMS = 2 * I_UP + 2 * I_DN + I_IN + I_INQ + I_MKV + I_BA + 2 * I_BP + I_OUT + 4 * I_PL;
        for (int it = gw; it < NITEMS; it += NGW) {
            int r = it;
            if (r < I_UP) { p0_transpose_item_i8<1>(ap->in[2], DM, NUP, NUP, WUP1q, scr, r, lane, qu1); continue; } r -= I_UP;
            if (r < I_DN) { p0_transpose_item_i8<0>(ap->in[3], FF, DM, DM, WDN1q, scr, r, lane, qd1); continue; } r -= I_DN;
            if (r < I_IN) { p0_transpose_item<2>(ap->in[6], DM, NIN, NZB, WIN, scr, r, lane); continue; } r -= I_IN;
            if (r < I_INQ) { p0_transpose_item_i8<0>(ap->in[6] + 4176, DM, NIN, NZQ, WINq, scr, r, lane, qin); continue; } r -= I_INQ;
            if (r < I_MKV) { p0_transpose_item<0>(ap->in[8], DM, 1024, 1024, WMKV, scr, r, lane); continue; } r -= I_MKV;
            if (r < I_BA) { p0_transpose_item<0>(ap->in[11], 1024, DM, DM, WBA, scr, r, lane, DM); continue; } r -= I_BA;
            if (r < I_BP) { p0_transpose_item<0>(ap->in[12], 512, DM, DM, WBA + 1024, scr, r, lane, DM); continue; } r -= I_BP;
            if (r < I_BP) { p0_transpose_item<0>(ap->in[13], 512, DM, DM, WBA + 1536, scr, r, lane, DM); continue; } r -= I_BP;
            if (r < I_OUT) { p0_transpose_item<0>(ap->in[14], DM, DM, DM, WOUT, scr, r, lane); continue; } r -= I_OUT;
            if (r < I_UP) { p0_transpose_item_i8<1>(ap->in[17], DM, NUP, NUP, WUP2q, scr, r, lane, qu2); continue; } r -= I_UP;
            if (r < I_DN) { p0_transpose_item_i8<0>(ap->in[18], FF, DM, DM, WDN2q, scr, r, lane, qd2); continue; } r -= I_DN;
            { const int g = r / I_PL; p0_transpose_item<0>(ap->in[9] + (size_t)g * 16384, 128, 128, 128, WPT + (size_t)g * 16384, scr, r % I_PL, lane); }
        }
        for (int m = gw; m < T; m += NGW) {
            f32x4 v[8];
#pragma unroll
            for (int j = 0; j < 8; ++j) v[j] = ((const GAS f32x4*)(XIN + (size_t)m * DM))[lane + 64 * j];
            quant_row_i8(v, X8 + (size_t)m * DM, SX1 + m, GQ1 + m, SG1 + m, s2u1, lane);
        }
        for (size_t i = (size_t)gw * 64 + lane; i < (size_t)512 * DM / 8; i += (size_t)NGW * 64) {
            const f32x4 a = ((const GAS f32x4*)MEMIN)[2 * i], c = ((const GAS f32x4*)MEMIN)[2 * i + 1];
            ((GAS v4u*)MEM16)[i] = (v4u){pk2(a.x, a.y), pk2(a.z, a.w), pk2(c.x, c.y), pk2(c.z, c.w)};
        }
    }
    SEAM(0);
    REP(1) if (IN(1)) { REPBAR(); WSP_DECL;
        pg8::Gemm g{(const bf16*)X8, (const bf16*)WUP1q, T, NUP, DM / 2}; pg8::StaticOrder S; S.init(T, NUP, G, bx);
        pg8::EpiSwigluI8 E{G8, FF, SX1, GQ1, QS + 1};
        pg8::gemm_phase<pg8::EpiSwigluI8, pg8::StaticOrder, true, true, true>(L + RING_OFF, g, S, E);
    }
    SEAM(1);
    REP(2) if (IN(2)) { REPBAR(); WSP_DECL;
        pg8::Gemm g{(const bf16*)G8, (const bf16*)WDN1q, T, DM, FF / 2}; pg8::StaticOrder S; S.init(T, DM, G, bx);
        pg8::EpiResI8<false> E{R, XIN, DM, ALPHA, 0.5f, SG1, QS + 4};
        pg8::gemm_phase<pg8::EpiResI8<false>, pg8::StaticOrder, true, true, true>(L + RING_OFF, g, S, E);
    }
    SEAM(2);
    REP(3) if (IN(3)) { REPBAR(); WSP_DECL; for (int m = gw; m < T; m += NGW) ln_row<true, true>(R + (size_t)m * DM, ap->in[4], ap->in[5], H1 + (size_t)m * DM, lane, H1q + (size_t)m * DM, SXH + m, DQ0 + m, DQ1 + m, 0.f); }
    SEAM(3);
    REP(4) if (IN(4)) { REPBAR(); WSP_DECL;
        { pg8::Gemm g{H1, WIN, T, NZB, DM}; pg8::OrderZ S; S.so.init(T, NZB, G, bx);
          pg8::EpiZ E{Q16, KI16, KM, WI};
          pg8::gemm_phase<pg8::EpiZ, pg8::OrderZ, true, true>(L + RING_OFF, g, S, E); }
        { pg8::Gemm g{(const bf16*)H1q, (const bf16*)WINq, T, NZQ, DM / 2}; pg8::OrderQ S; S.so.init(T, NZQ, G, bx); S.heavy = (32 * (NZB / 256) + 8) - 2 * G;
          pg8::EpiZq E{U16, ap->in[7], SXH, QS + 17};
          pg8::gemm_phase<pg8::EpiZq, pg8::OrderQ, true, true, true>(L + RING_OFF, g, S, E); }
    }
    SEAM(4);
    REP(5) if (IN(5)) { REPBAR(); WSP_DECL;
        for (int pp = vcu; pp < 256; pp += G) {
            const int b = pp >> 7, p = pp & 127;
#pragma unroll 1
            for (int k2 = 0; k2 < 2; ++k2) indexer_unit(L + RING_OFF, b, k2 ? 255 - p : p, QI16, KI16, WI, MASKQ);
        }
        __syncthreads();
    }
    SEAM(5);
    REP(6) if (IN(6)) { REPBAR(); WSP_DECL;
        const int xcd = bx & 7, ix = bx >> 3;
        if (ix < 32) {
            const int bh = xcd * 2 + (ix >> 4), qb = ix & 15, b = bh >> 3, hh = bh & 7;
            const size_t rowbase = (size_t)b * SEQ;
            const float ah = exp2f(-(float)(hh + 1)) * 11.313708498984761f;
            att::attn_block<1024, 2048, true>((const att::bf16*)(Q16 + (rowbase + qb * 256) * 1024 + hh * 128), (const att::bf16*)(K16 + rowbase * 1024 + hh * 128),
                                        (const att::bf16*)(V16 + rowbase * 1024 + hh * 128), (att::bf16*)(A16 + (rowbase + qb * 256) * 2048 + hh * 128),
                                        4 * (qb + 1), qb * 256, MASKQ + rowbase * 128, ah, (char*)lds + RING_OFF);
            if (qb < 8) { const int mi = bh * 8 + qb;
                const int mb = mi >> 6, mh = (mi >> 4) & 3, mq = mi & 15; const size_t mrow = (size_t)mb * SEQ + mq * 256;
                att::attn_block<512, 2048, false>((const att::bf16*)(QM16 + mrow * 512 + mh * 128), (const att::bf16*)(KM + (size_t)mb * MEMLEN * 512 + mh * 128),
                                            (const att::bf16*)(VM + (size_t)mb * MEMLEN * 512 + mh * 128), (att::bf16*)(M16 + mrow * 2048 + mh * 128),
                                            MEMLEN / 64, 0, nullptr, 0.f, (char*)lds + RING_OFF); }
            if (qb < 4) { for (int task = (bh * 4 + qb) * NWAVES + wave; task < 1024; task += 512) pool_task(task, U16, WPT, ap->in[10], P16, lane); }
        }
    }
    SEAM(6);
    REP(7) if (IN(7)) { REPBAR(); WSP_DECL;
        pg8::StaticOrder S; S.init(T, DM, G, bx);
        { pg8::Gemm g{A16, WBA, T, DM, DM}; pg8::OrderBr SB; SB.so = S; pg8::EpiBranch E{Y16, GATE}; pg8::gemm_phase<pg8::EpiBranch, pg8::OrderBr, true, true>(L + RING_OFF, g, SB, E); }
    }
    SEAM(7);
    REP(8) if (IN(8)) { REPBAR(); WSP_DECL;
        pg8::Gemm g{Y16, WOUT, T, DM, DM}; pg8::StaticOrder S; S.init(T, DM, G, bx);
        pg8::EpiRes<true> E{R, H1, DM, ALPHA, 1.0f};
        pg8::gemm_phase<pg8::EpiRes<true>, pg8::StaticOrder, true, true>(L + RING_OFF, g, S, E);
    }
    SEAM(8);
    REP(9) if (IN(9)) { REPBAR(); WSP_DECL; const float sig2 = QS[10]; for (int m = gw; m < T; m += NGW) ln_row<true, true>(R + (size_t)m * DM, ap->in[15], ap->in[16], H2 + (size_t)m * DM, lane, H2q + (size_t)m * DM, SX2 + m, GQ2 + m, SG2 + m, sig2); }
    SEAM(9);
    REP(10) if (IN(10)) { REPBAR(); WSP_DECL;
        pg8::Gemm g{(const bf16*)H2q, (const bf16*)WUP2q, T, NUP, DM / 2}; pg8::StaticOrder S; S.init(T, NUP, G, bx);
        pg8::EpiSwigluI8 E{G28, FF, SX2, GQ2, QS + 9};
        pg8::gemm_phase<pg8::EpiSwigluI8, pg8::StaticOrder, true, true, true>(L + RING_OFF, g, S, E);
    }
    SEAM(10);
    REP(11) if (IN(11)) { REPBAR(); WSP_DECL;
        pg8::Gemm g{(const bf16*)G28, (const bf16*)WDN2q, T, DM, FF / 2}; pg8::StaticOrder S; S.init(T, DM, G, bx);
        pg8::EpiResI8<true> E{R, H2, DM, ALPHA, 0.5f, SG2, QS + 12};
        pg8::gemm_phase<pg8::EpiResI8<true>, pg8::StaticOrder, true, true, true>(L + RING_OFF, g, S, E);
    }
    SEAM(11);
    REP(12) if (IN(12)) { REPBAR(); WSP_DECL; for (int m = gw; m < T; m += NGW) ln_row<false>(R + (size_t)m * DM, ap->in[19], ap->in[20], R + (size_t)m * DM, lane); }
#undef BIG
#undef X16
#undef WUP1
#undef WDN1
#undef Gb
#undef Q16
#undef K16
#undef V16
#undef QI16
#undef KI16
#undef WI
#undef U16
#undef QM16
#undef GATE
#undef WIN
#undef WMKV
#undef WBA
#undef WBP
#undef WBM
#undef WOUT
#undef WUP2
#undef WDN2
#undef WPT
#undef H1
#undef MEM16
#undef A16
#undef P16
#undef M16
#undef H2
#undef Y16
#undef KM
#undef VM
#undef MASKQ
#undef X8
#undef WUP1q
#undef WDN1q
#undef G8
#undef WUP2q
#undef WDN2q
#undef H2q
#undef G28
#undef QS
#undef SX1
#undef GQ1
#undef SG1
#undef SX2
#undef GQ2
#undef SG2
#undef SXH
#undef DQ0
#undef DQ1
#undef H1q
#undef WINq
#undef R
#undef XIN
#undef MEMIN
#undef WSP_DECL
#undef IN
#undef SEAM
}

extern "C" void kernel_launch(void* const* d_in, const int* in_sizes, int n_in, void* d_out, int out_size, void* d_ws, size_t ws_size, hipStream_t stream) {
    static int grid = 0;
    if (grid == 0) {
        if (n_in != 21 || in_sizes[0] != T * DM || out_size != T * DM || ws_size < WS_END) {
            fprintf(stderr, "kernel_launch: shape/workspace mismatch (n_in %d, in0 %d, out %d, ws %zu, need %zu); nothing launched\n", n_in, n_in > 0 ? in_sizes[0] : -1, out_size, ws_size, (size_t)WS_END);
            grid = -1; return; }
        int dev = 0, cus = 0;
        if (hipGetDevice(&dev) != hipSuccess || hipDeviceGetAttribute(&cus, hipDeviceAttributeMultiprocessorCount, dev) != hipSuccess) { grid = -1; return; }
        if (hipFuncSetAttribute((const void*)mk_fwd, hipFuncAttributeMaxDynamicSharedMemorySize, LDS_BYTES) != hipSuccess) { fprintf(stderr, "kernel_launch: hipFuncSetAttribute failed\n"); grid = -1; return; }
        (void)hipGetLastError();
        grid = cus;
        if (grid != 256) fprintf(stderr, "kernel_launch: %d CUs (built for 256)\n", grid);
    }
    if (grid < 0) return;
    if (hipMemsetAsync((char*)d_ws + WS_CTL, 0, CTL_ZERO_BYTES, stream) != hipSuccess) return;
    Args a{};
    for (int i = 0; i < 21; ++i) a.in[i] = (const float*)d_in[i];
    a.out = (float*)d_out; a.ws = (unsigned char*)d_ws;
#if MK_PER_PHASE
    for (int p = 0; p < N_PHASES; ++p) { a.ph_lo = p; a.ph_hi = p + 1; hipLaunchKernelGGL(mk_fwd, dim3(grid), dim3(NWAVES * 64), LDS_BYTES, stream, a); }
#else
    a.ph_lo = 0; a.ph_hi = N_PHASES;
    hipLaunchKernelGGL(mk_fwd, dim3(grid), dim3(NWAVES * 64), LDS_BYTES, stream, a);
#endif
}
```

```cpp
#include <hip/hip_runtime.h>
#include <hip/hip_bf16.h>
#include <cstdio>
#include <cstdint>

#ifndef MK_PER_PHASE
#define MK_PER_PHASE 0
#endif

namespace pg8 {
#define PG8_LAS __attribute__((address_space(3)))
typedef unsigned short bf16_t;
typedef short bf16x8 __attribute__((ext_vector_type(8)));
typedef float f32x4 __attribute__((ext_vector_type(4)));
typedef float f32x2 __attribute__((ext_vector_type(2)));
typedef unsigned u32x4 __attribute__((ext_vector_type(4)));
typedef unsigned u32x2 __attribute__((ext_vector_type(2)));
typedef int i32x4 __attribute__((ext_vector_type(4)));
template <bool I8> struct AccSel { typedef f32x4 type; };
template <> struct AccSel<true> { typedef i32x4 type; };
constexpr int BM = 256, BK = 64, HALF = 128, HTB = HALF * BK * 2, STAGE_BYTES = 8 * HTB, NXCD = 8, WGM = 8;

__host__ __device__ __forceinline__ int lds_byte(int r, int c) { const int st = (r >> 4) * 2 + (c >> 5), rr = r & 15, cc = c & 31, ob = rr * 64 + cc * 2; return st * 1024 + (ob ^ (((ob >> 9) & 1) << 5)); }
__host__ __device__ __forceinline__ void stage_rc(int b, int& R, int& C) { const int st = b / 1024, sb = b % 1024, swz = sb ^ (((sb >> 9) & 1) << 5); R = (st >> 1) * 16 + swz / 64; C = (st & 1) * 32 + (swz % 64) / 2; }
__host__ __device__ __forceinline__ int perm32(int rho) { const int n = rho >> 4, i = rho & 15; return 8 * (i >> 2) + 4 * n + (i & 3); }

struct Unit { int pm, pn, ko, nt, br; };
struct Gemm { const bf16_t* A; const bf16_t* Bt; int M, N, K; };

struct StaticOrder {
    int nM, nN, nwg, G, c;
    __host__ __device__ void init(int M, int N, int G_, int c_) { nM = M / BM; nN = N / BM; nwg = nM * nN; G = G_; c = c_; }
    __host__ __device__ bool next(int i, Unit& u) const {
        const long L = (long)i * G + c; if (L >= nwg) return false;
        int wgid = (int)L; { const int q = nwg / NXCD, r = nwg % NXCD, xcd = wgid % NXCD, off = wgid / NXCD; wgid = (xcd < r ? xcd * (q + 1) : r * (q + 1) + (xcd - r) * q) + off; }
        const int nig = WGM * nN, gid = wgid / nig, fm = gid * WGM, gsz = (nM - fm) < WGM ? (nM - fm) : WGM;
        u.pm = fm + ((wgid % nig) % gsz); u.pn = (wgid % nig) / gsz; u.ko = 0; u.nt = 0; u.br = 0; return true;
    }
    __device__ __forceinline__ void a_ready(const Unit&) const {}
    __device__ __forceinline__ void done(const Unit&) const {}
};
struct OrderZ {
    StaticOrder so;
    __device__ __forceinline__ bool next(int i, Unit& u) const {
        const long L = (long)i * so.G + so.c;
        if (L < so.nwg) return so.next(i, u);
        if (L < so.nwg + 8) { const int e = (int)(L - so.nwg); u.pm = 32 + (e >> 2); u.pn = so.nN + (e & 3); u.ko = 0; u.nt = 0; u.br = 0; return true; }
        return false;
    }
    __device__ __forceinline__ void a_ready(const Unit&) const {}
    __device__ __forceinline__ void done(const Unit&) const {}
};
struct OrderQ {
    StaticOrder so; int heavy;
    __device__ __forceinline__ bool next(int i, Unit& u) const {
        const int c = so.c, nl = so.G - heavy; long L;
        if (c >= heavy) { if (i >= 4) return false; L = (long)i * nl + (c - heavy); if (L >= 4L * nl) return false; }
        else { if (i >= 1) return false; L = 4L * nl + c; }
        if (L >= so.nwg) return false;
        int wgid = (int)L; { const int q = so.nwg / NXCD, r = so.nwg % NXCD, xcd = wgid % NXCD, off = wgid / NXCD; wgid = (xcd < r ? xcd * (q + 1) : r * (q + 1) + (xcd - r) * q) + off; }
        const int nig = WGM * so.nN, gid = wgid / nig, fm = gid * WGM, gsz = (so.nM - fm) < WGM ? (so.nM - fm) : WGM;
        u.pm = fm + ((wgid % nig) % gsz); u.pn = (wgid % nig) / gsz; u.ko = 0; u.nt = 0; u.br = 0; return true;
    }
    __device__ __forceinline__ void a_ready(const Unit&) const {}
    __device__ __forceinline__ void done(const Unit&) const {}
};
struct OrderBr {
    StaticOrder so;
    __device__ __forceinline__ bool next(int i, Unit& u) const {
        const int ti = i / 3, br = i - 3 * ti;
        if (!so.next(ti, u)) return false;
        u.br = br; u.ko = br == 0 ? 0 : (br == 1 ? 1024 : 1536); u.nt = br == 0 ? 16 : 8; return true;
    }
    __device__ __forceinline__ void a_ready(const Unit&) const {}
    __device__ __forceinline__ void done(const Unit&) const {}
};

__device__ __forceinline__ unsigned cvt_pk_bf16(float lo, float hi) { unsigned r; asm volatile("v_cvt_pk_bf16_f32 %0, %1, %2" : "=v"(r) : "v"(lo), "v"(hi)); return r; }
__device__ __forceinline__ float bf_lo(unsigned w) { return __uint_as_float(w << 16); }
__device__ __forceinline__ float bf_hi(unsigned w) { return __uint_as_float(w & 0xffff0000u); }
__device__ __forceinline__ float sigmoidf_(float x) { return __builtin_amdgcn_rcpf(1.0f + __builtin_amdgcn_exp2f(-1.4426950408889634f * x)); }

struct EpiSwiglu {
    static constexpr bool PERM = true, AFTER_DRAIN = false, CHAIN = false;
    bf16_t* G; int ldg;
    __device__ __forceinline__ void operator()(const f32x4 (&acc)[2][2][4][2], const Unit& u, int wr, int wc, int fr, int fq) const {
        const int row0 = u.pm * BM + wr * 64 + fr, col0 = u.pn * HALF + wc * 32 + 8 * fq;
#pragma unroll
        for (int ai = 0; ai < 2; ++ai)
#pragma unroll
            for (int m = 0; m < 4; ++m) {
                bf16_t* rowp = G + (size_t)(row0 + ai * HALF + m * 16) * ldg + col0;
                float g[8];
#pragma unroll
                for (int n = 0; n < 2; ++n)
#pragma unroll
                    for (int e = 0; e < 4; ++e) { const float a = acc[ai][0][m][n][e], uu = acc[ai][1][m][n][e]; g[n * 4 + e] = a * uu * sigmoidf_(a); }
                u32x4 w; w.x = cvt_pk_bf16(g[0], g[1]); w.y = cvt_pk_bf16(g[2], g[3]); w.z = cvt_pk_bf16(g[4], g[5]); w.w = cvt_pk_bf16(g[6], g[7]);
                *(u32x4*)rowp = w;
            }
    }
};
struct EpiSwigluI8 {
    static constexpr bool PERM = true, AFTER_DRAIN = false, CHAIN = false;
    signed char* G; int ldg; const float* sx; const float* gq; const float* wdq;
    __device__ __forceinline__ void operator()(const i32x4 (&acc)[2][2][4][2], const Unit& u, int wr, int wc, int fr, int fq) const {
        const int row0 = u.pm * BM + wr * 64 + fr, col0 = u.pn * HALF + wc * 32 + 8 * fq;
        const float wd = *wdq;
#pragma unroll
        for (int ai = 0; ai < 2; ++ai)
#pragma unroll
            for (int m = 0; m < 4; ++m) {
                const int row = row0 + ai * HALF + m * 16;
                const float sa = sx[row] * wd, gm = gq[row];
                unsigned w[2];
#pragma unroll
                for (int n = 0; n < 2; ++n) { int q[4];
#pragma unroll
                    for (int e = 0; e < 4; ++e) { const float a = (float)acc[ai][0][m][n][e] * sa, uu = (float)acc[ai][1][m][n][e] * sa; const float g = a * uu * sigmoidf_(a);
                        q[e] = (int)__builtin_rintf(fminf(fmaxf(g * gm, -127.f), 127.f)); }
                    w[n] = (unsigned)(q[0] & 255) | ((unsigned)(q[1] & 255) << 8) | ((unsigned)(q[2] & 255) << 16) | ((unsigned)q[3] << 24); }
                *(u32x2*)(G + (size_t)row * ldg + col0) = (u32x2){w[0], w[1]};
            }
    }
};
template <bool RESBF> struct EpiResI8 {
    static constexpr bool PERM = false, AFTER_DRAIN = false, CHAIN = false;
    float* out; const void* res; int ldc; float alpha, sc; const float* sg; const float* wdq;
    __device__ __forceinline__ void operator()(const i32x4 (&acc)[2][2][4][2], const Unit& u, int wr, int wc, int fr, int fq) const {
        const int row0 = u.pm * BM + wr * 64 + fr, col0 = u.pn * BM + wc * 32 + 4 * fq;
        const float wd = *wdq * sc;
#pragma unroll
        for (int ai = 0; ai < 2; ++ai)
#pragma unroll
            for (int m = 0; m < 4; ++m) { const int row = row0 + ai * HALF + m * 16; const size_t off = (size_t)row * ldc + col0; const float s = sg[row] * wd;
#pragma unroll
                for (int bj = 0; bj < 2; ++bj)
#pragma unroll
                    for (int n = 0; n < 2; ++n) { const size_t o = off + bj * HALF + n * 16; f32x4 r;
                        if (RESBF) { const u32x2 w = *(const u32x2*)((const bf16_t*)res + o); r = (f32x4){bf_lo(w.x), bf_hi(w.x), bf_lo(w.y), bf_hi(w.y)}; }
                        else r = *(const f32x4*)((const float*)res + o);
                        const i32x4 a = acc[ai][bj][m][n];
                        *(f32x4*)(out + o) = r * alpha + (f32x4){(float)a[0], (float)a[1], (float)a[2], (float)a[3]} * s; } }
    }
};
template <bool RESBF> struct EpiRes {
    static constexpr bool PERM = false, AFTER_DRAIN = false, CHAIN = false;
    float* out; const void* res; int ldc; float alpha, sc;
    __device__ __forceinline__ void operator()(const f32x4 (&acc)[2][2][4][2], const Unit& u, int wr, int wc, int fr, int fq) const {
        const int row0 = u.pm * BM + wr * 64 + fr, col0 = u.pn * BM + wc * 32 + 4 * fq;
#pragma unroll
        for (int ai = 0; ai < 2; ++ai)
#pragma unroll
            for (int m = 0; m < 4; ++m) { const size_t off = (size_t)(row0 + ai * HALF + m * 16) * ldc + col0;
#pragma unroll
                for (int bj = 0; bj < 2; ++bj)
#pragma unroll
                    for (int n = 0; n < 2; ++n) { const size_t o = off + bj * HALF + n * 16; f32x4 r;
                        if (RESBF) { const u32x2 w = *(const u32x2*)((const bf16_t*)res + o); r = (f32x4){bf_lo(w.x), bf_hi(w.x), bf_lo(w.y), bf_hi(w.y)}; }
                        else r = *(const f32x4*)((const float*)res + o);
                        *(f32x4*)(out + o) = r * alpha + acc[ai][bj][m][n] * sc; } }
    }
};
struct EpiBranch {
    static constexpr bool PERM = false, AFTER_DRAIN = false, CHAIN = true;
    bf16_t* Y16; const bf16_t* gate;
    __device__ __forceinline__ bool chain(f32x4 (&acc)[2][2][4][2], const Unit& u, int wr, int wc, int fr, int fq) const {
        const int row0 = u.pm * BM + wr * 64 + fr, col0 = u.pn * BM + wc * 32 + 4 * fq, br = u.br;
        const float FL = 8.673617379884035e-19f;
#pragma unroll
        for (int ai = 0; ai < 2; ++ai)
#pragma unroll
            for (int m = 0; m < 4; ++m) { const size_t row = (size_t)(row0 + ai * HALF + m * 16);
#pragma unroll
                for (int bj = 0; bj < 2; ++bj)
#pragma unroll
                    for (int n = 0; n < 2; ++n) { const int col = col0 + bj * HALF + n * 16;
                        const u32x2 w = *(const u32x2*)(gate + row * 6144 + br * 2048 + col);
                        f32x4 g = (f32x4){fmaxf(bf_lo(w.x), FL), fmaxf(bf_hi(w.x), FL), fmaxf(bf_lo(w.y), FL), fmaxf(bf_hi(w.y), FL)};
                        if (br < 2) { const u32x2 w2 = *(const u32x2*)(gate + row * 6144 + (br + 1) * 2048 + col);
                            g[0] *= __builtin_amdgcn_rcpf(fmaxf(bf_lo(w2.x), FL)); g[1] *= __builtin_amdgcn_rcpf(fmaxf(bf_hi(w2.x), FL));
                            g[2] *= __builtin_amdgcn_rcpf(fmaxf(bf_lo(w2.y), FL)); g[3] *= __builtin_amdgcn_rcpf(fmaxf(bf_hi(w2.y), FL));
                            acc[ai][bj][m][n] *= g; }
                        else { const f32x4 v = acc[ai][bj][m][n] * g; u32x2 o; o.x = cvt_pk_bf16(v[0], v[1]); o.y = cvt_pk_bf16(v[2], v[3]); *(u32x2*)(Y16 + row * 2048 + col) = o; } } }
        return br < 2;
    }
};
struct EpiZ {
    static constexpr bool PERM = true, AFTER_DRAIN = false, CHAIN = false;
    bf16_t *Q, *KI, *KM; float* WI;
    __device__ __forceinline__ void operator()(const f32x4 (&acc)[2][2][4][2], const Unit& u, int wr, int wc, int fr, int fq) const {
        const int pn = u.pn;
        bf16_t* base; int ld, ct = 0, mode = 0, rowoff = 0;
        if (pn < 16) { base = Q + (size_t)(pn >> 2) * ((size_t)8192 * 1024); ld = 1024; ct = pn & 3; }
        else if (pn == 16) { base = KI; ld = 64; mode = 2; }
        else { base = KM + (size_t)((pn - 17) >> 1) * (512 * 512); ld = 512; ct = (pn - 17) & 1; rowoff = 8192; }
        const int row0 = u.pm * BM + wr * 64 + fr - rowoff, cl = wc * 32 + 8 * fq;
        if (mode == 2) {
#pragma unroll
            for (int ai = 0; ai < 2; ++ai)
#pragma unroll
                for (int m = 0; m < 4; ++m) { const size_t row = (size_t)(row0 + ai * HALF + m * 16);
                    const f32x4 v0 = acc[ai][0][m][0], v1 = acc[ai][0][m][1];
                    if (cl < 64) { u32x4 w; w.x = cvt_pk_bf16(v0[0], v0[1]); w.y = cvt_pk_bf16(v0[2], v0[3]); w.z = cvt_pk_bf16(v1[0], v1[1]); w.w = cvt_pk_bf16(v1[2], v1[3]); *(u32x4*)(KI + row * 64 + cl) = w; }
                    else if (cl < 80) { const float s = 1.0f / 32.0f;
                        *(f32x4*)(WI + row * 16 + (cl - 64)) = v0 * s; *(f32x4*)(WI + row * 16 + (cl - 64) + 4) = v1 * s; } }
            return;
        }
        const int col0 = ct * BM + cl;
#pragma unroll
        for (int ai = 0; ai < 2; ++ai)
#pragma unroll
            for (int m = 0; m < 4; ++m) { bf16_t* rowp = base + (size_t)(row0 + ai * HALF + m * 16) * ld + col0;
#pragma unroll
                for (int bj = 0; bj < 2; ++bj) { const f32x4 v0 = acc[ai][bj][m][0], v1 = acc[ai][bj][m][1];
                    u32x4 w; w.x = cvt_pk_bf16(v0[0], v0[1]); w.y = cvt_pk_bf16(v0[2], v0[3]); w.z = cvt_pk_bf16(v1[0], v1[1]); w.w = cvt_pk_bf16(v1[2], v1[3]);
                    *(u32x4*)(rowp + bj * HALF) = w; } }
    }
};
struct EpiZq {
    static constexpr bool PERM = true, AFTER_DRAIN = false, CHAIN = false;
    bf16_t *U; const float* bgate; const float* sx; const float* wdq;
    __device__ __forceinline__ void operator()(const i32x4 (&acc)[2][2][4][2], const Unit& u, int wr, int wc, int fr, int fq) const {
        const int pn = u.pn; const bool gate = pn >= 4;
        bf16_t* base = U + (size_t)(gate ? 2 : (pn >> 1)) * ((size_t)8192 * 512);
        const int ld = gate ? 6144 : 512, ct = gate ? pn - 4 : (pn & 1);
        const int row0 = u.pm * BM + wr * 64 + fr, col0 = ct * BM + wc * 32 + 8 * fq;
        const float wd = *wdq;
        f32x4 bv[2][2];
#pragma unroll
        for (int bj = 0; bj < 2; ++bj)
#pragma unroll
            for (int n = 0; n < 2; ++n) bv[bj][n] = gate ? *(const f32x4*)(bgate + col0 + bj * HALF + 4 * n) : (f32x4){0.f, 0.f, 0.f, 0.f};
#pragma unroll
        for (int ai = 0; ai < 2; ++ai)
#pragma unroll
            for (int m = 0; m < 4; ++m) { const int row = row0 + ai * HALF + m * 16; bf16_t* rowp = base + (size_t)row * ld + col0; const float sa = sx[row] * wd;
#pragma unroll
                for (int bj = 0; bj < 2; ++bj) { const i32x4 a0 = acc[ai][bj][m][0], a1 = acc[ai][bj][m][1];
                    f32x4 v0 = (f32x4){(float)a0[0], (float)a0[1], (float)a0[2], (float)a0[3]} * sa + bv[bj][0], v1 = (f32x4){(float)a1[0], (float)a1[1], (float)a1[2], (float)a1[3]} * sa + bv[bj][1];
                    if (gate) {
#pragma unroll
                        for (int e = 0; e < 4; ++e) { v0[e] = sigmoidf_(v0[e]); v1[e] = sigmoidf_(v1[e]); } }
                    u32x4 w; w.x = cvt_pk_bf16(v0[0], v0[1]); w.y = cvt_pk_bf16(v0[2], v0[3]); w.z = cvt_pk_bf16(v1[0], v1[1]); w.w = cvt_pk_bf16(v1[2], v1[3]);
                    *(u32x4*)(rowp + bj * HALF) = w; } }
    }
};

template <class Epi, class Sched, bool ALIGN_EPI = false, bool SP2 = false, bool I8 = false>
__device__ __forceinline__ void gemm_phase(PG8_LAS unsigned char* lds, const Gemm g, const Sched& S, const Epi& E) {
    int tid_ = threadIdx.x; asm volatile("" : "+v"(tid_));
    const int tid = tid_, wid = __builtin_amdgcn_readfirstlane(tid >> 6), lane = tid & 63, wr = wid >> 2, wc = wid & 3, fr = lane & 15, fq = lane >> 4;
    const int K = g.K, nt = K / BK;
    unsigned voffA[2], voffB[2];
#pragma unroll
    for (int i = 0; i < 2; ++i) { int R, C; stage_rc(tid * 16 + i * 8192, R, C); const int Rb = Epi::PERM ? ((R & ~31) + perm32(R & 31)) : R;
        voffA[i] = (unsigned)(R * K + C) * 2u; voffB[i] = (unsigned)(Rb * K + C) * 2u; }
    const size_t kstep = (size_t)(BK * 2);
    const size_t hstep = (size_t)HALF * K * 2;
    const size_t tstep = 2 * hstep;
    const unsigned ldsw = (unsigned)wid * 1024u;
    const int aoff = lds_byte(wr * 64 + fr, fq * 8), boff = lds_byte(wc * 32 + fr, fq * 8);
#define PG8_SA(b, h) (((b) * 2 + (h)) * HTB)
#define PG8_SB(b, h) ((4 + (b) * 2 + (h)) * HTB)
#define PG8_STAGE(bufoff, gbase, voff) do { _Pragma("unroll") for (int _i = 0; _i < 2; ++_i) \
        __builtin_amdgcn_global_load_lds((const unsigned*)((const char*)(gbase) + (voff)[_i]), (PG8_LAS unsigned*)(lds + (bufoff) + ldsw + _i * 8192), 16, 0, 0); } while (0)
#define PG8_LDA(dst, b, h) do { _Pragma("unroll") for (int m = 0; m < 4; ++m) _Pragma("unroll") for (int k = 0; k < 2; ++k) dst[m][k] = *(const PG8_LAS bf16x8*)(lds + PG8_SA(b, h) + aoff + m * 2048 + k * 1024); } while (0)
#define PG8_LDB(dst, b, h) do { _Pragma("unroll") for (int n = 0; n < 2; ++n) _Pragma("unroll") for (int k = 0; k < 2; ++k) dst[n][k] = *(const PG8_LAS bf16x8*)(lds + PG8_SB(b, h) + boff + n * 2048 + k * 1024); } while (0)
#define PG8_MMA(ai, bj, At, Bt) do { __builtin_amdgcn_s_setprio(1); _Pragma("unroll") for (int m = 0; m < 4; ++m) _Pragma("unroll") for (int n = 0; n < 2; ++n) _Pragma("unroll") for (int k = 0; k < 2; ++k) \
        { if constexpr (I8) acc[ai][bj][m][n] = __builtin_amdgcn_mfma_i32_16x16x64_i8(__builtin_bit_cast(i32x4, Bt[n][k]), __builtin_bit_cast(i32x4, At[m][k]), acc[ai][bj][m][n], 0, 0, 0); \
          else acc[ai][bj][m][n] = __builtin_amdgcn_mfma_f32_16x16x32_bf16(Bt[n][k], At[m][k], acc[ai][bj][m][n], 0, 0, 0); } __builtin_amdgcn_s_setprio(0); } while (0)
#define PG8_WAIT_V(n) asm volatile("s_waitcnt vmcnt(" #n ")" ::: "memory")
#define PG8_WAIT_L(n) asm volatile("s_waitcnt lgkmcnt(" #n ")" ::: "memory")
#define PG8_BAR __builtin_amdgcn_s_barrier()
#define PG8_SCHED __builtin_amdgcn_sched_barrier(0)
    Unit cur, nxt; int ui = 0;
    if (!S.next(0, cur)) return;
    typedef typename AccSel<I8>::type acc_t;
    acc_t acc[2][2][4][2];
#pragma unroll
    for (int a = 0; a < 2; ++a)
#pragma unroll
        for (int b = 0; b < 2; ++b)
#pragma unroll
            for (int m = 0; m < 4; ++m)
#pragma unroll
                for (int n = 0; n < 2; ++n) acc[a][b][m][n] = acc_t{};
    bf16x8 At[4][2], B0[2][2], B1[2][2];
    const char* cA = (const char*)g.A + (size_t)cur.pm * tstep + (size_t)cur.ko * 2; const char* cB = (const char*)g.Bt + (size_t)cur.pn * tstep + (size_t)cur.ko * 2;
    int ntc = cur.nt ? cur.nt : nt;
    S.a_ready(cur);
    if constexpr (SP2) {
        PG8_STAGE(PG8_SB(0, 0), cB, voffB); PG8_STAGE(PG8_SB(0, 1), cB + hstep, voffB); PG8_STAGE(PG8_SA(0, 0), cA, voffA); PG8_STAGE(PG8_SA(0, 1), cA + hstep, voffA);
        if (wr == 1) PG8_BAR;
        PG8_WAIT_V(2); PG8_BAR;
        PG8_STAGE(PG8_SB(1, 0), cB + kstep, voffB); PG8_STAGE(PG8_SA(1, 0), cA + kstep, voffA); PG8_STAGE(PG8_SB(1, 1), cB + hstep + kstep, voffB);
        PG8_WAIT_V(6); PG8_BAR;
    } else {
        PG8_STAGE(PG8_SB(0, 0), cB, voffB); PG8_STAGE(PG8_SA(0, 0), cA, voffA); PG8_STAGE(PG8_SB(0, 1), cB + hstep, voffB); PG8_STAGE(PG8_SA(0, 1), cA + hstep, voffA);
        if (wr == 1) PG8_BAR;
        PG8_WAIT_V(4); PG8_BAR;
        PG8_STAGE(PG8_SB(1, 0), cB + kstep, voffB); PG8_STAGE(PG8_SA(1, 0), cA + kstep, voffA); PG8_STAGE(PG8_SB(1, 1), cB + hstep + kstep, voffB);
        PG8_WAIT_V(6); PG8_BAR;
    }
    for (;;) {
        const bool has_next = S.next(ui + 1, nxt);
        const char* nA = has_next ? (const char*)g.A + (size_t)nxt.pm * tstep + (size_t)nxt.ko * 2 : cA; const char* nB = has_next ? (const char*)g.Bt + (size_t)nxt.pn * tstep + (size_t)nxt.ko * 2 : cB;
        for (int t = 0; t < ntc; t += 2) {
            const bool last = (t == ntc - 2);
            const char* a1 = cA + (size_t)(t + 1) * kstep;
            const char* a2 = last ? nA : cA + (size_t)(t + 2) * kstep; const char* b2 = last ? nB : cB + (size_t)(t + 2) * kstep;
            const char* a3 = a2 + kstep; const char* b3 = b2 + kstep;
            if (last && has_next) S.a_ready(nxt);
            if constexpr (SP2) {
            PG8_LDB(B0, 0, 0); PG8_LDB(B1, 0, 1); PG8_SCHED; PG8_LDA(At, 0, 0); PG8_STAGE(PG8_SA(1, 1), a1 + hstep, voffA);
            PG8_WAIT_V(8); PG8_WAIT_L(0); PG8_BAR; PG8_MMA(0, 0, At, B0); PG8_MMA(0, 1, At, B1); PG8_BAR; PG8_SCHED;
            PG8_LDA(At, 0, 1); PG8_STAGE(PG8_SB(0, 0), b2, voffB); PG8_STAGE(PG8_SB(0, 1), b2 + hstep, voffB); PG8_STAGE(PG8_SA(0, 0), a2, voffA);
            PG8_WAIT_V(8); PG8_WAIT_L(0); PG8_BAR; PG8_MMA(1, 0, At, B0); PG8_MMA(1, 1, At, B1); PG8_BAR; PG8_SCHED;
            PG8_LDB(B0, 1, 0); PG8_LDB(B1, 1, 1); PG8_SCHED; PG8_LDA(At, 1, 0); PG8_STAGE(PG8_SA(0, 1), a2 + hstep, voffA);
            PG8_WAIT_V(8); PG8_WAIT_L(0); PG8_BAR; PG8_MMA(0, 0, At, B0); PG8_MMA(0, 1, At, B1); PG8_BAR; PG8_SCHED;
            PG8_LDA(At, 1, 1); PG8_STAGE(PG8_SB(1, 0), b3, voffB); PG8_STAGE(PG8_SB(1, 1), b3 + hstep, voffB); PG8_STAGE(PG8_SA(1, 0), a3, voffA);
            PG8_WAIT_V(8); PG8_WAIT_L(0); PG8_BAR; PG8_MMA(1, 0, At, B0); PG8_MMA(1, 1, At, B1); PG8_BAR; PG8_SCHED;
            } else {
            PG8_LDB(B0, 0, 0); PG8_SCHED; PG8_LDA(At, 0, 0); PG8_STAGE(PG8_SA(1, 1), a1 + hstep, voffA);
            PG8_WAIT_L(8); PG8_BAR; PG8_WAIT_L(0); PG8_MMA(0, 0, At, B0); PG8_BAR; PG8_SCHED;
            PG8_LDB(B1, 0, 1); PG8_STAGE(PG8_SB(0, 0), b2, voffB);
            PG8_BAR; PG8_WAIT_L(0); PG8_MMA(0, 1, At, B1); PG8_BAR;
            PG8_LDA(At, 0, 1); PG8_STAGE(PG8_SA(0, 0), a2, voffA);
            PG8_BAR; PG8_WAIT_L(0); PG8_MMA(1, 0, At, B0); PG8_BAR; PG8_SCHED;
            PG8_STAGE(PG8_SB(0, 1), b2 + hstep, voffB);
            PG8_WAIT_V(6); PG8_BAR; PG8_MMA(1, 1, At, B1); PG8_BAR;
            PG8_LDB(B0, 1, 0); PG8_SCHED; PG8_LDA(At, 1, 0); PG8_STAGE(PG8_SA(0, 1), a2 + hstep, voffA);
            PG8_WAIT_L(8); PG8_BAR; PG8_WAIT_L(0); PG8_MMA(0, 0, At, B0); PG8_BAR; PG8_SCHED;
            PG8_LDB(B1, 1, 1); PG8_STAGE(PG8_SB(1, 0), b3, voffB);
            PG8_BAR; PG8_WAIT_L(0); PG8_MMA(0, 1, At, B1); PG8_BAR;
            PG8_LDA(At, 1, 1); PG8_STAGE(PG8_SA(1, 0), a3, voffA);
            PG8_BAR; PG8_WAIT_L(0); PG8_MMA(1, 0, At, B0); PG8_BAR; PG8_SCHED;
            PG8_STAGE(PG8_SB(1, 1), b3 + hstep, voffB);
            PG8_WAIT_V(6); PG8_BAR; PG8_MMA(1, 1, At, B1); PG8_BAR;
            }
        }
        if constexpr (ALIGN_EPI) { if (wr == 0) PG8_BAR; }
        bool keep = false;
        if constexpr (Epi::CHAIN) { keep = E.chain(acc, cur, wr, wc, fr, fq); S.done(cur); }
        else if constexpr (!Epi::AFTER_DRAIN) { E(acc, cur, wr, wc, fr, fq); S.done(cur); }
        if (!has_next) break;
        if (!keep)
#pragma unroll
        for (int a = 0; a < 2; ++a)
#pragma unroll
            for (int b = 0; b < 2; ++b)
#pragma unroll
                for (int m = 0; m < 4; ++m)
#pragma unroll
                    for (int n = 0; n < 2; ++n) acc[a][b][m][n] = acc_t{};
        cur = nxt; cA = nA; cB = nB; ++ui; ntc = cur.nt ? cur.nt : nt;
        if constexpr (ALIGN_EPI) { if (wr == 1) PG8_BAR; }
    }
    PG8_WAIT_V(0);
    if constexpr (!ALIGN_EPI) { if (wr == 0) PG8_BAR; }
    PG8_BAR;
#undef PG8_SA
#undef PG8_SB
#undef PG8_STAGE
#undef PG8_LDA
#undef PG8_LDB
#undef PG8_MMA
#undef PG8_WAIT_V
#undef PG8_WAIT_L
#undef PG8_BAR
#undef PG8_SCHED
}
}

namespace att {
using bf16 = __hip_bfloat16;
typedef short bf16x8 __attribute__((ext_vector_type(8)));
typedef short s16x4 __attribute__((ext_vector_type(4)));
typedef float f32x16 __attribute__((ext_vector_type(16)));
typedef float f32x4 __attribute__((ext_vector_type(4)));
typedef unsigned u32x4 __attribute__((ext_vector_type(4)));
typedef unsigned u32x2 __attribute__((ext_vector_type(2)));
constexpr int D = 128;
constexpr float SCALE = 0.08838834764831845f;
constexpr float THR = 8.f;
constexpr int NW = 8, QBLK = 32, KVBLK = 64, QB = NW * QBLK;
constexpr int SHM_V = KVBLK * D * 2, SHM_K = KVBLK * D * 2;
constexpr int LDS_BYTES = 2 * SHM_V + 2 * SHM_K + NW * 64 * 4;
#define KSWZ(row, colB) ((row) * 256 + ((colB) ^ (((row) & 7) << 4)))
#define SBAR() __builtin_amdgcn_sched_barrier(0)
__device__ __forceinline__ int v_st(int k, int c) { const int kk = (k & ~0xC) | ((k & 4) << 1) | ((k & 8) >> 1); return ((kk >> 3) * 4 + (c >> 5)) * 512 + ((kk & 7) * 32 + (c & 31)) * 2; }
__device__ __forceinline__ int v_rd_base(int lane) { return ((lane & 3) << 3) | (((lane >> 2) & 3) << 6) | (((lane >> 4) & 1) << 5) | (((lane >> 5) & 1) << 8); }
constexpr int v_rd_off(int d0, int ks, int half) { return d0 * 512 + ks * 4096 + half * 2048; }
__device__ __forceinline__ int crow(int r, int hi) { return (r & 3) + 8 * (r >> 2) + 4 * hi; }
__device__ __forceinline__ unsigned cvtpk(float lo, float hi) { unsigned r; asm volatile("v_cvt_pk_bf16_f32 %0, %1, %2" : "=v"(r) : "v"(lo), "v"(hi)); return r; }
__device__ __forceinline__ bf16x8 load8(const bf16* p) { return *reinterpret_cast<const bf16x8*>(p); }
__device__ __forceinline__ void mask_alibi(f32x16& p0, f32x16& p1, u32x2 mw, int dq, int hi, float ah) {
    const float NEG = -__builtin_inff();
    const unsigned w0 = mw.x >> (4 * hi), w1 = mw.y >> (4 * hi);
    const float dqf = (float)dq;
#pragma unroll
    for (int r = 0; r < 16; ++r) {
        const int c = (r & 3) + 8 * (r >> 2);
        p0[r] = ((w0 >> c) & 1u) ? fmaf(ah, (float)c - dqf, p0[r]) : NEG;
        p1[r] = ((w1 >> c) & 1u) ? fmaf(ah, (float)(c + 32) - dqf, p1[r]) : NEG;
    }
}
__device__ __forceinline__ void partialSM(f32x16& p0, f32x16& p1, float& m_reg, float& mn, float& alpha) {
    float pmax = p0[0];
#pragma unroll
    for (int r = 1; r < 16; ++r) pmax = fmaxf(pmax, p0[r]);
#pragma unroll
    for (int r = 0; r < 16; ++r) pmax = fmaxf(pmax, p1[r]);
    { auto rr = __builtin_amdgcn_permlane32_swap(__float_as_uint(pmax), __float_as_uint(pmax), false, false);
      pmax = fmaxf(__uint_as_float(rr[0]), __uint_as_float(rr[1])); }
    constexpr float C2 = 1.4426950408889634f * SCALE;
    if (__builtin_expect(__all((pmax - m_reg) * SCALE <= THR), 1)) { mn = m_reg; alpha = 1.f; }
    else { mn = fmaxf(m_reg, pmax); alpha = __builtin_amdgcn_exp2f((m_reg - mn) * C2); m_reg = mn; }
    const float mnL = -mn * C2;
#pragma unroll
    for (int r = 0; r < 16; ++r) p0[r] = fmaf(p0[r], C2, mnL);
#pragma unroll
    for (int r = 0; r < 16; ++r) p1[r] = fmaf(p1[r], C2, mnL);
#pragma unroll
    for (int r = 0; r < 16; ++r) p0[r] = __builtin_amdgcn_exp2f(p0[r]);
}
__device__ __forceinline__ void finishSM(f32x16& p0, f32x16& p1, float alpha, float& l_reg, bf16x8& pa0, bf16x8& pa1, bf16x8& pa2, bf16x8& pa3) {
#pragma unroll
    for (int r = 0; r < 16; ++r) p1[r] = __builtin_amdgcn_exp2f(p1[r]);
    float ps = 0;
#pragma unroll
    for (int r = 0; r < 16; ++r) ps += p0[r];
#pragma unroll
    for (int r = 0; r < 16; ++r) ps += p1[r];
    { auto rr = __builtin_amdgcn_permlane32_swap(__float_as_uint(ps), __float_as_uint(ps), false, false);
      ps = __uint_as_float(rr[0]) + __uint_as_float(rr[1]); }
    l_reg = l_reg * alpha + ps;
#define PK4(P, B_, OUT) do { unsigned a0 = cvtpk(P[B_+0], P[B_+1]), a1 = cvtpk(P[B_+2], P[B_+3]);                          \
        unsigned b0 = cvtpk(P[B_+4], P[B_+5]), b1 = cvtpk(P[B_+6], P[B_+7]);                                             \
        auto r0 = __builtin_amdgcn_permlane32_swap(a0, b0, false, false); auto r1 = __builtin_amdgcn_permlane32_swap(a1, b1, false, false); \
        u32x4 w = {r0[0], r1[0], r0[1], r1[1]}; OUT = *reinterpret_cast<bf16x8*>(&w); } while (0)
    PK4(p0, 0, pa0); PK4(p0, 8, pa1); PK4(p1, 0, pa2); PK4(p1, 8, pa3);
#undef PK4
}
template <int KB>
__device__ __forceinline__ void qkt(f32x16& p0, f32x16& p1, const char* K_lds, int r32, int hi, const bf16x8* qr) {
    p0 = f32x16{}; p1 = f32x16{};
    const char* kb[4];
#pragma unroll
    for (int dd = 0; dd < 4; ++dd) kb[dd] = K_lds + KB * SHM_K + KSWZ(r32, (dd * 16 + hi * 8) * 2);
#pragma unroll
    for (int d0 = 0; d0 < 8; ++d0) { const char* a = kb[d0 & 3] + (d0 >> 2) * 128;
        bf16x8 b0 = *reinterpret_cast<const bf16x8*>(a);
        bf16x8 b1 = *reinterpret_cast<const bf16x8*>(a + 32 * 256);
        p0 = __builtin_amdgcn_mfma_f32_32x32x16_bf16(b0, qr[d0], p0, 0, 0, 0);
        p1 = __builtin_amdgcn_mfma_f32_32x32x16_bf16(b1, qr[d0], p1, 0, 0, 0); }
}
template <int VB>
__device__ __forceinline__ void pv_tile(f32x16* o, int vb0, bf16x8 pa0, bf16x8 pa1, bf16x8 pa2, bf16x8 pa3) {
#define TRRD(dst, off) asm volatile("ds_read_b64_tr_b16 %0, %1 offset:%2" : "=&v"(dst) : "v"(vb0), "i"(off) : "memory")
#define PV_D0(d0) do { s16x4 l0, l1, l2, l3, h0, h1, h2, h3; constexpr int b_ = VB * SHM_V + v_rd_off(d0, 0, 0); \
        TRRD(l0, b_); TRRD(h0, b_ + 2048); TRRD(l1, b_ + 4096); TRRD(h1, b_ + 6144); TRRD(l2, b_ + 8192); TRRD(h2, b_ + 10240); TRRD(l3, b_ + 12288); TRRD(h3, b_ + 14336); \
        asm volatile("s_waitcnt lgkmcnt(0)" ::: "memory"); SBAR();   \
        o[d0] = __builtin_amdgcn_mfma_f32_32x32x16_bf16(pa0, (bf16x8){l0[0], l0[1], l0[2], l0[3], h0[0], h0[1], h0[2], h0[3]}, o[d0], 0, 0, 0);   \
        o[d0] = __builtin_amdgcn_mfma_f32_32x32x16_bf16(pa1, (bf16x8){l1[0], l1[1], l1[2], l1[3], h1[0], h1[1], h1[2], h1[3]}, o[d0], 0, 0, 0);   \
        o[d0] = __builtin_amdgcn_mfma_f32_32x32x16_bf16(pa2, (bf16x8){l2[0], l2[1], l2[2], l2[3], h2[0], h2[1], h2[2], h2[3]}, o[d0], 0, 0, 0);   \
        o[d0] = __builtin_amdgcn_mfma_f32_32x32x16_bf16(pa3, (bf16x8){l3[0], l3[1], l3[2], l3[3], h3[0], h3[1], h3[2], h3[3]}, o[d0], 0, 0, 0); } while (0)
    PV_D0(0); PV_D0(1); PV_D0(2); PV_D0(3);
#undef PV_D0
#undef TRRD
}
template <int LD, int LDO, bool MASKED>
__device__ __forceinline__ void attn_block(const bf16* Q, const bf16* Kh, const bf16* Vh, bf16* O, int NT, int P0, const unsigned* maskbase, float ah, char* lds) {
    int tid_ = threadIdx.x; asm volatile("" : "+v"(tid_));
    const int tid = tid_, wid = __builtin_amdgcn_readfirstlane(tid >> 6), lane = tid & 63, r32 = lane & 31, hi = lane >> 5;
    const int qlo = P0 + wid * QBLK, qm = qlo + r32 - 4 * hi;
    char* V_lds = lds; char* K_lds = lds + 2 * SHM_V;
    float* ws = (float*)(lds + 2 * SHM_V + 2 * SHM_K) + wid * 64; float* li_l = ws, * al_l = ws + 32;
    float m_reg = -1e30f, l_reg = 0; f32x16 o[4] = {};
    const int sr = tid >> 4, sc = (tid & 15) * 8, vst0 = v_st(sr, sc), vst1 = v_st(32 + sr, sc), kws = KSWZ(sr, sc * 2);
    const int vb0 = (int)(uintptr_t)V_lds + v_rd_base(lane);
    const unsigned* mrow = MASKED ? maskbase + (size_t)(qlo + r32) * 128 : nullptr;
    bf16x8 qr[8], st_v0, st_v1, st_k0, st_k1;
#define ROW(p, k0, rr) ((p) + (size_t)((k0) + (rr)) * LD + sc)
#define VMW() asm volatile("s_waitcnt vmcnt(0)" ::: "memory")
#define SLOAD_H(k0) do { st_v0 = load8(ROW(Vh, k0, sr)); st_v1 = load8(ROW(Vh, k0, 32 + sr)); st_k0 = load8(ROW(Kh, k0, sr)); st_k1 = load8(ROW(Kh, k0, 32 + sr)); } while (0)
#define SWRITE_HK(bf) do { *(bf16x8*)(K_lds + (bf) * SHM_K + kws) = st_k0; *(bf16x8*)(K_lds + (bf) * SHM_K + kws + 32 * 256) = st_k1; } while (0)
#define SWRITE_HV(bf) do { *(bf16x8*)(V_lds + (bf) * SHM_V + vst0) = st_v0; *(bf16x8*)(V_lds + (bf) * SHM_V + vst1) = st_v1; } while (0)
#define SWRITE_H(bf) do { SWRITE_HV(bf); SWRITE_HK(bf); } while (0)
#define RESC(a) do { if (__any((a) < 1.f)) { if (hi == 0) al_l[r32] = (a); asm volatile("s_waitcnt lgkmcnt(0)" ::: "memory");              \
                     for (int d_ = 0; d_ < 4; ++d_) for (int r = 0; r < 16; ++r) o[d_][r] *= al_l[crow(r, hi)]; } } while (0)
#define KBASE(t) ((t) * KVBLK)
#define MLOAD(dst, t) do { if (MASKED) dst = *(const u32x2*)(mrow + 2 * (t)); } while (0)
#define MASKT(P0_, P1_, mw_, t) do { if (MASKED) mask_alibi(P0_, P1_, mw_, qm - KBASE(t), hi, ah); } while (0)
#pragma unroll
    for (int d0 = 0; d0 < 8; ++d0) qr[d0] = load8(Q + (size_t)(wid * QBLK + r32) * LD + d0 * 16 + hi * 8);
    SLOAD_H(0); VMW(); SWRITE_HK(0);
    __syncthreads();
    f32x16 pA0, pA1, pB0, pB1; float mnA, mnB, alA, alB; bf16x8 pa0, pa1, pa2, pa3;
    u32x2 mwA = {0u, 0u}, mwB = {0u, 0u};
    SWRITE_HV(0); SBAR();
    MLOAD(mwA, 0);
    if (NT > 1) SLOAD_H(KBASE(1));
    SBAR(); qkt<0>(pA0, pA1, K_lds, r32, hi, qr);
    MASKT(pA0, pA1, mwA, 0); partialSM(pA0, pA1, m_reg, mnA, alA);
    if (NT > 1) { VMW(); SWRITE_H(1); }
    __syncthreads();
#define HALF_STEP(PX0, PX1, mwX, mnX, alX, PY0, PY1, alY, t, KB, VB, SB) do {                                                 \
        SBAR(); MLOAD(mwX, t); qkt<KB>(PX0, PX1, K_lds, r32, hi, qr);                                                         \
        finishSM(PY0, PY1, alY, l_reg, pa0, pa1, pa2, pa3); SBAR();                                                           \
        if ((t) + 1 < NT) { SLOAD_H(KBASE((t) + 1)); SBAR(); }                                                                \
        pv_tile<VB>(o, vb0, pa0, pa1, pa2, pa3); MASKT(PX0, PX1, mwX, (t)); partialSM(PX0, PX1, m_reg, mnX, alX);             \
        __syncthreads();                                                                                                      \
        if ((t) + 1 < NT) { VMW(); SWRITE_H(SB); }                                                                            \
        RESC(alX); __syncthreads(); } while (0)
    for (int t = 1; t + 1 < NT; t += 2) {
        HALF_STEP(pB0, pB1, mwB, mnB, alB, pA0, pA1, alA, t, 1, 0, 0);
        HALF_STEP(pA0, pA1, mwA, mnA, alA, pB0, pB1, alB, t + 1, 0, 1, 1);
    }
    const bool even = (NT & 1) == 0;
    if (even) { SBAR(); MLOAD(mwB, NT - 1); qkt<1>(pB0, pB1, K_lds, r32, hi, qr); SBAR(); }
    finishSM(pA0, pA1, alA, l_reg, pa0, pa1, pa2, pa3); SBAR();
    pv_tile<0>(o, vb0, pa0, pa1, pa2, pa3);
    if (even) { MASKT(pB0, pB1, mwB, NT - 1); partialSM(pB0, pB1, m_reg, mnB, alB); __syncthreads(); RESC(alB);
        finishSM(pB0, pB1, alB, l_reg, pa0, pa1, pa2, pa3); SBAR(); pv_tile<1>(o, vb0, pa0, pa1, pa2, pa3); }
    SBAR();
    if (hi == 0) li_l[r32] = l_reg; asm volatile("s_waitcnt lgkmcnt(0)" ::: "memory");
    float rli[16];
#pragma unroll
    for (int r = 0; r < 16; ++r) rli[r] = __builtin_amdgcn_rcpf(li_l[crow(r, hi)]);
    bf16* Ow = O + (size_t)(wid * QBLK) * LDO;
#pragma unroll
    for (int r = 0; r < 16; ++r) { const int orow = crow(r, hi);
#pragma unroll
        for (int d0 = 0; d0 < 4; ++d0) { const float v = o[d0][r] * rli[r];
            const float vn = __shfl_xor(v, 1);
            if ((r32 & 1) == 0) *(unsigned*)(Ow + (size_t)orow * LDO + d0 * 32 + r32) = cvtpk(v, vn); } }
    __syncthreads();
#undef ROW
#undef VMW
#undef SLOAD_H
#undef SWRITE_HK
#undef SWRITE_HV
#undef SWRITE_H
#undef RESC
#undef KBASE
#undef MLOAD
#undef MASKT
#undef HALF_STEP
}
#undef KSWZ
#undef SBAR
}

constexpr int NWAVES = 8;
constexpr int BATCH = 2, SEQ = 4096, DM = 2048, T = BATCH * SEQ, FF = 5632, NUP = 2 * FF;
constexpr int NIN = 11344, NIN_PAD = 11520;
constexpr int MEMLEN = 256, TOPK = 256;
constexpr float ALPHA = 1.189207115002721f;
constexpr float LN_EPS = 1e-5f;
constexpr int N_PHASES = 13;

constexpr size_t WS_CTL = 0, CTL_ZERO_BYTES = 1u << 20;
constexpr size_t WS_BIG = 1u << 20;
constexpr size_t O_X16 = 0, O_WUP1 = O_X16 + (size_t)T * DM * 2, O_WDN1 = O_WUP1 + (size_t)NUP * DM * 2, O_G = O_WDN1 + (size_t)DM * FF * 2, BIG_BYTES = O_G + (size_t)T * FF * 2;
constexpr size_t O_Q = 0, O_K = O_Q + (size_t)T * 1024 * 2, O_V = O_K + (size_t)T * 1024 * 2, O_QI = O_V + (size_t)T * 1024 * 2, O_KI = O_QI + (size_t)T * 1024 * 2,
                 O_WI = O_KI + (size_t)T * 64 * 2, O_U = O_WI + (size_t)T * 16 * 4, O_QM = O_U + (size_t)T * 512 * 2, O_GATE = O_QM + (size_t)T * 512 * 2, O_MIXEND = O_GATE + (size_t)T * 6144 * 2;
static_assert(O_MIXEND <= BIG_BYTES, "mixer view fits");
constexpr size_t WS_WIN = WS_BIG + BIG_BYTES;
constexpr int NZB = 4352, NZQ = NIN_PAD - NZB;
constexpr size_t WS_WMKV = WS_WIN + (size_t)NZB * DM * 2;
constexpr size_t WS_WINQ = WS_WMKV + (size_t)1024 * DM * 2;
constexpr size_t WS_WBA = WS_WIN + (size_t)NIN_PAD * DM * 2 + (size_t)1024 * DM * 2;
constexpr size_t WS_WBP = WS_WBA + (size_t)DM * 1024 * 2;
constexpr size_t WS_WBM = WS_WBP + (size_t)DM * 512 * 2;
constexpr size_t WS_WOUT = WS_WBM + (size_t)DM * 512 * 2;
constexpr size_t WS_WUP2 = WS_WOUT + (size_t)DM * DM * 2;
constexpr size_t WS_WDN2 = WS_WUP2 + (size_t)NUP * DM * 2;
constexpr size_t WS_WPOOL = WS_WDN2 + (size_t)DM * FF * 2;
constexpr size_t WS_H1 = WS_WPOOL + (size_t)4 * 128 * 128 * 2;
constexpr size_t WS_MEM16 = WS_H1 + (size_t)T * DM * 2;
constexpr size_t WS_A16 = WS_MEM16 + (size_t)512 * DM * 2;
constexpr size_t WS_P16 = WS_A16 + (size_t)T * 1024 * 2;
constexpr size_t WS_M16 = WS_P16 + (size_t)T * 512 * 2;
constexpr size_t WS_Y16 = WS_M16 + (size_t)T * 512 * 2;
constexpr size_t WS_KM = WS_Y16 + (size_t)T * DM * 2;
constexpr size_t WS_VM = WS_KM + (size_t)512 * 512 * 2;
constexpr size_t WS_MASK = WS_VM + (size_t)512 * 512 * 2;
constexpr size_t WS_END = WS_MASK + (size_t)T * 128 * 4;
constexpr int CW_BAR = 4096;
constexpr size_t WS_QS = 65536;
constexpr size_t WS_ROWQ = 131072;
static_assert(WS_ROWQ + (size_t)9 * 8192 * 4 <= (1u << 20), "control region");

constexpr int RING_OFF = 0, RING_BYTES = 131072;
constexpr int LDSCTL_OFF = RING_BYTES, MISC_OFF = LDSCTL_OFF + 320;
constexpr int LDS_BYTES = 147456;

#define GAS __attribute__((address_space(1)))
#define LAS __attribute__((address_space(3)))
typedef unsigned short bf16;
typedef unsigned v4u __attribute__((ext_vector_type(4)));
typedef unsigned v2u __attribute__((ext_vector_type(2)));
typedef float f32x4 __attribute__((ext_vector_type(4)));
typedef float f32x16 __attribute__((ext_vector_type(16)));
typedef short bf16x8 __attribute__((ext_vector_type(8)));
#define LDS_WAIT() asm volatile("s_waitcnt lgkmcnt(0)" ::: "memory")
__device__ __forceinline__ unsigned f2bf(float f) { unsigned u = __builtin_bit_cast(unsigned, f); return (u + 0x7fffu + ((u >> 16) & 1u)) >> 16; }
__device__ __forceinline__ unsigned pk2(float lo, float hi) { return f2bf(lo) | (f2bf(hi) << 16); }

#define XB_TMO      128
#define XB_XCNT(j)  (256  + 64 * (j))
#define XB_XSUB(j)  (1280 + 64 * (j))
#define XB_XGEN(j)  (2304 + 64 * (j))
#define XB_TOP      3328
#define XB_TOPGEN   3392
#define XCD_BAR_WORDS 3456
#define XB_SPIN_CAP (1u << 22)
__device__ __forceinline__ unsigned xb_ld(unsigned* p)              { return __hip_atomic_load(p, __ATOMIC_RELAXED, __HIP_MEMORY_SCOPE_AGENT); }
__device__ __forceinline__ unsigned xb_add(unsigned* p, unsigned v) { return __hip_atomic_fetch_add(p, v, __ATOMIC_RELAXED, __HIP_MEMORY_SCOPE_AGENT); }
__device__ __forceinline__ unsigned xb_xcc_id() { return (unsigned)__builtin_amdgcn_s_getreg((3 << 11) | 20) & 0xFu; }
#define XB_SPIN(cond, bar) do { unsigned _sp = 0; while (cond) { __builtin_amdgcn_s_sleep(1); \
    if ((++_sp & 255u) == 0u) { if (xb_ld(&(bar)[XB_TMO])) break; if (_sp > XB_SPIN_CAP) { atomicAdd(&(bar)[XB_TMO], 1u); break; } } } } while (0)
struct XcdBarrier { unsigned* bar; unsigned x; volatile LAS unsigned* st; };
__device__ __forceinline__ XcdBarrier xcd_barrier_post(unsigned* bar, volatile LAS unsigned* st) {
    XcdBarrier b; b.bar = bar; b.x = xb_xcc_id(); b.st = st;
    if (threadIdx.x == 0) (void)xb_add(&bar[XB_XCNT(b.x)], 1u);
    return b;
}
__device__ __forceinline__ void xcd_barrier_complete(unsigned* bar, unsigned x, unsigned& nloc, unsigned& nx) {
    const unsigned G = gridDim.x * gridDim.y * gridDim.z;
    unsigned sum, cnt, mine, sp = 0u;
    for (;;) {
        sum = 0u; cnt = 0u; mine = 0u;
#pragma unroll
        for (unsigned j = 0; j < 16; ++j) { const unsigned c = xb_ld(&bar[XB_XCNT(j)]); sum += c; cnt += (c > 0u) ? 1u : 0u; mine = (j == x) ? c : mine; }
        if (sum == G) break;
        __builtin_amdgcn_s_sleep(1);
        if ((++sp & 255u) == 0u) { if (xb_ld(&bar[XB_TMO])) break; if (sp > XB_SPIN_CAP) { atomicAdd(&bar[XB_TMO], 1u); break; } }
    }
    nloc = mine > 0u ? mine : 1u; nx = cnt > 0u ? cnt : 1u;
}
__device__ __forceinline__ void xcd_barrier(const XcdBarrier& b) {
    asm volatile("s_waitcnt vmcnt(0)" ::: "memory");
    __syncthreads();
    if (threadIdx.x == 0) {
        unsigned* bar = b.bar;
        __builtin_amdgcn_s_waitcnt(0);
        unsigned nloc = b.st[0], nx = b.st[1];
        if (nloc == 0u) { xcd_barrier_complete(bar, b.x, nloc, nx); b.st[0] = nloc; b.st[1] = nx; }
        const unsigned old = xb_add(&bar[XB_XSUB(b.x)], 1u);
        const unsigned gen = old / nloc;
        if (old + 1u == (gen + 1u) * nloc) {
            __builtin_amdgcn_fence(__ATOMIC_RELEASE, "agent");
            asm volatile("s_waitcnt vmcnt(0)" ::: "memory");
            const unsigned og = xb_add(&bar[XB_TOP], 1u);
            const unsigned tg = og / nx;
            if (og + 1u == (tg + 1u) * nx) xb_add(&bar[XB_TOPGEN], 1u);
            else XB_SPIN(xb_ld(&bar[XB_TOPGEN]) == tg, bar);
            __builtin_amdgcn_fence(__ATOMIC_ACQUIRE, "agent");
            xb_add(&bar[XB_XGEN(b.x)], 1u);
            asm volatile("s_waitcnt vmcnt(0)" ::: "memory");
        } else {
            XB_SPIN(xb_ld(&bar[XB_XGEN(b.x)]) == gen, bar);
            __builtin_amdgcn_fence(__ATOMIC_ACQUIRE, "agent");
            asm volatile("s_waitcnt vmcnt(0)" ::: "memory");
        }
    }
    __syncthreads();
}

__device__ __forceinline__ float wave_sum(float v) {
#pragma unroll
    for (int o = 1; o < 64; o <<= 1) v += __shfl_xor(v, o);
    return v;
}
template <int MAP>
__device__ __forceinline__ void p0_transpose_item(const float* W, int K, int N, int NP, bf16* WT, LAS float* scr, int item, int lane, int ldw = 0) {
    if (ldw == 0) ldw = K;
    const int nblk = NP / 32, kb = item / nblk, nb = item % nblk, k0 = 64 * kb, np0 = 32 * nb;
    int n0 = np0; int nvalid = 32;
    if (MAP == 1) n0 = ((np0 >> 7) & 1) * FF + (np0 >> 8) * 128 + (np0 & 127);
    if (MAP == 2) { if (np0 < 4096) n0 = np0; else if (np0 < 4352) { n0 = np0; nvalid = 4176 - np0; nvalid = nvalid < 0 ? 0 : (nvalid > 32 ? 32 : nvalid); } else n0 = np0 - 176; }
    float v[32];
    const bool ok = (lane & 31) < nvalid;
#pragma unroll
    for (int i = 0; i < 32; ++i) { const int kk = 2 * i + (lane >> 5); v[i] = ok ? W[(size_t)(k0 + kk) * N + n0 + (lane & 31)] : 0.f; }
#pragma unroll
    for (int i = 0; i < 32; ++i) { const int kk = 2 * i + (lane >> 5); scr[kk * 33 + (lane & 31)] = v[i]; }
    LDS_WAIT(); asm volatile("" ::: "memory");
    const int c = lane & 7;
#pragma unroll
    for (int j = 0; j < 4; ++j) { const int n = (lane >> 3) + 8 * j; const LAS float* s = scr + (8 * c) * 33 + n;
        v4u o; o.x = pk2(s[0 * 33], s[1 * 33]); o.y = pk2(s[2 * 33], s[3 * 33]); o.z = pk2(s[4 * 33], s[5 * 33]); o.w = pk2(s[6 * 33], s[7 * 33]);
        *(GAS v4u*)(WT + (size_t)(np0 + n) * ldw + k0 + 8 * c) = o; }
    LDS_WAIT(); asm volatile("" ::: "memory");
}
__device__ __forceinline__ unsigned q8(float v, float qw) { return (unsigned)((int)__builtin_rintf(fminf(fmaxf(v * qw, -127.f), 127.f)) & 255); }
template <int MAP>
__device__ __forceinline__ void p0_transpose_item_i8(const float* W, int K, int N, int NP, signed char* WT, LAS float* scr, int item, int lane, float qw) {
    const int nblk = NP / 32, kb = item / nblk, nb = item % nblk, k0 = 64 * kb, np0 = 32 * nb;
    int n0 = np0;
    if (MAP == 1) n0 = ((np0 >> 7) & 1) * FF + (np0 >> 8) * 128 + (np0 & 127);
    float v[32];
#pragma unroll
    for (int i = 0; i < 32; ++i) { const int kk = 2 * i + (lane >> 5); v[i] = W[(size_t)(k0 + kk) * N + n0 + (lane & 31)]; }
#pragma unroll
    for (int i = 0; i < 32; ++i) { const int kk = 2 * i + (lane >> 5); scr[kk * 33 + (lane & 31)] = v[i]; }
    LDS_WAIT(); asm volatile("" ::: "memory");
#pragma unroll
    for (int j = 0; j < 2; ++j) { const int id = lane + 64 * j, n = id >> 2, c = id & 3; const LAS float* sp = scr + (16 * c) * 33 + n;
        v4u o;
        o.x = q8(sp[0 * 33], qw) | (q8(sp[1 * 33], qw) << 8) | (q8(sp[2 * 33], qw) << 16) | (q8(sp[3 * 33], qw) << 24);
        o.y = q8(sp[4 * 33], qw) | (q8(sp[5 * 33], qw) << 8) | (q8(sp[6 * 33], qw) << 16) | (q8(sp[7 * 33], qw) << 24);
        o.z = q8(sp[8 * 33], qw) | (q8(sp[9 * 33], qw) << 8) | (q8(sp[10 * 33], qw) << 16) | (q8(sp[11 * 33], qw) << 24);
        o.w = q8(sp[12 * 33], qw) | (q8(sp[13 * 33], qw) << 8) | (q8(sp[14 * 33], qw) << 16) | (q8(sp[15 * 33], qw) << 24);
        *(GAS v4u*)(WT + (size_t)(np0 + n) * K + k0 + 16 * c) = o; }
    LDS_WAIT(); asm volatile("" ::: "memory");
}
__device__ __forceinline__ float sample_sigma2(const float* W, int K, int N, int lane) {
    float s = 0.f;
#pragma unroll
    for (int j = 0; j < 4; ++j) { const f32x4 v = *(const GAS f32x4*)(W + (size_t)(j * (K / 4)) * N + lane * 4); s += (v.x * v.x + v.y * v.y) + (v.z * v.z + v.w * v.w); }
    return wave_sum(s) * (1.0f / 1024.0f);
}
__device__ __forceinline__ void quant_row_i8(const f32x4 (&v)[8], signed char* qrow, float* sx, float* gq, float* sg, float sig2, int lane) {
    float mx = 0.f, ss = 0.f;
#pragma unroll
    for (int j = 0; j < 8; ++j) { mx = fmaxf(mx, fmaxf(fmaxf(fabsf(v[j].x), fabsf(v[j].y)), fmaxf(fabsf(v[j].z), fabsf(v[j].w)))); ss += (v[j].x * v[j].x + v[j].y * v[j].y) + (v[j].z * v[j].z + v[j].w * v[j].w); }
#pragma unroll
    for (int o = 1; o < 64; o <<= 1) mx = fmaxf(mx, __shfl_xor(mx, o));
    ss = wave_sum(ss);
    const float m = fmaxf(mx, 1e-20f), qm = 127.f / m;
#pragma unroll
    for (int j = 0; j < 8; ++j) ((GAS unsigned*)qrow)[lane + 64 * j] = q8(v[j].x, qm) | (q8(v[j].y, qm) << 8) | (q8(v[j].z, qm) << 16) | (q8(v[j].w, qm) << 24);
    if (lane == 0) { const float clip = fmaxf(8.f * ss * sig2, 1e-20f);
        *sx = m * (1.0f / 127.f); *gq = 127.f / clip; *sg = clip * (1.0f / 127.f); }
}
template <bool OUT_BF16, bool Q8 = false>
__device__ __forceinline__ void ln_row(const float* xrow, const float* gam, const float* bet, void* orow, int lane, signed char* qrow = nullptr, float* sx = nullptr, float* gq = nullptr, float* sg = nullptr, float sig2 = 0.f) {
    const GAS f32x4* xr = (const GAS f32x4*)xrow + lane;
    f32x4 v[8]; float s = 0.f;
#pragma unroll
    for (int j = 0; j < 8; ++j) { v[j] = xr[64 * j]; s += (v[j].x + v[j].y) + (v[j].z + v[j].w); }
    const float mean = wave_sum(s) * (1.f / DM); float s2 = 0.f;
#pragma unroll
    for (int j = 0; j < 8; ++j) { v[j] = v[j] - mean; s2 += (v[j].x * v[j].x + v[j].y * v[j].y) + (v[j].z * v[j].z + v[j].w * v[j].w); }
    const float rstd = 1.f / sqrtf(wave_sum(s2) * (1.f / DM) + LN_EPS);
#pragma unroll
    for (int j = 0; j < 8; ++j) {
        const f32x4 gg = ((const GAS f32x4*)gam)[lane + 64 * j], bb = ((const GAS f32x4*)bet)[lane + 64 * j];
        const f32x4 y = v[j] * rstd * gg + bb;
        if (OUT_BF16) { ((GAS v2u*)orow)[lane + 64 * j] = (v2u){pk2(y.x, y.y), pk2(y.z, y.w)}; }
        else ((GAS f32x4*)orow)[lane + 64 * j] = y;
        if (Q8) v[j] = y;
    }
    if (Q8) quant_row_i8(v, qrow, sx, gq, sg, sig2, lane);
}

__device__ __forceinline__ unsigned ordkey(float s) { const unsigned u = __float_as_uint(s); return (u ^ ((unsigned)((int)u >> 31) | 0x80000000u)) >> 1; }
__device__ __forceinline__ float keyf(unsigned k31) { const unsigned k = k31 << 1; return __uint_as_float((k & 0x80000000u) ? (k ^ 0x80000000u) : ~k); }
template <int J, int JEND> __device__ __forceinline__ void mask_emit(const unsigned (&key)[128], unsigned thr, unsigned& o0a, unsigned& o1a, unsigned& o0b, unsigned& o1b) {
    const unsigned long long bal = __ballot(key[J] >= thr);
    const unsigned bl = (unsigned)bal, bh = (unsigned)(bal >> 32);
    if constexpr (J < 64) asm volatile("s_nop 1\n\tv_writelane_b32 %0, %2, %4\n\tv_writelane_b32 %1, %3, %4" : "+v"(o0a), "+v"(o1a) : "s"(bl), "s"(bh), "n"(J));
    else asm volatile("s_nop 1\n\tv_writelane_b32 %0, %2, %4\n\tv_writelane_b32 %1, %3, %4" : "+v"(o0b), "+v"(o1b) : "s"(bl), "s"(bh), "n"(J - 64));
    if constexpr (J + 1 < JEND) mask_emit<J + 1, JEND>(key, thr, o0a, o1a, o0b, o1b);
}
template <int G> __device__ __forceinline__ void mask_emit_groups(const unsigned (&key)[128], unsigned thr, int ntw, unsigned& o0a, unsigned& o1a, unsigned& o0b, unsigned& o1b) {
    if (16 * G < ntw) mask_emit<16 * G, 16 * G + 16>(key, thr, o0a, o1a, o0b, o1b);
    if constexpr (G + 1 < 8) mask_emit_groups<G + 1>(key, thr, ntw, o0a, o1a, o0b, o1b);
}
template <int G> __device__ __forceinline__ void count_groups(const unsigned (&key)[128], unsigned mid, int ntw, unsigned& nlt) {
    if (16 * G < ntw) { unsigned a = 0u;
#pragma unroll
        for (int j = 0; j < 16; ++j) a = __builtin_amdgcn_alignbit(a, key[16 * G + j] - mid, 31);
        nlt += (unsigned)__builtin_popcount(a); }
    if constexpr (G + 1 < 8) count_groups<G + 1>(key, mid, ntw, nlt);
}
template <int CTRL> __device__ __forceinline__ unsigned dpp_u(unsigned v) { return (unsigned)__builtin_amdgcn_update_dpp(0, (int)v, CTRL, 0xf, 0xf, true); }
__device__ __forceinline__ unsigned umin_(unsigned a, unsigned b) { return a < b ? a : b; }
__device__ __forceinline__ unsigned umax_(unsigned a, unsigned b) { return a > b ? a : b; }
__device__ __forceinline__ unsigned uadd_(unsigned a, unsigned b) { return a + b; }
#define HALF_REDUCE(v, OP) do { v = OP(v, dpp_u<0xB1>(v)); v = OP(v, dpp_u<0x4E>(v)); v = OP(v, dpp_u<0x141>(v)); v = OP(v, dpp_u<0x140>(v)); v = OP(v, (unsigned)__shfl_xor((int)v, 16)); } while (0)
typedef float f32x2_t __attribute__((ext_vector_type(2)));
__device__ __forceinline__ void indexer_unit(LAS unsigned char* lds, int b, int uidx, const bf16* QI16, const bf16* KI16, const float* WI, unsigned* MASKQ) {
    int tid_ = threadIdx.x; asm volatile("" : "+v"(tid_));
    const int tid = tid_, lane = tid & 63, wid = __builtin_amdgcn_readfirstlane(tid >> 6), r = lane & 31, h = lane >> 5;
    const int q0 = uidx * 16 + 2 * wid, tq = q0 + h;
    const int nchunk = ((uidx * 16 + 15) >> 8) + 1;
    bf16x8 aq[4];
    { const int qa = q0 + ((r >> 2) & 1), head = (r & 3) + 4 * (r >> 3);
      const bf16* qp = QI16 + (size_t)(b * SEQ + qa) * 1024 + head * 64 + 8 * h;
#pragma unroll
      for (int ks = 0; ks < 4; ++ks) aq[ks] = *(const GAS bf16x8*)(qp + ks * 16); }
    f32x2_t w2[8];
    { const GAS f32x4* wp = (const GAS f32x4*)(WI + (size_t)(b * SEQ + tq) * 16);
#pragma unroll
      for (int i = 0; i < 4; ++i) { const f32x4 t = wp[i]; w2[2 * i] = (f32x2_t){t.x, t.y}; w2[2 * i + 1] = (f32x2_t){t.z, t.w}; } }
    unsigned key[128]; unsigned kmn = 0x7FFFFFFFu, kmx = 0u; float ssum = 0.f, ssq = 0.f;
    const char* kbase = (const char*)(KI16 + (size_t)(b * SEQ) * 64);
    unsigned soff[4];
#pragma unroll
    for (int i = 0; i < 4; ++i) { const int kk = (wid * 4 + i) * 8 + (lane >> 3), cs = lane & 7; soff[i] = (unsigned)(kk * 128 + ((cs ^ ((kk >> 1) & 7)) << 4)); }
#define IDX_STAGE(c_) do { _Pragma("unroll") for (int i = 0; i < 4; ++i) \
        __builtin_amdgcn_global_load_lds((const unsigned*)(kbase + (size_t)(c_) * 32768 + soff[i]), (LAS unsigned*)(lds + ((c_) % 3) * 32768 + (wid * 4 + i) * 1024), 16, 0, 0); } while (0)
    const int x = (r >> 1) & 7;
    int roff[4];
#pragma unroll
    for (int ks = 0; ks < 4; ++ks) roff[ks] = r * 128 + (((2 * ks + h) ^ x) << 4);
    __syncthreads();
    IDX_STAGE(0);
    if (nchunk > 1) IDX_STAGE(1);
#pragma unroll
    for (int c = 0; c < 16; ++c) {
        if (c < nchunk) {
            if (c + 1 < nchunk) asm volatile("s_waitcnt vmcnt(4)" ::: "memory"); else asm volatile("s_waitcnt vmcnt(0)" ::: "memory");
            __builtin_amdgcn_s_barrier(); asm volatile("" ::: "memory");
            if (c + 2 < nchunk) IDX_STAGE(c + 2);
#pragma unroll
            for (int jj = 0; jj < 8; ++jj) {
                const int j = c * 8 + jj;
                f32x16 acc = {};
#pragma unroll
                for (int ks = 0; ks < 4; ++ks) { const bf16x8 bk = *(const LAS bf16x8*)(lds + (c % 3) * 32768 + jj * 4096 + roff[ks]);
                    acc = __builtin_amdgcn_mfma_f32_32x32x16_bf16(aq[ks], bk, acc, 0, 0, 0); }
                f32x2_t s2 = {0.f, 0.f};
#pragma unroll
                for (int i = 0; i < 8; ++i) { const int a0 = __float_as_int(acc[2 * i]), a1 = __float_as_int(acc[2 * i + 1]);
                    const f32x2_t a = {__int_as_float(a0 > 0 ? a0 : 0), __int_as_float(a1 > 0 ? a1 : 0)}; s2 = a * w2[i] + s2; }
                const float s = s2.x + s2.y;
                const bool valid = (j * 32 + r <= tq);
                { const float sv = valid ? s : 0.f; ssum += sv; ssq = fmaf(sv, sv, ssq); }
                unsigned kj = valid ? ordkey(s) : 0u;
                asm volatile("" : "+v"(kj));
                key[j] = kj; kmx = umax_(kmx, kj); kmn = umin_(kmn, valid ? kj : 0x7FFFFFFFu);
                __builtin_amdgcn_sched_barrier(0);
            }
        } else {
#pragma unroll
            for (int jj = 0; jj < 8; ++jj) key[c * 8 + jj] = 0u;
        }
    }
#undef IDX_STAGE
    unsigned thr = 1u;
    const int ntw = ((q0 + 1) >> 5) + 1;
    {
        HALF_REDUCE(kmn, umin_); HALF_REDUCE(kmx, umax_);
        { unsigned t = __float_as_uint(ssum);
#define FADD_(a, b) __float_as_uint(__uint_as_float(a) + __uint_as_float(b))
          HALF_REDUCE(t, FADD_); ssum = __uint_as_float(t); t = __float_as_uint(ssq); HALF_REDUCE(t, FADD_); ssq = __uint_as_float(t);
#undef FADD_
        }
        bool done = (tq + 1 <= TOPK);
        unsigned lo = kmn, hi = kmx + 1u;
        int clo = tq + 1, chi = 0, it = 0;
        const float nf = (float)(tq + 1), mu = ssum / nf, sd = sqrtf(fmaxf(ssq / nf - mu * mu, 1e-30f)), pp = fminf((float)TOPK / nf, 1.f);
        const float zq = 4.91f * (__builtin_amdgcn_exp2f(0.14f * __builtin_amdgcn_logf(1.f - pp)) - __builtin_amdgcn_exp2f(0.14f * __builtin_amdgcn_logf(pp)));
        const float v0 = fmaf(zq, sd, mu);
        if (!done && hi - lo <= 1u) { thr = lo; done = true; }
        while (!__all(done)) {
            unsigned mid;
            if (it < 2) mid = ordkey(it == 0 ? v0 - 0.25f * sd : v0 + 0.25f * sd);
            else { const float lof = keyf(lo), hif = keyf(hi - 1u);
              float frac = ((float)clo - ((float)TOPK - 0.5f)) / (float)(clo - chi);
              frac = fminf(fmaxf(frac, 0.125f), 0.875f);
              if (clo - chi > 48 || (it & 3) == 3) frac = 0.5f;
              mid = ordkey(fmaf(hif - lof, frac, lof)); }
            mid = mid <= lo ? lo + 1u : mid; mid = mid >= hi ? hi - 1u : mid;
            unsigned cu = 0u;
            count_groups<0>(key, mid, ntw, cu);
            HALF_REDUCE(cu, uadd_);
            cu = (unsigned)(512 * ((ntw + 15) >> 4)) - cu;
            const int cnt = (int)cu;
            if (!done) {
                if (cnt == TOPK) { thr = mid; done = true; }
                else if (cnt > TOPK) { lo = mid; clo = cnt; } else { hi = mid; chi = cnt; }
                if (!done && hi - lo <= 1u) { thr = lo; done = true; }
            }
            ++it;
        }
    }
    unsigned o0a = 0u, o0b = 0u, o1a = 0u, o1b = 0u;
    mask_emit_groups<0>(key, thr, ntw, o0a, o1a, o0b, o1b);
    GAS unsigned* mp = (GAS unsigned*)(MASKQ + (size_t)(b * SEQ + q0) * 128);
    mp[lane] = o0a; mp[64 + lane] = o0b; mp[128 + lane] = o1a; mp[192 + lane] = o1b;
}
#undef HALF_REDUCE

__device__ __forceinline__ void pool_task(int task, const bf16* U16, const bf16* WPT, const float* pscale, bf16* P16, int lane) {
    asm volatile("" : "+v"(lane));
    const int tile = task >> 2, g = task & 3, r = lane & 31, h = lane >> 5;
    const int tk = tile * 32 + r, pos = tk & (SEQ - 1), wlen = 2 << g;
    const int cnt = (pos + 1 < wlen) ? pos + 1 : wlen;
    const float rc = 1.0f / (float)cnt;
    bf16x8 pa[8];
#pragma unroll
    for (int ks = 0; ks < 8; ++ks) {
        const bf16* up = U16 + (size_t)tk * 512 + g * 128 + ks * 16 + 8 * h;
        float sum[8], self[8];
#pragma unroll
        for (int e = 0; e < 8; ++e) sum[e] = 0.f;
        for (int i = 0; i < wlen; ++i) {
            if (i < cnt) { const v4u t = *(const GAS v4u*)(up - (size_t)i * 512);
                const float f0 = pg8::bf_lo(t.x), f1 = pg8::bf_hi(t.x), f2 = pg8::bf_lo(t.y), f3 = pg8::bf_hi(t.y), f4 = pg8::bf_lo(t.z), f5 = pg8::bf_hi(t.z), f6 = pg8::bf_lo(t.w), f7 = pg8::bf_hi(t.w);
                if (i == 0) { self[0] = f0; self[1] = f1; self[2] = f2; self[3] = f3; self[4] = f4; self[5] = f5; self[6] = f6; self[7] = f7; }
                sum[0] += f0; sum[1] += f1; sum[2] += f2; sum[3] += f3; sum[4] += f4; sum[5] += f5; sum[6] += f6; sum[7] += f7; }
        }
        v4u o; o.x = pk2(sum[0] * rc - self[0], sum[1] * rc - self[1]); o.y = pk2(sum[2] * rc - self[2], sum[3] * rc - self[3]);
        o.z = pk2(sum[4] * rc - self[4], sum[5] * rc - self[5]); o.w = pk2(sum[6] * rc - self[6], sum[7] * rc - self[7]);
        pa[ks] = __builtin_bit_cast(bf16x8, o);
    }
#pragma unroll
    for (int nb = 0; nb < 4; ++nb) {
        f32x16 acc = {};
        const bf16* wp = WPT + (size_t)g * 16384 + (size_t)(nb * 32 + r) * 128 + 8 * h;
#pragma unroll
        for (int ks = 0; ks < 8; ++ks) { const bf16x8 bk = *(const GAS bf16x8*)(wp + ks * 16); acc = __builtin_amdgcn_mfma_f32_32x32x16_bf16(pa[ks], bk, acc, 0, 0, 0); }
        const int col = g * 128 + nb * 32 + r; const float ps = pscale[col];
#pragma unroll
        for (int i = 0; i < 16; ++i) { const int tok = tile * 32 + (i & 3) + 8 * (i >> 2) + 4 * h; P16[(size_t)tok * 2048 + col] = (bf16)f2bf(acc[i] * ps); }
    }
}

struct Args { const float* in[21]; float* out; unsigned char* ws; int ph_lo, ph_hi; };
__global__ void __launch_bounds__(NWAVES * 64, 2) mk_fwd(Args args) {
    extern __shared__ __attribute__((aligned(16))) unsigned char lds[];
    LAS unsigned char* L = (LAS unsigned char*)lds;
    volatile LAS unsigned* MISC = (volatile LAS unsigned*)(L + MISC_OFF);
    const int tid = threadIdx.x, lane = tid & 63, wave = __builtin_amdgcn_readfirstlane(tid >> 6);
    const int G = gridDim.x, bx = blockIdx.x;
    const int vcu = (G % 8 == 0) ? (bx % 8) * (G / 8) + bx / 8 : bx;
    const int gw = vcu * NWAVES + wave, NGW = G * NWAVES;
    unsigned char* ws = args.ws;
    for (int u = tid; u < (LDS_BYTES - LDSCTL_OFF) / 4; u += NWAVES * 64) ((LAS unsigned*)(L + LDSCTL_OFF))[u] = 0u;
    __syncthreads();
    XcdBarrier bar; bar.bar = (unsigned*)(ws + WS_CTL) + CW_BAR; bar.x = 0; bar.st = nullptr;
    if (!MK_PER_PHASE) bar = xcd_barrier_post((unsigned*)(ws + WS_CTL) + CW_BAR, MISC + 8);
    const int lo = args.ph_lo, hi = args.ph_hi;
#ifndef PH_MASK
#define PH_MASK 0x1FFF
#endif
#ifndef REP_MASK
#define REP_MASK 0x0
#endif
#define REP(k) for (int rep_ = 0; rep_ <= ((REP_MASK >> (k)) & 1); ++rep_)
#define REPBAR() do { if (rep_) xcd_barrier(bar); } while (0)
#define IN(k) (((PH_MASK >> (k)) & 1) && lo <= (k) && (k) < hi)
#define SEAM(k) do { if (IN(k) && IN((k) + 1)) xcd_barrier(bar); } while (0)
#define XIN (ap->in[0])
#define MEMIN (ap->in[1])
#define WSP_DECL unsigned char* wsp = args.ws; asm volatile("" : "+s"(wsp)); const __attribute__((address_space(4))) Args* ap = (const __attribute__((address_space(4))) Args*)__builtin_amdgcn_kernarg_segment_ptr(); asm volatile("" : "+s"(ap)); (void)wsp; (void)ap
#define BIG ((bf16*)(wsp + WS_BIG))
#define X16 ((bf16*)(wsp + WS_BIG + O_X16))
#define WUP1 ((bf16*)(wsp + WS_BIG + O_WUP1))
#define WDN1 ((bf16*)(wsp + WS_BIG + O_WDN1))
#define Gb ((bf16*)(wsp + WS_BIG + O_G))
#define Q16 ((bf16*)(wsp + WS_BIG + O_Q))
#define K16 ((bf16*)(wsp + WS_BIG + O_K))
#define V16 ((bf16*)(wsp + WS_BIG + O_V))
#define QI16 ((bf16*)(wsp + WS_BIG + O_QI))
#define KI16 ((bf16*)(wsp + WS_BIG + O_KI))
#define WI ((float*)(wsp + WS_BIG + O_WI))
#define U16 ((bf16*)(wsp + WS_BIG + O_U))
#define QM16 ((bf16*)(wsp + WS_BIG + O_QM))
#define GATE ((bf16*)(wsp + WS_BIG + O_GATE))
#define WIN ((bf16*)(wsp + WS_WIN))
#define WMKV ((bf16*)(wsp + WS_WMKV))
#define WBA ((bf16*)(wsp + WS_WBA))
#define WBP ((bf16*)(wsp + WS_WBP))
#define WBM ((bf16*)(wsp + WS_WBM))
#define WOUT ((bf16*)(wsp + WS_WOUT))
#define WUP2 ((bf16*)(wsp + WS_WUP2))
#define WDN2 ((bf16*)(wsp + WS_WDN2))
#define WPT ((bf16*)(wsp + WS_WPOOL))
#define H1 ((bf16*)(wsp + WS_H1))
#define MEM16 ((bf16*)(wsp + WS_MEM16))
#define A16 ((bf16*)(wsp + WS_A16))
#define P16 ((bf16*)(wsp + WS_A16) + 1024)
#define M16 ((bf16*)(wsp + WS_A16) + 1536)
#define H2 ((bf16*)(wsp + WS_A16))
#define Y16 ((bf16*)(wsp + WS_Y16))
#define KM ((bf16*)(wsp + WS_KM))
#define VM ((bf16*)(wsp + WS_VM))
#define MASKQ ((unsigned*)(wsp + WS_MASK))
#define X8 ((signed char*)(wsp + WS_BIG + O_X16))
#define WUP1q ((signed char*)(wsp + WS_BIG + O_WUP1))
#define WDN1q ((signed char*)(wsp + WS_BIG + O_WDN1))
#define G8 ((signed char*)(wsp + WS_BIG + O_G))
#define WUP2q ((signed char*)(wsp + WS_WUP2))
#define WDN2q ((signed char*)(wsp + WS_WDN2))
#define H2q ((signed char*)(wsp + WS_Y16))
#define G28 ((signed char*)(wsp + WS_BIG))
#define QS ((float*)(wsp + WS_QS))
#define SX1 ((float*)(wsp + WS_ROWQ))
#define GQ1 (SX1 + T)
#define SG1 (GQ1 + T)
#define SX2 (SG1 + T)
#define GQ2 (SX2 + T)
#define SG2 (GQ2 + T)
#define SXH (SG2 + T)
#define DQ0 (SXH + T)
#define DQ1 (DQ0 + T)
#define H1q ((signed char*)(wsp + WS_Y16))
#define WINq ((signed char*)(wsp + WS_WINQ))
#define R (ap->out)

    REP(0) if (IN(0)) { REPBAR(); WSP_DECL;
        LAS float* scr = (LAS float*)(L + RING_OFF + wave * 16384);
        const float s2u1 = fmaxf(sample_sigma2(ap->in[2], DM, NUP, lane), 1e-30f), s2d1 = fmaxf(sample_sigma2(ap->in[3], FF, DM, lane), 1e-30f);
        const float s2u2 = fmaxf(sample_sigma2(ap->in[17], DM, NUP, lane), 1e-30f), s2d2 = fmaxf(sample_sigma2(ap->in[18], FF, DM, lane), 1e-30f);
        const float qu1 = 127.f / (5.f * sqrtf(s2u1)), qd1 = 127.f / (5.f * sqrtf(s2d1)), qu2 = 127.f / (5.f * sqrtf(s2u2)), qd2 = 127.f / (5.f * sqrtf(s2d2));
        const float s2in = fmaxf(sample_sigma2(ap->in[6], DM, NIN, lane), 1e-30f), qin = 127.f / (5.f * sqrtf(s2in));
        if (gw == 0 && lane == 0) { QS[16] = qin; QS[17] = 1.f / qin; QS[0] = qu1; QS[1] = 1.f / qu1; QS[2] = s2u1; QS[3] = qd1; QS[4] = 1.f / qd1; QS[8] = qu2; QS[9] = 1.f / qu2; QS[10] = s2u2; QS[11] = qd2; QS[12] = 1.f / qd2; }
        constexpr int I_UP = (DM / 64) * (NUP / 32), I_DN = (FF / 64) * (DM / 32), I_IN = (DM / 64) * (NZB / 32), I_INQ = (DM / 64) * (NZQ / 32), I_MKV = (DM / 64) * (1024 / 32), I_BA = (1024 / 64) * (DM / 32),
                      I_BP = (512 / 64) * (DM / 32), I_OUT = (DM / 64) * (DM / 32), I_PL = (128 / 64) * (128 / 32);
        constexpr int NITEMS = 2 * I_UP + 2 * I_DN + I_IN + I_INQ + I_MKV + I_BA + 2 * I_BP + I_OUT + 4 * I_PL;
        for (int it = gw; it < NITEMS; it += NGW) {
            int r = it;
            if (r < I_UP) { p0_transpose_item_i8<1>(ap->in[2], DM, NUP, NUP, WUP1q, scr, r, lane, qu1); continue; } r -= I_UP;
            if (r < I_DN) { p0_transpose_item_i8<0>(ap->in[3], FF, DM, DM, WDN1q, scr, r, lane, qd1); continue; } r -= I_DN;
            if (r < I_IN) { p0_transpose_item<2>(ap->in[6], DM, NIN, NZB, WIN, scr, r, lane); continue; } r -= I_IN;
            if (r < I_INQ) { p0_transpose_item_i8<0>(ap->in[6] + 4176, DM, NIN, NZQ, WINq, scr, r, lane, qin); continue; } r -= I_INQ;
            if (r < I_MKV) { p0_transpose_item<0>(ap->in[8], DM, 1024, 1024, WMKV, scr, r, lane); continue; } r -= I_MKV;
            if (r < I_BA) { p0_transpose_item<0>(ap->in[11], 1024, DM, DM, WBA, scr, r, lane, DM); continue; } r -= I_BA;
            if (r < I_BP) { p0_transpose_item<0>(ap->in[12], 512, DM, DM, WBA + 1024, scr, r, lane, DM); continue; } r -= I_BP;
            if (r < I_BP) { p0_transpose_item<0>(ap->in[13], 512, DM, DM, WBA + 1536, scr, r, lane, DM); continue; } r -= I_BP;
            if (r < I_OUT) { p0_transpose_item<0>(ap->in[14], DM, DM, DM, WOUT, scr, r, lane); continue; } r -= I_OUT;
            if (r < I_UP) { p0_transpose_item_i8<1>(ap->in[17], DM, NUP, NUP, WUP2q, scr, r, lane, qu2); continue; } r -= I_UP;
            if (r < I_DN) { p0_transpose_item_i8<0>(ap->in[18], FF, DM, DM, WDN2q, scr, r, lane, qd2); continue; } r -= I_DN;
            { const int g = r / I_PL; p0_transpose_item<0>(ap->in[9] + (size_t)g * 16384, 128, 128, 128, WPT + (size_t)g * 16384, scr, r % I_PL, lane); }
        }
        for (int m = gw; m < T; m += NGW) {
            f32x4 v[8];
#pragma unroll
            for (int j = 0; j < 8; ++j) v[j] = ((const GAS f32x4*)(XIN + (size_t)m * DM))[lane + 64 * j];
            quant_row_i8(v, X8 + (size_t)m * DM, SX1 + m, GQ1 + m, SG1 + m, s2u1, lane);
        }
        for (size_t i = (size_t)gw * 64 + lane; i < (size_t)512 * DM / 8; i += (size_t)NGW * 64) {
            const f32x4 a = ((const GAS f32x4*)MEMIN)[2 * i], c = ((const GAS f32x4*)MEMIN)[2 * i + 1];
            ((GAS v4u*)MEM16)[i] = (v4u){pk2(a.x, a.y), pk2(a.z, a.w), pk2(c.x, c.y), pk2(c.z, c.w)};
        }
    }
    SEAM(0);
    REP(1) if (IN(1)) { REPBAR(); WSP_DECL;
        pg8::Gemm g{(const bf16*)X8, (const bf16*)WUP1q, T, NUP, DM / 2}; pg8::StaticOrder S; S.init(T, NUP, G, bx);
        pg8::EpiSwigluI8 E{G8, FF, SX1, GQ1, QS + 1};
        pg8::gemm_phase<pg8::EpiSwigluI8, pg8::StaticOrder, true, true, true>(L + RING_OFF, g, S, E);
    }
    SEAM(1);
    REP(2) if (IN(2)) { REPBAR(); WSP_DECL;
        pg8::Gemm g{(const bf16*)G8, (const bf16*)WDN1q, T, DM, FF / 2}; pg8::StaticOrder S; S.init(T, DM, G, bx);
        pg8::EpiResI8<false> E{R, XIN, DM, ALPHA, 0.5f, SG1, QS + 4};
        pg8::gemm_phase<pg8::EpiResI8<false>, pg8::StaticOrder, true, true, true>(L + RING_OFF, g, S, E);
    }
    SEAM(2);
    REP(3) if (IN(3)) { REPBAR(); WSP_DECL; for (int m = gw; m < T; m += NGW) ln_row<true, true>(R + (size_t)m * DM, ap->in[4], ap->in[5], H1 + (size_t)m * DM, lane, H1q + (size_t)m * DM, SXH + m, DQ0 + m, DQ1 + m, 0.f); }
    SEAM(3);
    REP(4) if (IN(4)) { REPBAR(); WSP_DECL;
        { pg8::Gemm g{H1, WIN, T, NZB, DM}; pg8::OrderZ S; S.so.init(T, NZB, G, bx);
          pg8::EpiZ E{Q16, KI16, KM, WI};
          pg8::gemm_phase<pg8::EpiZ, pg8::OrderZ, true, true>(L + RING_OFF, g, S, E); }
        { pg8::Gemm g{(const bf16*)H1q, (const bf16*)WINq, T, NZQ, DM / 2}; pg8::OrderQ S; S.so.init(T, NZQ, G, bx); S.heavy = (32 * (NZB / 256) + 8) - 2 * G;
          pg8::EpiZq E{U16, ap->in[7], SXH, QS + 17};
          pg8::gemm_phase<pg8::EpiZq, pg8::OrderQ, true, true, true>(L + RING_OFF, g, S, E); }
    }
    SEAM(4);
    REP(5) if (IN(5)) { REPBAR(); WSP_DECL;
        for (int pp = vcu; pp < 256; pp += G) {
            const int b = pp >> 7, p = pp & 127;
#pragma unroll 1
            for (int k2 = 0; k2 < 2; ++k2) indexer_unit(L + RING_OFF, b, k2 ? 255 - p : p, QI16, KI16, WI, MASKQ);
        }
        __syncthreads();
    }
    SEAM(5);
    REP(6) if (IN(6)) { REPBAR(); WSP_DECL;
        const int xcd = bx & 7, ix = bx >> 3;
        if (ix < 32) {
            const int bh = xcd * 2 + (ix >> 4), qb = ix & 15, b = bh >> 3, hh = bh & 7;
            const size_t rowbase = (size_t)b * SEQ;
            const float ah = exp2f(-(float)(hh + 1)) * 11.313708498984761f;
            att::attn_block<1024, 2048, true>((const att::bf16*)(Q16 + (rowbase + qb * 256) * 1024 + hh * 128), (const att::bf16*)(K16 + rowbase * 1024 + hh * 128),
                                        (const att::bf16*)(V16 + rowbase * 1024 + hh * 128), (att::bf16*)(A16 + (rowbase + qb * 256) * 2048 + hh * 128),
                                        4 * (qb + 1), qb * 256, MASKQ + rowbase * 128, ah, (char*)lds + RING_OFF);
            if (qb < 8) { const int mi = bh * 8 + qb;
                const int mb = mi >> 6, mh = (mi >> 4) & 3, mq = mi & 15; const size_t mrow = (size_t)mb * SEQ + mq * 256;
                att::attn_block<512, 2048, false>((const att::bf16*)(QM16 + mrow * 512 + mh * 128), (const att::bf16*)(KM + (size_t)mb * MEMLEN * 512 + mh * 128),
                                            (const att::bf16*)(VM + (size_t)mb * MEMLEN * 512 + mh * 128), (att::bf16*)(M16 + mrow * 2048 + mh * 128),
                                            MEMLEN / 64, 0, nullptr, 0.f, (char*)lds + RING_OFF); }
            if (qb < 4) { for (int task = (bh * 4 + qb) * NWAVES + wave; task < 1024; task += 512) pool_task(task, U16, WPT, ap->in[10], P16, lane); }
        }
    }
    SEAM(6);
    REP(7) if (IN(7)) { REPBAR(); WSP_DECL;
        pg8::StaticOrder S; S.init(T, DM, G, bx);
        { pg8::Gemm g{A16, WBA, T, DM, DM}; pg8::OrderBr SB; SB.so = S; pg8::EpiBranch E{Y16, GATE}; pg8::gemm_phase<pg8::EpiBranch, pg8::OrderBr, true, true>(L + RING_OFF, g, SB, E); }
    }
    SEAM(7);
    REP(8) if (IN(8)) { REPBAR(); WSP_DECL;
        pg8::Gemm g{Y16, WOUT, T, DM, DM}; pg8::StaticOrder S; S.init(T, DM, G, bx);
        pg8::EpiRes<true> E{R, H1, DM, ALPHA, 1.0f};
        pg8::gemm_phase<pg8::EpiRes<true>, pg8::StaticOrder, true, true>(L + RING_OFF, g, S, E);
    }
    SEAM(8);
    REP(9) if (IN(9)) { REPBAR(); WSP_DECL; const float sig2 = QS[10]; for (int m = gw; m < T; m += NGW) ln_row<true, true>(R + (size_t)m * DM, ap->in[15], ap->in[16], H2 + (size_t)m * DM, lane, H2q + (size_t)m * DM, SX2 + m, GQ2 + m, SG2 + m, sig2); }
    SEAM(9);
    REP(10) if (IN(10)) { REPBAR(); WSP_DECL;
        pg8::Gemm g{(const bf16*)H2q, (const bf16*)WUP2q, T, NUP, DM / 2}; pg8::StaticOrder S; S.init(T, NUP, G, bx);
        pg8::EpiSwigluI8 E{G28, FF, SX2, GQ2, QS + 9};
        pg8::gemm_phase<pg8::EpiSwigluI8, pg8::StaticOrder, true, true, true>(L + RING_OFF, g, S, E);
    }
    SEAM(10);
    REP(11) if (IN(11)) { REPBAR(); WSP_DECL;
        pg8::Gemm g{(const bf16*)G28, (const bf16*)WDN2q, T, DM, FF / 2}; pg8::StaticOrder S; S.init(T, DM, G, bx);
        pg8::EpiResI8<true> E{R, H2, DM, ALPHA, 0.5f, SG2, QS + 12};
        pg8::gemm_phase<pg8::EpiResI8<true>, pg8::StaticOrder, true, true, true>(L + RING_OFF, g, S, E);
    }
    SEAM(11);
    REP(12) if (IN(12)) { REPBAR(); WSP_DECL; for (int m = gw; m < T; m += NGW) ln_row<false>(R + (size_t)m * DM, ap->in[19], ap->in[20], R + (size_t)m * DM, lane); }
#undef BIG
#undef X16
#undef WUP1
#undef WDN1
#undef Gb
#undef Q16
#undef K16
#undef V16
#undef QI16
#undef KI16
#undef WI
#undef U16
#undef QM16
#undef GATE
#undef WIN
#undef WMKV
#undef WBA
#undef WBP
#undef WBM
#undef WOUT
#undef WUP2
#undef WDN2
#undef WPT
#undef H1
#undef MEM16
#undef A16
#undef P16
#undef M16
#undef H2
#undef Y16
#undef KM
#undef VM
#undef MASKQ
#undef X8
#undef WUP1q
#undef WDN1q
#undef G8
#undef WUP2q
#undef WDN2q
#undef H2q
#undef G28
#undef QS
#undef SX1
#undef GQ1
#undef SG1
#undef SX2
#undef GQ2
#undef SG2
#undef SXH
#undef DQ0
#undef DQ1
#undef H1q
#undef WINq
#undef R
#undef XIN
#undef MEMIN
#undef WSP_DECL
#undef IN
#undef SEAM
}

extern "C" void kernel_launch(void* const* d_in, const int* in_sizes, int n_in, void* d_out, int out_size, void* d_ws, size_t ws_size, hipStream_t stream) {
    static int grid = 0;
    if (grid == 0) {
        if (n_in != 21 || in_sizes[0] != T * DM || out_size != T * DM || ws_size < WS_END) {
            fprintf(stderr, "kernel_launch: shape/workspace mismatch (n_in %d, in0 %d, out %d, ws %zu, need %zu); nothing launched\n", n_in, n_in > 0 ? in_sizes[0] : -1, out_size, ws_size, (size_t)WS_END);
            grid = -1; return; }
        int dev = 0, cus = 0;
        if (hipGetDevice(&dev) != hipSuccess || hipDeviceGetAttribute(&cus, hipDeviceAttributeMultiprocessorCount, dev) != hipSuccess) { grid = -1; return; }
        if (hipFuncSetAttribute((const void*)mk_fwd, hipFuncAttributeMaxDynamicSharedMemorySize, LDS_BYTES) != hipSuccess) { fprintf(stderr, "kernel_launch: hipFuncSetAttribute failed\n"); grid = -1; return; }
        (void)hipGetLastError();
        grid = cus;
        if (grid != 256) fprintf(stderr, "kernel_launch: %d CUs (built for 256)\n", grid);
    }
    if (grid < 0) return;
    if (hipMemsetAsync((char*)d_ws + WS_CTL, 0, CTL_ZERO_BYTES, stream) != hipSuccess) return;
    Args a{};
    for (int i = 0; i < 21; ++i) a.in[i] = (const float*)d_in[i];
    a.out = (float*)d_out; a.ws = (unsigned char*)d_ws;
#if MK_PER_PHASE
    for (int p = 0; p < N_PHASES; ++p) { a.ph_lo = p; a.ph_hi = p + 1; hipLaunchKernelGGL(mk_fwd, dim3(grid), dim3(NWAVES * 64), LDS_BYTES, stream, a); }
#else
    a.ph_lo = 0; a.ph_hi = N_PHASES;
    hipLaunchKernelGGL(mk_fwd, dim3(grid), dim3(NWAVES * 64), LDS_BYTES, stream, a);
#endif
}
```

```cpp
#include <hip/hip_runtime.h>
#include <hip/hip_bf16.h>
#include <cstdio>
#include <cstdint>

#ifndef MK_PER_PHASE
#define MK_PER_PHASE 0
#endif

namespace pg8 {
#define PG8_LAS __attribute__((address_space(3)))
typedef unsigned short bf16_t;
typedef short bf16x8 __attribute__((ext_vector_type(8)));
typedef float f32x4 __attribute__((ext_vector_type(4)));
typedef float f32x2 __attribute__((ext_vector_type(2)));
typedef unsigned u32x4 __attribute__((ext_vector_type(4)));
typedef unsigned u32x2 __attribute__((ext_vector_type(2)));
typedef int i32x4 __attribute__((ext_vector_type(4)));
template <bool I8> struct AccSel { typedef f32x4 type; };
template <> struct AccSel<true> { typedef i32x4 type; };
constexpr int BM = 256, BK = 64, HALF = 128, HTB = HALF * BK * 2, STAGE_BYTES = 8 * HTB, NXCD = 8, WGM = 8;

__host__ __device__ __forceinline__ int lds_byte(int r, int c) { const int st = (r >> 4) * 2 + (c >> 5), rr = r & 15, cc = c & 31, ob = rr * 64 + cc * 2; return st * 1024 + (ob ^ (((ob >> 9) & 1) << 5)); }
__host__ __device__ __forceinline__ void stage_rc(int b, int& R, int& C) { const int st = b / 1024, sb = b % 1024, swz = sb ^ (((sb >> 9) & 1) << 5); R = (st >> 1) * 16 + swz / 64; C = (st & 1) * 32 + (swz % 64) / 2; }
__host__ __device__ __forceinline__ int perm32(int rho) { const int n = rho >> 4, i = rho & 15; return 8 * (i >> 2) + 4 * n + (i & 3); }

struct Unit { int pm, pn, ko, nt, br; };
struct Gemm { const bf16_t* A; const bf16_t* Bt; int M, N, K; };

struct StaticOrder {
    int nM, nN, nwg, G, c;
    __host__ __device__ void init(int M, int N, int G_, int c_) { nM = M / BM; nN = N / BM; nwg = nM * nN; G = G_; c = c_; }
    __host__ __device__ bool next(int i, Unit& u) const {
        const long L = (long)i * G + c; if (L >= nwg) return false;
        int wgid = (int)L; { const int q = nwg / NXCD, r = nwg % NXCD, xcd = wgid % NXCD, off = wgid / NXCD; wgid = (xcd < r ? xcd * (q + 1) : r * (q + 1) + (xcd - r) * q) + off; }
        const int nig = WGM * nN, gid = wgid / nig, fm = gid * WGM, gsz = (nM - fm) < WGM ? (nM - fm) : WGM;
        u.pm = fm + ((wgid % nig) % gsz); u.pn = (wgid % nig) / gsz; u.ko = 0; u.nt = 0; u.br = 0; return true;
    }
    __device__ __forceinline__ void a_ready(const Unit&) const {}
    __device__ __forceinline__ void done(const Unit&) const {}
};
struct OrderZ {
    StaticOrder so;
    __device__ __forceinline__ bool next(int i, Unit& u) const {
        const long L = (long)i * so.G + so.c;
        if (L < so.nwg) return so.next(i, u);
        if (L < so.nwg + 8) { const int e = (int)(L - so.nwg); u.pm = 32 + (e >> 2); u.pn = so.nN + (e & 3); u.ko = 0; u.nt = 0; u.br = 0; return true; }
        return false;
    }
    __device__ __forceinline__ void a_ready(const Unit&) const {}
    __device__ __forceinline__ void done(const Unit&) const {}
};
struct OrderQ {
    StaticOrder so; int heavy;
    __device__ __forceinline__ bool next(int i, Unit& u) const {
        const int c = so.c, nl = so.G - heavy; long L;
        if (c >= heavy) { if (i >= 4) return false; L = (long)i * nl + (c - heavy); if (L >= 4L * nl) return false; }
        else { if (i >= 1) return false; L = 4L * nl + c; }
        if (L >= so.nwg) return false;
        int wgid = (int)L; { const int q = so.nwg / NXCD, r = so.nwg % NXCD, xcd = wgid % NXCD, off = wgid / NXCD; wgid = (xcd < r ? xcd * (q + 1) : r * (q + 1) + (xcd - r) * q) + off; }
        const int nig = WGM * so.nN, gid = wgid / nig, fm = gid * WGM, gsz = (so.nM - fm) < WGM ? (so.nM - fm) : WGM;
        u.pm = fm + ((wgid % nig) % gsz); u.pn = (wgid % nig) / gsz; u.ko = 0; u.nt = 0; u.br = 0; return true;
    }
    __device__ __forceinline__ void a_ready(const Unit&) const {}
    __device__ __forceinline__ void done(const Unit&) const {}
};
struct OrderBr {
    StaticOrder so;
    __device__ __forceinline__ bool next(int i, Unit& u) const {
        const int ti = i / 3, br = i - 3 * ti;
        if (!so.next(ti, u)) return false;
        u.br = br; u.ko = br == 0 ? 0 : (br == 1 ? 1024 : 1536); u.nt = br == 0 ? 16 : 8; return true;
    }
    __device__ __forceinline__ void a_ready(const Unit&) const {}
    __device__ __forceinline__ void done(const Unit&) const {}
};

__device__ __forceinline__ unsigned cvt_pk_bf16(float lo, float hi) { unsigned r; asm volatile("v_cvt_pk_bf16_f32 %0, %1, %2" : "=v"(r) : "v"(lo), "v"(hi)); return r; }
__device__ __forceinline__ float bf_lo(unsigned w) { return __uint_as_float(w << 16); }
__device__ __forceinline__ float bf_hi(unsigned w) { return __uint_as_float(w & 0xffff0000u); }
__device__ __forceinline__ float sigmoidf_(float x) { return __builtin_amdgcn_rcpf(1.0f + __builtin_amdgcn_exp2f(-1.4426950408889634f * x)); }

struct EpiSwiglu {
    static constexpr bool PERM = true, AFTER_DRAIN = false, CHAIN = false;
    bf16_t* G; int ldg;
    __device__ __forceinline__ void operator()(const f32x4 (&acc)[2][2][4][2], const Unit& u, int wr, int wc, int fr, int fq) const {
        const int row0 = u.pm * BM + wr * 64 + fr, col0 = u.pn * HALF + wc * 32 + 8 * fq;
#pragma unroll
        for (int ai = 0; ai < 2; ++ai)
#pragma unroll
            for (int m = 0; m < 4; ++m) {
                bf16_t* rowp = G + (size_t)(row0 + ai * HALF + m * 16) * ldg + col0;
                float g[8];
#pragma unroll
                for (int n = 0; n < 2; ++n)
#pragma unroll
                    for (int e = 0; e < 4; ++e) { const float a = acc[ai][0][m][n][e], uu = acc[ai][1][m][n][e]; g[n * 4 + e] = a * uu * sigmoidf_(a); }
                u32x4 w; w.x = cvt_pk_bf16(g[0], g[1]); w.y = cvt_pk_bf16(g[2], g[3]); w.z = cvt_pk_bf16(g[4], g[5]); w.w = cvt_pk_bf16(g[6], g[7]);
                *(u32x4*)rowp = w;
            }
    }
};
struct EpiSwigluI8 {
    static constexpr bool PERM = true, AFTER_DRAIN = false, CHAIN = false;
    signed char* G; int ldg; const float* sx; const float* gq; const float* wdq;
    __device__ __forceinline__ void operator()(const i32x4 (&acc)[2][2][4][2], const Unit& u, int wr, int wc, int fr, int fq) const {
        const int row0 = u.pm * BM + wr * 64 + fr, col0 = u.pn * HALF + wc * 32 + 8 * fq;
        const float wd = *wdq;
#pragma unroll
        for (int ai = 0; ai < 2; ++ai)
#pragma unroll
            for (int m = 0; m < 4; ++m) {
                const int row = row0 + ai * HALF + m * 16;
                const float sa = sx[row] * wd, gm = gq[row];
                unsigned w[2];
#pragma unroll
                for (int n = 0; n < 2; ++n) { int q[4];
#pragma unroll
                    for (int e = 0; e < 4; ++e) { const float a = (float)acc[ai][0][m][n][e] * sa, uu = (float)acc[ai][1][m][n][e] * sa; const float g = a * uu * sigmoidf_(a);
                        q[e] = (int)__builtin_rintf(fminf(fmaxf(g * gm, -127.f), 127.f)); }
                    w[n] = (unsigned)(q[0] & 255) | ((unsigned)(q[1] & 255) << 8) | ((unsigned)(q[2] & 255) << 16) | ((unsigned)q[3] << 24); }
                *(u32x2*)(G + (size_t)row * ldg + col0) = (u32x2){w[0], w[1]};
            }
    }
};
template <bool RESBF> struct EpiResI8 {
    static constexpr bool PERM = false, AFTER_DRAIN = false, CHAIN = false;
    float* out; const void* res; int ldc; float alpha, sc; const float* sg; const float* wdq;
    __device__ __forceinline__ void operator()(const i32x4 (&acc)[2][2][4][2], const Unit& u, int wr, int wc, int fr, int fq) const {
        const int row0 = u.pm * BM + wr * 64 + fr, col0 = u.pn * BM + wc * 32 + 4 * fq;
        const float wd = *wdq * sc;
#pragma unroll
        for (int ai = 0; ai < 2; ++ai)
#pragma unroll
            for (int m = 0; m < 4; ++m) { const int row = row0 + ai * HALF + m * 16; const size_t off = (size_t)row * ldc + col0; const float s = sg[row] * wd;
#pragma unroll
                for (int bj = 0; bj < 2; ++bj)
#pragma unroll
                    for (int n = 0; n < 2; ++n) { const size_t o = off + bj * HALF + n * 16; f32x4 r;
                        if (RESBF) { const u32x2 w = *(const u32x2*)((const bf16_t*)res + o); r = (f32x4){bf_lo(w.x), bf_hi(w.x), bf_lo(w.y), bf_hi(w.y)}; }
                        else r = *(const f32x4*)((const float*)res + o);
                        const i32x4 a = acc[ai][bj][m][n];
                        *(f32x4*)(out + o) = r * alpha + (f32x4){(float)a[0], (float)a[1], (float)a[2], (float)a[3]} * s; } }
    }
};
template <bool RESBF> struct EpiRes {
    static constexpr bool PERM = false, AFTER_DRAIN = false, CHAIN = false;
    float* out; const void* res; int ldc; float alpha, sc;
    __device__ __forceinline__ void operator()(const f32x4 (&acc)[2][2][4][2], const Unit& u, int wr, int wc, int fr, int fq) const {
        const int row0 = u.pm * BM + wr * 64 + fr, col0 = u.pn * BM + wc * 32 + 4 * fq;
#pragma unroll
        for (int ai = 0; ai < 2; ++ai)
#pragma unroll
            for (int m = 0; m < 4; ++m) { const size_t off = (size_t)(row0 + ai * HALF + m * 16) * ldc + col0;
#pragma unroll
                for (int bj = 0; bj < 2; ++bj)
#pragma unroll
                    for (int n = 0; n < 2; ++n) { const size_t o = off + bj * HALF + n * 16; f32x4 r;
                        if (RESBF) { const u32x2 w = *(const u32x2*)((const bf16_t*)res + o); r = (f32x4){bf_lo(w.x), bf_hi(w.x), bf_lo(w.y), bf_hi(w.y)}; }
                        else r = *(const f32x4*)((const float*)res + o);
                        *(f32x4*)(out + o) = r * alpha + acc[ai][bj][m][n] * sc; } }
    }
};
struct EpiBranch {
    static constexpr bool PERM = false, AFTER_DRAIN = false, CHAIN = true;
    bf16_t* Y16; const bf16_t* gate;
    __device__ __forceinline__ bool chain(f32x4 (&acc)[2][2][4][2], const Unit& u, int wr, int wc, int fr, int fq) const {
        const int row0 = u.pm * BM + wr * 64 + fr, col0 = u.pn * BM + wc * 32 + 4 * fq, br = u.br;
        const float FL = 8.673617379884035e-19f;
#pragma unroll
        for (int ai = 0; ai < 2; ++ai)
#pragma unroll
            for (int m = 0; m < 4; ++m) { const size_t row = (size_t)(row0 + ai * HALF + m * 16);
#pragma unroll
                for (int bj = 0; bj < 2; ++bj)
#pragma unroll
                    for (int n = 0; n < 2; ++n) { const int col = col0 + bj * HALF + n * 16;
                        const u32x2 w = *(const u32x2*)(gate + row * 6144 + br * 2048 + col);
                        f32x4 g = (f32x4){fmaxf(bf_lo(w.x), FL), fmaxf(bf_hi(w.x), FL), fmaxf(bf_lo(w.y), FL), fmaxf(bf_hi(w.y), FL)};
                        if (br < 2) { const u32x2 w2 = *(const u32x2*)(gate + row * 6144 + (br + 1) * 2048 + col);
                            g[0] *= __builtin_amdgcn_rcpf(fmaxf(bf_lo(w2.x), FL)); g[1] *= __builtin_amdgcn_rcpf(fmaxf(bf_hi(w2.x), FL));
                            g[2] *= __builtin_amdgcn_rcpf(fmaxf(bf_lo(w2.y), FL)); g[3] *= __builtin_amdgcn_rcpf(fmaxf(bf_hi(w2.y), FL));
                            acc[ai][bj][m][n] *= g; }
                        else { const f32x4 v = acc[ai][bj][m][n] * g; u32x2 o; o.x = cvt_pk_bf16(v[0], v[1]); o.y = cvt_pk_bf16(v[2], v[3]); *(u32x2*)(Y16 + row * 2048 + col) = o; } } }
        return br < 2;
    }
};
struct EpiZ {
    static constexpr bool PERM = true, AFTER_DRAIN = false, CHAIN = false;
    bf16_t *Q, *KI, *KM; float* WI;
    __device__ __forceinline__ void operator()(const f32x4 (&acc)[2][2][4][2], const Unit& u, int wr, int wc, int fr, int fq) const {
        const int pn = u.pn;
        bf16_t* base; int ld, ct = 0, mode = 0, rowoff = 0;
        if (pn < 16) { base = Q + (size_t)(pn >> 2) * ((size_t)8192 * 1024); ld = 1024; ct = pn & 3; }
        else if (pn == 16) { base = KI; ld = 64; mode = 2; }
        else { base = KM + (size_t)((pn - 17) >> 1) * (512 * 512); ld = 512; ct = (pn - 17) & 1; rowoff = 8192; }
        const int row0 = u.pm * BM + wr * 64 + fr - rowoff, cl = wc * 32 + 8 * fq;
        if (mode == 2) {
#pragma unroll
            for (int ai = 0; ai < 2; ++ai)
#pragma unroll
                for (int m = 0; m < 4; ++m) { const size_t row = (size_t)(row0 + ai * HALF + m * 16);
                    const f32x4 v0 = acc[ai][0][m][0], v1 = acc[ai][0][m][1];
                    if (cl < 64) { u32x4 w; w.x = cvt_pk_bf16(v0[0], v0[1]); w.y = cvt_pk_bf16(v0[2], v0[3]); w.z = cvt_pk_bf16(v1[0], v1[1]); w.w = cvt_pk_bf16(v1[2], v1[3]); *(u32x4*)(KI + row * 64 + cl) = w; }
                    else if (cl < 80) { const float s = 1.0f / 32.0f;
                        *(f32x4*)(WI + row * 16 + (cl - 64)) = v0 * s; *(f32x4*)(WI + row * 16 + (cl - 64) + 4) = v1 * s; } }
            return;
        }
        const int col0 = ct * BM + cl;
#pragma unroll
        for (int ai = 0; ai < 2; ++ai)
#pragma unroll
            for (int m = 0; m < 4; ++m) { bf16_t* rowp = base + (size_t)(row0 + ai * HALF + m * 16) * ld + col0;
#pragma unroll
                for (int bj = 0; bj < 2; ++bj) { const f32x4 v0 = acc[ai][bj][m][0], v1 = acc[ai][bj][m][1];
                    u32x4 w; w.x = cvt_pk_bf16(v0[0], v0[1]); w.y = cvt_pk_bf16(v0[2], v0[3]); w.z = cvt_pk_bf16(v1[0], v1[1]); w.w = cvt_pk_bf16(v1[2], v1[3]);
                    *(u32x4*)(rowp + bj * HALF) = w; } }
    }
};
struct EpiZq {
    static constexpr bool PERM = true, AFTER_DRAIN = false, CHAIN = false;
    bf16_t *U; const float* bgate; const float* sx; const float* wdq;
    __device__ __forceinline__ void operator()(const i32x4 (&acc)[2][2][4][2], const Unit& u, int wr, int wc, int fr, int fq) const {
        const int pn = u.pn; const bool gate = pn >= 4;
        bf16_t* base = U + (size_t)(gate ? 2 : (pn >> 1)) * ((size_t)8192 * 512);
        const int ld = gate ? 6144 : 512, ct = gate ? pn - 4 : (pn & 1);
        const int row0 = u.pm * BM + wr * 64 + fr, col0 = ct * BM + wc * 32 + 8 * fq;
        const float wd = *wdq;
        f32x4 bv[2][2];
#pragma unroll
        for (int bj = 0; bj < 2; ++bj)
#pragma unroll
            for (int n = 0; n < 2; ++n) bv[bj][n] = gate ? *(const f32x4*)(bgate + col0 + bj * HALF + 4 * n) : (f32x4){0.f, 0.f, 0.f, 0.f};
#pragma unroll
        for (int ai = 0; ai < 2; ++ai)
#pragma unroll
            for (int m = 0; m < 4; ++m) { const int row = row0 + ai * HALF + m * 16; bf16_t* rowp = base + (size_t)row * ld + col0; const float sa = sx[row] * wd;
#pragma unroll
                for (int bj = 0; bj < 2; ++bj) { const i32x4 a0 = acc[ai][bj][m][0], a1 = acc[ai][bj][m][1];
                    f32x4 v0 = (f32x4){(float)a0[0], (float)a0[1], (float)a0[2], (float)a0[3]} * sa + bv[bj][0], v1 = (f32x4){(float)a1[0], (float)a1[1], (float)a1[2], (float)a1[3]} * sa + bv[bj][1];
                    if (gate) {
#pragma unroll
                        for (int e = 0; e < 4; ++e) { v0[e] = sigmoidf_(v0[e]); v1[e] = sigmoidf_(v1[e]); } }
                    u32x4 w; w.x = cvt_pk_bf16(v0[0], v0[1]); w.y = cvt_pk_bf16(v0[2], v0[3]); w.z = cvt_pk_bf16(v1[0], v1[1]); w.w = cvt_pk_bf16(v1[2], v1[3]);
                    *(u32x4*)(rowp + bj * HALF) = w; } }
    }
};

template <class Epi, class Sched, bool ALIGN_EPI = false, bool SP2 = false, bool I8 = false>
__device__ __forceinline__ void gemm_phase(PG8_LAS unsigned char* lds, const Gemm g, const Sched& S, const Epi& E) {
    int tid_ = threadIdx.x; asm volatile("" : "+v"(tid_));
    const int tid = tid_, wid = __builtin_amdgcn_readfirstlane(tid >> 6), lane = tid & 63, wr = wid >> 2, wc = wid & 3, fr = lane & 15, fq = lane >> 4;
    const int K = g.K, nt = K / BK;
    unsigned voffA[2], voffB[2];
#pragma unroll
    for (int i = 0; i < 2; ++i) { int R, C; stage_rc(tid * 16 + i * 8192, R, C); const int Rb = Epi::PERM ? ((R & ~31) + perm32(R & 31)) : R;
        voffA[i] = (unsigned)(R * K + C) * 2u; voffB[i] = (unsigned)(Rb * K + C) * 2u; }
    const size_t kstep = (size_t)(BK * 2);
    const size_t hstep = (size_t)HALF * K * 2;
    const size_t tstep = 2 * hstep;
    const unsigned ldsw = (unsigned)wid * 1024u;
    const int aoff = lds_byte(wr * 64 + fr, fq * 8), boff = lds_byte(wc * 32 + fr, fq * 8);
#define PG8_SA(b, h) (((b) * 2 + (h)) * HTB)
#define PG8_SB(b, h) ((4 + (b) * 2 + (h)) * HTB)
#define PG8_STAGE(bufoff, gbase, voff) do { _Pragma("unroll") for (int _i = 0; _i < 2; ++_i) \
        __builtin_amdgcn_global_load_lds((const unsigned*)((const char*)(gbase) + (voff)[_i]), (PG8_LAS unsigned*)(lds + (bufoff) + ldsw + _i * 8192), 16, 0, 0); } while (0)
#define PG8_LDA(dst, b, h) do { _Pragma("unroll") for (int m = 0; m < 4; ++m) _Pragma("unroll") for (int k = 0; k < 2; ++k) dst[m][k] = *(const PG8_LAS bf16x8*)(lds + PG8_SA(b, h) + aoff + m * 2048 + k * 1024); } while (0)
#define PG8_LDB(dst, b, h) do { _Pragma("unroll") for (int n = 0; n < 2; ++n) _Pragma("unroll") for (int k = 0; k < 2; ++k) dst[n][k] = *(const PG8_LAS bf16x8*)(lds + PG8_SB(b, h) + boff + n * 2048 + k * 1024); } while (0)
#define PG8_MMA(ai, bj, At, Bt) do { __builtin_amdgcn_s_setprio(1); _Pragma("unroll") for (int m = 0; m < 4; ++m) _Pragma("unroll") for (int n = 0; n < 2; ++n) _Pragma("unroll") for (int k = 0; k < 2; ++k) \
        { if constexpr (I8) acc[ai][bj][m][n] = __builtin_amdgcn_mfma_i32_16x16x64_i8(__builtin_bit_cast(i32x4, Bt[n][k]), __builtin_bit_cast(i32x4, At[m][k]), acc[ai][bj][m][n], 0, 0, 0); \
          else acc[ai][bj][m][n] = __builtin_amdgcn_mfma_f32_16x16x32_bf16(Bt[n][k], At[m][k], acc[ai][bj][m][n], 0, 0, 0); } __builtin_amdgcn_s_setprio(0); } while (0)
#define PG8_WAIT_V(n) asm volatile("s_waitcnt vmcnt(" #n ")" ::: "memory")
#define PG8_WAIT_L(n) asm volatile("s_waitcnt lgkmcnt(" #n ")" ::: "memory")
#define PG8_BAR __builtin_amdgcn_s_barrier()
#define PG8_SCHED __builtin_amdgcn_sched_barrier(0)
    Unit cur, nxt; int ui = 0;
    if (!S.next(0, cur)) return;
    typedef typename AccSel<I8>::type acc_t;
    acc_t acc[2][2][4][2];
#pragma unroll
    for (int a = 0; a < 2; ++a)
#pragma unroll
        for (int b = 0; b < 2; ++b)
#pragma unroll
            for (int m = 0; m < 4; ++m)
#pragma unroll
                for (int n = 0; n < 2; ++n) acc[a][b][m][n] = acc_t{};
    bf16x8 At[4][2], B0[2][2], B1[2][2];
    const char* cA = (const char*)g.A + (size_t)cur.pm * tstep + (size_t)cur.ko * 2; const char* cB = (const char*)g.Bt + (size_t)cur.pn * tstep + (size_t)cur.ko * 2;
    int ntc = cur.nt ? cur.nt : nt;
    S.a_ready(cur);
    if constexpr (SP2) {
        PG8_STAGE(PG8_SB(0, 0), cB, voffB); PG8_STAGE(PG8_SB(0, 1), cB + hstep, voffB); PG8_STAGE(PG8_SA(0, 0), cA, voffA); PG8_STAGE(PG8_SA(0, 1), cA + hstep, voffA);
        if (wr == 1) PG8_BAR;
        PG8_WAIT_V(2); PG8_BAR;
        PG8_STAGE(PG8_SB(1, 0), cB + kstep, voffB); PG8_STAGE(PG8_SA(1, 0), cA + kstep, voffA); PG8_STAGE(PG8_SB(1, 1), cB + hstep + kstep, voffB);
        PG8_WAIT_V(6); PG8_BAR;
    } else {
        PG8_STAGE(PG8_SB(0, 0), cB, voffB); PG8_STAGE(PG8_SA(0, 0), cA, voffA); PG8_STAGE(PG8_SB(0, 1), cB + hstep, voffB); PG8_STAGE(PG8_SA(0, 1), cA + hstep, voffA);
        if (wr == 1) PG8_BAR;
        PG8_WAIT_V(4); PG8_BAR;
        PG8_STAGE(PG8_SB(1, 0), cB + kstep, voffB); PG8_STAGE(PG8_SA(1, 0), cA + kstep, voffA); PG8_STAGE(PG8_SB(1, 1), cB + hstep + kstep, voffB);
        PG8_WAIT_V(6); PG8_BAR;
    }
    for (;;) {
        const bool has_next = S.next(ui + 1, nxt);
        const char* nA = has_next ? (const char*)g.A + (size_t)nxt.pm * tstep + (size_t)nxt.ko * 2 : cA; const char* nB = has_next ? (const char*)g.Bt + (size_t)nxt.pn * tstep + (size_t)nxt.ko * 2 : cB;
        for (int t = 0; t < ntc; t += 2) {
            const bool last = (t == ntc - 2);
            const char* a1 = cA + (size_t)(t + 1) * kstep;
            const char* a2 = last ? nA : cA + (size_t)(t + 2) * kstep; const char* b2 = last ? nB : cB + (size_t)(t + 2) * kstep;
            const char* a3 = a2 + kstep; const char* b3 = b2 + kstep;
            if (last && has_next) S.a_ready(nxt);
            if constexpr (SP2) {
            PG8_LDB(B0, 0, 0); PG8_LDB(B1, 0, 1); PG8_SCHED; PG8_LDA(At, 0, 0); PG8_STAGE(PG8_SA(1, 1), a1 + hstep, voffA);
            PG8_WAIT_V(8); PG8_WAIT_L(0); PG8_BAR; PG8_MMA(0, 0, At, B0); PG8_MMA(0, 1, At, B1); PG8_BAR; PG8_SCHED;
            PG8_LDA(At, 0, 1); PG8_STAGE(PG8_SB(0, 0), b2, voffB); PG8_STAGE(PG8_SB(0, 1), b2 + hstep, voffB); PG8_STAGE(PG8_SA(0, 0), a2, voffA);
            PG8_WAIT_V(8); PG8_WAIT_L(0); PG8_BAR; PG8_MMA(1, 0, At, B0); PG8_MMA(1, 1, At, B1); PG8_BAR; PG8_SCHED;
            PG8_LDB(B0, 1, 0); PG8_LDB(B1, 1, 1); PG8_SCHED; PG8_LDA(At, 1, 0); PG8_STAGE(PG8_SA(0, 1), a2 + hstep, voffA);
            PG8_WAIT_V(8); PG8_WAIT_L(0); PG8_BAR; PG8_MMA(0, 0, At, B0); PG8_MMA(0, 1, At, B1); PG8_BAR; PG8_SCHED;
            PG8_LDA(At, 1, 1); PG8_STAGE(PG8_SB(1, 0), b3, voffB); PG8_STAGE(PG8_SB(1, 1), b3 + hstep, voffB); PG8_STAGE(PG8_SA(1, 0), a3, voffA);
            PG8_WAIT_V(8); PG8_WAIT_L(0); PG8_BAR; PG8_MMA(1, 0, At, B0); PG8_MMA(1, 1, At, B1); PG8_BAR; PG8_SCHED;
            } else {
            PG8_LDB(B0, 0, 0); PG8_SCHED; PG8_LDA(At, 0, 0); PG8_STAGE(PG8_SA(1, 1), a1 + hstep, voffA);
            PG8_WAIT_L(8); PG8_BAR; PG8_WAIT_L(0); PG8_MMA(0, 0, At, B0); PG8_BAR; PG8_SCHED;
            PG8_LDB(B1, 0, 1); PG8_STAGE(PG8_SB(0, 0), b2, voffB);
            PG8_BAR; PG8_WAIT_L(0); PG8_MMA(0, 1, At, B1); PG8_BAR;
            PG8_LDA(At, 0, 1); PG8_STAGE(PG8_SA(0, 0), a2, voffA);
            PG8_BAR; PG8_WAIT_L(0); PG8_MMA(1, 0, At, B0); PG8_BAR; PG8_SCHED;
            PG8_STAGE(PG8_SB(0, 1), b2 + hstep, voffB);
            PG8_WAIT_V(6); PG8_BAR; PG8_MMA(1, 1, At, B1); PG8_BAR;
            PG8_LDB(B0, 1, 0); PG8_SCHED; PG8_LDA(At, 1, 0); PG8_STAGE(PG8_SA(0, 1), a2 + hstep, voffA);
            PG8_WAIT_L(8); PG8_BAR; PG8_WAIT_L(0); PG8_MMA(0, 0, At, B0); PG8_BAR; PG8_SCHED;
            PG8_LDB(B1, 1, 1); PG8_STAGE(PG8_SB(1, 0), b3, voffB);
            PG8_BAR; PG8_WAIT_L(0); PG8_MMA(0, 1, At, B1); PG8_BAR;
            PG8_LDA(At, 1, 1); PG8_STAGE(PG8_SA(1, 0), a3, voffA);
            PG8_BAR; PG8_WAIT_L(0); PG8_MMA(1, 0, At, B0); PG8_BAR; PG8_SCHED;
            PG8_STAGE(PG8_SB(1, 1), b3 + hstep, voffB);
            PG8_WAIT_V(6); PG8_BAR; PG8_MMA(1, 1, At, B1); PG8_BAR;
            }
        }
        if constexpr (ALIGN_EPI) { if (wr == 0) PG8_BAR; }
        bool keep = false;
        if constexpr (Epi::CHAIN) { keep = E.chain(acc, cur, wr, wc, fr, fq); S.done(cur); }
        else if constexpr (!Epi::AFTER_DRAIN) { E(acc, cur, wr, wc, fr, fq); S.done(cur); }
        if (!has_next) break;
        if (!keep)
#pragma unroll
        for (int a = 0; a < 2; ++a)
#pragma unroll
            for (int b = 0; b < 2; ++b)
#pragma unroll
                for (int m = 0; m < 4; ++m)
#pragma unroll
                    for (int n = 0; n < 2; ++n) acc[a][b][m][n] = acc_t{};
        cur = nxt; cA = nA; cB = nB; ++ui; ntc = cur.nt ? cur.nt : nt;
        if constexpr (ALIGN_EPI) { if (wr == 1) PG8_BAR; }
    }
    PG8_WAIT_V(0);
    if constexpr (!ALIGN_EPI) { if (wr == 0) PG8_BAR; }
    PG8_BAR;
#undef PG8_SA
#undef PG8_SB
#undef PG8_STAGE
#undef PG8_LDA
#undef PG8_LDB
#undef PG8_MMA
#undef PG8_WAIT_V
#undef PG8_WAIT_L
#undef PG8_BAR
#undef PG8_SCHED
}
}

namespace att {
using bf16 = __hip_bfloat16;
typedef short bf16x8 __attribute__((ext_vector_type(8)));
typedef short s16x4 __attribute__((ext_vector_type(4)));
typedef float f32x16 __attribute__((ext_vector_type(16)));
typedef float f32x4 __attribute__((ext_vector_type(4)));
typedef unsigned u32x4 __attribute__((ext_vector_type(4)));
typedef unsigned u32x2 __attribute__((ext_vector_type(2)));
constexpr int D = 128;
constexpr float SCALE = 0.08838834764831845f;
constexpr float THR = 8.f;
constexpr int NW = 8, QBLK = 32, KVBLK = 64, QB = NW * QBLK;
constexpr int SHM_V = KVBLK * D * 2, SHM_K = KVBLK * D * 2;
constexpr int LDS_BYTES = 2 * SHM_V + 2 * SHM_K + NW * 64 * 4;
#define KSWZ(row, colB) ((row) * 256 + ((colB) ^ (((row) & 7) << 4)))
#define SBAR() __builtin_amdgcn_sched_barrier(0)
__device__ __forceinline__ int v_st(int k, int c) { const int kk = (k & ~0xC) | ((k & 4) << 1) | ((k & 8) >> 1); return ((kk >> 3) * 4 + (c >> 5)) * 512 + ((kk & 7) * 32 + (c & 31)) * 2; }
__device__ __forceinline__ int v_rd_base(int lane) { return ((lane & 3) << 3) | (((lane >> 2) & 3) << 6) | (((lane >> 4) & 1) << 5) | (((lane >> 5) & 1) << 8); }
constexpr int v_rd_off(int d0, int ks, int half) { return d0 * 512 + ks * 4096 + half * 2048; }
__device__ __forceinline__ int crow(int r, int hi) { return (r & 3) + 8 * (r >> 2) + 4 * hi; }
__device__ __forceinline__ unsigned cvtpk(float lo, float hi) { unsigned r; asm volatile("v_cvt_pk_bf16_f32 %0, %1, %2" : "=v"(r) : "v"(lo), "v"(hi)); return r; }
__device__ __forceinline__ bf16x8 load8(const bf16* p) { return *reinterpret_cast<const bf16x8*>(p); }
__device__ __forceinline__ void mask_alibi(f32x16& p0, f32x16& p1, u32x2 mw, int dq, int hi, float ah) {
    const float NEG = -__builtin_inff();
    const unsigned w0 = mw.x >> (4 * hi), w1 = mw.y >> (4 * hi);
    const float dqf = (float)dq;
#pragma unroll
    for (int r = 0; r < 16; ++r) {
        const int c = (r & 3) + 8 * (r >> 2);
        p0[r] = ((w0 >> c) & 1u) ? fmaf(ah, (float)c - dqf, p0[r]) : NEG;
        p1[r] = ((w1 >> c) & 1u) ? fmaf(ah, (float)(c + 32) - dqf, p1[r]) : NEG;
    }
}
__device__ __forceinline__ void partialSM(f32x16& p0, f32x16& p1, float& m_reg, float& mn, float& alpha) {
    float pmax = p0[0];
#pragma unroll
    for (int r = 1; r < 16; ++r) pmax = fmaxf(pmax, p0[r]);
#pragma unroll
    for (int r = 0; r < 16; ++r) pmax = fmaxf(pmax, p1[r]);
    { auto rr = __builtin_amdgcn_permlane32_swap(__float_as_uint(pmax), __float_as_uint(pmax), false, false);
      pmax = fmaxf(__uint_as_float(rr[0]), __uint_as_float(rr[1])); }
    constexpr float C2 = 1.4426950408889634f * SCALE;
    if (__builtin_expect(__all((pmax - m_reg) * SCALE <= THR), 1)) { mn = m_reg; alpha = 1.f; }
    else { mn = fmaxf(m_reg, pmax); alpha = __builtin_amdgcn_exp2f((m_reg - mn) * C2); m_reg = mn; }
    const float mnL = -mn * C2;
#pragma unroll
    for (int r = 0; r < 16; ++r) p0[r] = fmaf(p0[r], C2, mnL);
#pragma unroll
    for (int r = 0; r < 16; ++r) p1[r] = fmaf(p1[r], C2, mnL);
#pragma unroll
    for (int r = 0; r < 16; ++r) p0[r] = __builtin_amdgcn_exp2f(p0[r]);
}
__device__ __forceinline__ void finishSM(f32x16& p0, f32x16& p1, float alpha, float& l_reg, bf16x8& pa0, bf16x8& pa1, bf16x8& pa2, bf16x8& pa3) {
#pragma unroll
    for (int r = 0; r < 16; ++r) p1[r] = __builtin_amdgcn_exp2f(p1[r]);
    float ps = 0;
#pragma unroll
    for (int r = 0; r < 16; ++r) ps += p0[r];
#pragma unroll
    for (int r = 0; r < 16; ++r) ps += p1[r];
    { auto rr = __builtin_amdgcn_permlane32_swap(__float_as_uint(ps), __float_as_uint(ps), false, false);
      ps = __uint_as_float(rr[0]) + __uint_as_float(rr[1]); }
    l_reg = l_reg * alpha + ps;
#define PK4(P, B_, OUT) do { unsigned a0 = cvtpk(P[B_+0], P[B_+1]), a1 = cvtpk(P[B_+2], P[B_+3]);                          \
        unsigned b0 = cvtpk(P[B_+4], P[B_+5]), b1 = cvtpk(P[B_+6], P[B_+7]);                                             \
        auto r0 = __builtin_amdgcn_permlane32_swap(a0, b0, false, false); auto r1 = __builtin_amdgcn_permlane32_swap(a1, b1, false, false); \
        u32x4 w = {r0[0], r1[0], r0[1], r1[1]}; OUT = *reinterpret_cast<bf16x8*>(&w); } while (0)
    PK4(p0, 0, pa0); PK4(p0, 8, pa1); PK4(p1, 0, pa2); PK4(p1, 8, pa3);
#undef PK4
}
template <int KB>
__device__ __forceinline__ void qkt(f32x16& p0, f32x16& p1, const char* K_lds, int r32, int hi, const bf16x8* qr) {
    p0 = f32x16{}; p1 = f32x16{};
    const char* kb[4];
#pragma unroll
    for (int dd = 0; dd < 4; ++dd) kb[dd] = K_lds + KB * SHM_K + KSWZ(r32, (dd * 16 + hi * 8) * 2);
#pragma unroll
    for (int d0 = 0; d0 < 8; ++d0) { const char* a = kb[d0 & 3] + (d0 >> 2) * 128;
        bf16x8 b0 = *reinterpret_cast<const bf16x8*>(a);
        bf16x8 b1 = *reinterpret_cast<const bf16x8*>(a + 32 * 256);
        p0 = __builtin_amdgcn_mfma_f32_32x32x16_bf16(b0, qr[d0], p0, 0, 0, 0);
        p1 = __builtin_amdgcn_mfma_f32_32x32x16_bf16(b1, qr[d0], p1, 0, 0, 0); }
}
template <int VB>
__device__ __forceinline__ void pv_tile(f32x16* o, int vb0, bf16x8 pa0, bf16x8 pa1, bf16x8 pa2, bf16x8 pa3) {
#define TRRD(dst, off) asm volatile("ds_read_b64_tr_b16 %0, %1 offset:%2" : "=&v"(dst) : "v"(vb0), "i"(off) : "memory")
#define PV_D0(d0) do { s16x4 l0, l1, l2, l3, h0, h1, h2, h3; constexpr int b_ = VB * SHM_V + v_rd_off(d0, 0, 0); \
        TRRD(l0, b_); TRRD(h0, b_ + 2048); TRRD(l1, b_ + 4096); TRRD(h1, b_ + 6144); TRRD(l2, b_ + 8192); TRRD(h2, b_ + 10240); TRRD(l3, b_ + 12288); TRRD(h3, b_ + 14336); \
        asm volatile("s_waitcnt lgkmcnt(0)" ::: "memory"); SBAR();   \
        o[d0] = __builtin_amdgcn_mfma_f32_32x32x16_bf16(pa0, (bf16x8){l0[0], l0[1], l0[2], l0[3], h0[0], h0[1], h0[2], h0[3]}, o[d0], 0, 0, 0);   \
        o[d0] = __builtin_amdgcn_mfma_f32_32x32x16_bf16(pa1, (bf16x8){l1[0], l1[1], l1[2], l1[3], h1[0], h1[1], h1[2], h1[3]}, o[d0], 0, 0, 0);   \
        o[d0] = __builtin_amdgcn_mfma_f32_32x32x16_bf16(pa2, (bf16x8){l2[0], l2[1], l2[2], l2[3], h2[0], h2[1], h2[2], h2[3]}, o[d0], 0, 0, 0);   \
        o[d0] = __builtin_amdgcn_mfma_f32_32x32x16_bf16(pa3, (bf16x8){l3[0], l3[1], l3[2], l3[3], h3[0], h3[1], h3[2], h3[3]}, o[d0], 0, 0, 0); } while (0)
    PV_D0(0); PV_D0(1); PV_D0(2); PV_D0(3);
#undef PV_D0
#undef TRRD
}
template <int LD, int LDO, bool MASKED>
__device__ __forceinline__ void attn_block(const bf16* Q, const bf16* Kh, const bf16* Vh, bf16* O, int NT, int P0, const unsigned* maskbase, float ah, char* lds) {
    int tid_ = threadIdx.x; asm volatile("" : "+v"(tid_));
    const int tid = tid_, wid = __builtin_amdgcn_readfirstlane(tid >> 6), lane = tid & 63, r32 = lane & 31, hi = lane >> 5;
    const int qlo = P0 + wid * QBLK, qm = qlo + r32 - 4 * hi;
    char* V_lds = lds; char* K_lds = lds + 2 * SHM_V;
    float* ws = (float*)(lds + 2 * SHM_V + 2 * SHM_K) + wid * 64; float* li_l = ws, * al_l = ws + 32;
    float m_reg = -1e30f, l_reg = 0; f32x16 o[4] = {};
    const int sr = tid >> 4, sc = (tid & 15) * 8, vst0 = v_st(sr, sc), vst1 = v_st(32 + sr, sc), kws = KSWZ(sr, sc * 2);
    const int vb0 = (int)(uintptr_t)V_lds + v_rd_base(lane);
    const unsigned* mrow = MASKED ? maskbase + (size_t)(qlo + r32) * 128 : nullptr;
    bf16x8 qr[8], st_v0, st_v1, st_k0, st_k1;
#define ROW(p, k0, rr) ((p) + (size_t)((k0) + (rr)) * LD + sc)
#define VMW() asm volatile("s_waitcnt vmcnt(0)" ::: "memory")
#define SLOAD_H(k0) do { st_v0 = load8(ROW(Vh, k0, sr)); st_v1 = load8(ROW(Vh, k0, 32 + sr)); st_k0 = load8(ROW(Kh, k0, sr)); st_k1 = load8(ROW(Kh, k0, 32 + sr)); } while (0)
#define SWRITE_HK(bf) do { *(bf16x8*)(K_lds + (bf) * SHM_K + kws) = st_k0; *(bf16x8*)(K_lds + (bf) * SHM_K + kws + 32 * 256) = st_k1; } while (0)
#define SWRITE_HV(bf) do { *(bf16x8*)(V_lds + (bf) * SHM_V + vst0) = st_v0; *(bf16x8*)(V_lds + (bf) * SHM_V + vst1) = st_v1; } while (0)
#define SWRITE_H(bf) do { SWRITE_HV(bf); SWRITE_HK(bf); } while (0)
#define RESC(a) do { if (__any((a) < 1.f)) { if (hi == 0) al_l[r32] = (a); asm volatile("s_waitcnt lgkmcnt(0)" ::: "memory");              \
                     for (int d_ = 0; d_ < 4; ++d_) for (int r = 0; r < 16; ++r) o[d_][r] *= al_l[crow(r, hi)]; } } while (0)
#define KBASE(t) ((t) * KVBLK)
#define MLOAD(dst, t) do { if (MASKED) dst = *(const u32x2*)(mrow + 2 * (t)); } while (0)
#define MASKT(P0_, P1_, mw_, t) do { if (MASKED) mask_alibi(P0_, P1_, mw_, qm - KBASE(t), hi, ah); } while (0)
#pragma unroll
    for (int d0 = 0; d0 < 8; ++d0) qr[d0] = load8(Q + (size_t)(wid * QBLK + r32) * LD + d0 * 16 + hi * 8);
    SLOAD_H(0); VMW(); SWRITE_HK(0);
    __syncthreads();
    f32x16 pA0, pA1, pB0, pB1; float mnA, mnB, alA, alB; bf16x8 pa0, pa1, pa2, pa3;
    u32x2 mwA = {0u, 0u}, mwB = {0u, 0u};
    SWRITE_HV(0); SBAR();
    MLOAD(mwA, 0);
    if (NT > 1) SLOAD_H(KBASE(1));
    SBAR(); qkt<0>(pA0, pA1, K_lds, r32, hi, qr);
    MASKT(pA0, pA1, mwA, 0); partialSM(pA0, pA1, m_reg, mnA, alA);
    if (NT > 1) { VMW(); SWRITE_H(1); }
    __syncthreads();
#define HALF_STEP(PX0, PX1, mwX, mnX, alX, PY0, PY1, alY, t, KB, VB, SB) do {                                                 \
        SBAR(); MLOAD(mwX, t); qkt<KB>(PX0, PX1, K_lds, r32, hi, qr);                                                         \
        finishSM(PY0, PY1, alY, l_reg, pa0, pa1, pa2, pa3); SBAR();                                                           \
        if ((t) + 1 < NT) { SLOAD_H(KBASE((t) + 1)); SBAR(); }                                                                \
        pv_tile<VB>(o, vb0, pa0, pa1, pa2, pa3); MASKT(PX0, PX1, mwX, (t)); partialSM(PX0, PX1, m_reg, mnX, alX);             \
        __syncthreads();                                                                                                      \
        if ((t) + 1 < NT) { VMW(); SWRITE_H(SB); }                                                                            \
        RESC(alX); __syncthreads(); } while (0)
    for (int t = 1; t + 1 < NT; t += 2) {
        HALF_STEP(pB0, pB1, mwB, mnB, alB, pA0, pA1, alA, t, 1, 0, 0);
        HALF_STEP(pA0, pA1, mwA, mnA, alA, pB0, pB1, alB, t + 1, 0, 1, 1);
    }
    const bool even = (NT & 1) == 0;
    if (even) { SBAR(); MLOAD(mwB, NT - 1); qkt<1>(pB0, pB1, K_lds, r32, hi, qr); SBAR(); }
    finishSM(pA0, pA1, alA, l_reg, pa0, pa1, pa2, pa3); SBAR();
    pv_tile<0>(o, vb0, pa0, pa1, pa2, pa3);
    if (even) { MASKT(pB0, pB1, mwB, NT - 1); partialSM(pB0, pB1, m_reg, mnB, alB); __syncthreads(); RESC(alB);
        finishSM(pB0, pB1, alB, l_reg, pa0, pa1, pa2, pa3); SBAR(); pv_tile<1>(o, vb0, pa0, pa1, pa2, pa3); }
    SBAR();
    if (hi == 0) li_l[r32] = l_reg; asm volatile("s_waitcnt lgkmcnt(0)" ::: "memory");
    float rli[16];
#pragma unroll
    for (int r = 0; r < 16; ++r) rli[r] = __builtin_amdgcn_rcpf(li_l[crow(r, hi)]);
    bf16* Ow = O + (size_t)(wid * QBLK) * LDO;
#pragma unroll
    for (int r = 0; r < 16; ++r) { const int orow = crow(r, hi);
#pragma unroll
        for (int d0 = 0; d0 < 4; ++d0) { const float v = o[d0][r] * rli[r];
            const float vn = __shfl_xor(v, 1);
            if ((r32 & 1) == 0) *(unsigned*)(Ow + (size_t)orow * LDO + d0 * 32 + r32) = cvtpk(v, vn); } }
    __syncthreads();
#undef ROW
#undef VMW
#undef SLOAD_H
#undef SWRITE_HK
#undef SWRITE_HV
#undef SWRITE_H
#undef RESC
#undef KBASE
#undef MLOAD
#undef MASKT
#undef HALF_STEP
}
#undef KSWZ
#undef SBAR
}

constexpr int NWAVES = 8;
constexpr int BATCH = 2, SEQ = 4096, DM = 2048, T = BATCH * SEQ, FF = 5632, NUP = 2 * FF;
constexpr int NIN = 11344, NIN_PAD = 11520;
constexpr int MEMLEN = 256, TOPK = 256;
constexpr float ALPHA = 1.189207115002721f;
constexpr float LN_EPS = 1e-5f;
constexpr int N_PHASES = 13;

constexpr size_t WS_CTL = 0, CTL_ZERO_BYTES = 1u << 20;
constexpr size_t WS_BIG = 1u << 20;
constexpr size_t O_X16 = 0, O_WUP1 = O_X16 + (size_t)T * DM * 2, O_WDN1 = O_WUP1 + (size_t)NUP * DM * 2, O_G = O_WDN1 + (size_t)DM * FF * 2, BIG_BYTES = O_G + (size_t)T * FF * 2;
constexpr size_t O_Q = 0, O_K = O_Q + (size_t)T * 1024 * 2, O_V = O_K + (size_t)T * 1024 * 2, O_QI = O_V + (size_t)T * 1024 * 2, O_KI = O_QI + (size_t)T * 1024 * 2,
                 O_WI = O_KI + (size_t)T * 64 * 2, O_U = O_WI + (size_t)T * 16 * 4, O_QM = O_U + (size_t)T * 512 * 2, O_GATE = O_QM + (size_t)T * 512 * 2, O_MIXEND = O_GATE + (size_t)T * 6144 * 2;
static_assert(O_MIXEND <= BIG_BYTES, "mixer view fits");
constexpr size_t WS_WIN = WS_BIG + BIG_BYTES;
constexpr int NZB = 4352, NZQ = NIN_PAD - NZB;
constexpr size_t WS_WMKV = WS_WIN + (size_t)NZB * DM * 2;
constexpr size_t WS_WINQ = WS_WMKV + (size_t)1024 * DM * 2;
constexpr size_t WS_WBA = WS_WIN + (size_t)NIN_PAD * DM * 2 + (size_t)1024 * DM * 2;
constexpr size_t WS_WBP = WS_WBA + (size_t)DM * 1024 * 2;
constexpr size_t WS_WBM = WS_WBP + (size_t)DM * 512 * 2;
constexpr size_t WS_WOUT = WS_WBM + (size_t)DM * 512 * 2;
constexpr size_t WS_WUP2 = WS_WOUT + (size_t)DM * DM * 2;
constexpr size_t WS_WDN2 = WS_WUP2 + (size_t)NUP * DM * 2;
constexpr size_t WS_WPOOL = WS_WDN2 + (size_t)DM * FF * 2;
constexpr size_t WS_H1 = WS_WPOOL + (size_t)4 * 128 * 128 * 2;
constexpr size_t WS_MEM16 = WS_H1 + (size_t)T * DM * 2;
constexpr size_t WS_A16 = WS_MEM16 + (size_t)512 * DM * 2;
constexpr size_t WS_P16 = WS_A16 + (size_t)T * 1024 * 2;
constexpr size_t WS_M16 = WS_P16 + (size_t)T * 512 * 2;
constexpr size_t WS_Y16 = WS_M16 + (size_t)T * 512 * 2;
constexpr size_t WS_KM = WS_Y16 + (size_t)T * DM * 2;
constexpr size_t WS_VM = WS_KM + (size_t)512 * 512 * 2;
constexpr size_t WS_MASK = WS_VM + (size_t)512 * 512 * 2;
constexpr size_t WS_END = WS_MASK + (size_t)T * 128 * 4;
constexpr int CW_BAR = 4096;
constexpr size_t WS_QS = 65536;
constexpr size_t WS_ROWQ = 131072;
static_assert(WS_ROWQ + (size_t)9 * 8192 * 4 <= (1u << 20), "control region");

constexpr int RING_OFF = 0, RING_BYTES = 131072;
constexpr int LDSCTL_OFF = RING_BYTES, MISC_OFF = LDSCTL_OFF + 320;
constexpr int LDS_BYTES = 147456;

#define GAS __attribute__((address_space(1)))
#define LAS __attribute__((address_space(3)))
typedef unsigned short bf16;
typedef unsigned v4u __attribute__((ext_vector_type(4)));
typedef unsigned v2u __attribute__((ext_vector_type(2)));
typedef float f32x4 __attribute__((ext_vector_type(4)));
typedef float f32x16 __attribute__((ext_vector_type(16)));
typedef short bf16x8 __attribute__((ext_vector_type(8)));
#define LDS_WAIT() asm volatile("s_waitcnt lgkmcnt(0)" ::: "memory")
__device__ __forceinline__ unsigned f2bf(float f) { unsigned u = __builtin_bit_cast(unsigned, f); return (u + 0x7fffu + ((u >> 16) & 1u)) >> 16; }
__device__ __forceinline__ unsigned pk2(float lo, float hi) { return f2bf(lo) | (f2bf(hi) << 16); }

#define XB_TMO      128
#define XB_XCNT(j)  (256  + 64 * (j))
#define XB_XSUB(j)  (1280 + 64 * (j))
#define XB_XGEN(j)  (2304 + 64 * (j))
#define XB_TOP      3328
#define XB_TOPGEN   3392
#define XCD_BAR_WORDS 3456
#define XB_SPIN_CAP (1u << 22)
__device__ __forceinline__ unsigned xb_ld(unsigned* p)              { return __hip_atomic_load(p, __ATOMIC_RELAXED, __HIP_MEMORY_SCOPE_AGENT); }
__device__ __forceinline__ unsigned xb_add(unsigned* p, unsigned v) { return __hip_atomic_fetch_add(p, v, __ATOMIC_RELAXED, __HIP_MEMORY_SCOPE_AGENT); }
__device__ __forceinline__ unsigned xb_xcc_id() { return (unsigned)__builtin_amdgcn_s_getreg((3 << 11) | 20) & 0xFu; }
#define XB_SPIN(cond, bar) do { unsigned _sp = 0; while (cond) { __builtin_amdgcn_s_sleep(1); \
    if ((++_sp & 255u) == 0u) { if (xb_ld(&(bar)[XB_TMO])) break; if (_sp > XB_SPIN_CAP) { atomicAdd(&(bar)[XB_TMO], 1u); break; } } } } while (0)
struct XcdBarrier { unsigned* bar; unsigned x; volatile LAS unsigned* st; };
__device__ __forceinline__ XcdBarrier xcd_barrier_post(unsigned* bar, volatile LAS unsigned* st) {
    XcdBarrier b; b.bar = bar; b.x = xb_xcc_id(); b.st = st;
    if (threadIdx.x == 0) (void)xb_add(&bar[XB_XCNT(b.x)], 1u);
    return b;
}
__device__ __forceinline__ void xcd_barrier_complete(unsigned* bar, unsigned x, unsigned& nloc, unsigned& nx) {
    const unsigned G = gridDim.x * gridDim.y * gridDim.z;
    unsigned sum, cnt, mine, sp = 0u;
    for (;;) {
        sum = 0u; cnt = 0u; mine = 0u;
#pragma unroll
        for (unsigned j = 0; j < 16; ++j) { const unsigned c = xb_ld(&bar[XB_XCNT(j)]); sum += c; cnt += (c > 0u) ? 1u : 0u; mine = (j == x) ? c : mine; }
        if (sum == G) break;
        __builtin_amdgcn_s_sleep(1);
        if ((++sp & 255u) == 0u) { if (xb_ld(&bar[XB_TMO])) break; if (sp > XB_SPIN_CAP) { atomicAdd(&bar[XB_TMO], 1u); break; } }
    }
    nloc = mine > 0u ? mine : 1u; nx = cnt > 0u ? cnt : 1u;
}
__device__ __forceinline__ void xcd_barrier(const XcdBarrier& b) {
    asm volatile("s_waitcnt vmcnt(0)" ::: "memory");
    __syncthreads();
    if (threadIdx.x == 0) {
        unsigned* bar = b.bar;
        __builtin_amdgcn_s_waitcnt(0);
        unsigned nloc = b.st[0], nx = b.st[1];
        if (nloc == 0u) { xcd_barrier_complete(bar, b.x, nloc, nx); b.st[0] = nloc; b.st[1] = nx; }
        const unsigned old = xb_add(&bar[XB_XSUB(b.x)], 1u);
        const unsigned gen = old / nloc;
        if (old + 1u == (gen + 1u) * nloc) {
            __builtin_amdgcn_fence(__ATOMIC_RELEASE, "agent");
            asm volatile("s_waitcnt vmcnt(0)" ::: "memory");
            const unsigned og = xb_add(&bar[XB_TOP], 1u);
            const unsigned tg = og / nx;
            if (og + 1u == (tg + 1u) * nx) xb_add(&bar[XB_TOPGEN], 1u);
            else XB_SPIN(xb_ld(&bar[XB_TOPGEN]) == tg, bar);
            __builtin_amdgcn_fence(__ATOMIC_ACQUIRE, "agent");
            xb_add(&bar[XB_XGEN(b.x)], 1u);
            asm volatile("s_waitcnt vmcnt(0)" ::: "memory");
        } else {
            XB_SPIN(xb_ld(&bar[XB_XGEN(b.x)]) == gen, bar);
            __builtin_amdgcn_fence(__ATOMIC_ACQUIRE, "agent");
            asm volatile("s_waitcnt vmcnt(0)" ::: "memory");
        }
    }
    __syncthreads();
}

__device__ __forceinline__ float wave_sum(float v) {
#pragma unroll
    for (int o = 1; o < 64; o <<= 1) v += __shfl_xor(v, o);
    return v;
}
template <int MAP>
__device__ __forceinline__ void p0_transpose_item(const float* W, int K, int N, int NP, bf16* WT, LAS float* scr, int item, int lane, int ldw = 0) {
    if (ldw == 0) ldw = K;
    const int nblk = NP / 32, kb = item / nblk, nb = item % nblk, k0 = 64 * kb, np0 = 32 * nb;
    int n0 = np0; int nvalid = 32;
    if (MAP == 1) n0 = ((np0 >> 7) & 1) * FF + (np0 >> 8) * 128 + (np0 & 127);
    if (MAP == 2) { if (np0 < 4096) n0 = np0; else if (np0 < 4352) { n0 = np0; nvalid = 4176 - np0; nvalid = nvalid < 0 ? 0 : (nvalid > 32 ? 32 : nvalid); } else n0 = np0 - 176; }
    float v[32];
    const bool ok = (lane & 31) < nvalid;
#pragma unroll
    for (int i = 0; i < 32; ++i) { const int kk = 2 * i + (lane >> 5); v[i] = ok ? W[(size_t)(k0 + kk) * N + n0 + (lane & 31)] : 0.f; }
#pragma unroll
    for (int i = 0; i < 32; ++i) { const int kk = 2 * i + (lane >> 5); scr[kk * 33 + (lane & 31)] = v[i]; }
    LDS_WAIT(); asm volatile("" ::: "memory");
    const int c = lane & 7;
#pragma unroll
    for (int j = 0; j < 4; ++j) { const int n = (lane >> 3) + 8 * j; const LAS float* s = scr + (8 * c) * 33 + n;
        v4u o; o.x = pk2(s[0 * 33], s[1 * 33]); o.y = pk2(s[2 * 33], s[3 * 33]); o.z = pk2(s[4 * 33], s[5 * 33]); o.w = pk2(s[6 * 33], s[7 * 33]);
        *(GAS v4u*)(WT + (size_t)(np0 + n) * ldw + k0 + 8 * c) = o; }
    LDS_WAIT(); asm volatile("" ::: "memory");
}
__device__ __forceinline__ unsigned q8(float v, float qw) { return (unsigned)((int)__builtin_rintf(fminf(fmaxf(v * qw, -127.f), 127.f)) & 255); }
template <int MAP>
__device__ __forceinline__ void p0_transpose_item_i8(const float* W, int K, int N, int NP, signed char* WT, LAS float* scr, int item, int lane, float qw) {
    const int nblk = NP / 32, kb = item / nblk, nb = item % nblk, k0 = 64 * kb, np0 = 32 * nb;
    int n0 = np0;
    if (MAP == 1) n0 = ((np0 >> 7) & 1) * FF + (np0 >> 8) * 128 + (np0 & 127);
    float v[32];
#pragma unroll
    for (int i = 0; i < 32; ++i) { const int kk = 2 * i + (lane >> 5); v[i] = W[(size_t)(k0 + kk) * N + n0 + (lane & 31)]; }
#pragma unroll
    for (int i = 0; i < 32; ++i) { const int kk = 2 * i + (lane >> 5); scr[kk * 33 + (lane & 31)] = v[i]; }
    LDS_WAIT(); asm volatile("" ::: "memory");
#pragma unroll
    for (int j = 0; j < 2; ++j) { const int id = lane + 64 * j, n = id >> 2, c = id & 3; const LAS float* sp = scr + (16 * c) * 33 + n;
        v4u o;
        o.x = q8(sp[0 * 33], qw) | (q8(sp[1 * 33], qw) << 8) | (q8(sp[2 * 33], qw) << 16) | (q8(sp[3 * 33], qw) << 24);
        o.y = q8(sp[4 * 33], qw) | (q8(sp[5 * 33], qw) << 8) | (q8(sp[6 * 33], qw) << 16) | (q8(sp[7 * 33], qw) << 24);
        o.z = q8(sp[8 * 33], qw) | (q8(sp[9 * 33], qw) << 8) | (q8(sp[10 * 33], qw) << 16) | (q8(sp[11 * 33], qw) << 24);
        o.w = q8(sp[12 * 33], qw) | (q8(sp[13 * 33], qw) << 8) | (q8(sp[14 * 33], qw) << 16) | (q8(sp[15 * 33], qw) << 24);
        *(GAS v4u*)(WT + (size_t)(np0 + n) * K + k0 + 16 * c) = o; }
    LDS_WAIT(); asm volatile("" ::: "memory");
}
__device__ __forceinline__ float sample_sigma2(const float* W, int K, int N, int lane) {
    float s = 0.f;
#pragma unroll
    for (int j = 0; j < 4; ++j) { const f32x4 v = *(const GAS f32x4*)(W + (size_t)(j * (K / 4)) * N + lane * 4); s += (v.x * v.x + v.y * v.y) + (v.z * v.z + v.w * v.w); }
    return wave_sum(s) * (1.0f / 1024.0f);
}
__device__ __forceinline__ void quant_row_i8(const f32x4 (&v)[8], signed char* qrow, float* sx, float* gq, float* sg, float sig2, int lane) {
    float mx = 0.f, ss = 0.f;
#pragma unroll
    for (int j = 0; j < 8; ++j) { mx = fmaxf(mx, fmaxf(fmaxf(fabsf(v[j].x), fabsf(v[j].y)), fmaxf(fabsf(v[j].z), fabsf(v[j].w)))); ss += (v[j].x * v[j].x + v[j].y * v[j].y) + (v[j].z * v[j].z + v[j].w * v[j].w); }
#pragma unroll
    for (int o = 1; o < 64; o <<= 1) mx = fmaxf(mx, __shfl_xor(mx, o));
    ss = wave_sum(ss);
    const float m = fmaxf(mx, 1e-20f), qm = 127.f / m;
#pragma unroll
    for (int j = 0; j < 8; ++j) ((GAS unsigned*)qrow)[lane + 64 * j] = q8(v[j].x, qm) | (q8(v[j].y, qm) << 8) | (q8(v[j].z, qm) << 16) | (q8(v[j].w, qm) << 24);
    if (lane == 0) { const float clip = fmaxf(8.f * ss * sig2, 1e-20f);
        *sx = m * (1.0f / 127.f); *gq = 127.f / clip; *sg = clip * (1.0f / 127.f); }
}
template <bool OUT_BF16, bool Q8 = false>
__device__ __forceinline__ void ln_row(const float* xrow, const float* gam, const float* bet, void* orow, int lane, signed char* qrow = nullptr, float* sx = nullptr, float* gq = nullptr, float* sg = nullptr, float sig2 = 0.f) {
    const GAS f32x4* xr = (const GAS f32x4*)xrow + lane;
    f32x4 v[8]; float s = 0.f;
#pragma unroll
    for (int j = 0; j < 8; ++j) { v[j] = xr[64 * j]; s += (v[j].x + v[j].y) + (v[j].z + v[j].w); }
    const float mean = wave_sum(s) * (1.f / DM); float s2 = 0.f;
#pragma unroll
    for (int j = 0; j < 8; ++j) { v[j] = v[j] - mean; s2 += (v[j].x * v[j].x + v[j].y * v[j].y) + (v[j].z * v[j].z + v[j].w * v[j].w); }
    const float rstd = 1.f / sqrtf(wave_sum(s2) * (1.f / DM) + LN_EPS);
#pragma unroll
    for (int j = 0; j < 8; ++j) {
        const f32x4 gg = ((const GAS f32x4*)gam)[lane + 64 * j], bb = ((const GAS f32x4*)bet)[lane + 64 * j];
        const f32x4 y = v[j] * rstd * gg + bb;
        if (OUT_BF16) { ((GAS v2u*)orow)[lane + 64 * j] = (v2u){pk2(y.x, y.y), pk2(y.z, y.w)}; }
        else ((GAS f32x4*)orow)[lane + 64 * j] = y;
        if (Q8) v[j] = y;
    }
    if (Q8) quant_row_i8(v, qrow, sx, gq, sg, sig2, lane);
}

__device__ __forceinline__ unsigned ordkey(float s) { const unsigned u = __float_as_uint(s); return (u ^ ((unsigned)((int)u >> 31) | 0x80000000u)) >> 1; }
__device__ __forceinline__ float keyf(unsigned k31) { const unsigned k = k31 << 1; return __uint_as_float((k & 0x80000000u) ? (k ^ 0x80000000u) : ~k); }
template <int J, int JEND> __device__ __forceinline__ void mask_emit(const unsigned (&key)[128], unsigned thr, unsigned& o0a, unsigned& o1a, unsigned& o0b, unsigned& o1b) {
    const unsigned long long bal = __ballot(key[J] >= thr);
    const unsigned bl = (unsigned)bal, bh = (unsigned)(bal >> 32);
    if constexpr (J < 64) asm volatile("s_nop 1\n\tv_writelane_b32 %0, %2, %4\n\tv_writelane_b32 %1, %3, %4" : "+v"(o0a), "+v"(o1a) : "s"(bl), "s"(bh), "n"(J));
    else asm volatile("s_nop 1\n\tv_writelane_b32 %0, %2, %4\n\tv_writelane_b32 %1, %3, %4" : "+v"(o0b), "+v"(o1b) : "s"(bl), "s"(bh), "n"(J - 64));
    if constexpr (J + 1 < JEND) mask_emit<J + 1, JEND>(key, thr, o0a, o1a, o0b, o1b);
}
template <int G> __device__ __forceinline__ void mask_emit_groups(const unsigned (&key)[128], unsigned thr, int ntw, unsigned& o0a, unsigned& o1a, unsigned& o0b, unsigned& o1b) {
    if (16 * G < ntw) mask_emit<16 * G, 16 * G + 16>(key, thr, o0a, o1a, o0b, o1b);
    if constexpr (G + 1 < 8) mask_emit_groups<G + 1>(key, thr, ntw, o0a, o1a, o0b, o1b);
}
template <int G> __device__ __forceinline__ void count_groups(const unsigned (&key)[128], unsigned mid, int ntw, unsigned& nlt) {
    if (16 * G < ntw) { unsigned a = 0u;
#pragma unroll
        for (int j = 0; j < 16; ++j) a = __builtin_amdgcn_alignbit(a, key[16 * G + j] - mid, 31);
        nlt += (unsigned)__builtin_popcount(a); }
    if constexpr (G + 1 < 8) count_groups<G + 1>(key, mid, ntw, nlt);
}
template <int CTRL> __device__ __forceinline__ unsigned dpp_u(unsigned v) { return (unsigned)__builtin_amdgcn_update_dpp(0, (int)v, CTRL, 0xf, 0xf, true); }
__device__ __forceinline__ unsigned umin_(unsigned a, unsigned b) { return a < b ? a : b; }
__device__ __forceinline__ unsigned umax_(unsigned a, unsigned b) { return a > b ? a : b; }
__device__ __forceinline__ unsigned uadd_(unsigned a, unsigned b) { return a + b; }
#define HALF_REDUCE(v, OP) do { v = OP(v, dpp_u<0xB1>(v)); v = OP(v, dpp_u<0x4E>(v)); v = OP(v, dpp_u<0x141>(v)); v = OP(v, dpp_u<0x140>(v)); v = OP(v, (unsigned)__shfl_xor((int)v, 16)); } while (0)
typedef float f32x2_t __attribute__((ext_vector_type(2)));
__device__ __forceinline__ void indexer_unit(LAS unsigned char* lds, int b, int uidx, const bf16* QI16, const bf16* KI16, const float* WI, unsigned* MASKQ) {
    int tid_ = threadIdx.x; asm volatile("" : "+v"(tid_));
    const int tid = tid_, lane = tid & 63, wid = __builtin_amdgcn_readfirstlane(tid >> 6), r = lane & 31, h = lane >> 5;
    const int q0 = uidx * 16 + 2 * wid, tq = q0 + h;
    const int nchunk = ((uidx * 16 + 15) >> 8) + 1;
    bf16x8 aq[4];
    { const int qa = q0 + ((r >> 2) & 1), head = (r & 3) + 4 * (r >> 3);
      const bf16* qp = QI16 + (size_t)(b * SEQ + qa) * 1024 + head * 64 + 8 * h;
#pragma unroll
      for (int ks = 0; ks < 4; ++ks) aq[ks] = *(const GAS bf16x8*)(qp + ks * 16); }
    f32x2_t w2[8];
    { const GAS f32x4* wp = (const GAS f32x4*)(WI + (size_t)(b * SEQ + tq) * 16);
#pragma unroll
      for (int i = 0; i < 4; ++i) { const f32x4 t = wp[i]; w2[2 * i] = (f32x2_t){t.x, t.y}; w2[2 * i + 1] = (f32x2_t){t.z, t.w}; } }
    unsigned key[128]; unsigned kmn = 0x7FFFFFFFu, kmx = 0u; float ssum = 0.f, ssq = 0.f;
    const char* kbase = (const char*)(KI16 + (size_t)(b * SEQ) * 64);
    unsigned soff[4];
#pragma unroll
    for (int i = 0; i < 4; ++i) { const int kk = (wid * 4 + i) * 8 + (lane >> 3), cs = lane & 7; soff[i] = (unsigned)(kk * 128 + ((cs ^ ((kk >> 1) & 7)) << 4)); }
#define IDX_STAGE(c_) do { _Pragma("unroll") for (int i = 0; i < 4; ++i) \
        __builtin_amdgcn_global_load_lds((const unsigned*)(kbase + (size_t)(c_) * 32768 + soff[i]), (LAS unsigned*)(lds + ((c_) % 3) * 32768 + (wid * 4 + i) * 1024), 16, 0, 0); } while (0)
    const int x = (r >> 1) & 7;
    int roff[4];
#pragma unroll
    for (int ks = 0; ks < 4; ++ks) roff[ks] = r * 128 + (((2 * ks + h) ^ x) << 4);
    __syncthreads();
    IDX_STAGE(0);
    if (nchunk > 1) IDX_STAGE(1);
#pragma unroll
    for (int c = 0; c < 16; ++c) {
        if (c < nchunk) {
            if (c + 1 < nchunk) asm volatile("s_waitcnt vmcnt(4)" ::: "memory"); else asm volatile("s_waitcnt vmcnt(0)" ::: "memory");
            __builtin_amdgcn_s_barrier(); asm volatile("" ::: "memory");
            if (c + 2 < nchunk) IDX_STAGE(c + 2);
#pragma unroll
            for (int jj = 0; jj < 8; ++jj) {
                const int j = c * 8 + jj;
                f32x16 acc = {};
#pragma unroll
                for (int ks = 0; ks < 4; ++ks) { const bf16x8 bk = *(const LAS bf16x8*)(lds + (c % 3) * 32768 + jj * 4096 + roff[ks]);
                    acc = __builtin_amdgcn_mfma_f32_32x32x16_bf16(aq[ks], bk, acc, 0, 0, 0); }
                f32x2_t s2 = {0.f, 0.f};
#pragma unroll
                for (int i = 0; i < 8; ++i) { const int a0 = __float_as_int(acc[2 * i]), a1 = __float_as_int(acc[2 * i + 1]);
                    const f32x2_t a = {__int_as_float(a0 > 0 ? a0 : 0), __int_as_float(a1 > 0 ? a1 : 0)}; s2 = a * w2[i] + s2; }
                const float s = s2.x + s2.y;
                const bool valid = (j * 32 + r <= tq);
                { const float sv = valid ? s : 0.f; ssum += sv; ssq = fmaf(sv, sv, ssq); }
                unsigned kj = valid ? ordkey(s) : 0u;
                asm volatile("" : "+v"(kj));
                key[j] = kj; kmx = umax_(kmx, kj); kmn = umin_(kmn, valid ? kj : 0x7FFFFFFFu);
                __builtin_amdgcn_sched_barrier(0);
            }
        } else {
#pragma unroll
            for (int jj = 0; jj < 8; ++jj) key[c * 8 + jj] = 0u;
        }
    }
#undef IDX_STAGE
    unsigned thr = 1u;
    const int ntw = ((q0 + 1) >> 5) + 1;
    {
        HALF_REDUCE(kmn, umin_); HALF_REDUCE(kmx, umax_);
        { unsigned t = __float_as_uint(ssum);
#define FADD_(a, b) __float_as_uint(__uint_as_float(a) + __uint_as_float(b))
          HALF_REDUCE(t, FADD_); ssum = __uint_as_float(t); t = __float_as_uint(ssq); HALF_REDUCE(t, FADD_); ssq = __uint_as_float(t);
#undef FADD_
        }
        bool done = (tq + 1 <= TOPK);
        unsigned lo = kmn, hi = kmx + 1u;
        int clo = tq + 1, chi = 0, it = 0;
        const float nf = (float)(tq + 1), mu = ssum / nf, sd = sqrtf(fmaxf(ssq / nf - mu * mu, 1e-30f)), pp = fminf((float)TOPK / nf, 1.f);
        const float zq = 4.91f * (__builtin_amdgcn_exp2f(0.14f * __builtin_amdgcn_logf(1.f - pp)) - __builtin_amdgcn_exp2f(0.14f * __builtin_amdgcn_logf(pp)));
        const float v0 = fmaf(zq, sd, mu);
        if (!done && hi - lo <= 1u) { thr = lo; done = true; }
        while (!__all(done)) {
            unsigned mid;
            if (it < 2) mid = ordkey(it == 0 ? v0 - 0.25f * sd : v0 + 0.25f * sd);
            else { const float lof = keyf(lo), hif = keyf(hi - 1u);
              float frac = ((float)clo - ((float)TOPK - 0.5f)) / (float)(clo - chi);
              frac = fminf(fmaxf(frac, 0.125f), 0.875f);
              if (clo - chi > 48 || (it & 3) == 3) frac = 0.5f;
              mid = ordkey(fmaf(hif - lof, frac, lof)); }
            mid = mid <= lo ? lo + 1u : mid; mid = mid >= hi ? hi - 1u : mid;
            unsigned cu = 0u;
            count_groups<0>(key, mid, ntw, cu);
            HALF_REDUCE(cu, uadd_);
            cu = (unsigned)(512 * ((ntw + 15) >> 4)) - cu;
            const int cnt = (int)cu;
            if (!done) {
                if (cnt == TOPK) { thr = mid; done = true; }
                else if (cnt > TOPK) { lo = mid; clo = cnt; } else { hi = mid; chi = cnt; }
                if (!done && hi - lo <= 1u) { thr = lo; done = true; }
            }
            ++it;
        }
    }
    unsigned o0a = 0u, o0b = 0u, o1a = 0u, o1b = 0u;
    mask_emit_groups<0>(key, thr, ntw, o0a, o1a, o0b, o1b);
    GAS unsigned* mp = (GAS unsigned*)(MASKQ + (size_t)(b * SEQ + q0) * 128);
    mp[lane] = o0a; mp[64 + lane] = o0b; mp[128 + lane] = o1a; mp[192 + lane] = o1b;
}
#undef HALF_REDUCE

__device__ __forceinline__ void pool_task(int task, const bf16* U16, const bf16* WPT, const float* pscale, bf16* P16, int lane) {
    asm volatile("" : "+v"(lane));
    const int tile = task >> 2, g = task & 3, r = lane & 31, h = lane >> 5;
    const int tk = tile * 32 + r, pos = tk & (SEQ - 1), wlen = 2 << g;
    const int cnt = (pos + 1 < wlen) ? pos + 1 : wlen;
    const float rc = 1.0f / (float)cnt;
    bf16x8 pa[8];
#pragma unroll
    for (int ks = 0; ks < 8; ++ks) {
        const bf16* up = U16 + (size_t)tk * 512 + g * 128 + ks * 16 + 8 * h;
        float sum[8], self[8];
#pragma unroll
        for (int e = 0; e < 8; ++e) sum[e] = 0.f;
        for (int i = 0; i < wlen; ++i) {
            if (i < cnt) { const v4u t = *(const GAS v4u*)(up - (size_t)i * 512);
                const float f0 = pg8::bf_lo(t.x), f1 = pg8::bf_hi(t.x), f2 = pg8::bf_lo(t.y), f3 = pg8::bf_hi(t.y), f4 = pg8::bf_lo(t.z), f5 = pg8::bf_hi(t.z), f6 = pg8::bf_lo(t.w), f7 = pg8::bf_hi(t.w);
                if (i == 0) { self[0] = f0; self[1] = f1; self[2] = f2; self[3] = f3; self[4] = f4; self[5] = f5; self[6] = f6; self[7] = f7; }
                sum[0] += f0; sum[1] += f1; sum[2] += f2; sum[3] += f3; sum[4] += f4; sum[5] += f5; sum[6] += f6; sum[7] += f7; }
        }
        v4u o; o.x = pk2(sum[0] * rc - self[0], sum[1] * rc - self[1]); o.y = pk2(sum[2] * rc - self[2], sum[3] * rc - self[3]);
        o.z = pk2(sum[4] * rc - self[4], sum[5] * rc - self[5]); o.w = pk2(sum[6] * rc - self[6], sum[7] * rc - self[7]);
        pa[ks] = __builtin_bit_cast(bf16x8, o);
    }
#pragma unroll
    for (int nb = 0; nb < 4; ++nb) {
        f32x16 acc = {};
        const bf16* wp = WPT + (size_t)g * 16384 + (size_t)(nb * 32 + r) * 128 + 8 * h;
#pragma unroll
        for (int ks = 0; ks < 8; ++ks) { const bf16x8 bk = *(const GAS bf16x8*)(wp + ks * 16); acc = __builtin_amdgcn_mfma_f32_32x32x16_bf16(pa[ks], bk, acc, 0, 0, 0); }
        const int col = g * 128 + nb * 32 + r; const float ps = pscale[col];
#pragma unroll
        for (int i = 0; i < 16; ++i) { const int tok = tile * 32 + (i & 3) + 8 * (i >> 2) + 4 * h; P16[(size_t)tok * 2048 + col] = (bf16)f2bf(acc[i] * ps); }
    }
}

struct Args { const float* in[21]; float* out; unsigned char* ws; int ph_lo, ph_hi; };
__global__ void __launch_bounds__(NWAVES * 64, 2) mk_fwd(Args args) {
    extern __shared__ __attribute__((aligned(16))) unsigned char lds[];
    LAS unsigned char* L = (LAS unsigned char*)lds;
    volatile LAS unsigned* MISC = (volatile LAS unsigned*)(L + MISC_OFF);
    const int tid = threadIdx.x, lane = tid & 63, wave = __builtin_amdgcn_readfirstlane(tid >> 6);
    const int G = gridDim.x, bx = blockIdx.x;
    const int vcu = (G % 8 == 0) ? (bx % 8) * (G / 8) + bx / 8 : bx;
    const int gw = vcu * NWAVES + wave, NGW = G * NWAVES;
    unsigned char* ws = args.ws;
    for (int u = tid; u < (LDS_BYTES - LDSCTL_OFF) / 4; u += NWAVES * 64) ((LAS unsigned*)(L + LDSCTL_OFF))[u] = 0u;
    __syncthreads();
    XcdBarrier bar; bar.bar = (unsigned*)(ws + WS_CTL) + CW_BAR; bar.x = 0; bar.st = nullptr;
    if (!MK_PER_PHASE) bar = xcd_barrier_post((unsigned*)(ws + WS_CTL) + CW_BAR, MISC + 8);
    const int lo = args.ph_lo, hi = args.ph_hi;
#ifndef PH_MASK
#define PH_MASK 0x1FFF
#endif
#ifndef REP_MASK
#define REP_MASK 0x0
#endif
#define REP(k) for (int rep_ = 0; rep_ <= ((REP_MASK >> (k)) & 1); ++rep_)
#define REPBAR() do { if (rep_) xcd_barrier(bar); } while (0)
#define IN(k) (((PH_MASK >> (k)) & 1) && lo <= (k) && (k) < hi)
#define SEAM(k) do { if (IN(k) && IN((k) + 1)) xcd_barrier(bar); } while (0)
#define XIN (ap->in[0])
#define MEMIN (ap->in[1])
#define WSP_DECL unsigned char* wsp = args.ws; asm volatile("" : "+s"(wsp)); const __attribute__((address_space(4))) Args* ap = (const __attribute__((address_space(4))) Args*)__builtin_amdgcn_kernarg_segment_ptr(); asm volatile("" : "+s"(ap)); (void)wsp; (void)ap
#define BIG ((bf16*)(wsp + WS_BIG))
#define X16 ((bf16*)(wsp + WS_BIG + O_X16))
#define WUP1 ((bf16*)(wsp + WS_BIG + O_WUP1))
#define WDN1 ((bf16*)(wsp + WS_BIG + O_WDN1))
#define Gb ((bf16*)(wsp + WS_BIG + O_G))
#define Q16 ((bf16*)(wsp + WS_BIG + O_Q))
#define K16 ((bf16*)(wsp + WS_BIG + O_K))
#define V16 ((bf16*)(wsp + WS_BIG + O_V))
#define QI16 ((bf16*)(wsp + WS_BIG + O_QI))
#define KI16 ((bf16*)(wsp + WS_BIG + O_KI))
#define WI ((float*)(wsp + WS_BIG + O_WI))
#define U16 ((bf16*)(wsp + WS_BIG + O_U))
#define QM16 ((bf16*)(wsp + WS_BIG + O_QM))
#define GATE ((bf16*)(wsp + WS_BIG + O_GATE))
#define WIN ((bf16*)(wsp + WS_WIN))
#define WMKV ((bf16*)(wsp + WS_WMKV))
#define WBA ((bf16*)(wsp + WS_WBA))
#define WBP ((bf16*)(wsp + WS_WBP))
#define WBM ((bf16*)(wsp + WS_WBM))
#define WOUT ((bf16*)(wsp + WS_WOUT))
#define WUP2 ((bf16*)(wsp + WS_WUP2))
#define WDN2 ((bf16*)(wsp + WS_WDN2))
#define WPT ((bf16*)(wsp + WS_WPOOL))
#define H1 ((bf16*)(wsp + WS_H1))
#define MEM16 ((bf16*)(wsp + WS_MEM16))
#define A16 ((bf16*)(wsp + WS_A16))
#define P16 ((bf16*)(wsp + WS_A16) + 1024)
#define M16 ((bf16*)(wsp + WS_A16) + 1536)
#define H2 ((bf16*)(wsp + WS_A16))
#define Y16 ((bf16*)(wsp + WS_Y16))
#define KM ((bf16*)(wsp + WS_KM))
#define VM ((bf16*)(wsp + WS_VM))
#define MASKQ ((unsigned*)(wsp + WS_MASK))
#define X8 ((signed char*)(wsp + WS_BIG + O_X16))
#define WUP1q ((signed char*)(wsp + WS_BIG + O_WUP1))
#define WDN1q ((signed char*)(wsp + WS_BIG + O_WDN1))
#define G8 ((signed char*)(wsp + WS_BIG + O_G))
#define WUP2q ((signed char*)(wsp + WS_WUP2))
#define WDN2q ((signed char*)(wsp + WS_WDN2))
#define H2q ((signed char*)(wsp + WS_Y16))
#define G28 ((signed char*)(wsp + WS_BIG))
#define QS ((float*)(wsp + WS_QS))
#define SX1 ((float*)(wsp + WS_ROWQ))
#define GQ1 (SX1 + T)
#define SG1 (GQ1 + T)
#define SX2 (SG1 + T)
#define GQ2 (SX2 + T)
#define SG2 (GQ2 + T)
#define SXH (SG2 + T)
#define DQ0 (SXH + T)
#define DQ1 (DQ0 + T)
#define H1q ((signed char*)(wsp + WS_Y16))
#define WINq ((signed char*)(wsp + WS_WINQ))
#define R (ap->out)

    REP(0) if (IN(0)) { REPBAR(); WSP_DECL;
        LAS float* scr = (LAS float*)(L + RING_OFF + wave * 16384);
        const float s2u1 = fmaxf(sample_sigma2(ap->in[2], DM, NUP, lane), 1e-30f), s2d1 = fmaxf(sample_sigma2(ap->in[3], FF, DM, lane), 1e-30f);
        const float s2u2 = fmaxf(sample_sigma2(ap->in[17], DM, NUP, lane), 1e-30f), s2d2 = fmaxf(sample_sigma2(ap->in[18], FF, DM, lane), 1e-30f);
        const float qu1 = 127.f / (5.f * sqrtf(s2u1)), qd1 = 127.f / (5.f * sqrtf(s2d1)), qu2 = 127.f / (5.f * sqrtf(s2u2)), qd2 = 127.f / (5.f * sqrtf(s2d2));
        const float s2in = fmaxf(sample_sigma2(ap->in[6], DM, NIN, lane), 1e-30f), qin = 127.f / (5.f * sqrtf(s2in));
        if (gw == 0 && lane == 0) { QS[16] = qin; QS[17] = 1.f / qin; QS[0] = qu1; QS[1] = 1.f / qu1; QS[2] = s2u1; QS[3] = qd1; QS[4] = 1.f / qd1; QS[8] = qu2; QS[9] = 1.f / qu2; QS[10] = s2u2; QS[11] = qd2; QS[12] = 1.f / qd2; }
        constexpr int I_UP = (DM / 64) * (NUP / 32), I_DN = (FF / 64) * (DM / 32), I_IN = (DM / 64) * (NZB / 32), I_INQ = (DM / 64) * (NZQ / 32), I_MKV = (DM / 64) * (1024 / 32), I_BA = (1024 / 64) * (DM / 32),
                      I_BP = (512 / 64) * (DM / 32), I_OUT = (DM / 64) * (DM / 32), I_PL = (128 / 64) * (128 / 32);
        constexpr int NITEMS = I_UP + I_DN + I_IN + I_INQ + I_MKV + 4 * I_PL;
        for (int it = gw; it < NITEMS; it += NGW) {
            int r = it;
            if (r < I_UP) { p0_transpose_item_i8<1>(ap->in[2], DM, NUP, NUP, WUP1q, scr, r, lane, qu1); continue; } r -= I_UP;
            if (r < I_DN) { p0_transpose_item_i8<0>(ap->in[3], FF, DM, DM, WDN1q, scr, r, lane, qd1); continue; } r -= I_DN;
            if (r < I_IN) { p0_transpose_item<2>(ap->in[6], DM, NIN, NZB, WIN, scr, r, lane); continue; } r -= I_IN;
            if (r < I_INQ) { p0_transpose_item_i8<0>(ap->in[6] + 4176, DM, NIN, NZQ, WINq, scr, r, lane, qin); continue; } r -= I_INQ;
            if (r < I_MKV) { p0_transpose_item<0>(ap->in[8], DM, 1024, 1024, WMKV, scr, r, lane); continue; } r -= I_MKV;
            { const int g = r / I_PL; p0_transpose_item<0>(ap->in[9] + (size_t)g * 16384, 128, 128, 128, WPT + (size_t)g * 16384, scr, r % I_PL, lane); }
        }
        for (int m = gw; m < T; m += NGW) {
            f32x4 v[8];
#pragma unroll
            for (int j = 0; j < 8; ++j) v[j] = ((const GAS f32x4*)(XIN + (size_t)m * DM))[lane + 64 * j];
            quant_row_i8(v, X8 + (size_t)m * DM, SX1 + m, GQ1 + m, SG1 + m, s2u1, lane);
        }
        for (size_t i = (size_t)gw * 64 + lane; i < (size_t)512 * DM / 8; i += (size_t)NGW * 64) {
            const f32x4 a = ((const GAS f32x4*)MEMIN)[2 * i], c = ((const GAS f32x4*)MEMIN)[2 * i + 1];
            ((GAS v4u*)MEM16)[i] = (v4u){pk2(a.x, a.y), pk2(a.z, a.w), pk2(c.x, c.y), pk2(c.z, c.w)};
        }
    }
    SEAM(0);
    REP(1) if (IN(1)) { REPBAR(); WSP_DECL;
        pg8::Gemm g{(const bf16*)X8, (const bf16*)WUP1q, T, NUP, DM / 2}; pg8::StaticOrder S; S.init(T, NUP, G, bx);
        pg8::EpiSwigluI8 E{G8, FF, SX1, GQ1, QS + 1};
        pg8::gemm_phase<pg8::EpiSwigluI8, pg8::StaticOrder, true, true, true>(L + RING_OFF, g, S, E);
    }
    SEAM(1);
    REP(2) if (IN(2)) { REPBAR(); WSP_DECL;
        pg8::Gemm g{(const bf16*)G8, (const bf16*)WDN1q, T, DM, FF / 2}; pg8::StaticOrder S; S.init(T, DM, G, bx);
        pg8::EpiResI8<false> E{R, XIN, DM, ALPHA, 0.5f, SG1, QS + 4};
        pg8::gemm_phase<pg8::EpiResI8<false>, pg8::StaticOrder, true, true, true>(L + RING_OFF, g, S, E);
    }
    SEAM(2);
    REP(3) if (IN(3)) { REPBAR(); WSP_DECL; for (int m = gw; m < T; m += NGW) ln_row<true, true>(R + (size_t)m * DM, ap->in[4], ap->in[5], H1 + (size_t)m * DM, lane, H1q + (size_t)m * DM, SXH + m, DQ0 + m, DQ1 + m, 0.f); }
    SEAM(3);
    REP(4) if (IN(4)) { REPBAR(); WSP_DECL;
        { pg8::Gemm g{H1, WIN, T, NZB, DM}; pg8::OrderZ S; S.so.init(T, NZB, G, bx);
          pg8::EpiZ E{Q16, KI16, KM, WI};
          pg8::gemm_phase<pg8::EpiZ, pg8::OrderZ, true, true>(L + RING_OFF, g, S, E); }
        { pg8::Gemm g{(const bf16*)H1q, (const bf16*)WINq, T, NZQ, DM / 2}; pg8::OrderQ S; S.so.init(T, NZQ, G, bx); S.heavy = (32 * (NZB / 256) + 8) - 2 * G;
          pg8::EpiZq E{U16, ap->in[7], SXH, QS + 17};
          pg8::gemm_phase<pg8::EpiZq, pg8::OrderQ, true, true, true>(L + RING_OFF, g, S, E); }
    }
    SEAM(4);
    REP(5) if (IN(5)) { REPBAR(); WSP_DECL;
        for (int pp = vcu; pp < 256; pp += G) {
            const int b = pp >> 7, p = pp & 127;
#pragma unroll 1
            for (int k2 = 0; k2 < 2; ++k2) indexer_unit(L + RING_OFF, b, k2 ? 255 - p : p, QI16, KI16, WI, MASKQ);
        }
        __syncthreads();
    }
    SEAM(5);
    REP(6) if (IN(6)) { REPBAR(); WSP_DECL;
        const int xcd = bx & 7, ix = bx >> 3;
        if (ix < 32) {
            const int bh = xcd * 2 + (ix >> 4), qb = ix & 15, b = bh >> 3, hh = bh & 7;
            const size_t rowbase = (size_t)b * SEQ;
            const float ah = exp2f(-(float)(hh + 1)) * 11.313708498984761f;
            att::attn_block<1024, 2048, true>((const att::bf16*)(Q16 + (rowbase + qb * 256) * 1024 + hh * 128), (const att::bf16*)(K16 + rowbase * 1024 + hh * 128),
                                        (const att::bf16*)(V16 + rowbase * 1024 + hh * 128), (att::bf16*)(A16 + (rowbase + qb * 256) * 2048 + hh * 128),
                                        4 * (qb + 1), qb * 256, MASKQ + rowbase * 128, ah, (char*)lds + RING_OFF);
            if (qb < 8) { const int mi = bh * 8 + qb;
                const int mb = mi >> 6, mh = (mi >> 4) & 3, mq = mi & 15; const size_t mrow = (size_t)mb * SEQ + mq * 256;
                att::attn_block<512, 2048, false>((const att::bf16*)(QM16 + mrow * 512 + mh * 128), (const att::bf16*)(KM + (size_t)mb * MEMLEN * 512 + mh * 128),
                                            (const att::bf16*)(VM + (size_t)mb * MEMLEN * 512 + mh * 128), (att::bf16*)(M16 + mrow * 2048 + mh * 128),
                                            MEMLEN / 64, 0, nullptr, 0.f, (char*)lds + RING_OFF); }
            if (qb < 4) { for (int task = (bh * 4 + qb) * NWAVES + wave; task < 1024; task += 512) pool_task(task, U16, WPT, ap->in[10], P16, lane); }
        }
        {
            constexpr int I_UP = (DM / 64) * (NUP / 32), I_DN = (FF / 64) * (DM / 32), I_BA = (1024 / 64) * (DM / 32), I_BP = (512 / 64) * (DM / 32), I_OUT = (DM / 64) * (DM / 32);
            constexpr int NQI = I_BA + 2 * I_BP + I_OUT + I_UP + I_DN;
            LAS float* scr = (LAS float*)(L + RING_OFF + wave * 8448);
            const float qu2 = QS[8], qd2 = QS[11];
            unsigned* qctr = (unsigned*)(wsp + 8192);
            for (;;) {
                unsigned it0 = 0u;
                if (lane == 0) it0 = __hip_atomic_fetch_add(qctr, 4u, __ATOMIC_RELAXED, __HIP_MEMORY_SCOPE_AGENT);
                it0 = (unsigned)__builtin_amdgcn_readfirstlane((int)it0);
                if (it0 >= (unsigned)NQI) break;
                for (int k = 0; k < 4; ++k) { int r = (int)it0 + k; if (r >= NQI) break;
                    if (r < I_BA) { p0_transpose_item<0>(ap->in[11], 1024, DM, DM, WBA, scr, r, lane, DM); continue; } r -= I_BA;
                    if (r < I_BP) { p0_transpose_item<0>(ap->in[12], 512, DM, DM, WBA + 1024, scr, r, lane, DM); continue; } r -= I_BP;
                    if (r < I_BP) { p0_transpose_item<0>(ap->in[13], 512, DM, DM, WBA + 1536, scr, r, lane, DM); continue; } r -= I_BP;
                    if (r < I_OUT) { p0_transpose_item<0>(ap->in[14], DM, DM, DM, WOUT, scr, r, lane); continue; } r -= I_OUT;
                    if (r < I_UP) p0_transpose_item_i8<1>(ap->in[17], DM, NUP, NUP, WUP2q, scr, r, lane, qu2);
                    else p0_transpose_item_i8<0>(ap->in[18], FF, DM, DM, WDN2q, scr, r - I_UP, lane, qd2); }
            }
        }
    }
    SEAM(6);
    REP(7) if (IN(7)) { REPBAR(); WSP_DECL;
        pg8::StaticOrder S; S.init(T, DM, G, bx);
        { pg8::Gemm g{A16, WBA, T, DM, DM}; pg8::OrderBr SB; SB.so = S; pg8::EpiBranch E{Y16, GATE}; pg8::gemm_phase<pg8::EpiBranch, pg8::OrderBr, true, true>(L + RING_OFF, g, SB, E); }
    }
    SEAM(7);
    REP(8) if (IN(8)) { REPBAR(); WSP_DECL;
        pg8::Gemm g{Y16, WOUT, T, DM, DM}; pg8::StaticOrder S; S.init(T, DM, G, bx);
        pg8::EpiRes<true> E{R, H1, DM, ALPHA, 1.0f};
        pg8::gemm_phase<pg8::EpiRes<true>, pg8::StaticOrder, true, true>(L + RING_OFF, g, S, E);
    }
    SEAM(8);
    REP(9) if (IN(9)) { REPBAR(); WSP_DECL; const float sig2 = QS[10]; for (int m = gw; m < T; m += NGW) ln_row<true, true>(R + (size_t)m * DM, ap->in[15], ap->in[16], H2 + (size_t)m * DM, lane, H2q + (size_t)m * DM, SX2 + m, GQ2 + m, SG2 + m, sig2); }
    SEAM(9);
    REP(10) if (IN(10)) { REPBAR(); WSP_DECL;
        pg8::Gemm g{(const bf16*)H2q, (const bf16*)WUP2q, T, NUP, DM / 2}; pg8::StaticOrder S; S.init(T, NUP, G, bx);
        pg8::EpiSwigluI8 E{G28, FF, SX2, GQ2, QS + 9};
        pg8::gemm_phase<pg8::EpiSwigluI8, pg8::StaticOrder, true, true, true>(L + RING_OFF, g, S, E);
    }
    SEAM(10);
    REP(11) if (IN(11)) { REPBAR(); WSP_DECL;
        pg8::Gemm g{(const bf16*)G28, (const bf16*)WDN2q, T, DM, FF / 2}; pg8::StaticOrder S; S.init(T, DM, G, bx);
        pg8::EpiResI8<true> E{R, H2, DM, ALPHA, 0.5f, SG2, QS + 12};
        pg8::gemm_phase<pg8::EpiResI8<true>, pg8::StaticOrder, true, true, true>(L + RING_OFF, g, S, E);
    }
    SEAM(11);
    REP(12) if (IN(12)) { REPBAR(); WSP_DECL; for (int m = gw; m < T; m += NGW) ln_row<false>(R + (size_t)m * DM, ap->in[19], ap->in[20], R + (size_t)m * DM, lane); }
#undef BIG
#undef X16
#undef WUP1
#undef WDN1
#undef Gb
#undef Q16
#undef K16
#undef V16
#undef QI16
#undef KI16
#undef WI
#undef U16
#undef QM16
#undef GATE
#undef WIN
#undef WMKV
#undef WBA
#undef WBP
#undef WBM
#undef WOUT
#undef WUP2
#undef WDN2
#undef WPT
#undef H1
#undef MEM16
#undef A16
#undef P16
#undef M16
#undef H2
#undef Y16
#undef KM
#undef VM
#undef MASKQ
#undef X8
#undef WUP1q
#undef WDN1q
#undef G8
#undef WUP2q
#undef WDN2q
#undef H2q
#undef G28
#undef QS
#undef SX1
#undef GQ1
#undef SG1
#undef SX2
#undef GQ2
#undef SG2
#undef SXH
#undef DQ0
#undef DQ1
#undef H1q
#undef WINq
#undef R
#undef XIN
#undef MEMIN
#undef WSP_DECL
#undef IN
#undef SEAM
}

extern "C" void kernel_launch(void* const* d_in, const int* in_sizes, int n_in, void* d_out, int out_size, void* d_ws, size_t ws_size, hipStream_t stream) {
    static int grid = 0;
    if (grid == 0) {
        if (n_in != 21 || in_sizes[0] != T * DM || out_size != T * DM || ws_size < WS_END) {
            fprintf(stderr, "kernel_launch: shape/workspace mismatch (n_in %d, in0 %d, out %d, ws %zu, need %zu); nothing launched\n", n_in, n_in > 0 ? in_sizes[0] : -1, out_size, ws_size, (size_t)WS_END);
            grid = -1; return; }
        int dev = 0, cus = 0;
        if (hipGetDevice(&dev) != hipSuccess || hipDeviceGetAttribute(&cus, hipDeviceAttributeMultiprocessorCount, dev) != hipSuccess) { grid = -1; return; }
        if (hipFuncSetAttribute((const void*)mk_fwd, hipFuncAttributeMaxDynamicSharedMemorySize, LDS_BYTES) != hipSuccess) { fprintf(stderr, "kernel_launch: hipFuncSetAttribute failed\n"); grid = -1; return; }
        (void)hipGetLastError();
        grid = cus;
        if (grid != 256) fprintf(stderr, "kernel_launch: %d CUs (built for 256)\n", grid);
    }
    if (grid < 0) return;
    if (hipMemsetAsync((char*)d_ws + WS_CTL, 0, CTL_ZERO_BYTES, stream) != hipSuccess) return;
    Args a{};
    for (int i = 0; i < 21; ++i) a.in[i] = (const float*)d_in[i];
    a.out = (float*)d_out; a.ws = (unsigned char*)d_ws;
#if MK_PER_PHASE
    for (int p = 0; p < N_PHASES; ++p) { a.ph_lo = p; a.ph_hi = p + 1; hipLaunchKernelGGL(mk_fwd, dim3(grid), dim3(NWAVES * 64), LDS_BYTES, stream, a); }
#else
    a.ph_lo = 0; a.ph_hi = N_PHASES;
    hipLaunchKernelGGL(mk_fwd, dim3(grid), dim3(NWAVES * 64), LDS_BYTES, stream, a);
#endif
}
```

```cpp
#include <hip/hip_runtime.h>
#include <hip/hip_bf16.h>
#include <cstdio>
#include <cstdint>

#ifndef MK_PER_PHASE
#define MK_PER_PHASE 0
#endif

namespace pg8 {
#define PG8_LAS __attribute__((address_space(3)))
typedef unsigned short bf16_t;
typedef short bf16x8 __attribute__((ext_vector_type(8)));
typedef float f32x4 __attribute__((ext_vector_type(4)));
typedef float f32x2 __attribute__((ext_vector_type(2)));
typedef unsigned u32x4 __attribute__((ext_vector_type(4)));
typedef unsigned u32x2 __attribute__((ext_vector_type(2)));
typedef int i32x4 __attribute__((ext_vector_type(4)));
template <bool I8> struct AccSel { typedef f32x4 type; };
template <> struct AccSel<true> { typedef i32x4 type; };
constexpr int BM = 256, BK = 64, HALF = 128, HTB = HALF * BK * 2, STAGE_BYTES = 8 * HTB, NXCD = 8, WGM = 8;

__host__ __device__ __forceinline__ int lds_byte(int r, int c) { const int st = (r >> 4) * 2 + (c >> 5), rr = r & 15, cc = c & 31, ob = rr * 64 + cc * 2; return st * 1024 + (ob ^ (((ob >> 9) & 1) << 5)); }
__host__ __device__ __forceinline__ void stage_rc(int b, int& R, int& C) { const int st = b / 1024, sb = b % 1024, swz = sb ^ (((sb >> 9) & 1) << 5); R = (st >> 1) * 16 + swz / 64; C = (st & 1) * 32 + (swz % 64) / 2; }
__host__ __device__ __forceinline__ int perm32(int rho) { const int n = rho >> 4, i = rho & 15; return 8 * (i >> 2) + 4 * n + (i & 3); }

struct Unit { int pm, pn, ko, nt, br; };
struct Gemm { const bf16_t* A; const bf16_t* Bt; int M, N, K; };

struct StaticOrder {
    int nM, nN, nwg, G, c;
    __host__ __device__ void init(int M, int N, int G_, int c_) { nM = M / BM; nN = N / BM; nwg = nM * nN; G = G_; c = c_; }
    __host__ __device__ bool next(int i, Unit& u) const {
        const long L = (long)i * G + c; if (L >= nwg) return false;
        int wgid = (int)L; { const int q = nwg / NXCD, r = nwg % NXCD, xcd = wgid % NXCD, off = wgid / NXCD; wgid = (xcd < r ? xcd * (q + 1) : r * (q + 1) + (xcd - r) * q) + off; }
        const int nig = WGM * nN, gid = wgid / nig, fm = gid * WGM, gsz = (nM - fm) < WGM ? (nM - fm) : WGM;
        u.pm = fm + ((wgid % nig) % gsz); u.pn = (wgid % nig) / gsz; u.ko = 0; u.nt = 0; u.br = 0; return true;
    }
    __device__ __forceinline__ void a_ready(const Unit&) const {}
    __device__ __forceinline__ void done(const Unit&) const {}
};
struct OrderZ {
    StaticOrder so;
    __device__ __forceinline__ bool next(int i, Unit& u) const {
        const long L = (long)i * so.G + so.c;
        if (L < so.nwg) return so.next(i, u);
        if (L < so.nwg + 8) { const int e = (int)(L - so.nwg); u.pm = 32 + (e >> 2); u.pn = so.nN + (e & 3); u.ko = 0; u.nt = 0; u.br = 0; return true; }
        return false;
    }
    __device__ __forceinline__ void a_ready(const Unit&) const {}
    __device__ __forceinline__ void done(const Unit&) const {}
};
struct OrderQ {
    StaticOrder so; int heavy;
    __device__ __forceinline__ bool next(int i, Unit& u) const {
        const int c = so.c, nl = so.G - heavy; long L;
        if (c >= heavy) { if (i >= 4) return false; L = (long)i * nl + (c - heavy); if (L >= 4L * nl) return false; }
        else { if (i >= 1) return false; L = 4L * nl + c; }
        if (L >= so.nwg) return false;
        int wgid = (int)L; { const int q = so.nwg / NXCD, r = so.nwg % NXCD, xcd = wgid % NXCD, off = wgid / NXCD; wgid = (xcd < r ? xcd * (q + 1) : r * (q + 1) + (xcd - r) * q) + off; }
        const int nig = WGM * so.nN, gid = wgid / nig, fm = gid * WGM, gsz = (so.nM - fm) < WGM ? (so.nM - fm) : WGM;
        u.pm = fm + ((wgid % nig) % gsz); u.pn = (wgid % nig) / gsz; u.ko = 0; u.nt = 0; u.br = 0; return true;
    }
    __device__ __forceinline__ void a_ready(const Unit&) const {}
    __device__ __forceinline__ void done(const Unit&) const {}
};
struct OrderBr {
    StaticOrder so;
    __device__ __forceinline__ bool next(int i, Unit& u) const {
        const int ti = i / 3, br = i - 3 * ti;
        if (!so.next(ti, u)) return false;
        u.br = br; u.ko = br == 0 ? 0 : (br == 1 ? 1024 : 1536); u.nt = br == 0 ? 16 : 8; return true;
    }
    __device__ __forceinline__ void a_ready(const Unit&) const {}
    __device__ __forceinline__ void done(const Unit&) const {}
};

__device__ __forceinline__ unsigned cvt_pk_bf16(float lo, float hi) { unsigned r; asm volatile("v_cvt_pk_bf16_f32 %0, %1, %2" : "=v"(r) : "v"(lo), "v"(hi)); return r; }
__device__ __forceinline__ float bf_lo(unsigned w) { return __uint_as_float(w << 16); }
__device__ __forceinline__ float bf_hi(unsigned w) { return __uint_as_float(w & 0xffff0000u); }
__device__ __forceinline__ float sigmoidf_(float x) { return __builtin_amdgcn_rcpf(1.0f + __builtin_amdgcn_exp2f(-1.4426950408889634f * x)); }

struct EpiSwiglu {
    static constexpr bool PERM = true, AFTER_DRAIN = false, CHAIN = false;
    bf16_t* G; int ldg;
    __device__ __forceinline__ void operator()(const f32x4 (&acc)[2][2][4][2], const Unit& u, int wr, int wc, int fr, int fq) const {
        const int row0 = u.pm * BM + wr * 64 + fr, col0 = u.pn * HALF + wc * 32 + 8 * fq;
#pragma unroll
        for (int ai = 0; ai < 2; ++ai)
#pragma unroll
            for (int m = 0; m < 4; ++m) {
                bf16_t* rowp = G + (size_t)(row0 + ai * HALF + m * 16) * ldg + col0;
                float g[8];
#pragma unroll
                for (int n = 0; n < 2; ++n)
#pragma unroll
                    for (int e = 0; e < 4; ++e) { const float a = acc[ai][0][m][n][e], uu = acc[ai][1][m][n][e]; g[n * 4 + e] = a * uu * sigmoidf_(a); }
                u32x4 w; w.x = cvt_pk_bf16(g[0], g[1]); w.y = cvt_pk_bf16(g[2], g[3]); w.z = cvt_pk_bf16(g[4], g[5]); w.w = cvt_pk_bf16(g[6], g[7]);
                *(u32x4*)rowp = w;
            }
    }
};
struct EpiSwigluI8 {
    static constexpr bool PERM = true, AFTER_DRAIN = false, CHAIN = false;
    signed char* G; int ldg; const float* sx; const float* gq; const float* wdq;
    __device__ __forceinline__ void operator()(const i32x4 (&acc)[2][2][4][2], const Unit& u, int wr, int wc, int fr, int fq) const {
        const int row0 = u.pm * BM + wr * 64 + fr, col0 = u.pn * HALF + wc * 32 + 8 * fq;
        const float wd = *wdq;
#pragma unroll
        for (int ai = 0; ai < 2; ++ai)
#pragma unroll
            for (int m = 0; m < 4; ++m) {
                const int row = row0 + ai * HALF + m * 16;
                const float sa = sx[row] * wd, gm = gq[row];
                unsigned w[2];
#pragma unroll
                for (int n = 0; n < 2; ++n) { int q[4];
#pragma unroll
                    for (int e = 0; e < 4; ++e) { const float a = (float)acc[ai][0][m][n][e] * sa, uu = (float)acc[ai][1][m][n][e] * sa; const float g = a * uu * sigmoidf_(a);
                        q[e] = (int)__builtin_rintf(fminf(fmaxf(g * gm, -127.f), 127.f)); }
                    w[n] = (unsigned)(q[0] & 255) | ((unsigned)(q[1] & 255) << 8) | ((unsigned)(q[2] & 255) << 16) | ((unsigned)q[3] << 24); }
                *(u32x2*)(G + (size_t)row * ldg + col0) = (u32x2){w[0], w[1]};
            }
    }
};
template <bool RESBF> struct EpiResI8 {
    static constexpr bool PERM = false, AFTER_DRAIN = false, CHAIN = false;
    float* out; const void* res; int ldc; float alpha, sc; const float* sg; const float* wdq;
    __device__ __forceinline__ void operator()(const i32x4 (&acc)[2][2][4][2], const Unit& u, int wr, int wc, int fr, int fq) const {
        const int row0 = u.pm * BM + wr * 64 + fr, col0 = u.pn * BM + wc * 32 + 4 * fq;
        const float wd = *wdq * sc;
#pragma unroll
        for (int ai = 0; ai < 2; ++ai)
#pragma unroll
            for (int m = 0; m < 4; ++m) { const int row = row0 + ai * HALF + m * 16; const size_t off = (size_t)row * ldc + col0; const float s = sg[row] * wd;
#pragma unroll
                for (int bj = 0; bj < 2; ++bj)
#pragma unroll
                    for (int n = 0; n < 2; ++n) { const size_t o = off + bj * HALF + n * 16; f32x4 r;
                        if (RESBF) { const u32x2 w = *(const u32x2*)((const bf16_t*)res + o); r = (f32x4){bf_lo(w.x), bf_hi(w.x), bf_lo(w.y), bf_hi(w.y)}; }
                        else r = *(const f32x4*)((const float*)res + o);
                        const i32x4 a = acc[ai][bj][m][n];
                        *(f32x4*)(out + o) = r * alpha + (f32x4){(float)a[0], (float)a[1], (float)a[2], (float)a[3]} * s; } }
    }
};
template <bool RESBF> struct EpiRes {
    static constexpr bool PERM = false, AFTER_DRAIN = false, CHAIN = false;
    float* out; const void* res; int ldc; float alpha, sc;
    __device__ __forceinline__ void operator()(const f32x4 (&acc)[2][2][4][2], const Unit& u, int wr, int wc, int fr, int fq) const {
        const int row0 = u.pm * BM + wr * 64 + fr, col0 = u.pn * BM + wc * 32 + 4 * fq;
#pragma unroll
        for (int ai = 0; ai < 2; ++ai)
#pragma unroll
            for (int m = 0; m < 4; ++m) { const size_t off = (size_t)(row0 + ai * HALF + m * 16) * ldc + col0;
#pragma unroll
                for (int bj = 0; bj < 2; ++bj)
#pragma unroll
                    for (int n = 0; n < 2; ++n) { const size_t o = off + bj * HALF + n * 16; f32x4 r;
                        if (RESBF) { const u32x2 w = *(const u32x2*)((const bf16_t*)res + o); r = (f32x4){bf_lo(w.x), bf_hi(w.x), bf_lo(w.y), bf_hi(w.y)}; }
                        else r = *(const f32x4*)((const float*)res + o);
                        *(f32x4*)(out + o) = r * alpha + acc[ai][bj][m][n] * sc; } }
    }
};
struct EpiBranch {
    static constexpr bool PERM = false, AFTER_DRAIN = false, CHAIN = true;
    bf16_t* Y16; const bf16_t* gate;
    __device__ __forceinline__ bool chain(f32x4 (&acc)[2][2][4][2], const Unit& u, int wr, int wc, int fr, int fq) const {
        const int row0 = u.pm * BM + wr * 64 + fr, col0 = u.pn * BM + wc * 32 + 4 * fq, br = u.br;
        const float FL = 8.673617379884035e-19f;
#pragma unroll
        for (int ai = 0; ai < 2; ++ai)
#pragma unroll
            for (int m = 0; m < 4; ++m) { const size_t row = (size_t)(row0 + ai * HALF + m * 16);
#pragma unroll
                for (int bj = 0; bj < 2; ++bj)
#pragma unroll
                    for (int n = 0; n < 2; ++n) { const int col = col0 + bj * HALF + n * 16;
                        const u32x2 w = *(const u32x2*)(gate + row * 6144 + br * 2048 + col);
                        f32x4 g = (f32x4){fmaxf(bf_lo(w.x), FL), fmaxf(bf_hi(w.x), FL), fmaxf(bf_lo(w.y), FL), fmaxf(bf_hi(w.y), FL)};
                        if (br < 2) { const u32x2 w2 = *(const u32x2*)(gate + row * 6144 + (br + 1) * 2048 + col);
                            g[0] *= __builtin_amdgcn_rcpf(fmaxf(bf_lo(w2.x), FL)); g[1] *= __builtin_amdgcn_rcpf(fmaxf(bf_hi(w2.x), FL));
                            g[2] *= __builtin_amdgcn_rcpf(fmaxf(bf_lo(w2.y), FL)); g[3] *= __builtin_amdgcn_rcpf(fmaxf(bf_hi(w2.y), FL));
                            acc[ai][bj][m][n] *= g; }
                        else { const f32x4 v = acc[ai][bj][m][n] * g; u32x2 o; o.x = cvt_pk_bf16(v[0], v[1]); o.y = cvt_pk_bf16(v[2], v[3]); *(u32x2*)(Y16 + row * 2048 + col) = o; } } }
        return br < 2;
    }
};
struct EpiZ {
    static constexpr bool PERM = true, AFTER_DRAIN = false, CHAIN = false;
    bf16_t *QI, *KI, *KM; float* WI;
    __device__ __forceinline__ void operator()(const f32x4 (&acc)[2][2][4][2], const Unit& u, int wr, int wc, int fr, int fq) const {
        const int pn = u.pn;
        bf16_t* base; int ld, ct = 0, mode = 0, rowoff = 0;
        if (pn < 4) { base = QI; ld = 1024; ct = pn; }
        else if (pn == 4) { base = KI; ld = 64; mode = 2; }
        else { base = KM + (size_t)((pn - 5) >> 1) * (512 * 512); ld = 512; ct = (pn - 5) & 1; rowoff = 8192; }
        const int row0 = u.pm * BM + wr * 64 + fr - rowoff, cl = wc * 32 + 8 * fq;
        if (mode == 2) {
#pragma unroll
            for (int ai = 0; ai < 2; ++ai)
#pragma unroll
                for (int m = 0; m < 4; ++m) { const size_t row = (size_t)(row0 + ai * HALF + m * 16);
                    const f32x4 v0 = acc[ai][0][m][0], v1 = acc[ai][0][m][1];
                    if (cl < 64) { u32x4 w; w.x = cvt_pk_bf16(v0[0], v0[1]); w.y = cvt_pk_bf16(v0[2], v0[3]); w.z = cvt_pk_bf16(v1[0], v1[1]); w.w = cvt_pk_bf16(v1[2], v1[3]); *(u32x4*)(KI + row * 64 + cl) = w; }
                    else if (cl < 80) { const float s = 1.0f / 32.0f;
                        *(f32x4*)(WI + row * 16 + (cl - 64)) = v0 * s; *(f32x4*)(WI + row * 16 + (cl - 64) + 4) = v1 * s; } }
            return;
        }
        const int col0 = ct * BM + cl;
#pragma unroll
        for (int ai = 0; ai < 2; ++ai)
#pragma unroll
            for (int m = 0; m < 4; ++m) { bf16_t* rowp = base + (size_t)(row0 + ai * HALF + m * 16) * ld + col0;
#pragma unroll
                for (int bj = 0; bj < 2; ++bj) { const f32x4 v0 = acc[ai][bj][m][0], v1 = acc[ai][bj][m][1];
                    u32x4 w; w.x = cvt_pk_bf16(v0[0], v0[1]); w.y = cvt_pk_bf16(v0[2], v0[3]); w.z = cvt_pk_bf16(v1[0], v1[1]); w.w = cvt_pk_bf16(v1[2], v1[3]);
                    *(u32x4*)(rowp + bj * HALF) = w; } }
    }
};
struct EpiZq {
    static constexpr bool PERM = true, AFTER_DRAIN = false, CHAIN = false;
    bf16_t *Q, *U; const float* bgate; const float* sx; const float* wdq;
    __device__ __forceinline__ void operator()(const i32x4 (&acc)[2][2][4][2], const Unit& u, int wr, int wc, int fr, int fq) const {
        const int pn = u.pn; const bool gate = pn >= 16, qkv = pn < 12;
        bf16_t* base = qkv ? Q + (size_t)(pn >> 2) * ((size_t)8192 * 1024)
                           : U + (size_t)(gate ? 2 : ((pn - 12) >> 1)) * ((size_t)8192 * 512);
        const int ld = qkv ? 1024 : (gate ? 6144 : 512), ct = qkv ? (pn & 3) : (gate ? pn - 16 : ((pn - 12) & 1));
        const int row0 = u.pm * BM + wr * 64 + fr, col0 = ct * BM + wc * 32 + 8 * fq;
        const float wd = *wdq;
        f32x4 bv[2][2];
#pragma unroll
        for (int bj = 0; bj < 2; ++bj)
#pragma unroll
            for (int n = 0; n < 2; ++n) bv[bj][n] = gate ? *(const f32x4*)(bgate + col0 + bj * HALF + 4 * n) : (f32x4){0.f, 0.f, 0.f, 0.f};
#pragma unroll
        for (int ai = 0; ai < 2; ++ai)
#pragma unroll
            for (int m = 0; m < 4; ++m) { const int row = row0 + ai * HALF + m * 16; bf16_t* rowp = base + (size_t)row * ld + col0; const float sa = sx[row] * wd;
#pragma unroll
                for (int bj = 0; bj < 2; ++bj) { const i32x4 a0 = acc[ai][bj][m][0], a1 = acc[ai][bj][m][1];
                    f32x4 v0 = (f32x4){(float)a0[0], (float)a0[1], (float)a0[2], (float)a0[3]} * sa + bv[bj][0], v1 = (f32x4){(float)a1[0], (float)a1[1], (float)a1[2], (float)a1[3]} * sa + bv[bj][1];
                    if (gate) {
#pragma unroll
                        for (int e = 0; e < 4; ++e) { v0[e] = sigmoidf_(v0[e]); v1[e] = sigmoidf_(v1[e]); } }
                    u32x4 w; w.x = cvt_pk_bf16(v0[0], v0[1]); w.y = cvt_pk_bf16(v0[2], v0[3]); w.z = cvt_pk_bf16(v1[0], v1[1]); w.w = cvt_pk_bf16(v1[2], v1[3]);
                    *(u32x4*)(rowp + bj * HALF) = w; } }
    }
};

template <class Epi, class Sched, bool ALIGN_EPI = false, bool SP2 = false, bool I8 = false>
__device__ __forceinline__ void gemm_phase(PG8_LAS unsigned char* lds, const Gemm g, const Sched& S, const Epi& E) {
    int tid_ = threadIdx.x; asm volatile("" : "+v"(tid_));
    const int tid = tid_, wid = __builtin_amdgcn_readfirstlane(tid >> 6), lane = tid & 63, wr = wid >> 2, wc = wid & 3, fr = lane & 15, fq = lane >> 4;
    const int K = g.K, nt = K / BK;
    unsigned voffA[2], voffB[2];
#pragma unroll
    for (int i = 0; i < 2; ++i) { int R, C; stage_rc(tid * 16 + i * 8192, R, C); const int Rb = Epi::PERM ? ((R & ~31) + perm32(R & 31)) : R;
        voffA[i] = (unsigned)(R * K + C) * 2u; voffB[i] = (unsigned)(Rb * K + C) * 2u; }
    const size_t kstep = (size_t)(BK * 2);
    const size_t hstep = (size_t)HALF * K * 2;
    const size_t tstep = 2 * hstep;
    const unsigned ldsw = (unsigned)wid * 1024u;
    const int aoff = lds_byte(wr * 64 + fr, fq * 8), boff = lds_byte(wc * 32 + fr, fq * 8);
#define PG8_SA(b, h) (((b) * 2 + (h)) * HTB)
#define PG8_SB(b, h) ((4 + (b) * 2 + (h)) * HTB)
#define PG8_STAGE(bufoff, gbase, voff) do { _Pragma("unroll") for (int _i = 0; _i < 2; ++_i) \
        __builtin_amdgcn_global_load_lds((const unsigned*)((const char*)(gbase) + (voff)[_i]), (PG8_LAS unsigned*)(lds + (bufoff) + ldsw + _i * 8192), 16, 0, 0); } while (0)
#define PG8_LDA(dst, b, h) do { _Pragma("unroll") for (int m = 0; m < 4; ++m) _Pragma("unroll") for (int k = 0; k < 2; ++k) dst[m][k] = *(const PG8_LAS bf16x8*)(lds + PG8_SA(b, h) + aoff + m * 2048 + k * 1024); } while (0)
#define PG8_LDB(dst, b, h) do { _Pragma("unroll") for (int n = 0; n < 2; ++n) _Pragma("unroll") for (int k = 0; k < 2; ++k) dst[n][k] = *(const PG8_LAS bf16x8*)(lds + PG8_SB(b, h) + boff + n * 2048 + k * 1024); } while (0)
#define PG8_MMA(ai, bj, At, Bt) do { __builtin_amdgcn_s_setprio(1); _Pragma("unroll") for (int m = 0; m < 4; ++m) _Pragma("unroll") for (int n = 0; n < 2; ++n) _Pragma("unroll") for (int k = 0; k < 2; ++k) \
        { if constexpr (I8) acc[ai][bj][m][n] = __builtin_amdgcn_mfma_i32_16x16x64_i8(__builtin_bit_cast(i32x4, Bt[n][k]), __builtin_bit_cast(i32x4, At[m][k]), acc[ai][bj][m][n], 0, 0, 0); \
          else acc[ai][bj][m][n] = __builtin_amdgcn_mfma_f32_16x16x32_bf16(Bt[n][k], At[m][k], acc[ai][bj][m][n], 0, 0, 0); } __builtin_amdgcn_s_setprio(0); } while (0)
#define PG8_WAIT_V(n) asm volatile("s_waitcnt vmcnt(" #n ")" ::: "memory")
#define PG8_WAIT_L(n) asm volatile("s_waitcnt lgkmcnt(" #n ")" ::: "memory")
#define PG8_BAR __builtin_amdgcn_s_barrier()
#define PG8_SCHED __builtin_amdgcn_sched_barrier(0)
    Unit cur, nxt; int ui = 0;
    if (!S.next(0, cur)) return;
    typedef typename AccSel<I8>::type acc_t;
    acc_t acc[2][2][4][2];
#pragma unroll
    for (int a = 0; a < 2; ++a)
#pragma unroll
        for (int b = 0; b < 2; ++b)
#pragma unroll
            for (int m = 0; m < 4; ++m)
#pragma unroll
                for (int n = 0; n < 2; ++n) acc[a][b][m][n] = acc_t{};
    bf16x8 At[4][2], B0[2][2], B1[2][2];
    const char* cA = (const char*)g.A + (size_t)cur.pm * tstep + (size_t)cur.ko * 2; const char* cB = (const char*)g.Bt + (size_t)cur.pn * tstep + (size_t)cur.ko * 2;
    int ntc = cur.nt ? cur.nt : nt;
    S.a_ready(cur);
    if constexpr (SP2) {
        PG8_STAGE(PG8_SB(0, 0), cB, voffB); PG8_STAGE(PG8_SB(0, 1), cB + hstep, voffB); PG8_STAGE(PG8_SA(0, 0), cA, voffA); PG8_STAGE(PG8_SA(0, 1), cA + hstep, voffA);
        if (wr == 1) PG8_BAR;
        PG8_WAIT_V(2); PG8_BAR;
        PG8_STAGE(PG8_SB(1, 0), cB + kstep, voffB); PG8_STAGE(PG8_SA(1, 0), cA + kstep, voffA); PG8_STAGE(PG8_SB(1, 1), cB + hstep + kstep, voffB);
        PG8_WAIT_V(6); PG8_BAR;
    } else {
        PG8_STAGE(PG8_SB(0, 0), cB, voffB); PG8_STAGE(PG8_SA(0, 0), cA, voffA); PG8_STAGE(PG8_SB(0, 1), cB + hstep, voffB); PG8_STAGE(PG8_SA(0, 1), cA + hstep, voffA);
        if (wr == 1) PG8_BAR;
        PG8_WAIT_V(4); PG8_BAR;
        PG8_STAGE(PG8_SB(1, 0), cB + kstep, voffB); PG8_STAGE(PG8_SA(1, 0), cA + kstep, voffA); PG8_STAGE(PG8_SB(1, 1), cB + hstep + kstep, voffB);
        PG8_WAIT_V(6); PG8_BAR;
    }
    for (;;) {
        const bool has_next = S.next(ui + 1, nxt);
        const char* nA = has_next ? (const char*)g.A + (size_t)nxt.pm * tstep + (size_t)nxt.ko * 2 : cA; const char* nB = has_next ? (const char*)g.Bt + (size_t)nxt.pn * tstep + (size_t)nxt.ko * 2 : cB;
        for (int t = 0; t < ntc; t += 2) {
            const bool last = (t == ntc - 2);
            const char* a1 = cA + (size_t)(t + 1) * kstep;
            const char* a2 = last ? nA : cA + (size_t)(t + 2) * kstep; const char* b2 = last ? nB : cB + (size_t)(t + 2) * kstep;
            const char* a3 = a2 + kstep; const char* b3 = b2 + kstep;
            if (last && has_next) S.a_ready(nxt);
            if constexpr (SP2) {
            PG8_LDB(B0, 0, 0); PG8_LDB(B1, 0, 1); PG8_SCHED; PG8_LDA(At, 0, 0); PG8_STAGE(PG8_SA(1, 1), a1 + hstep, voffA);
            PG8_WAIT_V(8); PG8_WAIT_L(0); PG8_BAR; PG8_MMA(0, 0, At, B0); PG8_MMA(0, 1, At, B1); PG8_BAR; PG8_SCHED;
            PG8_LDA(At, 0, 1); PG8_STAGE(PG8_SB(0, 0), b2, voffB); PG8_STAGE(PG8_SB(0, 1), b2 + hstep, voffB); PG8_STAGE(PG8_SA(0, 0), a2, voffA);
            PG8_WAIT_V(8); PG8_WAIT_L(0); PG8_BAR; PG8_MMA(1, 0, At, B0); PG8_MMA(1, 1, At, B1); PG8_BAR; PG8_SCHED;
            PG8_LDB(B0, 1, 0); PG8_LDB(B1, 1, 1); PG8_SCHED; PG8_LDA(At, 1, 0); PG8_STAGE(PG8_SA(0, 1), a2 + hstep, voffA);
            PG8_WAIT_V(8); PG8_WAIT_L(0); PG8_BAR; PG8_MMA(0, 0, At, B0); PG8_MMA(0, 1, At, B1); PG8_BAR; PG8_SCHED;
            PG8_LDA(At, 1, 1); PG8_STAGE(PG8_SB(1, 0), b3, voffB); PG8_STAGE(PG8_SB(1, 1), b3 + hstep, voffB); PG8_STAGE(PG8_SA(1, 0), a3, voffA);
            PG8_WAIT_V(8); PG8_WAIT_L(0); PG8_BAR; PG8_MMA(1, 0, At, B0); PG8_MMA(1, 1, At, B1); PG8_BAR; PG8_SCHED;
            } else {
            PG8_LDB(B0, 0, 0); PG8_SCHED; PG8_LDA(At, 0, 0); PG8_STAGE(PG8_SA(1, 1), a1 + hstep, voffA);
            PG8_WAIT_L(8); PG8_BAR; PG8_WAIT_L(0); PG8_MMA(0, 0, At, B0); PG8_BAR; PG8_SCHED;
            PG8_LDB(B1, 0, 1); PG8_STAGE(PG8_SB(0, 0), b2, voffB);
            PG8_BAR; PG8_WAIT_L(0); PG8_MMA(0, 1, At, B1); PG8_BAR;
            PG8_LDA(At, 0, 1); PG8_STAGE(PG8_SA(0, 0), a2, voffA);
            PG8_BAR; PG8_WAIT_L(0); PG8_MMA(1, 0, At, B0); PG8_BAR; PG8_SCHED;
            PG8_STAGE(PG8_SB(0, 1), b2 + hstep, voffB);
            PG8_WAIT_V(6); PG8_BAR; PG8_MMA(1, 1, At, B1); PG8_BAR;
            PG8_LDB(B0, 1, 0); PG8_SCHED; PG8_LDA(At, 1, 0); PG8_STAGE(PG8_SA(0, 1), a2 + hstep, voffA);
            PG8_WAIT_L(8); PG8_BAR; PG8_WAIT_L(0); PG8_MMA(0, 0, At, B0); PG8_BAR; PG8_SCHED;
            PG8_LDB(B1, 1, 1); PG8_STAGE(PG8_SB(1, 0), b3, voffB);
            PG8_BAR; PG8_WAIT_L(0); PG8_MMA(0, 1, At, B1); PG8_BAR;
            PG8_LDA(At, 1, 1); PG8_STAGE(PG8_SA(1, 0), a3, voffA);
            PG8_BAR; PG8_WAIT_L(0); PG8_MMA(1, 0, At, B0); PG8_BAR; PG8_SCHED;
            PG8_STAGE(PG8_SB(1, 1), b3 + hstep, voffB);
            PG8_WAIT_V(6); PG8_BAR; PG8_MMA(1, 1, At, B1); PG8_BAR;
            }
        }
        if constexpr (ALIGN_EPI) { if (wr == 0) PG8_BAR; }
        bool keep = false;
        if constexpr (Epi::CHAIN) { keep = E.chain(acc, cur, wr, wc, fr, fq); S.done(cur); }
        else if constexpr (!Epi::AFTER_DRAIN) { E(acc, cur, wr, wc, fr, fq); S.done(cur); }
        if (!has_next) break;
        if (!keep)
#pragma unroll
        for (int a = 0; a < 2; ++a)
#pragma unroll
            for (int b = 0; b < 2; ++b)
#pragma unroll
                for (int m = 0; m < 4; ++m)
#pragma unroll
                    for (int n = 0; n < 2; ++n) acc[a][b][m][n] = acc_t{};
        cur = nxt; cA = nA; cB = nB; ++ui; ntc = cur.nt ? cur.nt : nt;
        if constexpr (ALIGN_EPI) { if (wr == 1) PG8_BAR; }
    }
    PG8_WAIT_V(0);
    if constexpr (!ALIGN_EPI) { if (wr == 0) PG8_BAR; }
    PG8_BAR;
#undef PG8_SA
#undef PG8_SB
#undef PG8_STAGE
#undef PG8_LDA
#undef PG8_LDB
#undef PG8_MMA
#undef PG8_WAIT_V
#undef PG8_WAIT_L
#undef PG8_BAR
#undef PG8_SCHED
}
}

namespace att {
using bf16 = __hip_bfloat16;
typedef short bf16x8 __attribute__((ext_vector_type(8)));
typedef short s16x4 __attribute__((ext_vector_type(4)));
typedef float f32x16 __attribute__((ext_vector_type(16)));
typedef float f32x4 __attribute__((ext_vector_type(4)));
typedef unsigned u32x4 __attribute__((ext_vector_type(4)));
typedef unsigned u32x2 __attribute__((ext_vector_type(2)));
constexpr int D = 128;
constexpr float SCALE = 0.08838834764831845f;
constexpr float THR = 8.f;
constexpr int NW = 8, QBLK = 32, KVBLK = 64, QB = NW * QBLK;
constexpr int SHM_V = KVBLK * D * 2, SHM_K = KVBLK * D * 2;
constexpr int LDS_BYTES = 2 * SHM_V + 2 * SHM_K + NW * 64 * 4;
#define KSWZ(row, colB) ((row) * 256 + ((colB) ^ (((row) & 7) << 4)))
#define SBAR() __builtin_amdgcn_sched_barrier(0)
__device__ __forceinline__ int v_st(int k, int c) { const int kk = (k & ~0xC) | ((k & 4) << 1) | ((k & 8) >> 1); return ((kk >> 3) * 4 + (c >> 5)) * 512 + ((kk & 7) * 32 + (c & 31)) * 2; }
__device__ __forceinline__ int v_rd_base(int lane) { return ((lane & 3) << 3) | (((lane >> 2) & 3) << 6) | (((lane >> 4) & 1) << 5) | (((lane >> 5) & 1) << 8); }
constexpr int v_rd_off(int d0, int ks, int half) { return d0 * 512 + ks * 4096 + half * 2048; }
__device__ __forceinline__ int crow(int r, int hi) { return (r & 3) + 8 * (r >> 2) + 4 * hi; }
__device__ __forceinline__ unsigned cvtpk(float lo, float hi) { unsigned r; asm volatile("v_cvt_pk_bf16_f32 %0, %1, %2" : "=v"(r) : "v"(lo), "v"(hi)); return r; }
__device__ __forceinline__ bf16x8 load8(const bf16* p) { return *reinterpret_cast<const bf16x8*>(p); }
__device__ __forceinline__ void mask_alibi(f32x16& p0, f32x16& p1, u32x2 mw, int dq, int hi, float ah) {
    const float NEG = -__builtin_inff();
    const unsigned w0 = mw.x >> (4 * hi), w1 = mw.y >> (4 * hi);
    const float dqf = (float)dq;
#pragma unroll
    for (int r = 0; r < 16; ++r) {
        const int c = (r & 3) + 8 * (r >> 2);
        p0[r] = ((w0 >> c) & 1u) ? fmaf(ah, (float)c - dqf, p0[r]) : NEG;
        p1[r] = ((w1 >> c) & 1u) ? fmaf(ah, (float)(c + 32) - dqf, p1[r]) : NEG;
    }
}
__device__ __forceinline__ void partialSM(f32x16& p0, f32x16& p1, float& m_reg, float& mn, float& alpha) {
    float pmax = p0[0];
#pragma unroll
    for (int r = 1; r < 16; ++r) pmax = fmaxf(pmax, p0[r]);
#pragma unroll
    for (int r = 0; r < 16; ++r) pmax = fmaxf(pmax, p1[r]);
    { auto rr = __builtin_amdgcn_permlane32_swap(__float_as_uint(pmax), __float_as_uint(pmax), false, false);
      pmax = fmaxf(__uint_as_float(rr[0]), __uint_as_float(rr[1])); }
    constexpr float C2 = 1.4426950408889634f * SCALE;
    if (__builtin_expect(__all((pmax - m_reg) * SCALE <= THR), 1)) { mn = m_reg; alpha = 1.f; }
    else { mn = fmaxf(m_reg, pmax); alpha = __builtin_amdgcn_exp2f((m_reg - mn) * C2); m_reg = mn; }
    const float mnL = -mn * C2;
#pragma unroll
    for (int r = 0; r < 16; ++r) p0[r] = fmaf(p0[r], C2, mnL);
#pragma unroll
    for (int r = 0; r < 16; ++r) p1[r] = fmaf(p1[r], C2, mnL);
#pragma unroll
    for (int r = 0; r < 16; ++r) p0[r] = __builtin_amdgcn_exp2f(p0[r]);
}
__device__ __forceinline__ void finishSM(f32x16& p0, f32x16& p1, float alpha, float& l_reg, bf16x8& pa0, bf16x8& pa1, bf16x8& pa2, bf16x8& pa3) {
#pragma unroll
    for (int r = 0; r < 16; ++r) p1[r] = __builtin_amdgcn_exp2f(p1[r]);
    float ps = 0;
#pragma unroll
    for (int r = 0; r < 16; ++r) ps += p0[r];
#pragma unroll
    for (int r = 0; r < 16; ++r) ps += p1[r];
    { auto rr = __builtin_amdgcn_permlane32_swap(__float_as_uint(ps), __float_as_uint(ps), false, false);
      ps = __uint_as_float(rr[0]) + __uint_as_float(rr[1]); }
    l_reg = l_reg * alpha + ps;
#define PK4(P, B_, OUT) do { unsigned a0 = cvtpk(P[B_+0], P[B_+1]), a1 = cvtpk(P[B_+2], P[B_+3]);                          \
        unsigned b0 = cvtpk(P[B_+4], P[B_+5]), b1 = cvtpk(P[B_+6], P[B_+7]);                                             \
        auto r0 = __builtin_amdgcn_permlane32_swap(a0, b0, false, false); auto r1 = __builtin_amdgcn_permlane32_swap(a1, b1, false, false); \
        u32x4 w = {r0[0], r1[0], r0[1], r1[1]}; OUT = *reinterpret_cast<bf16x8*>(&w); } while (0)
    PK4(p0, 0, pa0); PK4(p0, 8, pa1); PK4(p1, 0, pa2); PK4(p1, 8, pa3);
#undef PK4
}
template <int KB>
__device__ __forceinline__ void qkt(f32x16& p0, f32x16& p1, const char* K_lds, int r32, int hi, const bf16x8* qr) {
    p0 = f32x16{}; p1 = f32x16{};
    const char* kb[4];
#pragma unroll
    for (int dd = 0; dd < 4; ++dd) kb[dd] = K_lds + KB * SHM_K + KSWZ(r32, (dd * 16 + hi * 8) * 2);
#pragma unroll
    for (int d0 = 0; d0 < 8; ++d0) { const char* a = kb[d0 & 3] + (d0 >> 2) * 128;
        bf16x8 b0 = *reinterpret_cast<const bf16x8*>(a);
        bf16x8 b1 = *reinterpret_cast<const bf16x8*>(a + 32 * 256);
        p0 = __builtin_amdgcn_mfma_f32_32x32x16_bf16(b0, qr[d0], p0, 0, 0, 0);
        p1 = __builtin_amdgcn_mfma_f32_32x32x16_bf16(b1, qr[d0], p1, 0, 0, 0); }
}
template <int VB>
__device__ __forceinline__ void pv_tile(f32x16* o, int vb0, bf16x8 pa0, bf16x8 pa1, bf16x8 pa2, bf16x8 pa3) {
#define TRRD(dst, off) asm volatile("ds_read_b64_tr_b16 %0, %1 offset:%2" : "=&v"(dst) : "v"(vb0), "i"(off) : "memory")
#define PV_D0(d0) do { s16x4 l0, l1, l2, l3, h0, h1, h2, h3; constexpr int b_ = VB * SHM_V + v_rd_off(d0, 0, 0); \
        TRRD(l0, b_); TRRD(h0, b_ + 2048); TRRD(l1, b_ + 4096); TRRD(h1, b_ + 6144); TRRD(l2, b_ + 8192); TRRD(h2, b_ + 10240); TRRD(l3, b_ + 12288); TRRD(h3, b_ + 14336); \
        asm volatile("s_waitcnt lgkmcnt(0)" ::: "memory"); SBAR();   \
        o[d0] = __builtin_amdgcn_mfma_f32_32x32x16_bf16(pa0, (bf16x8){l0[0], l0[1], l0[2], l0[3], h0[0], h0[1], h0[2], h0[3]}, o[d0], 0, 0, 0);   \
        o[d0] = __builtin_amdgcn_mfma_f32_32x32x16_bf16(pa1, (bf16x8){l1[0], l1[1], l1[2], l1[3], h1[0], h1[1], h1[2], h1[3]}, o[d0], 0, 0, 0);   \
        o[d0] = __builtin_amdgcn_mfma_f32_32x32x16_bf16(pa2, (bf16x8){l2[0], l2[1], l2[2], l2[3], h2[0], h2[1], h2[2], h2[3]}, o[d0], 0, 0, 0);   \
        o[d0] = __builtin_amdgcn_mfma_f32_32x32x16_bf16(pa3, (bf16x8){l3[0], l3[1], l3[2], l3[3], h3[0], h3[1], h3[2], h3[3]}, o[d0], 0, 0, 0); } while (0)
    PV_D0(0); PV_D0(1); PV_D0(2); PV_D0(3);
#undef PV_D0
#undef TRRD
}
template <int LD, int LDO, bool MASKED>
__device__ __forceinline__ void attn_block(const bf16* Q, const bf16* Kh, const bf16* Vh, bf16* O, int NT, int P0, const unsigned* maskbase, float ah, char* lds) {
    int tid_ = threadIdx.x; asm volatile("" : "+v"(tid_));
    const int tid = tid_, wid = __builtin_amdgcn_readfirstlane(tid >> 6), lane = tid & 63, r32 = lane & 31, hi = lane >> 5;
    const int qlo = P0 + wid * QBLK, qm = qlo + r32 - 4 * hi;
    char* V_lds = lds; char* K_lds = lds + 2 * SHM_V;
    float* ws = (float*)(lds + 2 * SHM_V + 2 * SHM_K) + wid * 64; float* li_l = ws, * al_l = ws + 32;
    float m_reg = -1e30f, l_reg = 0; f32x16 o[4] = {};
    const int sr = tid >> 4, sc = (tid & 15) * 8, vst0 = v_st(sr, sc), vst1 = v_st(32 + sr, sc), kws = KSWZ(sr, sc * 2);
    const int vb0 = (int)(uintptr_t)V_lds + v_rd_base(lane);
    const unsigned* mrow = MASKED ? maskbase + (size_t)(qlo + r32) * 128 : nullptr;
    bf16x8 qr[8], st_v0, st_v1, st_k0, st_k1;
#define ROW(p, k0, rr) ((p) + (size_t)((k0) + (rr)) * LD + sc)
#define VMW() asm volatile("s_waitcnt vmcnt(0)" ::: "memory")
#define SLOAD_H(k0) do { st_v0 = load8(ROW(Vh, k0, sr)); st_v1 = load8(ROW(Vh, k0, 32 + sr)); st_k0 = load8(ROW(Kh, k0, sr)); st_k1 = load8(ROW(Kh, k0, 32 + sr)); } while (0)
#define SWRITE_HK(bf) do { *(bf16x8*)(K_lds + (bf) * SHM_K + kws) = st_k0; *(bf16x8*)(K_lds + (bf) * SHM_K + kws + 32 * 256) = st_k1; } while (0)
#define SWRITE_HV(bf) do { *(bf16x8*)(V_lds + (bf) * SHM_V + vst0) = st_v0; *(bf16x8*)(V_lds + (bf) * SHM_V + vst1) = st_v1; } while (0)
#define SWRITE_H(bf) do { SWRITE_HV(bf); SWRITE_HK(bf); } while (0)
#define RESC(a) do { if (__any((a) < 1.f)) { if (hi == 0) al_l[r32] = (a); asm volatile("s_waitcnt lgkmcnt(0)" ::: "memory");              \
                     for (int d_ = 0; d_ < 4; ++d_) for (int r = 0; r < 16; ++r) o[d_][r] *= al_l[crow(r, hi)]; } } while (0)
#define KBASE(t) ((t) * KVBLK)
#define MLOAD(dst, t) do { if (MASKED) dst = *(const u32x2*)(mrow + 2 * (t)); } while (0)
#define MASKT(P0_, P1_, mw_, t) do { if (MASKED) mask_alibi(P0_, P1_, mw_, qm - KBASE(t), hi, ah); } while (0)
#pragma unroll
    for (int d0 = 0; d0 < 8; ++d0) qr[d0] = load8(Q + (size_t)(wid * QBLK + r32) * LD + d0 * 16 + hi * 8);
    SLOAD_H(0); VMW(); SWRITE_HK(0);
    __syncthreads();
    f32x16 pA0, pA1, pB0, pB1; float mnA, mnB, alA, alB; bf16x8 pa0, pa1, pa2, pa3;
    u32x2 mwA = {0u, 0u}, mwB = {0u, 0u};
    SWRITE_HV(0); SBAR();
    MLOAD(mwA, 0);
    if (NT > 1) SLOAD_H(KBASE(1));
    SBAR(); qkt<0>(pA0, pA1, K_lds, r32, hi, qr);
    MASKT(pA0, pA1, mwA, 0); partialSM(pA0, pA1, m_reg, mnA, alA);
    if (NT > 1) { VMW(); SWRITE_H(1); }
    __syncthreads();
#define HALF_STEP(PX0, PX1, mwX, mnX, alX, PY0, PY1, alY, t, KB, VB, SB) do {                                                 \
        SBAR(); MLOAD(mwX, t); qkt<KB>(PX0, PX1, K_lds, r32, hi, qr);                                                         \
        finishSM(PY0, PY1, alY, l_reg, pa0, pa1, pa2, pa3); SBAR();                                                           \
        if ((t) + 1 < NT) { SLOAD_H(KBASE((t) + 1)); SBAR(); }                                                                \
        pv_tile<VB>(o, vb0, pa0, pa1, pa2, pa3); MASKT(PX0, PX1, mwX, (t)); partialSM(PX0, PX1, m_reg, mnX, alX);             \
        __syncthreads();                                                                                                      \
        if ((t) + 1 < NT) { VMW(); SWRITE_H(SB); }                                                                            \
        RESC(alX); __syncthreads(); } while (0)
    for (int t = 1; t + 1 < NT; t += 2) {
        HALF_STEP(pB0, pB1, mwB, mnB, alB, pA0, pA1, alA, t, 1, 0, 0);
        HALF_STEP(pA0, pA1, mwA, mnA, alA, pB0, pB1, alB, t + 1, 0, 1, 1);
    }
    const bool even = (NT & 1) == 0;
    if (even) { SBAR(); MLOAD(mwB, NT - 1); qkt<1>(pB0, pB1, K_lds, r32, hi, qr); SBAR(); }
    finishSM(pA0, pA1, alA, l_reg, pa0, pa1, pa2, pa3); SBAR();
    pv_tile<0>(o, vb0, pa0, pa1, pa2, pa3);
    if (even) { MASKT(pB0, pB1, mwB, NT - 1); partialSM(pB0, pB1, m_reg, mnB, alB); __syncthreads(); RESC(alB);
        finishSM(pB0, pB1, alB, l_reg, pa0, pa1, pa2, pa3); SBAR(); pv_tile<1>(o, vb0, pa0, pa1, pa2, pa3); }
    SBAR();
    if (hi == 0) li_l[r32] = l_reg; asm volatile("s_waitcnt lgkmcnt(0)" ::: "memory");
    float rli[16];
#pragma unroll
    for (int r = 0; r < 16; ++r) rli[r] = __builtin_amdgcn_rcpf(li_l[crow(r, hi)]);
    bf16* Ow = O + (size_t)(wid * QBLK) * LDO;
#pragma unroll
    for (int r = 0; r < 16; ++r) { const int orow = crow(r, hi);
#pragma unroll
        for (int d0 = 0; d0 < 4; ++d0) { const float v = o[d0][r] * rli[r];
            const float vn = __shfl_xor(v, 1);
            if ((r32 & 1) == 0) *(unsigned*)(Ow + (size_t)orow * LDO + d0 * 32 + r32) = cvtpk(v, vn); } }
    __syncthreads();
#undef ROW
#undef VMW
#undef SLOAD_H
#undef SWRITE_HK
#undef SWRITE_HV
#undef SWRITE_H
#undef RESC
#undef KBASE
#undef MLOAD
#undef MASKT
#undef HALF_STEP
}
#undef KSWZ
#undef SBAR
}

constexpr int NWAVES = 8;
constexpr int BATCH = 2, SEQ = 4096, DM = 2048, T = BATCH * SEQ, FF = 5632, NUP = 2 * FF;
constexpr int NIN = 11344, NIN_PAD = 11520;
constexpr int MEMLEN = 256, TOPK = 256;
constexpr float ALPHA = 1.189207115002721f;
constexpr float LN_EPS = 1e-5f;
constexpr int N_PHASES = 13;

constexpr size_t WS_CTL = 0, CTL_ZERO_BYTES = 1u << 20;
constexpr size_t WS_BIG = 1u << 20;
constexpr size_t O_X16 = 0, O_WUP1 = O_X16 + (size_t)T * DM * 2, O_WDN1 = O_WUP1 + (size_t)NUP * DM * 2, O_G = O_WDN1 + (size_t)DM * FF * 2, BIG_BYTES = O_G + (size_t)T * FF * 2;
constexpr size_t O_Q = 0, O_K = O_Q + (size_t)T * 1024 * 2, O_V = O_K + (size_t)T * 1024 * 2, O_QI = O_V + (size_t)T * 1024 * 2, O_KI = O_QI + (size_t)T * 1024 * 2,
                 O_WI = O_KI + (size_t)T * 64 * 2, O_U = O_WI + (size_t)T * 16 * 4, O_QM = O_U + (size_t)T * 512 * 2, O_GATE = O_QM + (size_t)T * 512 * 2, O_MIXEND = O_GATE + (size_t)T * 6144 * 2;
static_assert(O_MIXEND <= BIG_BYTES, "mixer view fits");
constexpr size_t WS_WIN = WS_BIG + BIG_BYTES;
constexpr int NZB = 1280, NZQ = NIN_PAD - NZB;
constexpr size_t WS_WMKV = WS_WIN + (size_t)NZB * DM * 2;
constexpr size_t WS_WINQ = WS_WMKV + (size_t)1024 * DM * 2;
constexpr size_t WS_WBA = WS_WIN + (size_t)NIN_PAD * DM * 2 + (size_t)1024 * DM * 2;
constexpr size_t WS_WBP = WS_WBA + (size_t)DM * 1024 * 2;
constexpr size_t WS_WBM = WS_WBP + (size_t)DM * 512 * 2;
constexpr size_t WS_WOUT = WS_WBM + (size_t)DM * 512 * 2;
constexpr size_t WS_WUP2 = WS_WOUT + (size_t)DM * DM * 2;
constexpr size_t WS_WDN2 = WS_WUP2 + (size_t)NUP * DM * 2;
constexpr size_t WS_WPOOL = WS_WDN2 + (size_t)DM * FF * 2;
constexpr size_t WS_H1 = WS_WPOOL + (size_t)4 * 128 * 128 * 2;
constexpr size_t WS_MEM16 = WS_H1 + (size_t)T * DM * 2;
constexpr size_t WS_A16 = WS_MEM16 + (size_t)512 * DM * 2;
constexpr size_t WS_P16 = WS_A16 + (size_t)T * 1024 * 2;
constexpr size_t WS_M16 = WS_P16 + (size_t)T * 512 * 2;
constexpr size_t WS_Y16 = WS_M16 + (size_t)T * 512 * 2;
constexpr size_t WS_KM = WS_Y16 + (size_t)T * DM * 2;
constexpr size_t WS_VM = WS_KM + (size_t)512 * 512 * 2;
constexpr size_t WS_MASK = WS_VM + (size_t)512 * 512 * 2;
constexpr size_t WS_END = WS_MASK + (size_t)T * 128 * 4;
constexpr int CW_BAR = 4096;
constexpr size_t WS_QS = 65536;
constexpr size_t WS_ROWQ = 131072;
static_assert(WS_ROWQ + (size_t)9 * 8192 * 4 <= (1u << 20), "control region");

constexpr int RING_OFF = 0, RING_BYTES = 131072;
constexpr int LDSCTL_OFF = RING_BYTES, MISC_OFF = LDSCTL_OFF + 320;
constexpr int LDS_BYTES = 147456;

#define GAS __attribute__((address_space(1)))
#define LAS __attribute__((address_space(3)))
typedef unsigned short bf16;
typedef unsigned v4u __attribute__((ext_vector_type(4)));
typedef unsigned v2u __attribute__((ext_vector_type(2)));
typedef float f32x4 __attribute__((ext_vector_type(4)));
typedef float f32x16 __attribute__((ext_vector_type(16)));
typedef short bf16x8 __attribute__((ext_vector_type(8)));
#define LDS_WAIT() asm volatile("s_waitcnt lgkmcnt(0)" ::: "memory")
__device__ __forceinline__ unsigned f2bf(float f) { unsigned u = __builtin_bit_cast(unsigned, f); return (u + 0x7fffu + ((u >> 16) & 1u)) >> 16; }
__device__ __forceinline__ unsigned pk2(float lo, float hi) { return f2bf(lo) | (f2bf(hi) << 16); }

#define XB_TMO      128
#define XB_XCNT(j)  (256  + 64 * (j))
#define XB_XSUB(j)  (1280 + 64 * (j))
#define XB_XGEN(j)  (2304 + 64 * (j))
#define XB_TOP      3328
#define XB_TOPGEN   3392
#define XCD_BAR_WORDS 3456
#define XB_SPIN_CAP (1u << 22)
__device__ __forceinline__ unsigned xb_ld(unsigned* p)              { return __hip_atomic_load(p, __ATOMIC_RELAXED, __HIP_MEMORY_SCOPE_AGENT); }
__device__ __forceinline__ unsigned xb_add(unsigned* p, unsigned v) { return __hip_atomic_fetch_add(p, v, __ATOMIC_RELAXED, __HIP_MEMORY_SCOPE_AGENT); }
__device__ __forceinline__ unsigned xb_xcc_id() { return (unsigned)__builtin_amdgcn_s_getreg((3 << 11) | 20) & 0xFu; }
#define XB_SPIN(cond, bar) do { unsigned _sp = 0; while (cond) { __builtin_amdgcn_s_sleep(1); \
    if ((++_sp & 255u) == 0u) { if (xb_ld(&(bar)[XB_TMO])) break; if (_sp > XB_SPIN_CAP) { atomicAdd(&(bar)[XB_TMO], 1u); break; } } } } while (0)
struct XcdBarrier { unsigned* bar; unsigned x; volatile LAS unsigned* st; };
__device__ __forceinline__ XcdBarrier xcd_barrier_post(unsigned* bar, volatile LAS unsigned* st) {
    XcdBarrier b; b.bar = bar; b.x = xb_xcc_id(); b.st = st;
    if (threadIdx.x == 0) (void)xb_add(&bar[XB_XCNT(b.x)], 1u);
    return b;
}
__device__ __forceinline__ void xcd_barrier_complete(unsigned* bar, unsigned x, unsigned& nloc, unsigned& nx) {
    const unsigned G = gridDim.x * gridDim.y * gridDim.z;
    unsigned sum, cnt, mine, sp = 0u;
    for (;;) {
        sum = 0u; cnt = 0u; mine = 0u;
#pragma unroll
        for (unsigned j = 0; j < 16; ++j) { const unsigned c = xb_ld(&bar[XB_XCNT(j)]); sum += c; cnt += (c > 0u) ? 1u : 0u; mine = (j == x) ? c : mine; }
        if (sum == G) break;
        __builtin_amdgcn_s_sleep(1);
        if ((++sp & 255u) == 0u) { if (xb_ld(&bar[XB_TMO])) break; if (sp > XB_SPIN_CAP) { atomicAdd(&bar[XB_TMO], 1u); break; } }
    }
    nloc = mine > 0u ? mine : 1u; nx = cnt > 0u ? cnt : 1u;
}
__device__ __forceinline__ void xcd_barrier(const XcdBarrier& b) {
    asm volatile("s_waitcnt vmcnt(0)" ::: "memory");
    __syncthreads();
    if (threadIdx.x == 0) {
        unsigned* bar = b.bar;
        __builtin_amdgcn_s_waitcnt(0);
        unsigned nloc = b.st[0], nx = b.st[1];
        if (nloc == 0u) { xcd_barrier_complete(bar, b.x, nloc, nx); b.st[0] = nloc; b.st[1] = nx; }
        const unsigned old = xb_add(&bar[XB_XSUB(b.x)], 1u);
        const unsigned gen = old / nloc;
        if (old + 1u == (gen + 1u) * nloc) {
            __builtin_amdgcn_fence(__ATOMIC_RELEASE, "agent");
            asm volatile("s_waitcnt vmcnt(0)" ::: "memory");
            const unsigned og = xb_add(&bar[XB_TOP], 1u);
            const unsigned tg = og / nx;
            if (og + 1u == (tg + 1u) * nx) xb_add(&bar[XB_TOPGEN], 1u);
            else XB_SPIN(xb_ld(&bar[XB_TOPGEN]) == tg, bar);
            __builtin_amdgcn_fence(__ATOMIC_ACQUIRE, "agent");
            xb_add(&bar[XB_XGEN(b.x)], 1u);
            asm volatile("s_waitcnt vmcnt(0)" ::: "memory");
        } else {
            XB_SPIN(xb_ld(&bar[XB_XGEN(b.x)]) == gen, bar);
            __builtin_amdgcn_fence(__ATOMIC_ACQUIRE, "agent");
            asm volatile("s_waitcnt vmcnt(0)" ::: "memory");
        }
    }
    __syncthreads();
}

__device__ __forceinline__ float wave_sum(float v) {
#pragma unroll
    for (int o = 1; o < 64; o <<= 1) v += __shfl_xor(v, o);
    return v;
}
template <int MAP>
__device__ __forceinline__ void p0_transpose_item(const float* W, int K, int N, int NP, bf16* WT, LAS float* scr, int item, int lane, int ldw = 0) {
    if (ldw == 0) ldw = K;
    asm volatile("" : "+v"(lane));
    const int nblk = NP / 32, kb = item / nblk, nb = item % nblk, k0 = 64 * kb, np0 = 32 * nb;
    int n0 = np0; int nvalid = 32;
    if (MAP == 1) n0 = ((np0 >> 7) & 1) * FF + (np0 >> 8) * 128 + (np0 & 127);
    if (MAP == 2) { n0 = 3072 + np0; if (np0 >= 1024) { nvalid = 1104 - np0; nvalid = nvalid < 0 ? 0 : (nvalid > 32 ? 32 : nvalid); } }
    float v[32];
    const bool ok = (lane & 31) < nvalid;
#pragma unroll
    for (int i = 0; i < 32; ++i) { const int kk = 2 * i + (lane >> 5); v[i] = ok ? W[(size_t)(k0 + kk) * N + n0 + (lane & 31)] : 0.f; }
#pragma unroll
    for (int i = 0; i < 32; ++i) { const int kk = 2 * i + (lane >> 5); scr[kk * 33 + (lane & 31)] = v[i]; }
    LDS_WAIT(); asm volatile("" ::: "memory");
    const int c = lane & 7;
#pragma unroll
    for (int j = 0; j < 4; ++j) { const int n = (lane >> 3) + 8 * j; const LAS float* s = scr + (8 * c) * 33 + n;
        v4u o; o.x = pk2(s[0 * 33], s[1 * 33]); o.y = pk2(s[2 * 33], s[3 * 33]); o.z = pk2(s[4 * 33], s[5 * 33]); o.w = pk2(s[6 * 33], s[7 * 33]);
        *(GAS v4u*)(WT + (size_t)(np0 + n) * ldw + k0 + 8 * c) = o; }
    LDS_WAIT(); asm volatile("" ::: "memory");
}
__device__ __forceinline__ unsigned q8(float v, float qw) { return (unsigned)((int)__builtin_rintf(fminf(fmaxf(v * qw, -127.f), 127.f)) & 255); }
template <int MAP>
__device__ __forceinline__ void p0_transpose_item_i8(const float* W, int K, int N, int NP, signed char* WT, LAS float* scr, int item, int lane, float qw) {
    asm volatile("" : "+v"(lane));
    const int nblk = NP / 32, kb = item / nblk, nb = item % nblk, k0 = 64 * kb, np0 = 32 * nb;
    int n0 = np0;
    if (MAP == 1) n0 = ((np0 >> 7) & 1) * FF + (np0 >> 8) * 128 + (np0 & 127);
    if (MAP == 3) n0 = np0 < 3072 ? np0 : np0 + 1104;
    float v[32];
#pragma unroll
    for (int i = 0; i < 32; ++i) { const int kk = 2 * i + (lane >> 5); v[i] = W[(size_t)(k0 + kk) * N + n0 + (lane & 31)]; }
#pragma unroll
    for (int i = 0; i < 32; ++i) { const int kk = 2 * i + (lane >> 5); scr[kk * 33 + (lane & 31)] = v[i]; }
    LDS_WAIT(); asm volatile("" ::: "memory");
#pragma unroll
    for (int j = 0; j < 2; ++j) { const int id = lane + 64 * j, n = id >> 2, c = id & 3; const LAS float* sp = scr + (16 * c) * 33 + n;
        v4u o;
        o.x = q8(sp[0 * 33], qw) | (q8(sp[1 * 33], qw) << 8) | (q8(sp[2 * 33], qw) << 16) | (q8(sp[3 * 33], qw) << 24);
        o.y = q8(sp[4 * 33], qw) | (q8(sp[5 * 33], qw) << 8) | (q8(sp[6 * 33], qw) << 16) | (q8(sp[7 * 33], qw) << 24);
        o.z = q8(sp[8 * 33], qw) | (q8(sp[9 * 33], qw) << 8) | (q8(sp[10 * 33], qw) << 16) | (q8(sp[11 * 33], qw) << 24);
        o.w = q8(sp[12 * 33], qw) | (q8(sp[13 * 33], qw) << 8) | (q8(sp[14 * 33], qw) << 16) | (q8(sp[15 * 33], qw) << 24);
        *(GAS v4u*)(WT + (size_t)(np0 + n) * K + k0 + 16 * c) = o; }
    LDS_WAIT(); asm volatile("" ::: "memory");
}
__device__ __forceinline__ float sample_sigma2(const float* W, int K, int N, int lane) {
    float s = 0.f;
#pragma unroll
    for (int j = 0; j < 4; ++j) { const f32x4 v = *(const GAS f32x4*)(W + (size_t)(j * (K / 4)) * N + lane * 4); s += (v.x * v.x + v.y * v.y) + (v.z * v.z + v.w * v.w); }
    return wave_sum(s) * (1.0f / 1024.0f);
}
__device__ __forceinline__ void quant_row_i8(const f32x4 (&v)[8], signed char* qrow, float* sx, float* gq, float* sg, float sig2, int lane) {
    float mx = 0.f, ss = 0.f;
#pragma unroll
    for (int j = 0; j < 8; ++j) { mx = fmaxf(mx, fmaxf(fmaxf(fabsf(v[j].x), fabsf(v[j].y)), fmaxf(fabsf(v[j].z), fabsf(v[j].w)))); ss += (v[j].x * v[j].x + v[j].y * v[j].y) + (v[j].z * v[j].z + v[j].w * v[j].w); }
#pragma unroll
    for (int o = 1; o < 64; o <<= 1) mx = fmaxf(mx, __shfl_xor(mx, o));
    ss = wave_sum(ss);
    const float m = fmaxf(mx, 1e-20f), qm = 127.f / m;
#pragma unroll
    for (int j = 0; j < 8; ++j) ((GAS unsigned*)qrow)[lane + 64 * j] = q8(v[j].x, qm) | (q8(v[j].y, qm) << 8) | (q8(v[j].z, qm) << 16) | (q8(v[j].w, qm) << 24);
    if (lane == 0) { const float clip = fmaxf(8.f * ss * sig2, 1e-20f);
        *sx = m * (1.0f / 127.f); *gq = 127.f / clip; *sg = clip * (1.0f / 127.f); }
}
template <bool OUT_BF16, bool Q8 = false>
__device__ __forceinline__ void ln_row(const float* xrow, const float* gam, const float* bet, void* orow, int lane, signed char* qrow = nullptr, float* sx = nullptr, float* gq = nullptr, float* sg = nullptr, float sig2 = 0.f) {
    const GAS f32x4* xr = (const GAS f32x4*)xrow + lane;
    f32x4 v[8]; float s = 0.f;
#pragma unroll
    for (int j = 0; j < 8; ++j) { v[j] = xr[64 * j]; s += (v[j].x + v[j].y) + (v[j].z + v[j].w); }
    const float mean = wave_sum(s) * (1.f / DM); float s2 = 0.f;
#pragma unroll
    for (int j = 0; j < 8; ++j) { v[j] = v[j] - mean; s2 += (v[j].x * v[j].x + v[j].y * v[j].y) + (v[j].z * v[j].z + v[j].w * v[j].w); }
    const float rstd = 1.f / sqrtf(wave_sum(s2) * (1.f / DM) + LN_EPS);
#pragma unroll
    for (int j = 0; j < 8; ++j) {
        const f32x4 gg = ((const GAS f32x4*)gam)[lane + 64 * j], bb = ((const GAS f32x4*)bet)[lane + 64 * j];
        const f32x4 y = v[j] * rstd * gg + bb;
        if (OUT_BF16) { ((GAS v2u*)orow)[lane + 64 * j] = (v2u){pk2(y.x, y.y), pk2(y.z, y.w)}; }
        else ((GAS f32x4*)orow)[lane + 64 * j] = y;
        if (Q8) v[j] = y;
    }
    if (Q8) quant_row_i8(v, qrow, sx, gq, sg, sig2, lane);
}

__device__ __forceinline__ unsigned ordkey(float s) { const unsigned u = __float_as_uint(s); return (u ^ ((unsigned)((int)u >> 31) | 0x80000000u)) >> 1; }
__device__ __forceinline__ float keyf(unsigned k31) { const unsigned k = k31 << 1; return __uint_as_float((k & 0x80000000u) ? (k ^ 0x80000000u) : ~k); }
template <int J, int JEND> __device__ __forceinline__ void mask_emit(const unsigned (&key)[128], unsigned thr, unsigned& o0a, unsigned& o1a, unsigned& o0b, unsigned& o1b) {
    const unsigned long long bal = __ballot(key[J] >= thr);
    const unsigned bl = (unsigned)bal, bh = (unsigned)(bal >> 32);
    if constexpr (J < 64) asm volatile("s_nop 1\n\tv_writelane_b32 %0, %2, %4\n\tv_writelane_b32 %1, %3, %4" : "+v"(o0a), "+v"(o1a) : "s"(bl), "s"(bh), "n"(J));
    else asm volatile("s_nop 1\n\tv_writelane_b32 %0, %2, %4\n\tv_writelane_b32 %1, %3, %4" : "+v"(o0b), "+v"(o1b) : "s"(bl), "s"(bh), "n"(J - 64));
    if constexpr (J + 1 < JEND) mask_emit<J + 1, JEND>(key, thr, o0a, o1a, o0b, o1b);
}
template <int G> __device__ __forceinline__ void mask_emit_groups(const unsigned (&key)[128], unsigned thr, int ntw, unsigned& o0a, unsigned& o1a, unsigned& o0b, unsigned& o1b) {
    if (16 * G < ntw) mask_emit<16 * G, 16 * G + 16>(key, thr, o0a, o1a, o0b, o1b);
    if constexpr (G + 1 < 8) mask_emit_groups<G + 1>(key, thr, ntw, o0a, o1a, o0b, o1b);
}
template <int G> __device__ __forceinline__ void count_groups(const unsigned (&key)[128], unsigned mid, int ntw, unsigned& nlt) {
    if (16 * G < ntw) { unsigned a = 0u;
#pragma unroll
        for (int j = 0; j < 16; ++j) a = __builtin_amdgcn_alignbit(a, key[16 * G + j] - mid, 31);
        nlt += (unsigned)__builtin_popcount(a); }
    if constexpr (G + 1 < 8) count_groups<G + 1>(key, mid, ntw, nlt);
}
template <int CTRL> __device__ __forceinline__ unsigned dpp_u(unsigned v) { return (unsigned)__builtin_amdgcn_update_dpp(0, (int)v, CTRL, 0xf, 0xf, true); }
__device__ __forceinline__ unsigned umin_(unsigned a, unsigned b) { return a < b ? a : b; }
__device__ __forceinline__ unsigned umax_(unsigned a, unsigned b) { return a > b ? a : b; }
__device__ __forceinline__ unsigned uadd_(unsigned a, unsigned b) { return a + b; }
#define HALF_REDUCE(v, OP) do { v = OP(v, dpp_u<0xB1>(v)); v = OP(v, dpp_u<0x4E>(v)); v = OP(v, dpp_u<0x141>(v)); v = OP(v, dpp_u<0x140>(v)); v = OP(v, (unsigned)__shfl_xor((int)v, 16)); } while (0)
typedef float f32x2_t __attribute__((ext_vector_type(2)));
__device__ __forceinline__ void indexer_unit(LAS unsigned char* lds, int b, int uidx, const bf16* QI16, const bf16* KI16, const float* WI, unsigned* MASKQ) {
    int tid_ = threadIdx.x; asm volatile("" : "+v"(tid_));
    const int tid = tid_, lane = tid & 63, wid = __builtin_amdgcn_readfirstlane(tid >> 6), r = lane & 31, h = lane >> 5;
    const int q0 = uidx * 16 + 2 * wid, tq = q0 + h;
    const int nchunk = ((uidx * 16 + 15) >> 8) + 1;
    bf16x8 aq[4];
    { const int qa = q0 + ((r >> 2) & 1), head = (r & 3) + 4 * (r >> 3);
      const bf16* qp = QI16 + (size_t)(b * SEQ + qa) * 1024 + head * 64 + 8 * h;
#pragma unroll
      for (int ks = 0; ks < 4; ++ks) aq[ks] = *(const GAS bf16x8*)(qp + ks * 16); }
    f32x2_t w2[8];
    { const GAS f32x4* wp = (const GAS f32x4*)(WI + (size_t)(b * SEQ + tq) * 16);
#pragma unroll
      for (int i = 0; i < 4; ++i) { const f32x4 t = wp[i]; w2[2 * i] = (f32x2_t){t.x, t.y}; w2[2 * i + 1] = (f32x2_t){t.z, t.w}; } }
    unsigned key[128]; unsigned kmn = 0x7FFFFFFFu, kmx = 0u; float ssum = 0.f, ssq = 0.f;
    const char* kbase = (const char*)(KI16 + (size_t)(b * SEQ) * 64);
    unsigned soff[4];
#pragma unroll
    for (int i = 0; i < 4; ++i) { const int kk = (wid * 4 + i) * 8 + (lane >> 3), cs = lane & 7; soff[i] = (unsigned)(kk * 128 + ((cs ^ ((kk >> 1) & 7)) << 4)); }
#define IDX_STAGE(c_) do { _Pragma("unroll") for (int i = 0; i < 4; ++i) \
        __builtin_amdgcn_global_load_lds((const unsigned*)(kbase + (size_t)(c_) * 32768 + soff[i]), (LAS unsigned*)(lds + ((c_) % 3) * 32768 + (wid * 4 + i) * 1024), 16, 0, 0); } while (0)
    const int x = (r >> 1) & 7;
    int roff[4];
#pragma unroll
    for (int ks = 0; ks < 4; ++ks) roff[ks] = r * 128 + (((2 * ks + h) ^ x) << 4);
    __syncthreads();
    IDX_STAGE(0);
    if (nchunk > 1) IDX_STAGE(1);
#pragma unroll
    for (int c = 0; c < 16; ++c) {
        if (c < nchunk) {
            if (c + 1 < nchunk) asm volatile("s_waitcnt vmcnt(4)" ::: "memory"); else asm volatile("s_waitcnt vmcnt(0)" ::: "memory");
            __builtin_amdgcn_s_barrier(); asm volatile("" ::: "memory");
            if (c + 2 < nchunk) IDX_STAGE(c + 2);
#pragma unroll
            for (int jj = 0; jj < 8; ++jj) {
                const int j = c * 8 + jj;
                f32x16 acc = {};
#pragma unroll
                for (int ks = 0; ks < 4; ++ks) { const bf16x8 bk = *(const LAS bf16x8*)(lds + (c % 3) * 32768 + jj * 4096 + roff[ks]);
                    acc = __builtin_amdgcn_mfma_f32_32x32x16_bf16(aq[ks], bk, acc, 0, 0, 0); }
                f32x2_t s2 = {0.f, 0.f};
#pragma unroll
                for (int i = 0; i < 8; ++i) { const int a0 = __float_as_int(acc[2 * i]), a1 = __float_as_int(acc[2 * i + 1]);
                    const f32x2_t a = {__int_as_float(a0 > 0 ? a0 : 0), __int_as_float(a1 > 0 ? a1 : 0)}; s2 = a * w2[i] + s2; }
                const float s = s2.x + s2.y;
                const bool valid = (j * 32 + r <= tq);
                { const float sv = valid ? s : 0.f; ssum += sv; ssq = fmaf(sv, sv, ssq); }
                unsigned kj = valid ? ordkey(s) : 0u;
                asm volatile("" : "+v"(kj));
                key[j] = kj; kmx = umax_(kmx, kj); kmn = umin_(kmn, valid ? kj : 0x7FFFFFFFu);
                __builtin_amdgcn_sched_barrier(0);
            }
        } else {
#pragma unroll
            for (int jj = 0; jj < 8; ++jj) key[c * 8 + jj] = 0u;
        }
    }
#undef IDX_STAGE
    unsigned thr = 1u;
    const int ntw = ((q0 + 1) >> 5) + 1;
    {
        HALF_REDUCE(kmn, umin_); HALF_REDUCE(kmx, umax_);
        { unsigned t = __float_as_uint(ssum);
#define FADD_(a, b) __float_as_uint(__uint_as_float(a) + __uint_as_float(b))
          HALF_REDUCE(t, FADD_); ssum = __uint_as_float(t); t = __float_as_uint(ssq); HALF_REDUCE(t, FADD_); ssq = __uint_as_float(t);
#undef FADD_
        }
        bool done = (tq + 1 <= TOPK);
        unsigned lo = kmn, hi = kmx + 1u;
        int clo = tq + 1, chi = 0, it = 0;
        const float nf = (float)(tq + 1), mu = ssum / nf, sd = sqrtf(fmaxf(ssq / nf - mu * mu, 1e-30f)), pp = fminf((float)TOPK / nf, 1.f);
        const float zq = 4.91f * (__builtin_amdgcn_exp2f(0.14f * __builtin_amdgcn_logf(1.f - pp)) - __builtin_amdgcn_exp2f(0.14f * __builtin_amdgcn_logf(pp)));
        const float v0 = fmaf(zq, sd, mu);
        if (!done && hi - lo <= 1u) { thr = lo; done = true; }
        while (!__all(done)) {
            unsigned mid;
            if (it < 2) mid = ordkey(it == 0 ? v0 - 0.25f * sd : v0 + 0.25f * sd);
            else { const float lof = keyf(lo), hif = keyf(hi - 1u);
              float frac = ((float)clo - ((float)TOPK - 0.5f)) / (float)(clo - chi);
              frac = fminf(fmaxf(frac, 0.125f), 0.875f);
              if (clo - chi > 48 || (it & 3) == 3) frac = 0.5f;
              mid = ordkey(fmaf(hif - lof, frac, lof)); }
            mid = mid <= lo ? lo + 1u : mid; mid = mid >= hi ? hi - 1u : mid;
            unsigned cu = 0u;
            count_groups<0>(key, mid, ntw, cu);
            HALF_REDUCE(cu, uadd_);
            cu = (unsigned)(512 * ((ntw + 15) >> 4)) - cu;
            const int cnt = (int)cu;
            if (!done) {
                if (cnt == TOPK) { thr = mid; done = true; }
                else if (cnt > TOPK) { lo = mid; clo = cnt; } else { hi = mid; chi = cnt; }
                if (!done && hi - lo <= 1u) { thr = lo; done = true; }
            }
            ++it;
        }
    }
    unsigned o0a = 0u, o0b = 0u, o1a = 0u, o1b = 0u;
    mask_emit_groups<0>(key, thr, ntw, o0a, o1a, o0b, o1b);
    GAS unsigned* mp = (GAS unsigned*)(MASKQ + (size_t)(b * SEQ + q0) * 128);
    mp[lane] = o0a; mp[64 + lane] = o0b; mp[128 + lane] = o1a; mp[192 + lane] = o1b;
}
#undef HALF_REDUCE

__device__ __forceinline__ void pool_task(int task, const bf16* U16, const bf16* WPT, const float* pscale, bf16* P16, int lane) {
    asm volatile("" : "+v"(lane));
    const int tile = task >> 2, g = task & 3, r = lane & 31, h = lane >> 5;
    const int tk = tile * 32 + r, pos = tk & (SEQ - 1), wlen = 2 << g;
    const int cnt = (pos + 1 < wlen) ? pos + 1 : wlen;
    const float rc = 1.0f / (float)cnt;
    bf16x8 pa[8];
#pragma unroll
    for (int ks = 0; ks < 8; ++ks) {
        const bf16* up = U16 + (size_t)tk * 512 + g * 128 + ks * 16 + 8 * h;
        float sum[8], self[8];
#pragma unroll
        for (int e = 0; e < 8; ++e) sum[e] = 0.f;
        for (int i = 0; i < wlen; ++i) {
            if (i < cnt) { const v4u t = *(const GAS v4u*)(up - (size_t)i * 512);
                const float f0 = pg8::bf_lo(t.x), f1 = pg8::bf_hi(t.x), f2 = pg8::bf_lo(t.y), f3 = pg8::bf_hi(t.y), f4 = pg8::bf_lo(t.z), f5 = pg8::bf_hi(t.z), f6 = pg8::bf_lo(t.w), f7 = pg8::bf_hi(t.w);
                if (i == 0) { self[0] = f0; self[1] = f1; self[2] = f2; self[3] = f3; self[4] = f4; self[5] = f5; self[6] = f6; self[7] = f7; }
                sum[0] += f0; sum[1] += f1; sum[2] += f2; sum[3] += f3; sum[4] += f4; sum[5] += f5; sum[6] += f6; sum[7] += f7; }
        }
        v4u o; o.x = pk2(sum[0] * rc - self[0], sum[1] * rc - self[1]); o.y = pk2(sum[2] * rc - self[2], sum[3] * rc - self[3]);
        o.z = pk2(sum[4] * rc - self[4], sum[5] * rc - self[5]); o.w = pk2(sum[6] * rc - self[6], sum[7] * rc - self[7]);
        pa[ks] = __builtin_bit_cast(bf16x8, o);
    }
#pragma unroll
    for (int nb = 0; nb < 4; ++nb) {
        f32x16 acc = {};
        const bf16* wp = WPT + (size_t)g * 16384 + (size_t)(nb * 32 + r) * 128 + 8 * h;
#pragma unroll
        for (int ks = 0; ks < 8; ++ks) { const bf16x8 bk = *(const GAS bf16x8*)(wp + ks * 16); acc = __builtin_amdgcn_mfma_f32_32x32x16_bf16(pa[ks], bk, acc, 0, 0, 0); }
        const int col = g * 128 + nb * 32 + r; const float ps = pscale[col];
#pragma unroll
        for (int i = 0; i < 16; ++i) { const int tok = tile * 32 + (i & 3) + 8 * (i >> 2) + 4 * h; P16[(size_t)tok * 2048 + col] = (bf16)f2bf(acc[i] * ps); }
    }
}

struct Args { const float* in[21]; float* out; unsigned char* ws; int ph_lo, ph_hi; };
__global__ void __launch_bounds__(NWAVES * 64, 2) mk_fwd(Args args) {
    extern __shared__ __attribute__((aligned(16))) unsigned char lds[];
    LAS unsigned char* L = (LAS unsigned char*)lds;
    volatile LAS unsigned* MISC = (volatile LAS unsigned*)(L + MISC_OFF);
    const int tid = threadIdx.x, lane = tid & 63, wave = __builtin_amdgcn_readfirstlane(tid >> 6);
    const int G = gridDim.x, bx = blockIdx.x;
    const int vcu = (G % 8 == 0) ? (bx % 8) * (G / 8) + bx / 8 : bx;
    const int gw = vcu * NWAVES + wave, NGW = G * NWAVES;
    unsigned char* ws = args.ws;
    for (int u = tid; u < (LDS_BYTES - LDSCTL_OFF) / 4; u += NWAVES * 64) ((LAS unsigned*)(L + LDSCTL_OFF))[u] = 0u;
    __syncthreads();
    XcdBarrier bar; bar.bar = (unsigned*)(ws + WS_CTL) + CW_BAR; bar.x = 0; bar.st = nullptr;
    if (!MK_PER_PHASE) bar = xcd_barrier_post((unsigned*)(ws + WS_CTL) + CW_BAR, MISC + 8);
    const int lo = args.ph_lo, hi = args.ph_hi;
#ifndef PH_MASK
#define PH_MASK 0x1FFF
#endif
#ifndef REP_MASK
#define REP_MASK 0x0
#endif
#define REP(k) for (int rep_ = 0; rep_ <= ((REP_MASK >> (k)) & 1); ++rep_)
#define REPBAR() do { if (rep_) xcd_barrier(bar); } while (0)
#define IN(k) (((PH_MASK >> (k)) & 1) && lo <= (k) && (k) < hi)
#define SEAM(k) do { if (IN(k) && IN((k) + 1)) xcd_barrier(bar); } while (0)
#define XIN (ap->in[0])
#define MEMIN (ap->in[1])
#define WSP_DECL unsigned char* wsp = args.ws; asm volatile("" : "+s"(wsp)); const __attribute__((address_space(4))) Args* ap = (const __attribute__((address_space(4))) Args*)__builtin_amdgcn_kernarg_segment_ptr(); asm volatile("" : "+s"(ap)); (void)wsp; (void)ap
#define BIG ((bf16*)(wsp + WS_BIG))
#define X16 ((bf16*)(wsp + WS_BIG + O_X16))
#define WUP1 ((bf16*)(wsp + WS_BIG + O_WUP1))
#define WDN1 ((bf16*)(wsp + WS_BIG + O_WDN1))
#define Gb ((bf16*)(wsp + WS_BIG + O_G))
#define Q16 ((bf16*)(wsp + WS_BIG + O_Q))
#define K16 ((bf16*)(wsp + WS_BIG + O_K))
#define V16 ((bf16*)(wsp + WS_BIG + O_V))
#define QI16 ((bf16*)(wsp + WS_BIG + O_QI))
#define KI16 ((bf16*)(wsp + WS_BIG + O_KI))
#define WI ((float*)(wsp + WS_BIG + O_WI))
#define U16 ((bf16*)(wsp + WS_BIG + O_U))
#define QM16 ((bf16*)(wsp + WS_BIG + O_QM))
#define GATE ((bf16*)(wsp + WS_BIG + O_GATE))
#define WIN ((bf16*)(wsp + WS_WIN))
#define WMKV ((bf16*)(wsp + WS_WMKV))
#define WBA ((bf16*)(wsp + WS_WBA))
#define WBP ((bf16*)(wsp + WS_WBP))
#define WBM ((bf16*)(wsp + WS_WBM))
#define WOUT ((bf16*)(wsp + WS_WOUT))
#define WUP2 ((bf16*)(wsp + WS_WUP2))
#define WDN2 ((bf16*)(wsp + WS_WDN2))
#define WPT ((bf16*)(wsp + WS_WPOOL))
#define H1 ((bf16*)(wsp + WS_H1))
#define MEM16 ((bf16*)(wsp + WS_MEM16))
#define A16 ((bf16*)(wsp + WS_A16))
#define P16 ((bf16*)(wsp + WS_A16) + 1024)
#define M16 ((bf16*)(wsp + WS_A16) + 1536)
#define H2 ((bf16*)(wsp + WS_A16))
#define Y16 ((bf16*)(wsp + WS_Y16))
#define KM ((bf16*)(wsp + WS_KM))
#define VM ((bf16*)(wsp + WS_VM))
#define MASKQ ((unsigned*)(wsp + WS_MASK))
#define X8 ((signed char*)(wsp + WS_BIG + O_X16))
#define WUP1q ((signed char*)(wsp + WS_BIG + O_WUP1))
#define WDN1q ((signed char*)(wsp + WS_BIG + O_WDN1))
#define G8 ((signed char*)(wsp + WS_BIG + O_G))
#define WUP2q ((signed char*)(wsp + WS_WUP2))
#define WDN2q ((signed char*)(wsp + WS_WDN2))
#define H2q ((signed char*)(wsp + WS_Y16))
#define G28 ((signed char*)(wsp + WS_BIG))
#define QS ((float*)(wsp + WS_QS))
#define SX1 ((float*)(wsp + WS_ROWQ))
#define GQ1 (SX1 + T)
#define SG1 (GQ1 + T)
#define SX2 (SG1 + T)
#define GQ2 (SX2 + T)
#define SG2 (GQ2 + T)
#define SXH (SG2 + T)
#define DQ0 (SXH + T)
#define DQ1 (DQ0 + T)
#define H1q ((signed char*)(wsp + WS_Y16))
#define WINq ((signed char*)(wsp + WS_WINQ))
#define R (ap->out)

    REP(0) if (IN(0)) { REPBAR(); WSP_DECL;
        LAS float* scr = (LAS float*)(L + RING_OFF + wave * 16384);
        const float s2u1 = fmaxf(sample_sigma2(ap->in[2], DM, NUP, lane), 1e-30f), s2d1 = fmaxf(sample_sigma2(ap->in[3], FF, DM, lane), 1e-30f);
        const float s2u2 = fmaxf(sample_sigma2(ap->in[17], DM, NUP, lane), 1e-30f), s2d2 = fmaxf(sample_sigma2(ap->in[18], FF, DM, lane), 1e-30f);
        const float qu1 = 127.f / (5.f * sqrtf(s2u1)), qd1 = 127.f / (5.f * sqrtf(s2d1)), qu2 = 127.f / (5.f * sqrtf(s2u2)), qd2 = 127.f / (5.f * sqrtf(s2d2));
        const float s2in = fmaxf(sample_sigma2(ap->in[6], DM, NIN, lane), 1e-30f), qin = 127.f / (5.f * sqrtf(s2in));
        if (gw == 0 && lane == 0) { QS[16] = qin; QS[17] = 1.f / qin; QS[0] = qu1; QS[1] = 1.f / qu1; QS[2] = s2u1; QS[3] = qd1; QS[4] = 1.f / qd1; QS[8] = qu2; QS[9] = 1.f / qu2; QS[10] = s2u2; QS[11] = qd2; QS[12] = 1.f / qd2; }
        constexpr int I_UP = (DM / 64) * (NUP / 32), I_DN = (FF / 64) * (DM / 32), I_IN = (DM / 64) * (NZB / 32), I_INQ = (DM / 64) * (NZQ / 32), I_MKV = (DM / 64) * (1024 / 32), I_BA = (1024 / 64) * (DM / 32),
                      I_BP = (512 / 64) * (DM / 32), I_OUT = (DM / 64) * (DM / 32), I_PL = (128 / 64) * (128 / 32);
        constexpr int NITEMS = I_UP + I_DN + I_IN + I_INQ + I_MKV + 4 * I_PL;
        for (int it = gw; it < NITEMS; it += NGW) {
            int r = it;
            if (r < I_UP) { p0_transpose_item_i8<1>(ap->in[2], DM, NUP, NUP, WUP1q, scr, r, lane, qu1); continue; } r -= I_UP;
            if (r < I_DN) { p0_transpose_item_i8<0>(ap->in[3], FF, DM, DM, WDN1q, scr, r, lane, qd1); continue; } r -= I_DN;
            if (r < I_IN) { p0_transpose_item<2>(ap->in[6], DM, NIN, NZB, WIN, scr, r, lane); continue; } r -= I_IN;
            if (r < I_INQ) { p0_transpose_item_i8<3>(ap->in[6], DM, NIN, NZQ, WINq, scr, r, lane, qin); continue; } r -= I_INQ;
            if (r < I_MKV) { p0_transpose_item<0>(ap->in[8], DM, 1024, 1024, WMKV, scr, r, lane); continue; } r -= I_MKV;
            { const int g = r / I_PL; p0_transpose_item<0>(ap->in[9] + (size_t)g * 16384, 128, 128, 128, WPT + (size_t)g * 16384, scr, r % I_PL, lane); }
        }
        for (int m = gw; m < T; m += NGW) {
            f32x4 v[8];
#pragma unroll
            for (int j = 0; j < 8; ++j) v[j] = ((const GAS f32x4*)(XIN + (size_t)m * DM))[lane + 64 * j];
            quant_row_i8(v, X8 + (size_t)m * DM, SX1 + m, GQ1 + m, SG1 + m, s2u1, lane);
        }
        for (size_t i = (size_t)gw * 64 + lane; i < (size_t)512 * DM / 8; i += (size_t)NGW * 64) {
            const f32x4 a = ((const GAS f32x4*)MEMIN)[2 * i], c = ((const GAS f32x4*)MEMIN)[2 * i + 1];
            ((GAS v4u*)MEM16)[i] = (v4u){pk2(a.x, a.y), pk2(a.z, a.w), pk2(c.x, c.y), pk2(c.z, c.w)};
        }
    }
    SEAM(0);
    REP(1) if (IN(1)) { REPBAR(); WSP_DECL;
        pg8::Gemm g{(const bf16*)X8, (const bf16*)WUP1q, T, NUP, DM / 2}; pg8::StaticOrder S; S.init(T, NUP, G, bx);
        pg8::EpiSwigluI8 E{G8, FF, SX1, GQ1, QS + 1};
        pg8::gemm_phase<pg8::EpiSwigluI8, pg8::StaticOrder, true, true, true>(L + RING_OFF, g, S, E);
    }
    SEAM(1);
    REP(2) if (IN(2)) { REPBAR(); WSP_DECL;
        pg8::Gemm g{(const bf16*)G8, (const bf16*)WDN1q, T, DM, FF / 2}; pg8::StaticOrder S; S.init(T, DM, G, bx);
        pg8::EpiResI8<false> E{R, XIN, DM, ALPHA, 0.5f, SG1, QS + 4};
        pg8::gemm_phase<pg8::EpiResI8<false>, pg8::StaticOrder, true, true, true>(L + RING_OFF, g, S, E);
    }
    SEAM(2);
    REP(3) if (IN(3)) { REPBAR(); WSP_DECL; for (int m = gw; m < T; m += NGW) ln_row<true, true>(R + (size_t)m * DM, ap->in[4], ap->in[5], H1 + (size_t)m * DM, lane, H1q + (size_t)m * DM, SXH + m, DQ0 + m, DQ1 + m, 0.f); }
    SEAM(3);
    REP(4) if (IN(4)) { REPBAR(); WSP_DECL;
        { pg8::Gemm g{H1, WIN, T, NZB, DM}; pg8::OrderZ S; S.so.init(T, NZB, G, bx);
          pg8::EpiZ E{QI16, KI16, KM, WI};
          pg8::gemm_phase<pg8::EpiZ, pg8::OrderZ, true, true>(L + RING_OFF, g, S, E); }
        { pg8::Gemm g{(const bf16*)H1q, (const bf16*)WINq, T, NZQ, DM / 2}; pg8::StaticOrder S; S.init(T, NZQ, G, bx);
          pg8::EpiZq E{Q16, U16, ap->in[7], SXH, QS + 17};
          pg8::gemm_phase<pg8::EpiZq, pg8::StaticOrder, true, true, true>(L + RING_OFF, g, S, E); }
    }
    SEAM(4);
    REP(5) if (IN(5)) { REPBAR(); WSP_DECL;
        for (int pp = vcu; pp < 256; pp += G) {
            const int b = pp >> 7, p = pp & 127;
#pragma unroll 1
            for (int k2 = 0; k2 < 2; ++k2) indexer_unit(L + RING_OFF, b, k2 ? 255 - p : p, QI16, KI16, WI, MASKQ);
        }
        __syncthreads();
    }
    SEAM(5);
    REP(6) if (IN(6)) { REPBAR(); WSP_DECL;
        const int xcd = bx & 7, ix = bx >> 3;
        if (ix < 32) {
            const int bh = xcd * 2 + (ix >> 4), qb = ix & 15, b = bh >> 3, hh = bh & 7;
            const size_t rowbase = (size_t)b * SEQ;
            const float ah = exp2f(-(float)(hh + 1)) * 11.313708498984761f;
            att::attn_block<1024, 2048, true>((const att::bf16*)(Q16 + (rowbase + qb * 256) * 1024 + hh * 128), (const att::bf16*)(K16 + rowbase * 1024 + hh * 128),
                                        (const att::bf16*)(V16 + rowbase * 1024 + hh * 128), (att::bf16*)(A16 + (rowbase + qb * 256) * 2048 + hh * 128),
                                        4 * (qb + 1), qb * 256, MASKQ + rowbase * 128, ah, (char*)lds + RING_OFF);
            if (qb < 8) { const int mi = bh * 8 + qb;
                const int mb = mi >> 6, mh = (mi >> 4) & 3, mq = mi & 15; const size_t mrow = (size_t)mb * SEQ + mq * 256;
                att::attn_block<512, 2048, false>((const att::bf16*)(QM16 + mrow * 512 + mh * 128), (const att::bf16*)(KM + (size_t)mb * MEMLEN * 512 + mh * 128),
                                            (const att::bf16*)(VM + (size_t)mb * MEMLEN * 512 + mh * 128), (att::bf16*)(M16 + mrow * 2048 + mh * 128),
                                            MEMLEN / 64, 0, nullptr, 0.f, (char*)lds + RING_OFF); }
            if (qb < 4) { for (int task = (bh * 4 + qb) * NWAVES + wave; task < 1024; task += 512) pool_task(task, U16, WPT, ap->in[10], P16, lane); }
        }
        {
            constexpr int I_UP = (DM / 64) * (NUP / 32), I_DN = (FF / 64) * (DM / 32), I_BA = (1024 / 64) * (DM / 32), I_BP = (512 / 64) * (DM / 32), I_OUT = (DM / 64) * (DM / 32);
            constexpr int NQI = I_BA + 2 * I_BP + I_OUT + I_UP + I_DN;
            LAS float* scr = (LAS float*)(L + RING_OFF + wave * 8448);
            const float qu2 = QS[8], qd2 = QS[11];
            unsigned* qctr = (unsigned*)(wsp + 8192);
            for (;;) {
                unsigned it0 = 0u;
                if (lane == 0) it0 = __hip_atomic_fetch_add(qctr, 4u, __ATOMIC_RELAXED, __HIP_MEMORY_SCOPE_AGENT);
                it0 = (unsigned)__builtin_amdgcn_readfirstlane((int)it0);
                if (it0 >= (unsigned)NQI) break;
                for (int k = 0; k < 4; ++k) { int r = (int)it0 + k; if (r >= NQI) break;
                    if (r < I_BA) { p0_transpose_item<0>(ap->in[11], 1024, DM, DM, WBA, scr, r, lane, DM); continue; } r -= I_BA;
                    if (r < I_BP) { p0_transpose_item<0>(ap->in[12], 512, DM, DM, WBA + 1024, scr, r, lane, DM); continue; } r -= I_BP;
                    if (r < I_BP) { p0_transpose_item<0>(ap->in[13], 512, DM, DM, WBA + 1536, scr, r, lane, DM); continue; } r -= I_BP;
                    if (r < I_OUT) { p0_transpose_item<0>(ap->in[14], DM, DM, DM, WOUT, scr, r, lane); continue; } r -= I_OUT;
                    if (r < I_UP) p0_transpose_item_i8<1>(ap->in[17], DM, NUP, NUP, WUP2q, scr, r, lane, qu2);
                    else p0_transpose_item_i8<0>(ap->in[18], FF, DM, DM, WDN2q, scr, r - I_UP, lane, qd2); }
            }
        }
    }
    SEAM(6);
    REP(7) if (IN(7)) { REPBAR(); WSP_DECL;
        pg8::StaticOrder S; S.init(T, DM, G, bx);
        { pg8::Gemm g{A16, WBA, T, DM, DM}; pg8::OrderBr SB; SB.so = S; pg8::EpiBranch E{Y16, GATE}; pg8::gemm_phase<pg8::EpiBranch, pg8::OrderBr, true, true>(L + RING_OFF, g, SB, E); }
    }
    SEAM(7);
    REP(8) if (IN(8)) { REPBAR(); WSP_DECL;
        pg8::Gemm g{Y16, WOUT, T, DM, DM}; pg8::StaticOrder S; S.init(T, DM, G, bx);
        pg8::EpiRes<true> E{R, H1, DM, ALPHA, 1.0f};
        pg8::gemm_phase<pg8::EpiRes<true>, pg8::StaticOrder, true, true>(L + RING_OFF, g, S, E);
    }
    SEAM(8);
    REP(9) if (IN(9)) { REPBAR(); WSP_DECL; const float sig2 = QS[10]; for (int m = gw; m < T; m += NGW) ln_row<true, true>(R + (size_t)m * DM, ap->in[15], ap->in[16], H2 + (size_t)m * DM, lane, H2q + (size_t)m * DM, SX2 + m, GQ2 + m, SG2 + m, sig2); }
    SEAM(9);
    REP(10) if (IN(10)) { REPBAR(); WSP_DECL;
        pg8::Gemm g{(const bf16*)H2q, (const bf16*)WUP2q, T, NUP, DM / 2}; pg8::StaticOrder S; S.init(T, NUP, G, bx);
        pg8::EpiSwigluI8 E{G28, FF, SX2, GQ2, QS + 9};
        pg8::gemm_phase<pg8::EpiSwigluI8, pg8::StaticOrder, true, true, true>(L + RING_OFF, g, S, E);
    }
    SEAM(10);
    REP(11) if (IN(11)) { REPBAR(); WSP_DECL;
        pg8::Gemm g{(const bf16*)G28, (const bf16*)WDN2q, T, DM, FF / 2}; pg8::StaticOrder S; S.init(T, DM, G, bx);
        pg8::EpiResI8<true> E{R, H2, DM, ALPHA, 0.5f, SG2, QS + 12};
        pg8::gemm_phase<pg8::EpiResI8<true>, pg8::StaticOrder, true, true, true>(L + RING_OFF, g, S, E);
    }
    SEAM(11);
    REP(12) if (IN(12)) { REPBAR(); WSP_DECL; for (int m = gw; m < T; m += NGW) ln_row<false>(R + (size_t)m * DM, ap->in[19], ap->in[20], R + (size_t)m * DM, lane); }
#undef BIG
#undef X16
#undef WUP1
#undef WDN1
#undef Gb
#undef Q16
#undef K16
#undef V16
#undef QI16
#undef KI16
#undef WI
#undef U16
#undef QM16
#undef GATE
#undef WIN
#undef WMKV
#undef WBA
#undef WBP
#undef WBM
#undef WOUT
#undef WUP2
#undef WDN2
#undef WPT
#undef H1
#undef MEM16
#undef A16
#undef P16
#undef M16
#undef H2
#undef Y16
#undef KM
#undef VM
#undef MASKQ
#undef X8
#undef WUP1q
#undef WDN1q
#undef G8
#undef WUP2q
#undef WDN2q
#undef H2q
#undef G28
#undef QS
#undef SX1
#undef GQ1
#undef SG1
#undef SX2
#undef GQ2
#undef SG2
#undef SXH
#undef DQ0
#undef DQ1
#undef H1q
#undef WINq
#undef R
#undef XIN
#undef MEMIN
#undef WSP_DECL
#undef IN
#undef SEAM
}

extern "C" void kernel_launch(void* const* d_in, const int* in_sizes, int n_in, void* d_out, int out_size, void* d_ws, size_t ws_size, hipStream_t stream) {
    static int grid = 0;
    if (grid == 0) {
        if (n_in != 21 || in_sizes[0] != T * DM || out_size != T * DM || ws_size < WS_END) {
            fprintf(stderr, "kernel_launch: shape/workspace mismatch (n_in %d, in0 %d, out %d, ws %zu, need %zu); nothing launched\n", n_in, n_in > 0 ? in_sizes[0] : -1, out_size, ws_size, (size_t)WS_END);
            grid = -1; return; }
        int dev = 0, cus = 0;
        if (hipGetDevice(&dev) != hipSuccess || hipDeviceGetAttribute(&cus, hipDeviceAttributeMultiprocessorCount, dev) != hipSuccess) { grid = -1; return; }
        if (hipFuncSetAttribute((const void*)mk_fwd, hipFuncAttributeMaxDynamicSharedMemorySize, LDS_BYTES) != hipSuccess) { fprintf(stderr, "kernel_launch: hipFuncSetAttribute failed\n"); grid = -1; return; }
        (void)hipGetLastError();
        grid = cus;
        if (grid != 256) fprintf(stderr, "kernel_launch: %d CUs (built for 256)\n", grid);
    }
    if (grid < 0) return;
    if (hipMemsetAsync((char*)d_ws + WS_CTL, 0, CTL_ZERO_BYTES, stream) != hipSuccess) return;
    Args a{};
    for (int i = 0; i < 21; ++i) a.in[i] = (const float*)d_in[i];
    a.out = (float*)d_out; a.ws = (unsigned char*)d_ws;
#if MK_PER_PHASE
    for (int p = 0; p < N_PHASES; ++p) { a.ph_lo = p; a.ph_hi = p + 1; hipLaunchKernelGGL(mk_fwd, dim3(grid), dim3(NWAVES * 64), LDS_BYTES, stream, a); }
#else
    a.ph_lo = 0; a.ph_hi = N_PHASES;
    hipLaunchKernelGGL(mk_fwd, dim3(grid), dim3(NWAVES * 64), LDS_BYTES, stream, a);
#endif
}
```
